# Optimizing an MI355X kernel written in HIP

```python
import jax, jax.numpy as jnp
from jax import lax
import numpy as np

D_MODEL = 1024
BATCH = 2
SEQ = 16384
DEPTH = 4

GRID_W = 64
N_META = 16
HEAD_DIM = 64
N_Q_HEADS = D_MODEL // HEAD_DIM
N_KV_HEADS = 4
GROUP = N_Q_HEADS // N_KV_HEADS
QKV_WIDTH = (N_Q_HEADS + 2 * N_KV_HEADS) * HEAD_DIM
Q_BLOCK = 128
ROPE_AXIS = HEAD_DIM // 2
ROPE_THETA = 10000.0
D_RNN = D_MODEL
N_RG_BLOCKS = 4
RG_BW = D_RNN // N_RG_BLOCKS
CONV_W = 4
CONV_LEFT = 2
RG_C = 8.0
D_FF = 2816
N_ATTN = (DEPTH + 1) // 2
N_REC = DEPTH // 2
NORM_EPS = 1e-6

kernel_name = "hybrid_gqa_rglru_macaron_encoder"


def rms_norm(x, g):
    xf = x.astype(jnp.float32)
    y = xf * lax.rsqrt(jnp.mean(xf * xf, axis=-1, keepdims=True) + NORM_EPS)
    return (y * g.astype(jnp.float32)).astype(x.dtype)


def swiglu(x, w_in, w_out):
    h = x @ w_in
    return (jax.nn.silu(h[..., :D_FF]) * h[..., D_FF:]) @ w_out


def axial_rope_tables(n_tok):
    rows = n_tok // GRID_W
    row = jnp.repeat(jnp.arange(rows, dtype=jnp.float32), GRID_W)
    col = jnp.tile(jnp.arange(GRID_W, dtype=jnp.float32), rows)
    zeros = jnp.zeros((N_META,), jnp.float32)
    row = jnp.concatenate([zeros, row])
    col = jnp.concatenate([zeros, col])
    inv = 1.0 / (ROPE_THETA ** (jnp.arange(0, ROPE_AXIS, 2, dtype=jnp.float32) / ROPE_AXIS))
    theta = jnp.concatenate([row[:, None] * inv, col[:, None] * inv], axis=-1)
    return jnp.cos(theta), jnp.sin(theta)


def apply_rope(x, cos, sin):
    shape = (1, cos.shape[0]) + (1,) * (x.ndim - 3) + (ROPE_AXIS,)
    c = cos.reshape(shape).astype(x.dtype)
    s = sin.reshape(shape).astype(x.dtype)
    x1, x2 = x[..., :ROPE_AXIS], x[..., ROPE_AXIS:]
    return jnp.concatenate([x1 * c - x2 * s, x1 * s + x2 * c], axis=-1)


def attention_mixer(x, w_qkv, q_gain, k_gain, w_o, cos, sin):
    B, L, _ = x.shape
    qkv = x @ w_qkv
    q = qkv[..., :N_Q_HEADS * HEAD_DIM].reshape(B, L, N_KV_HEADS, GROUP, HEAD_DIM)
    k = qkv[..., N_Q_HEADS * HEAD_DIM:(N_Q_HEADS + N_KV_HEADS) * HEAD_DIM].reshape(B, L, N_KV_HEADS, HEAD_DIM)
    v = qkv[..., (N_Q_HEADS + N_KV_HEADS) * HEAD_DIM:].reshape(B, L, N_KV_HEADS, HEAD_DIM)
    q = apply_rope(rms_norm(q, q_gain), cos, sin) * (HEAD_DIM ** -0.5)
    k = apply_rope(rms_norm(k, k_gain), cos, sin)

    def attend(qb):
        s = jnp.einsum('bqhgd,bkhd->bhgqk', qb, k).astype(jnp.float32)
        p = jax.nn.softmax(s, axis=-1).astype(v.dtype)
        return jnp.einsum('bhgqk,bkhd->bqhgd', p, v)

    o_meta = attend(q[:, :N_META])
    n_real = L - N_META
    n_blk = n_real // Q_BLOCK
    qr = q[:, N_META:].reshape(B, n_blk, Q_BLOCK, N_KV_HEADS, GROUP, HEAD_DIM).swapaxes(0, 1)
    o_real = lax.map(attend, qr).swapaxes(0, 1).reshape(B, n_real, N_KV_HEADS, GROUP, HEAD_DIM)
    o = jnp.concatenate([o_meta, o_real], axis=1).reshape(B, L, N_Q_HEADS * HEAD_DIM)
    return o @ w_o


def _lin_combine(left, right):
    a1, b1 = left
    a2, b2 = right
    return a1 * a2, a2 * b1 + b2


def recurrent_mixer(x, w_in, conv_w, conv_b, gate_w, gate_b, lam, w_out):
    B, L, _ = x.shape
    u = x @ w_in
    gate = jax.nn.gelu(u[..., :D_RNN])
    xr = u[..., D_RNN:]
    xp = jnp.pad(xr, ((0, 0), (CONV_LEFT, CONV_W - 1 - CONV_LEFT), (0, 0)))
    xc = conv_b + sum(xp[:, j:j + L] * conv_w[j] for j in range(CONV_W))
    xb = xc.reshape(B, L, N_RG_BLOCKS, RG_BW)
    g = jnp.einsum('blhi,dghij->dgblhj', xb, gate_w).reshape(2, 2, B, L, D_RNN)
    g = jax.nn.sigmoid((g + gate_b[:, :, None, None, :]).astype(jnp.float32))
    r, i = g[:, 0], g[:, 1]
    log_a = -RG_C * r * jax.nn.softplus(-lam.astype(jnp.float32))[:, None, None, :]
    a = jnp.exp(log_a)
    b = jnp.sqrt(-jnp.expm1(2.0 * log_a)) * i * xc.astype(jnp.float32)[None]
    _, h_f = lax.associative_scan(_lin_combine, (a[0], b[0]), axis=1)
    _, h_b = lax.associative_scan(_lin_combine, (a[1], b[1]), axis=1, reverse=True)
    y = (h_f + h_b).astype(x.dtype) * gate
    return y @ w_out


def setup_inputs(seed: int = 0) -> dict:
    key = jax.random.key(seed)
    ks = jax.random.split(key, 20)
    nrm = lambda k, shape, fan_in: jax.random.normal(k, shape, jnp.float32) * (fan_in ** -0.5)
    a0 = jax.random.uniform(ks[14], (N_REC, 2, D_RNN), jnp.float32, 0.9, 0.999)
    return {
        "x": jax.random.normal(ks[0], (BATCH, SEQ, D_MODEL), jnp.float32),
        "meta_tokens": jax.random.normal(ks[1], (N_META, D_MODEL), jnp.float32),
        "norm_gains": 1.0 + 0.05 * jax.random.normal(ks[2], (DEPTH, 6, D_MODEL), jnp.float32),
        "ffn_w_in": nrm(ks[3], (DEPTH, 2, D_MODEL, 2 * D_FF), D_MODEL),
        "ffn_w_out": nrm(ks[4], (DEPTH, 2, D_FF, D_MODEL), D_FF),
        "attn_w_qkv": nrm(ks[5], (N_ATTN, D_MODEL, QKV_WIDTH), D_MODEL),
        "attn_q_gain": 1.0 + 0.05 * jax.random.normal(ks[6], (N_ATTN, HEAD_DIM), jnp.float32),
        "attn_k_gain": 1.0 + 0.05 * jax.random.normal(ks[7], (N_ATTN, HEAD_DIM), jnp.float32),
        "attn_w_o": nrm(ks[8], (N_ATTN, N_Q_HEADS * HEAD_DIM, D_MODEL), N_Q_HEADS * HEAD_DIM),
        "rec_w_in": nrm(ks[9], (N_REC, D_MODEL, 2 * D_RNN), D_MODEL),
        "rec_conv_w": nrm(ks[10], (N_REC, CONV_W, D_RNN), CONV_W),
        "rec_conv_b": 0.01 * jax.random.normal(ks[11], (N_REC, D_RNN), jnp.float32),
        "rec_gate_w": nrm(ks[12], (N_REC, 2, 2, N_RG_BLOCKS, RG_BW, RG_BW), RG_BW),
        "rec_gate_b": 0.01 * jax.random.normal(ks[13], (N_REC, 2, 2, D_RNN), jnp.float32),
        "rec_lambda": jnp.log(a0) - jnp.log1p(-a0),
        "rec_w_out": nrm(ks[15], (N_REC, D_RNN, D_MODEL), D_RNN),
    }


def reference(x, meta_tokens, norm_gains, ffn_w_in, ffn_w_out, attn_w_qkv, attn_q_gain,
              attn_k_gain, attn_w_o, rec_w_in, rec_conv_w, rec_conv_b, rec_gate_w,
              rec_gate_b, rec_lambda, rec_w_out):
    B, n_tok, _ = x.shape
    h = jnp.concatenate([jnp.broadcast_to(meta_tokens.astype(x.dtype)[None], (B, N_META, D_MODEL)), x], axis=1)
    cos, sin = axial_rope_tables(n_tok)
    for layer in range(DEPTH):
        g = norm_gains[layer]
        h = h + 0.5 * rms_norm(swiglu(rms_norm(h, g[0]), ffn_w_in[layer, 0], ffn_w_out[layer, 0]), g[1])
        hn = rms_norm(h, g[2])
        if layer % 2 == 0:
            j = layer // 2
            m = attention_mixer(hn, attn_w_qkv[j], attn_q_gain[j], attn_k_gain[j], attn_w_o[j], cos, sin)
        else:
            j = layer // 2
            m = recurrent_mixer(hn, rec_w_in[j], rec_conv_w[j], rec_conv_b[j], rec_gate_w[j],
                                rec_gate_b[j], rec_lambda[j], rec_w_out[j])
        h = h + rms_norm(m, g[3])
        h = h + 0.5 * rms_norm(swiglu(rms_norm(h, g[4]), ffn_w_in[layer, 1], ffn_w_out[layer, 1]), g[5])
    return h[:, N_META:]
```

```cpp
#include <hip/hip_runtime.h>
#include <hip/hip_cooperative_groups.h>
#include <cstdio>
#include <cstdint>
namespace cg = cooperative_groups;

constexpr int NREAL = 32768, NROWS = 32800, ROWS_ALLOC = 33280;
constexpr int DMODEL = 1024, DFF = 2816, LSEQ_ = 16384, NCHUNK = 257;
constexpr float NORM_EPS = 1e-6f;
constexpr float LOG2E = 1.4426950408889634f;

namespace pg8 {

#define PG8_LAS __attribute__((address_space(3)))
typedef unsigned short bf16_t;
typedef short bf16x8 __attribute__((ext_vector_type(8)));
typedef float f32x4 __attribute__((ext_vector_type(4)));
typedef unsigned u32x4 __attribute__((ext_vector_type(4)));
constexpr int BM = 256, BK = 64, HALF = 128, HTB = HALF * BK * 2  , STAGE_BYTES = 8 * HTB, NXCD = 8, WGM = 8;

__host__ __device__ __forceinline__ int lds_byte(int r, int c) { const int st = (r >> 4) * 2 + (c >> 5), rr = r & 15, cc = c & 31, ob = rr * 64 + cc * 2; return st * 1024 + (ob ^ (((ob >> 9) & 1) << 5)); }
__host__ __device__ __forceinline__ void stage_rc(int b, int& R, int& C) { const int st = b / 1024, sb = b % 1024, swz = sb ^ (((sb >> 9) & 1) << 5); R = (st >> 1) * 16 + swz / 64; C = (st & 1) * 32 + (swz % 64) / 2; }
__host__ __device__ __forceinline__ int perm32(int rho) { const int n = rho >> 4, i = rho & 15; return 8 * (i >> 2) + 4 * n + (i & 3); }

struct Unit { int pm, pn; };
struct Gemm { const bf16_t* A; const bf16_t* Bt; int lda, ldb, K, akmode; };

struct StaticOrder {
    int nM, nN, nwg, G, c;
    __host__ __device__ void init(int M, int N, int G_, int c_) { nM = M / BM; nN = N / BM; nwg = nM * nN; G = G_; c = c_; }
    __host__ __device__ bool next(int i, Unit& u) const {
        const long L = (long)i * G + c; if (L >= nwg) return false;
        int wgid = (int)L; { const int q = nwg / NXCD, r = nwg % NXCD, xcd = wgid % NXCD, off = wgid / NXCD; wgid = (xcd < r ? xcd * (q + 1) : r * (q + 1) + (xcd - r) * q) + off; }
        const int nig = WGM * nN, gid = wgid / nig, fm = gid * WGM, gsz = (nM - fm) < WGM ? (nM - fm) : WGM;
        u.pm = fm + ((wgid % nig) % gsz); u.pn = (wgid % nig) / gsz; return true;
    }
    __device__ __forceinline__ void a_ready(const Unit&) const {}
    __device__ __forceinline__ void done(const Unit&) const {}
};


__device__ __forceinline__ unsigned cvt_pk_bf16(float lo, float hi) { unsigned r; asm volatile("v_cvt_pk_bf16_f32 %0, %1, %2" : "=v"(r) : "v"(lo), "v"(hi)); return r; }
__device__ __forceinline__ float sigm(float x) { return __builtin_amdgcn_rcpf(1.f + __builtin_amdgcn_exp2f(-1.4426950408889634f * x)); }
__device__ __forceinline__ float gelu_tanh(float x) { const float z = 0.7978845608028654f * (x + 0.044715f * x * x * x); return x * sigm(2.f * z); }
__device__ __forceinline__ float bf2f(unsigned short b) { return __uint_as_float((unsigned)b << 16); }
__device__ __forceinline__ u32x4 pack8(const f32x4 a, const f32x4 b) { u32x4 w; w.x = cvt_pk_bf16(a[0], a[1]); w.y = cvt_pk_bf16(a[2], a[3]); w.z = cvt_pk_bf16(b[0], b[1]); w.w = cvt_pk_bf16(b[2], b[3]); return w; }

struct EpiSwiGLU {
    static constexpr bool PERM = true, AFTER_DRAIN = false;
    bf16_t* O;
    __device__ __forceinline__ void operator()(const f32x4 (&acc)[2][2][4][2], const Unit& u, int wr, int wc, int fr_in, int fq) const {
        int fr = fr_in; asm volatile("" : "+v"(fr));
        const int row0 = u.pm * BM + wr * 64 + fr, col0 = u.pn * 128 + wc * 32 + 8 * fq;
#pragma unroll
        for (int ai = 0; ai < 2; ++ai)
#pragma unroll
            for (int m = 0; m < 4; ++m) {
                f32x4 v[2];
#pragma unroll
                for (int n = 0; n < 2; ++n)
#pragma unroll
                    for (int j = 0; j < 4; ++j) { const float gt = acc[ai][0][m][n][j]; v[n][j] = gt * sigm(gt) * acc[ai][1][m][n][j]; }
                *(u32x4*)((char*)O + ((unsigned)(row0 + ai * HALF + m * 16) * 2816u + (unsigned)col0) * 2u) = pack8(v[0], v[1]);
            }
    }
};
struct EpiPlain {
    static constexpr bool PERM = true, AFTER_DRAIN = false;
    bf16_t* O;
    __device__ __forceinline__ void operator()(const f32x4 (&acc)[2][2][4][2], const Unit& u, int wr, int wc, int fr_in, int fq) const {
        int fr = fr_in; asm volatile("" : "+v"(fr));
        const int row0 = u.pm * BM + wr * 64 + fr, col0 = u.pn * BM + wc * 32 + 8 * fq;
#pragma unroll
        for (int ai = 0; ai < 2; ++ai)
#pragma unroll
            for (int m = 0; m < 4; ++m)
#pragma unroll
                for (int bj = 0; bj < 2; ++bj)
                    *(u32x4*)((char*)O + ((unsigned)(row0 + ai * HALF + m * 16) * 1024u + (unsigned)(col0 + bj * HALF)) * 2u) = pack8(acc[ai][bj][m][0], acc[ai][bj][m][1]);
    }
};
struct EpiRecIn {
    static constexpr bool PERM = true, AFTER_DRAIN = false;
    bf16_t* G; bf16_t* X;
    __device__ __forceinline__ void operator()(const f32x4 (&acc)[2][2][4][2], const Unit& u, int wr, int wc, int fr_in, int fq) const {
        int fr = fr_in; asm volatile("" : "+v"(fr));
        const int row0 = u.pm * BM + wr * 64 + fr, col0 = (u.pn & 3) * BM + wc * 32 + 8 * fq; const bool isg = u.pn < 4; bf16_t* O = isg ? G : X;
#pragma unroll
        for (int ai = 0; ai < 2; ++ai)
#pragma unroll
            for (int m = 0; m < 4; ++m)
#pragma unroll
                for (int bj = 0; bj < 2; ++bj) {
                    f32x4 v0 = acc[ai][bj][m][0], v1 = acc[ai][bj][m][1];
                    if (isg) {
#pragma unroll
                        for (int j = 0; j < 4; ++j) { v0[j] = gelu_tanh(v0[j]); v1[j] = gelu_tanh(v1[j]); } }
                    *(u32x4*)((char*)O + ((unsigned)(row0 + ai * HALF + m * 16) * 1024u + (unsigned)(col0 + bj * HALF)) * 2u) = pack8(v0, v1);
                }
    }
};
struct EpiQKV {
    static constexpr bool PERM = true, AFTER_DRAIN = false;
    bf16_t *Q, *K, *V; const float *qg, *kg, *cs, *sn; float c2;
    __device__ __forceinline__ void operator()(const f32x4 (&acc)[2][2][4][2], const Unit& u, int wr, int wc, int fr_in, int fq) const {
        int fr = fr_in; asm volatile("" : "+v"(fr));
        const int row0 = u.pm * BM + wr * 64 + fr, pn = u.pn;
        if (pn == 5) {
#pragma unroll
            for (int ai = 0; ai < 2; ++ai)
#pragma unroll
                for (int m = 0; m < 4; ++m)
#pragma unroll
                    for (int bj = 0; bj < 2; ++bj)
                        *(u32x4*)((char*)V + ((unsigned)(row0 + ai * HALF + m * 16) * 256u + (unsigned)(wc * 64 + bj * 32 + 8 * fq)) * 2u) = pack8(acc[ai][bj][m][0], acc[ai][bj][m][1]);
            return;
        }
        const bool isq = pn < 4; const float* gp = isq ? qg : kg; const float sc = isq ? c2 : 1.f;
        bf16_t* O = isq ? Q : K; const int pitch = isq ? 1024 : 256; const int hc = (isq ? (4 * pn + wc) : wc) * 64 + 8 * fq;
#pragma unroll
        for (int ai = 0; ai < 2; ++ai)
#pragma unroll
            for (int m = 0; m < 4; ++m) {
                const int row = row0 + ai * HALF + m * 16;
                float ss = 0.f;
#pragma unroll
                for (int bj = 0; bj < 2; ++bj)
#pragma unroll
                    for (int n = 0; n < 2; ++n) { const f32x4 x = acc[ai][bj][m][n]; ss += (x[0] * x[0] + x[1] * x[1]) + (x[2] * x[2] + x[3] * x[3]); }
                ss += __shfl_xor(ss, 16); ss += __shfl_xor(ss, 32);
                const float rms = __builtin_amdgcn_rsqf(ss * (1.f / 64.f) + 1e-6f);
                const int s = row & 16383;
                f32x4 o1[2], o2[2];
#pragma unroll
                for (int n = 0; n < 2; ++n) {
                    const unsigned to = ((unsigned)s * 32u + (unsigned)(8 * fq + 4 * n)) * 4u; const f32x4 c = *(const f32x4*)((const char*)cs + to), sn4 = *(const f32x4*)((const char*)sn + to);
                    const f32x4 g1 = *(const f32x4*)(gp + 8 * fq + 4 * n), g2 = *(const f32x4*)(gp + 32 + 8 * fq + 4 * n);
                    const f32x4 x1 = acc[ai][0][m][n] * rms * g1, x2 = acc[ai][1][m][n] * rms * g2;
                    o1[n] = (x1 * c - x2 * sn4) * sc; o2[n] = (x1 * sn4 + x2 * c) * sc;
                }
                bf16_t* p = (bf16_t*)((char*)O + ((unsigned)row * (unsigned)pitch + (unsigned)hc) * 2u);
                *(u32x4*)(p) = pack8(o1[0], o1[1]); *(u32x4*)(p + 32) = pack8(o2[0], o2[1]);                asm volatile("" ::: "memory");
            }
    }
};
struct EpiGate {
    static constexpr bool PERM = true, AFTER_DRAIN = false;
    unsigned* AB;
    __device__ __forceinline__ void operator()(const f32x4 (&acc)[2][2][4][2], const Unit& u, int wr, int wc, int fr_in, int fq) const {
        int fr = fr_in; asm volatile("" : "+v"(fr));
        const int row0 = u.pm * BM + wr * 64 + fr, pn = u.pn, d = pn >> 3, ch0 = ((pn >> 1) & 3) * 256 + (pn & 1) * 128 + wc * 32 + 8 * fq;
        unsigned* ab = AB + (size_t)d * NROWS * 1024;
#pragma unroll
        for (int n = 0; n < 2; ++n) {
#pragma unroll
            for (int ai = 0; ai < 2; ++ai)
#pragma unroll
                for (int m = 0; m < 4; ++m) {
                    const int row = row0 + ai * HALF + m * 16;
                    u32x4 w;
#pragma unroll
                    for (int j = 0; j < 4; ++j) w[j] = cvt_pk_bf16(acc[ai][0][m][n][j], acc[ai][1][m][n][j]);
                    *(u32x4*)((char*)ab + ((unsigned)row * 1024u + (unsigned)(ch0 + 4 * n)) * 4u) = w;
                }
        }
    }
};
template <class Epi, class Sched, bool ALIGN_EPI = false, bool SP2 = false>
__device__ __forceinline__ void gemm_phase(PG8_LAS unsigned char* lds, const Gemm g, const Sched& S, const Epi& E) {
    int tid_ = threadIdx.x; asm volatile("" : "+v"(tid_)); const int tid = tid_, wid = __builtin_amdgcn_readfirstlane(tid >> 6), lane = tid & 63, wr = wid >> 2, wc = wid & 3, fr = lane & 15, fq = lane >> 4;
    const int K = g.K, nt = K / BK;
    unsigned voffA[2], voffB[2];
#pragma unroll
    for (int i = 0; i < 2; ++i) { int R, C; stage_rc(tid * 16 + i * 8192, R, C); const int Rb = Epi::PERM ? ((R & ~31) + perm32(R & 31)) : R;
        voffA[i] = (unsigned)(R * g.lda + C) * 2u; voffB[i] = (unsigned)(Rb * g.ldb + C) * 2u; }
    const size_t kstep = (size_t)(BK * 2);
    const size_t hstepA = (size_t)HALF * g.lda * 2, hstepB = (size_t)HALF * g.ldb * 2;
    const size_t tstepA = 2 * hstepA, tstepB = 2 * hstepB;
    const unsigned ldsw = (unsigned)wid * 1024u;
    const int aoff = lds_byte(wr * 64 + fr, fq * 8), boff = lds_byte(wc * 32 + fr, fq * 8);
#define AKOFF(pn) ((size_t)(g.akmode ? ((size_t)(((pn) >> 1) & 3) * ((size_t)33280 * 512)) : 0))
#define PG8_SA(b, h) (((b) * 2 + (h)) * HTB)
#define PG8_SB(b, h) ((4 + (b) * 2 + (h)) * HTB)
#define PG8_STAGE(bufoff, gbase, voff) do { _Pragma("unroll") for (int _i = 0; _i < 2; ++_i) \
        __builtin_amdgcn_global_load_lds((const unsigned*)((const char*)(gbase) + (voff)[_i]), (PG8_LAS unsigned*)(lds + (bufoff) + ldsw + _i * 8192), 16, 0, 0); } while (0)
#define PG8_LDA(dst, b, h) do { _Pragma("unroll") for (int m = 0; m < 4; ++m) _Pragma("unroll") for (int k = 0; k < 2; ++k) dst[m][k] = *(const PG8_LAS bf16x8*)(lds + PG8_SA(b, h) + aoff + m * 2048 + k * 1024); } while (0)
#define PG8_LDB(dst, b, h) do { _Pragma("unroll") for (int n = 0; n < 2; ++n) _Pragma("unroll") for (int k = 0; k < 2; ++k) dst[n][k] = *(const PG8_LAS bf16x8*)(lds + PG8_SB(b, h) + boff + n * 2048 + k * 1024); } while (0)
#define PG8_MMA(ai, bj, At, Bt) do { __builtin_amdgcn_s_setprio(1); _Pragma("unroll") for (int m = 0; m < 4; ++m) _Pragma("unroll") for (int n = 0; n < 2; ++n) _Pragma("unroll") for (int k = 0; k < 2; ++k) \
        acc[ai][bj][m][n] = __builtin_amdgcn_mfma_f32_16x16x32_bf16(Bt[n][k], At[m][k], acc[ai][bj][m][n], 0, 0, 0); __builtin_amdgcn_s_setprio(0); } while (0)
#define PG8_WAIT_V(n) asm volatile("s_waitcnt vmcnt(" #n ")" ::: "memory")
#define PG8_WAIT_L(n) asm volatile("s_waitcnt lgkmcnt(" #n ")" ::: "memory")
#define PG8_BAR __builtin_amdgcn_s_barrier()
#define PG8_SCHED __builtin_amdgcn_sched_barrier(0)
    Unit cur, nxt; int ui = 0;
    if (!S.next(0, cur)) return;
    f32x4 acc[2][2][4][2];
#pragma unroll
    for (int a = 0; a < 2; ++a)
#pragma unroll
        for (int b = 0; b < 2; ++b)
#pragma unroll
            for (int m = 0; m < 4; ++m)
#pragma unroll
                for (int n = 0; n < 2; ++n) acc[a][b][m][n] = (f32x4){0.f, 0.f, 0.f, 0.f};
    bf16x8 At[4][2], B0[2][2], B1[2][2];
    const char* cA = (const char*)g.A + (size_t)cur.pm * tstepA + AKOFF(cur.pn); const char* cB = (const char*)g.Bt + (size_t)cur.pn * tstepB;
    S.a_ready(cur);
    if constexpr (SP2) {
        PG8_STAGE(PG8_SB(0, 0), cB, voffB); PG8_STAGE(PG8_SB(0, 1), cB + hstepB, voffB); PG8_STAGE(PG8_SA(0, 0), cA, voffA); PG8_STAGE(PG8_SA(0, 1), cA + hstepA, voffA);
        if (wr == 1) PG8_BAR;
        PG8_WAIT_V(2); PG8_BAR;
        PG8_STAGE(PG8_SB(1, 0), cB + kstep, voffB); PG8_STAGE(PG8_SA(1, 0), cA + kstep, voffA); PG8_STAGE(PG8_SB(1, 1), cB + hstepB + kstep, voffB);
        PG8_WAIT_V(6); PG8_BAR;
    } else {
        PG8_STAGE(PG8_SB(0, 0), cB, voffB); PG8_STAGE(PG8_SA(0, 0), cA, voffA); PG8_STAGE(PG8_SB(0, 1), cB + hstepB, voffB); PG8_STAGE(PG8_SA(0, 1), cA + hstepA, voffA);
        if (wr == 1) PG8_BAR;
        PG8_WAIT_V(4); PG8_BAR;
        PG8_STAGE(PG8_SB(1, 0), cB + kstep, voffB); PG8_STAGE(PG8_SA(1, 0), cA + kstep, voffA); PG8_STAGE(PG8_SB(1, 1), cB + hstepB + kstep, voffB);
        PG8_WAIT_V(6); PG8_BAR;
    }
    for (;;) {
        const bool has_next = S.next(ui + 1, nxt);
        const char* nA = has_next ? (const char*)g.A + (size_t)nxt.pm * tstepA + AKOFF(nxt.pn) : cA; const char* nB = has_next ? (const char*)g.Bt + (size_t)nxt.pn * tstepB : cB;
        _Pragma("unroll 1") for (int t = 0; t < nt; t += 2) {
            const bool last = (t == nt - 2);
            const char* a1 = cA + (size_t)(t + 1) * kstep;
            const char* a2 = last ? nA : cA + (size_t)(t + 2) * kstep; const char* b2 = last ? nB : cB + (size_t)(t + 2) * kstep;
            const char* a3 = a2 + kstep; const char* b3 = b2 + kstep;
            if (last && has_next) S.a_ready(nxt);
            if constexpr (SP2) {
            PG8_LDB(B0, 0, 0); PG8_LDB(B1, 0, 1); PG8_SCHED; PG8_LDA(At, 0, 0); PG8_STAGE(PG8_SA(1, 1), a1 + hstepA, voffA);
            PG8_WAIT_V(8); PG8_WAIT_L(0); PG8_BAR; PG8_MMA(0, 0, At, B0); PG8_MMA(0, 1, At, B1); PG8_BAR; PG8_SCHED;
            PG8_LDA(At, 0, 1); PG8_STAGE(PG8_SB(0, 0), b2, voffB); PG8_STAGE(PG8_SB(0, 1), b2 + hstepB, voffB); PG8_STAGE(PG8_SA(0, 0), a2, voffA);
            PG8_WAIT_V(8); PG8_WAIT_L(0); PG8_BAR; PG8_MMA(1, 0, At, B0); PG8_MMA(1, 1, At, B1); PG8_BAR; PG8_SCHED;
            PG8_LDB(B0, 1, 0); PG8_LDB(B1, 1, 1); PG8_SCHED; PG8_LDA(At, 1, 0); PG8_STAGE(PG8_SA(0, 1), a2 + hstepA, voffA);
            PG8_WAIT_V(8); PG8_WAIT_L(0); PG8_BAR; PG8_MMA(0, 0, At, B0); PG8_MMA(0, 1, At, B1); PG8_BAR; PG8_SCHED;
            PG8_LDA(At, 1, 1); PG8_STAGE(PG8_SB(1, 0), b3, voffB); PG8_STAGE(PG8_SB(1, 1), b3 + hstepB, voffB); PG8_STAGE(PG8_SA(1, 0), a3, voffA);
            PG8_WAIT_V(8); PG8_WAIT_L(0); PG8_BAR; PG8_MMA(1, 0, At, B0); PG8_MMA(1, 1, At, B1); PG8_BAR; PG8_SCHED;
            } else {
            PG8_LDB(B0, 0, 0); PG8_SCHED; PG8_LDA(At, 0, 0); PG8_STAGE(PG8_SA(1, 1), a1 + hstepA, voffA);
            PG8_WAIT_L(8); PG8_BAR; PG8_WAIT_L(0); PG8_MMA(0, 0, At, B0); PG8_BAR; PG8_SCHED;
            PG8_LDB(B1, 0, 1); PG8_STAGE(PG8_SB(0, 0), b2, voffB);
            PG8_BAR; PG8_WAIT_L(0); PG8_MMA(0, 1, At, B1); PG8_BAR;
            PG8_LDA(At, 0, 1); PG8_STAGE(PG8_SA(0, 0), a2, voffA);
            PG8_BAR; PG8_WAIT_L(0); PG8_MMA(1, 0, At, B0); PG8_BAR; PG8_SCHED;
            PG8_STAGE(PG8_SB(0, 1), b2 + hstepB, voffB);
            PG8_WAIT_V(6); PG8_BAR; PG8_MMA(1, 1, At, B1); PG8_BAR;
            PG8_LDB(B0, 1, 0); PG8_SCHED; PG8_LDA(At, 1, 0); PG8_STAGE(PG8_SA(0, 1), a2 + hstepA, voffA);
            PG8_WAIT_L(8); PG8_BAR; PG8_WAIT_L(0); PG8_MMA(0, 0, At, B0); PG8_BAR; PG8_SCHED;
            PG8_LDB(B1, 1, 1); PG8_STAGE(PG8_SB(1, 0), b3, voffB);
            PG8_BAR; PG8_WAIT_L(0); PG8_MMA(0, 1, At, B1); PG8_BAR;
            PG8_LDA(At, 1, 1); PG8_STAGE(PG8_SA(1, 0), a3, voffA);
            PG8_BAR; PG8_WAIT_L(0); PG8_MMA(1, 0, At, B0); PG8_BAR; PG8_SCHED;
            PG8_STAGE(PG8_SB(1, 1), b3 + hstepB, voffB);
            PG8_WAIT_V(6); PG8_BAR; PG8_MMA(1, 1, At, B1); PG8_BAR;
            }
        }
        if constexpr (ALIGN_EPI) { if (wr == 0) PG8_BAR; }
        if constexpr (!Epi::AFTER_DRAIN) { E(acc, cur, wr, wc, fr, fq); S.done(cur); }
        if (!has_next) break;
#pragma unroll
        for (int a = 0; a < 2; ++a)
#pragma unroll
            for (int b = 0; b < 2; ++b)
#pragma unroll
                for (int m = 0; m < 4; ++m)
#pragma unroll
                    for (int n = 0; n < 2; ++n) acc[a][b][m][n] = (f32x4){0.f, 0.f, 0.f, 0.f};
        cur = nxt; cA = nA; cB = nB; ++ui;
        if constexpr (ALIGN_EPI) { if (wr == 1) PG8_BAR; }
    }
    PG8_WAIT_V(0);
    if constexpr (!ALIGN_EPI) { if (wr == 0) PG8_BAR; }
    PG8_BAR;
    if constexpr (Epi::AFTER_DRAIN) { E.fused(acc, cur, wr, wc, fr, fq, lds, wid, lane); S.done(cur); }
#undef AKOFF
#undef PG8_SA
#undef PG8_SB
#undef PG8_STAGE
#undef PG8_LDA
#undef PG8_LDB
#undef PG8_MMA
#undef PG8_WAIT_V
#undef PG8_WAIT_L
#undef PG8_BAR
#undef PG8_SCHED
}
}

#ifndef PG8_SP2
#define PG8_SP2 true
#endif
#ifndef PG8_ALIGN
#define PG8_ALIGN true
#endif

#include <hip/hip_bf16.h>
#include <cmath>
namespace attn_body {
using bf16=__hip_bfloat16;
using bf16x8=__attribute__((ext_vector_type(8)))short;
using s16x4=__attribute__((ext_vector_type(4)))short;
using f32x16=__attribute__((ext_vector_type(16)))float;
using u32x4=__attribute__((ext_vector_type(4)))unsigned;
constexpr int D=64,QP=1024,KP=256,LSEQ=16384,NREALR=32768;
constexpr int NW=8,QBLK=32,QB=QBLK*NW,KVBLK=64;

__device__ __forceinline__ int crow(int r,int hi){return (r&3)+8*(r>>2)+4*hi;}
#define SBAR() __builtin_amdgcn_sched_barrier(0)
__device__ __forceinline__ void cmask(f32x16&p0,f32x16&p1,int jb,int qrel,int hi){
  const float NEG=-INFINITY; int kb=64*jb+4*hi;
  #pragma unroll
  for(int r=0;r<16;++r){int kv=kb+(r&3)+8*(r>>2); if(kv>qrel)p0[r]=NEG; if(kv+32>qrel)p1[r]=NEG;}
}

constexpr int NSLOT=3, SLOTB=8192;
constexpr int LDS_K=0, LDS_V=NSLOT*SLOTB, LDS_WS=2*NSLOT*SLOTB, LDS_OST=LDS_WS+NW*64*4, LDS_BYTES=LDS_OST+NW*4096;
constexpr float C2=0.125f*1.4426950408889634f;
__device__ __forceinline__ void glds16(const void*gsrc,unsigned lds_dst){unsigned keep;
  asm volatile("s_mov_b32 %0, m0\n\ts_mov_b32 m0, %2\n\ts_nop 0\n\tglobal_load_lds_dwordx4 %1, off\n\ts_mov_b32 m0, %0":"=&s"(keep):"v"(gsrc),"s"(lds_dst):"memory");}
__device__ __forceinline__ float max3f(float a,float b,float c){float r;asm("v_max3_f32 %0, %1, %2, %3":"=v"(r):"v"(a),"v"(b),"v"(c));return r;}
__device__ __forceinline__ float max2f(float a,float b){float r;asm("v_max_f32_e32 %0, %1, %2":"=v"(r):"v"(a),"v"(b));return r;}
__device__ __forceinline__ float fadd_s(float a,float b){float r;asm("v_add_f32_e32 %0, %1, %2":"=v"(r):"v"(a),"v"(b));return r;}
__device__ __forceinline__ float fsub_s(float a,float b){float r;asm("v_sub_f32_e32 %0, %1, %2":"=v"(r):"v"(a),"v"(b));return r;}
typedef float f32x2_t __attribute__((ext_vector_type(2))); typedef __bf16 bf16x2_t __attribute__((ext_vector_type(2)));
__device__ __forceinline__ unsigned cvtpk_s(float lo,float hi){f32x2_t v={lo,hi};bf16x2_t b=__builtin_convertvector(v,bf16x2_t);return __builtin_bit_cast(unsigned,b);}
#define WAIT_BAR(N) asm volatile("s_waitcnt vmcnt(" #N ") lgkmcnt(0)\n\ts_barrier":::"memory")

__device__ __forceinline__ void qkt(f32x16&p0,f32x16&p1,const char*Kslot,const bf16x8*qr,const f32x16&negm,int r32,int hi){
  const char*kb=Kslot+hi*1024+r32*16;
  #pragma unroll
  for(int d0=0;d0<4;++d0){
    const bf16x8 b0=*reinterpret_cast<const bf16x8*>(kb+d0*2048);
    const bf16x8 b1=*reinterpret_cast<const bf16x8*>(kb+d0*2048+512);
    if(d0==0){p0=__builtin_amdgcn_mfma_f32_32x32x16_bf16(b0,qr[0],negm,0,0,0);p1=__builtin_amdgcn_mfma_f32_32x32x16_bf16(b1,qr[0],negm,0,0,0);}
    else{p0=__builtin_amdgcn_mfma_f32_32x32x16_bf16(b0,qr[d0],p0,0,0,0);p1=__builtin_amdgcn_mfma_f32_32x32x16_bf16(b1,qr[d0],p1,0,0,0);}}
}
typedef __attribute__((address_space(3))) const char* lds_cptr;
typedef short v4i16_t __attribute__((ext_vector_type(4)));
__device__ __forceinline__ void kload8(bf16x8*kf,lds_cptr kp){
  kf[0]=*(const __attribute__((address_space(3))) bf16x8*)(kp);      kf[1]=*(const __attribute__((address_space(3))) bf16x8*)(kp+512);
  kf[2]=*(const __attribute__((address_space(3))) bf16x8*)(kp+2048); kf[3]=*(const __attribute__((address_space(3))) bf16x8*)(kp+2560);
  kf[4]=*(const __attribute__((address_space(3))) bf16x8*)(kp+4096); kf[5]=*(const __attribute__((address_space(3))) bf16x8*)(kp+4608);
  kf[6]=*(const __attribute__((address_space(3))) bf16x8*)(kp+6144); kf[7]=*(const __attribute__((address_space(3))) bf16x8*)(kp+6656);
}
__device__ __forceinline__ void kload2(bf16x8*kf,lds_cptr kp,int j){ kf[2*j]=*(const __attribute__((address_space(3))) bf16x8*)(kp+j*2048); kf[2*j+1]=*(const __attribute__((address_space(3))) bf16x8*)(kp+j*2048+512); }
__device__ __forceinline__ s16x4 vtr(lds_cptr p){ return __builtin_bit_cast(s16x4,__builtin_amdgcn_ds_read_tr16_b64_v4i16((__attribute__((address_space(3))) v4i16_t*)p)); }
__device__ __forceinline__ float rowmax(const f32x16&p0,const f32x16&p1){
  float a=max3f(p0[0],p0[1],p1[0]),b=max3f(p0[2],p0[3],p1[1]);a=max3f(a,p1[2],p1[3]);
  #pragma unroll
  for(int r=4;r<16;r+=4){a=max3f(a,p0[r],p0[r+1]);b=max3f(b,p0[r+2],p0[r+3]);a=max3f(a,p1[r],p1[r+1]);b=max3f(b,p1[r+2],p1[r+3]);}
  const float m=max2f(a,b);
  auto rr=__builtin_amdgcn_permlane32_swap(__float_as_uint(m),__float_as_uint(m),false,false);
  return max2f(__uint_as_float(rr[0]),__uint_as_float(rr[1]));
}
__device__ __forceinline__ void pv(f32x16*o,int vb,bf16x8 pa0,bf16x8 pa1,bf16x8 pa2,bf16x8 pa3){
  #pragma unroll
  for(int d0=0;d0<2;++d0){s16x4 lo[4],hi[4];
    #pragma unroll
    for(int ks=0;ks<4;++ks){
      asm volatile("ds_read_b64_tr_b16 %0,%1 offset:%c2":"=&v"(lo[ks]):"v"(vb),"i"(d0*4096+ks*1024):"memory");
      asm volatile("ds_read_b64_tr_b16 %0,%1 offset:%c2":"=&v"(hi[ks]):"v"(vb),"i"(d0*4096+ks*1024+512):"memory");}
    asm volatile("s_waitcnt lgkmcnt(0)":::"memory");SBAR();
    #define PK(k) (bf16x8){lo[k][0],lo[k][1],lo[k][2],lo[k][3],hi[k][0],hi[k][1],hi[k][2],hi[k][3]}
    o[d0]=__builtin_amdgcn_mfma_f32_32x32x16_bf16(pa0,PK(0),o[d0],0,0,0);
    o[d0]=__builtin_amdgcn_mfma_f32_32x32x16_bf16(pa1,PK(1),o[d0],0,0,0);
    o[d0]=__builtin_amdgcn_mfma_f32_32x32x16_bf16(pa2,PK(2),o[d0],0,0,0);
    o[d0]=__builtin_amdgcn_mfma_f32_32x32x16_bf16(pa3,PK(3),o[d0],0,0,0);
    #undef PK
  }
}

#ifndef ATTN_STORE16
#define ATTN_STORE16(p,v) (*(u32x4*)(p)=(v))
#endif
template<int THRL> __device__ __forceinline__ void attn_unit(int b,int h,long qrow0,int nvalid,const bf16*Q,const bf16*__restrict__ K,const bf16*__restrict__ V,bf16*O,char*shm){
  int tid_=threadIdx.x; asm volatile("":"+v"(tid_)); const int tid=tid_,lane=tid&63,r32=lane&31,hi=lane>>5; const int wid=__builtin_amdgcn_readfirstlane(tid>>6);
  const long rowbase=(long)b*LSEQ; const long metaoff=((long)(NREALR+b*16)-rowbase)*KP;
  const bf16*Qw=Q+(qrow0+wid*QBLK)*QP+h*D;
  const bf16*Kh=K+rowbase*KP+(h>>2)*D,*Vh=V+rowbase*KP+(h>>2)*D;
  const unsigned lds0=(unsigned)(uintptr_t)shm;
  float*wsf=(float*)(shm+LDS_WS)+wid*64;
  const bf16*ksrc=Kh+(long)lane*KP+wid*8;
  const bf16*vsrc=Vh+(long)(16*(wid&3)+(lane>>2))*KP+(wid>>2)*32+(lane&3)*8;
  const unsigned kdst=lds0+LDS_K+wid*1024, vdst=lds0+LDS_V+wid*1024;
  #define TOFF(tt) (((tt)<256)?(long)(tt)*KVBLK*KP:metaoff)
  #define DMA_K(t,slot) glds16(ksrc+TOFF(t),(unsigned)__builtin_amdgcn_readfirstlane(kdst+(slot)))
  #define DMA_V(t,slot) glds16(vsrc+TOFF(t),(unsigned)__builtin_amdgcn_readfirstlane(vdst+(slot)))
  const int vb0=(int)(lds0+LDS_V)+((lane>>4)&1)*32+(lane&3)*8+(4*hi+((lane&15)>>2))*64;
  const char*Kbase=shm+LDS_K; bf16x8 kf[8];
  const lds_cptr shm3=(lds_cptr)shm; const lds_cptr kp0=shm3+LDS_K+hi*1024+r32*16; const lds_cptr vp0=shm3+LDS_V+((lane>>4)&1)*32+(lane&3)*8+(4*hi+((lane&15)>>2))*64;
  constexpr int NT=257;
  DMA_K(0,0);DMA_V(0,0);DMA_K(1,SLOTB);
  bf16x8 qr[4];
  #pragma unroll
  for(int d0=0;d0<4;++d0)qr[d0]=*reinterpret_cast<const bf16x8*>(&Qw[(long)r32*QP+d0*16+hi*8]);
  float mhat=0.f,l_reg=0.f;f32x16 o[2];o[0]=f32x16{};o[1]=f32x16{};f32x16 negm=f32x16{};asm volatile("":"+v"(negm));
    #define CMASK(P0,P1,t) do{}while(0)
  bool resc=false;
  #define START(P0,P1) do{ const float rm=rowmax(P0,P1); resc=false; \
    { const float dl=rm; mhat=fadd_s(mhat,dl); \
      _Pragma("unroll") for(int r=0;r<16;++r){P0[r]=fsub_s(P0[r],dl);P1[r]=fsub_s(P1[r],dl);} \
      _Pragma("unroll") for(int r=0;r<16;++r)negm[r]=-mhat; asm volatile("":"+v"(negm)); } \
    _Pragma("unroll") for(int r=0;r<16;++r)P0[r]=__builtin_amdgcn_exp2f(P0[r]); }while(0)
  #define RESC() do{ if(resc){ asm volatile("s_waitcnt lgkmcnt(0)":::"memory"); \
      _Pragma("unroll") for(int d_=0;d_<2;++d_) _Pragma("unroll") for(int r=0;r<16;++r)o[d_][r]*=wsf[crow(r,hi)]; } }while(0)
  f32x16 pA0,pA1,pB0,pB1;
  int sl_prev=0,sl_cur=0,sl_next=SLOTB;
  #define ROT() do{sl_prev=sl_cur;sl_cur=sl_next;sl_next=(sl_next==(NSLOT-1)*SLOTB)?0:sl_next+SLOTB;}while(0)
  DMA_K(2,2*SLOTB);
  WAIT_BAR(3);
  qkt(pA0,pA1,Kbase,qr,negm,r32,hi);asm volatile("s_nop 15\n\ts_nop 7":"+v"(pA0),"+v"(pA1));CMASK(pA0,pA1,0);
  START(pA0,pA1);
  _Pragma("unroll") for(int r=0;r<16;++r)pA1[r]=__builtin_amdgcn_exp2f(pA1[r]);
  WAIT_BAR(0);
  DMA_K(3,0);DMA_V(1,SLOTB);
  ROT();
  kload8(kf,kp0+sl_cur);
  WAIT_BAR(2);
  s16x4 vlo[8],vhi[8]; u32x4 pw0,pw1,pw2,pw3;
  #define PKW(P,B) cvtpk_s(P[B],P[B+1])
  #define PAF(k) __builtin_bit_cast(bf16x8,pw##k)
  #define VFR(i) (bf16x8){vlo[i][0],vlo[i][1],vlo[i][2],vlo[i][3],vhi[i][0],vhi[i][1],vhi[i][2],vhi[i][3]}
  #define PIN(x) asm volatile("":"+v"(x))
  #define MX3(a,b,c) __builtin_fmaxf(__builtin_fmaxf((a),(b)),(c))
  #define GAPA(MF,A0,A1,A2,A3,W0,W1,PW) do{ MF; sacc+=A0; sacc+=A1; sacc+=A2; sacc+=A3; PIN(sacc); W0; W1; PIN(PW); SBAR(); }while(0)
  #define EX(v) __builtin_amdgcn_exp2f(v)
  #define GAPB(MF,X,B) do{ MF; X[B]=EX(X[B]); X[B+1]=EX(X[B+1]); X[B+2]=EX(X[B+2]); X[B+3]=EX(X[B+3]); PIN(X); SBAR(); }while(0)
  #define VRD(i) do{ vlo[i]=vtr(vp_+(((i)>>2)*4096+((i)&3)*1024)); vhi[i]=vtr(vp_+(((i)>>2)*4096+((i)&3)*1024+512)); }while(0)
  #define KRD(G,j) do{ if(G){ kload2(kf,kp0+sl_next,j); SBAR(); } }while(0)
  #define STEP(C0,C1,P0,P1,t,GK,GV,GL) do{ SBAR(); \
    const lds_cptr vp_=vp0+sl_prev; \
    VRD(0); SBAR(); float sacc=(P0[0]+P0[1]); \
    GAPA(C0=__builtin_amdgcn_mfma_f32_32x32x16_bf16(kf[0],qr[0],negm,0,0,0), P0[2],P0[3],P0[4],P0[5],     pw0[0]=PKW(P0,0), pw0[1]=PKW(P0,2), pw0); \
    VRD(4); SBAR(); GAPA(C1=__builtin_amdgcn_mfma_f32_32x32x16_bf16(kf[1],qr[0],negm,0,0,0), P0[6],P0[7],P0[8],P0[9],     pw0[2]=PKW(P0,4), pw0[3]=PKW(P0,6), pw0); \
    VRD(1); SBAR(); GAPA(C0=__builtin_amdgcn_mfma_f32_32x32x16_bf16(kf[2],qr[1],C0,0,0,0),   P0[10],P0[11],P0[12],P0[13], pw1[0]=PKW(P0,8), pw1[1]=PKW(P0,10), pw1); \
    VRD(5); SBAR(); GAPA(C1=__builtin_amdgcn_mfma_f32_32x32x16_bf16(kf[3],qr[1],C1,0,0,0),   P0[14],P0[15],P1[0],P1[1],   pw1[2]=PKW(P0,12),pw1[3]=PKW(P0,14), pw1); \
    VRD(2); SBAR(); GAPA(C0=__builtin_amdgcn_mfma_f32_32x32x16_bf16(kf[4],qr[2],C0,0,0,0),   P1[2],P1[3],P1[4],P1[5],     pw2[0]=PKW(P1,0), pw2[1]=PKW(P1,2), pw2); \
    VRD(6); SBAR(); GAPA(C1=__builtin_amdgcn_mfma_f32_32x32x16_bf16(kf[5],qr[2],C1,0,0,0),   P1[6],P1[7],P1[8],P1[9],     pw2[2]=PKW(P1,4), pw2[3]=PKW(P1,6), pw2); \
    VRD(3); SBAR(); GAPA(C0=__builtin_amdgcn_mfma_f32_32x32x16_bf16(kf[6],qr[3],C0,0,0,0),   P1[10],P1[11],P1[12],P1[13], pw3[0]=PKW(P1,8), pw3[1]=PKW(P1,10), pw3); \
    VRD(7); SBAR(); GAPA(C1=__builtin_amdgcn_mfma_f32_32x32x16_bf16(kf[7],qr[3],C1,0,0,0),   P1[14],P1[15],0.f,0.f,       pw3[2]=PKW(P1,12),pw3[3]=PKW(P1,14), pw3); \
    l_reg+=sacc; \
    if(GK){DMA_K((t)+3,sl_cur);} if(GV){DMA_V((t)+1,sl_next);} \
    CMASK(C0,C1,t); \
    { float a=MX3(C0[0],C0[1],C1[0]),b=MX3(C0[2],C0[3],C1[1]); a=MX3(a,C1[2],C1[3]); \
      _Pragma("unroll") for(int r=4;r<16;r+=4){a=MX3(a,C0[r],C0[r+1]);b=MX3(b,C0[r+2],C0[r+3]);a=MX3(a,C1[r],C1[r+1]);b=MX3(b,C1[r+2],C1[r+3]);} \
      float rm=__builtin_fmaxf(a,b); { auto rr=__builtin_amdgcn_permlane32_swap(__float_as_uint(rm),__float_as_uint(rm),false,false); rm=__builtin_fmaxf(__uint_as_float(rr[0]),__uint_as_float(rr[1])); } \
      resc=false; \
      if(__builtin_expect(__any(rm>(float)THRL),0)){ const float dl=__builtin_fmaxf(rm,0.f); mhat+=dl; \
        _Pragma("unroll") for(int r=0;r<16;++r){C0[r]-=dl;C1[r]-=dl;} \
        _Pragma("unroll") for(int r=0;r<16;++r)negm[r]=-mhat; asm volatile("":"+v"(negm)); \
        const float f=__builtin_amdgcn_exp2f(-dl); l_reg*=f; if(hi==0)wsf[r32]=f; resc=true; } } \
    SBAR(); \
    GAPB(o[0]=__builtin_amdgcn_mfma_f32_32x32x16_bf16(PAF(0),VFR(0),o[0],0,0,0), C0,0); \
    GAPB(o[1]=__builtin_amdgcn_mfma_f32_32x32x16_bf16(PAF(0),VFR(4),o[1],0,0,0), C0,4); \
    KRD(GL,0); GAPB(o[0]=__builtin_amdgcn_mfma_f32_32x32x16_bf16(PAF(1),VFR(1),o[0],0,0,0), C0,8); \
    KRD(GL,1); GAPB(o[1]=__builtin_amdgcn_mfma_f32_32x32x16_bf16(PAF(1),VFR(5),o[1],0,0,0), C0,12); \
    KRD(GL,2); GAPB(o[0]=__builtin_amdgcn_mfma_f32_32x32x16_bf16(PAF(2),VFR(2),o[0],0,0,0), C1,0); \
    KRD(GL,3); GAPB(o[1]=__builtin_amdgcn_mfma_f32_32x32x16_bf16(PAF(2),VFR(6),o[1],0,0,0), C1,4); \
    GAPB(o[0]=__builtin_amdgcn_mfma_f32_32x32x16_bf16(PAF(3),VFR(3),o[0],0,0,0), C1,8); \
    GAPB(o[1]=__builtin_amdgcn_mfma_f32_32x32x16_bf16(PAF(3),VFR(7),o[1],0,0,0), C1,12); \
    }while(0)
  int t=1;
  #undef CMASK
  #define CMASK(P0,P1,t) do{}while(0)
  for(;t+5<NT;t+=2){
    STEP(pB0,pB1,pA0,pA1,t,true,true,true);     WAIT_BAR(2); RESC(); ROT();
    STEP(pA0,pA1,pB0,pB1,t+1,true,true,true);   WAIT_BAR(2); RESC(); ROT();
  }
  #undef CMASK
  #define CMASK(P0,P1,t) do{ if((t)==NT-1){ _Pragma("unroll") for(int r_=8;r_<16;++r_)P0[r_]=-INFINITY; _Pragma("unroll") for(int r_=0;r_<16;++r_)P1[r_]=-INFINITY; } }while(0)
  #define ENDW(tt) do{ if((tt)+3<NT){WAIT_BAR(2);} else if((tt)+2<NT){WAIT_BAR(1);} else {WAIT_BAR(0);} }while(0)
  for(;t+1<NT;t+=2){
    STEP(pB0,pB1,pA0,pA1,t,(t+3<NT),(t+1<NT),(t+1<NT));       ENDW(t);   RESC(); ROT();
    STEP(pA0,pA1,pB0,pB1,t+1,(t+4<NT),(t+2<NT),(t+2<NT));     ENDW(t+1); RESC(); ROT();
  }
  { float sacc=pA0[0]+pA0[1]; _Pragma("unroll") for(int r=2;r<16;++r)sacc+=pA0[r]; _Pragma("unroll") for(int r=0;r<16;++r)sacc+=pA1[r]; l_reg+=sacc;
    pw0=(u32x4){PKW(pA0,0),PKW(pA0,2),PKW(pA0,4),PKW(pA0,6)};pw1=(u32x4){PKW(pA0,8),PKW(pA0,10),PKW(pA0,12),PKW(pA0,14)};pw2=(u32x4){PKW(pA1,0),PKW(pA1,2),PKW(pA1,4),PKW(pA1,6)};pw3=(u32x4){PKW(pA1,8),PKW(pA1,10),PKW(pA1,12),PKW(pA1,14)};
    SBAR(); pv(o,vb0+sl_prev,PAF(0),PAF(1),PAF(2),PAF(3)); }
  #undef PKW
  #undef PAF
  #undef VFR
  #undef PIN
  #undef MX3
  #undef GAPA
  #undef GAPB
  #undef EX
  #undef VRD
  #undef KRD
  #undef STEP
  #undef ENDW
  {auto rr=__builtin_amdgcn_permlane32_swap(__float_as_uint(l_reg),__float_as_uint(l_reg),false,false);l_reg=__uint_as_float(rr[0])+__uint_as_float(rr[1]);}
  if(hi==0)wsf[32+r32]=l_reg;asm volatile("s_waitcnt lgkmcnt(0)":::"memory");
  float rli[16];
  #pragma unroll
  for(int r=0;r<16;++r)rli[r]=__builtin_amdgcn_rcpf(wsf[32+crow(r,hi)]);
  bf16*Ow=O+(qrow0+wid*QBLK)*QP+h*D; const int nv=nvalid-wid*QBLK;
  { bf16*stg=(bf16*)(shm+LDS_OST)+wid*2048;
    #pragma unroll
    for(int r=0;r<16;++r){const int orow=crow(r,hi);
      #pragma unroll
      for(int d0=0;d0<2;++d0)stg[orow*64+d0*32+r32]=__float2bfloat16(o[d0][r]*rli[r]);}
    asm volatile("s_waitcnt lgkmcnt(0)":::"memory");
    #pragma unroll
    for(int i=0;i<4;++i){const int row=i*8+(lane>>3),ch=lane&7; const u32x4 v=*(const u32x4*)(stg+row*64+ch*8); if(row<nv)ATTN_STORE16(Ow+(long)row*QP+ch*8,v);} }
  asm volatile("s_waitcnt lgkmcnt(0)\n\ts_barrier":::"memory");
  #undef TOFF
  #undef DMA_K
  #undef DMA_V
  #undef CMASK
  #undef START
  #undef RESC
  #undef ROT
}
constexpr int ATTN_LDS_BYTES=LDS_BYTES;
#undef SBAR
#undef WAIT_BAR
}


#ifndef PG8_SP2
#define PG8_SP2 true
#endif
#ifndef PG8_ALIGN
#define PG8_ALIGN true
#endif
#define LAS __attribute__((address_space(3)))
#ifndef PHM
#define PHM 0xffff
#endif
using pg8::bf16_t; using pg8::f32x4; using pg8::u32x4; using pg8::bf16x8;
typedef float f32x16_t __attribute__((ext_vector_type(16)));
typedef float f32x2_tt __attribute__((ext_vector_type(2)));
constexpr size_t MiB = 1u << 20;
constexpr size_t WS_COS = 1 * MiB, WS_SIN = 3 * MiB, WS_HMETA = 5 * MiB, WS_W = 8 * MiB, WS_XN = 168 * MiB, WS_Y = 234 * MiB, WS_R3 = 300 * MiB, WS_R1 = 366 * MiB,
                 WS_K = WS_R1 + 66 * MiB, WS_V = WS_R1 + 83 * MiB, WS_AGG = 624 * MiB, WS_CIN = 633 * MiB, WS_END = 640 * MiB;
constexpr size_t W_IN = 0, W_OUT = W_IN + (size_t)8 * 5632 * 1024, W_QKV = W_OUT + (size_t)8 * 1024 * 2816, W_O = W_QKV + (size_t)2 * 1536 * 1024,
                 W_RIN = W_O + (size_t)2 * 1024 * 1024, W_RG = W_RIN + (size_t)2 * 2048 * 1024, W_RO = W_RG + (size_t)2 * 4096 * 256, W_END = W_RO + (size_t)2 * 1024 * 1024;
static_assert(W_END * 2 <= 160 * MiB, "weights");
constexpr int LDS_BYTES = 147456;
constexpr float ATT_C2 = 0.125f * 1.4426950408889634f;

__device__ __forceinline__ float wave_sum(float v) {
#pragma unroll
    for (int o = 1; o < 64; o <<= 1) v += __shfl_xor(v, o);
    return v;
}
__device__ __forceinline__ unsigned f2bf(float f) { unsigned u = __builtin_bit_cast(unsigned, f); return (u + 0x7fffu + ((u >> 16) & 1u)) >> 16; }
__device__ __forceinline__ unsigned pk2(float lo, float hi) { return f2bf(lo) | (f2bf(hi) << 16); }
__device__ __forceinline__ float bf2f(unsigned b) { return __uint_as_float(b << 16); }

__device__ __forceinline__ void tr_item(const float* W, int K, int N, bf16_t* WT, int k0, int n0, int dest_row0, float* scr, int lane) {
#pragma unroll 8
    for (int i = 0; i < 32; ++i) { const int kk = 2 * i + (lane >> 5); scr[kk * 33 + (lane & 31)] = W[(size_t)(k0 + kk) * N + n0 + (lane & 31)]; }
    __builtin_amdgcn_s_waitcnt(0); asm volatile("" ::: "memory");
    const int c = lane & 7;
#pragma unroll
    for (int j = 0; j < 4; ++j) { const int n = (lane >> 3) + 8 * j; const float* s = scr + (8 * c) * 33 + n;
        u32x4 o; o.x = pk2(s[0 * 33], s[1 * 33]); o.y = pk2(s[2 * 33], s[3 * 33]); o.z = pk2(s[4 * 33], s[5 * 33]); o.w = pk2(s[6 * 33], s[7 * 33]);
        *(u32x4*)(WT + (size_t)(dest_row0 + n) * K + k0 + 8 * c) = o; }
    __builtin_amdgcn_s_waitcnt(0); asm volatile("" ::: "memory");
}

#define XB_TMO      128
#define XB_XCNT(j)  (256  + 64 * (j))
#define XB_XSUB(j)  (1280 + 64 * (j))
#define XB_XGEN(j)  (2304 + 64 * (j))
#define XB_TOP      3328
#define XB_TOPGEN   3392
#define XCD_BAR_WORDS 3456
#define XB_SPIN_CAP (1u << 18)

__device__ __forceinline__ unsigned xb_ld(unsigned* p)              { return __hip_atomic_load(p, __ATOMIC_RELAXED, __HIP_MEMORY_SCOPE_AGENT); }
__device__ __forceinline__ unsigned xb_add(unsigned* p, unsigned v) { return __hip_atomic_fetch_add(p, v, __ATOMIC_RELAXED, __HIP_MEMORY_SCOPE_AGENT); }
__device__ __forceinline__ unsigned xb_xcc_id() { return (unsigned)__builtin_amdgcn_s_getreg((3 << 11) | 20) & 0xFu; }
#define XB_SPIN(cond, bar) do { unsigned _sp = 0; while (cond) { __builtin_amdgcn_s_sleep(1); \
    if ((++_sp & 255u) == 0u) { if (xb_ld(&(bar)[XB_TMO])) break; if (_sp > XB_SPIN_CAP) { atomicAdd(&(bar)[XB_TMO], 1u); break; } } } } while (0)

struct XcdBarrier {
    unsigned* bar; unsigned x;
    volatile LAS unsigned* st;
};

__device__ __forceinline__ XcdBarrier xcd_barrier_post(unsigned* bar, volatile LAS unsigned* st) {
    XcdBarrier b; b.bar = bar; b.x = xb_xcc_id(); b.st = st;
    if (threadIdx.x == 0) (void)xb_add(&bar[XB_XCNT(b.x)], 1u);
    return b;
}
__device__ __forceinline__ void xcd_barrier_complete(unsigned* bar, unsigned x, unsigned& nloc, unsigned& nx) {
    const unsigned G = gridDim.x * gridDim.y * gridDim.z;
    unsigned sum, cnt, mine, sp = 0u;
    for (;;) {
        sum = 0u; cnt = 0u; mine = 0u;
#pragma unroll
        for (unsigned j = 0; j < 16; ++j) { const unsigned c = xb_ld(&bar[XB_XCNT(j)]); sum += c; cnt += (c > 0u) ? 1u : 0u; mine = (j == x) ? c : mine; }
        if (sum == G) break;
        __builtin_amdgcn_s_sleep(1);
        if ((++sp & 255u) == 0u) { if (xb_ld(&bar[XB_TMO])) break; if (sp > XB_SPIN_CAP) { atomicAdd(&bar[XB_TMO], 1u); break; } }
    }
    nloc = mine > 0u ? mine : 1u; nx = cnt > 0u ? cnt : 1u;
}

__device__ __forceinline__ void xcd_barrier(const XcdBarrier& b) {
    asm volatile("s_waitcnt vmcnt(0)" ::: "memory");
    __syncthreads();
    if (threadIdx.x == 0) {
        unsigned* bar = b.bar;
        __builtin_amdgcn_s_waitcnt(0);
        unsigned nloc = b.st[0], nx = b.st[1];
        if (nloc == 0u) { xcd_barrier_complete(bar, b.x, nloc, nx); b.st[0] = nloc; b.st[1] = nx; }
        const unsigned old = xb_add(&bar[XB_XSUB(b.x)], 1u);
        const unsigned gen = old / nloc;
        if (old + 1u == (gen + 1u) * nloc) {
            __builtin_amdgcn_fence(__ATOMIC_RELEASE, "agent");
            asm volatile("s_waitcnt vmcnt(0)" ::: "memory");
            const unsigned og = xb_add(&bar[XB_TOP], 1u);
            const unsigned tg = og / nx;
            if (og + 1u == (tg + 1u) * nx) xb_add(&bar[XB_TOPGEN], 1u);
            else XB_SPIN(xb_ld(&bar[XB_TOPGEN]) == tg, bar);
            __builtin_amdgcn_fence(__ATOMIC_ACQUIRE, "agent");
            xb_add(&bar[XB_XGEN(b.x)], 1u);
            asm volatile("s_waitcnt vmcnt(0)" ::: "memory");
        } else {
            XB_SPIN(xb_ld(&bar[XB_XGEN(b.x)]) == gen, bar);
            __builtin_amdgcn_fence(__ATOMIC_ACQUIRE, "agent");
            asm volatile("s_waitcnt vmcnt(0)" ::: "memory");
        }
    }
    __syncthreads();
}

struct Args { const float* in[16]; float* out; unsigned char* ws; };

__device__ __forceinline__ float* hrow_ptr(float* out, float* hmeta, int row) { return row < NREAL ? out + (size_t)row * 1024 : hmeta + (size_t)(row - NREAL) * 1024; }

__device__ __forceinline__ void norm_row_store(const f32x4 (&v)[4], const float* g, bf16_t* orow, int lane) {
    float s = 0.f;
#pragma unroll
    for (int j = 0; j < 4; ++j) s += (v[j].x * v[j].x + v[j].y * v[j].y) + (v[j].z * v[j].z + v[j].w * v[j].w);
    const float r = __builtin_amdgcn_rsqf(wave_sum(s) * (1.f / 1024.f) + NORM_EPS);
    unsigned long long* o8 = (unsigned long long*)orow + lane;
#pragma unroll
    for (int j = 0; j < 4; ++j) { const f32x4 gg = ((const f32x4*)g)[lane + 64 * j];
        o8[64 * j] = (unsigned long long)pk2(v[j].x * r * gg.x, v[j].y * r * gg.y) | ((unsigned long long)pk2(v[j].z * r * gg.z, v[j].w * r * gg.w) << 32); }
}

__device__ __forceinline__ int crow_(int r, int hi) { return (r & 3) + 8 * (r >> 2) + 4 * hi; }
__device__ __forceinline__ void thin_tile(float* T, float* part, const bf16_t* A, int lda, const bf16_t* B0, const bf16_t* B1, int ldb, int K, int wave, int lane, int tid) {
    const int r32 = lane & 31, hi = lane >> 5, kc = K >> 3, kbeg = wave * kc;
    const bf16_t* ap = A + (size_t)r32 * lda + kbeg + hi * 8;
    const bf16_t* b0p = B0 + (size_t)r32 * ldb + kbeg + hi * 8;
    const bf16_t* b1p = B1 + (size_t)r32 * ldb + kbeg + hi * 8;
    f32x16_t c0 = {}, c1 = {};
#pragma unroll 2
    for (int k = 0; k < kc; k += 16) {
        const bf16x8 a = *(const bf16x8*)(ap + k), b0 = *(const bf16x8*)(b0p + k), b1 = *(const bf16x8*)(b1p + k);
        c0 = __builtin_amdgcn_mfma_f32_32x32x16_bf16(a, b0, c0, 0, 0, 0);
        c1 = __builtin_amdgcn_mfma_f32_32x32x16_bf16(a, b1, c1, 0, 0, 0);
    }
#pragma unroll
    for (int r = 0; r < 16; ++r) { const int tok = crow_(r, hi); part[wave * 2048 + tok * 64 + r32] = c0[r]; part[wave * 2048 + tok * 64 + 32 + r32] = c1[r]; }
    __syncthreads();
    for (int i = tid; i < 2048; i += 512) { float s = 0.f;
#pragma unroll
        for (int w = 0; w < 8; ++w) s += part[w * 2048 + i];
        T[i] = s; }
    __syncthreads();
}
enum ThinKind { TK_SWIGLU = 0, TK_PLAIN = 1, TK_RECIN = 2, TK_QKV = 3, TK_GATE = 4 };
struct ThinP { const bf16_t* A; int lda; const bf16_t* Bt; int ldb; int K; int nunits;
               bf16_t* O0; bf16_t* O1; bf16_t* O2; unsigned* AB; const float* p0; const float* p1; };
template <int KIND> __device__ __forceinline__ void thin_phase(unsigned char* lds, const ThinP& P, int tid, int wave, int lane, int bid, int G) {
    float* part = (float*)lds; float* T = (float*)(lds + 65536);
    for (int u = bid; u < P.nunits; u += G) {
        int r0, r1, ak = 0;
        if (KIND == TK_SWIGLU) { const int c0 = 32 * u; r0 = (c0 >> 7) * 256 + (c0 & 127); r1 = r0 + 128; }
        else if (KIND == TK_PLAIN || KIND == TK_RECIN) { r0 = 64 * u; r1 = r0 + 32; }
        else if (KIND == TK_QKV) { r0 = (u >> 2) * 256 + 32 * (u & 3); r1 = r0 + 128; }
        else { const int d = u >> 5, h = (u >> 3) & 3, g32 = u & 7; r0 = (d * 8 + h * 2 + (g32 >> 2)) * 256 + (g32 & 3) * 32; r1 = r0 + 128; ak = h * (ROWS_ALLOC * 256); }
        thin_tile(T, part, P.A + (size_t)NREAL * P.lda + ak, P.lda, P.Bt + (size_t)r0 * P.ldb, P.Bt + (size_t)r1 * P.ldb, P.ldb, P.K, wave, lane, tid);
        if (KIND == TK_SWIGLU) {
            for (int idx = tid; idx < 1024; idx += 512) { const int r = idx >> 5, c = idx & 31; const float gt = T[r * 64 + c], up = T[r * 64 + 32 + c];
                P.O0[(size_t)(NREAL + r) * 2816 + 32 * u + c] = (bf16_t)f2bf(gt * pg8::sigm(gt) * up); }
        } else if (KIND == TK_PLAIN) {
            for (int idx = tid; idx < 2048; idx += 512) { const int r = idx >> 6, c = idx & 63; P.O0[(size_t)(NREAL + r) * 1024 + 64 * u + c] = (bf16_t)f2bf(T[idx]); }
        } else if (KIND == TK_RECIN) {
            for (int idx = tid; idx < 2048; idx += 512) { const int r = idx >> 6, c = idx & 63; const float v = T[idx];
                if (u < 16) P.O0[(size_t)(NREAL + r) * 1024 + 64 * u + c] = (bf16_t)f2bf(pg8::gelu_tanh(v));
                else P.O1[(size_t)(NREAL + r) * 1024 + 64 * (u - 16) + c] = (bf16_t)f2bf(v); }
        } else if (KIND == TK_QKV) {
            for (int idx = tid; idx < 2048; idx += 512) { const int r = idx >> 6, dd = idx & 63; const float v = T[idx];
                if (u < 20) { const float rms = __builtin_amdgcn_rsqf(wave_sum(v * v) * (1.f / 64.f) + NORM_EPS);
                    if (u < 16) P.O0[(size_t)(NREAL + r) * 1024 + 64 * u + dd] = (bf16_t)f2bf(v * rms * P.p0[dd] * ATT_C2);
                    else P.O1[(size_t)(NREAL + r) * 256 + 64 * (u - 16) + dd] = (bf16_t)f2bf(v * rms * P.p1[dd]); }
                else P.O2[(size_t)(NREAL + r) * 256 + 64 * (u - 20) + dd] = (bf16_t)f2bf(v); }
        } else {
            const int d = u >> 5, h = (u >> 3) & 3, g32 = u & 7, cb = h * 256 + g32 * 32;
            for (int idx = tid; idx < 1024; idx += 512) { const int r = idx >> 5, c = idx & 31, ch = cb + c;
                P.AB[((size_t)d * NROWS + NREAL + r) * 1024 + ch] = pk2(T[r * 64 + c], T[r * 64 + 32 + c]); }
        }
        __syncthreads();
    }
}

__device__ __forceinline__ int chunk_row0(int b, int j) { return j == 0 ? NREAL + b * 16 : b * 16384 + (j - 1) * 64; }
__device__ __forceinline__ void ab_from(unsigned w, float xc, float sp, float rb, float ib, float& a, float& b) {
    const float r = pg8::sigm(__uint_as_float(w << 16) + rb), ig = pg8::sigm(__uint_as_float(w & 0xffff0000u) + ib);
    a = __builtin_amdgcn_exp2f(sp * r); b = __builtin_amdgcn_sqrtf((1.f - a) * (1.f + a)) * ig * xc;
}
__device__ __forceinline__ float sp_of(float lam) { const float e = __builtin_amdgcn_exp2f(-LOG2E * lam); return -8.f * LOG2E * (0.6931471805599453f * __builtin_amdgcn_logf(1.f + e)); }
template <int LEN> __device__ __forceinline__ void scanA_item(const unsigned* ab, const bf16_t* xc, int dir, float sp, float rb, float ib, f32x2_tt* outp) {
    constexpr int BT = LEN < 32 ? LEN : 32;
    float h = 0.f, P = 1.f;
#pragma unroll 1
    for (int t0 = 0; t0 < LEN; t0 += BT) {
        unsigned w[BT]; unsigned short x[BT];
#pragma unroll
        for (int t = 0; t < BT; ++t) { const int tt = dir ? LEN - 1 - (t0 + t) : t0 + t; w[t] = ab[(size_t)tt * 1024]; x[t] = xc[(size_t)tt * 256]; }
#pragma unroll
        for (int t = 0; t < BT; ++t) { float a, b; ab_from(w[t], bf2f(x[t]), sp, rb, ib, a, b); h = a * h + b; P *= a; }
    }
    *outp = (f32x2_tt){P, h};
}
template <int LEN> __device__ __forceinline__ void scanC_item(const unsigned* abf, const unsigned* abb, const bf16_t* xc, const bf16_t* gate, bf16_t* y, float cf, float cb, float spf, float spb, float rbf, float ibf, float rbb, float ibb) {
    constexpr int BT = LEN < 32 ? LEN : 32;
    float hf[LEN]; float h = cf;
#pragma unroll
    for (int t0 = 0; t0 < LEN; t0 += BT) {
        unsigned w[BT]; unsigned short x[BT];
#pragma unroll
        for (int t = 0; t < BT; ++t) { w[t] = abf[(size_t)(t0 + t) * 1024]; x[t] = xc[(size_t)(t0 + t) * 256]; }
#pragma unroll
        for (int t = 0; t < BT; ++t) { float a, b; ab_from(w[t], bf2f(x[t]), spf, rbf, ibf, a, b); h = a * h + b; hf[t0 + t] = h; }
        asm volatile("" ::: "memory");
    }
    h = cb;
#pragma unroll
    for (int t0 = LEN - BT; t0 >= 0; t0 -= BT) {
        unsigned w[BT]; unsigned short x[BT], g[BT];
#pragma unroll
        for (int t = 0; t < BT; ++t) { w[t] = abb[(size_t)(t0 + t) * 1024]; x[t] = xc[(size_t)(t0 + t) * 256]; g[t] = gate[(size_t)(t0 + t) * 1024]; }
#pragma unroll
        for (int t = BT - 1; t >= 0; --t) { float a, b; ab_from(w[t], bf2f(x[t]), spb, rbb, ibb, a, b); h = a * h + b;
            y[(size_t)(t0 + t) * 1024] = (bf16_t)f2bf((hf[t0 + t] + h) * bf2f(g[t])); }
        asm volatile("" ::: "memory");
    }
}


typedef const __attribute__((address_space(4))) Args* KArgP;
#define KARGS() ({ KArgP p_ = (KArgP)__builtin_amdgcn_kernarg_segment_ptr(); asm volatile("" : "+s"(p_)); p_; })
#define GSYNC() do { KArgP apb_ = KARGS(); XcdBarrier b_; b_.bar = (unsigned*)(apb_->ws + 16384); b_.x = xb_xcc_id(); b_.st = (volatile LAS unsigned*)(ldsl + 131072 + 32); xcd_barrier(b_); } while (0)
#define WSP(T, off) ((T*)(ws + (off)))
#define IDS() int tid_ = threadIdx.x; asm volatile("" : "+v"(tid_)); const int tid = tid_, lane = tid & 63, wave = __builtin_amdgcn_readfirstlane(tid >> 6); const int G = gridDim.x, bid = blockIdx.x; \
              const int vcu = (G % 8 == 0) ? (bid % 8) * (G / 8) + bid / 8 : bid; const int gw = vcu * 8 + wave, NGW = G * 8; const int gtid = bid * 512 + tid, GT = G * 512; \
              (void)lane; (void)vcu; (void)gw; (void)NGW; (void)gtid; (void)GT;

__global__ void __launch_bounds__(512, 2) fwd_megakernel(Args args_unused) {
    extern __shared__ __attribute__((aligned(16))) unsigned char lds[];
    cg::grid_group grid = cg::this_grid();
    LAS unsigned char* ldsl = (LAS unsigned char*)lds;
    for (int u = threadIdx.x; u < 64; u += 512) ((LAS unsigned*)(ldsl + 131072))[u] = 0u;
    __syncthreads();
    { KArgP ap0 = KARGS(); (void)xcd_barrier_post((unsigned*)(ap0->ws + 16384), (volatile LAS unsigned*)(ldsl + 131072 + 32)); }
    grid.sync();

#if PHM & 1
    {
        KArgP ap = KARGS(); unsigned char* ws = ap->ws; IDS();
        float* scr = (float*)(lds + wave * 16384); bf16_t* Wb = WSP(bf16_t, WS_W);
#ifdef NANFILL
        {
            u32x4* f0 = (u32x4*)(ws + WS_Y); const size_t n16 = (WS_END - WS_Y) / 16; const u32x4 q = {0xffffffffu, 0xffffffffu, 0xffffffffu, 0xffffffffu};
            for (size_t i = gtid; i < n16; i += GT) f0[i] = q;
        }
#endif
        constexpr int IA = 8 * 2816, IB = 8 * 1408, IC = 2 * 768, ID = 2 * 512, IE = 2 * 1024, IF = 32 * 32, IG = 2 * 512, NIT = IA + IB + IC + ID + IE + IF + IG;
        for (int it = gw; it < NIT; it += NGW) {
            int r = it;
            if (r < IA) { const int mat = r / 2816, q = r % 2816, kb = q / 176, nb = q % 176, n0 = 32 * nb, bj = n0 / 2816, c = n0 % 2816;
                tr_item(ap->in[3] + (size_t)mat * 1024 * 5632, 1024, 5632, Wb + W_IN + (size_t)mat * 5632 * 1024, 64 * kb, n0, (c >> 7) * 256 + bj * 128 + (c & 127), scr, lane); continue; } r -= IA;
            if (r < IB) { const int mat = r / 1408, q = r % 1408, kb = q / 32, nb = q % 32;
                tr_item(ap->in[4] + (size_t)mat * 2816 * 1024, 2816, 1024, Wb + W_OUT + (size_t)mat * 1024 * 2816, 64 * kb, 32 * nb, 32 * nb, scr, lane); continue; } r -= IB;
            if (r < IC) { const int mat = r / 768, q = r % 768, kb = q / 48, nb = q % 48, n0 = 32 * nb, tile = n0 >> 8, rr = n0 & 255;
                tr_item(ap->in[5] + (size_t)mat * 1024 * 1536, 1024, 1536, Wb + W_QKV + (size_t)mat * 1536 * 1024, 64 * kb, n0, tile * 256 + 128 * ((rr & 63) >> 5) + 32 * (rr >> 6), scr, lane); continue; } r -= IC;
            if (r < ID) { const int mat = r / 512, q = r % 512, kb = q / 32, nb = q % 32;
                tr_item(ap->in[8] + (size_t)mat * 1024 * 1024, 1024, 1024, Wb + W_O + (size_t)mat * 1024 * 1024, 64 * kb, 32 * nb, 32 * nb, scr, lane); continue; } r -= ID;
            if (r < IE) { const int mat = r / 1024, q = r % 1024, kb = q / 64, nb = q % 64;
                tr_item(ap->in[9] + (size_t)mat * 1024 * 2048, 1024, 2048, Wb + W_RIN + (size_t)mat * 2048 * 1024, 64 * kb, 32 * nb, 32 * nb, scr, lane); continue; } r -= IE;
            if (r < IF) { const int sub = r >> 5, q = r & 31, kb = q >> 3, nb = q & 7, n0 = 32 * nb, jl = sub >> 4, d = (sub >> 3) & 1, g = (sub >> 2) & 1, h = sub & 3;
                tr_item(ap->in[12] + (size_t)sub * 256 * 256, 256, 256, Wb + W_RG + (size_t)jl * 4096 * 256, 64 * kb, n0, (d * 8 + h * 2 + (n0 >> 7)) * 256 + g * 128 + (n0 & 127), scr, lane); continue; } r -= IF;
            { const int mat = r / 512, q = r % 512, kb = q / 32, nb = q % 32;
                tr_item(ap->in[15] + (size_t)mat * 1024 * 1024, 1024, 1024, Wb + W_RO + (size_t)mat * 1024 * 1024, 64 * kb, 32 * nb, 32 * nb, scr, lane); }
        }
        float* tcos = WSP(float, WS_COS); float* tsin = WSP(float, WS_SIN);
        for (int idx = gtid; idx < 16384 * 32; idx += GT) { const int s = idx >> 5, j = idx & 31, jj = j & 15; const float pos = (float)(j < 16 ? (s >> 6) : (s & 63));
            const float inv = __builtin_amdgcn_exp2f(-(float)jj * (13.287712379549449f / 16.f)); const float th = pos * inv;
            const double turns = (double)th * 0.15915494309189535; const float fr = (float)(turns - __builtin_floor(turns));
            tcos[idx] = __builtin_amdgcn_cosf(fr); tsin[idx] = __builtin_amdgcn_sinf(fr); }
        float* out = ap->out; float* hmeta = WSP(float, WS_HMETA); bf16_t* XN = WSP(bf16_t, WS_XN); const float* gains = ap->in[2];
        for (int row = gw; row < NROWS; row += NGW) {
            const float* src = row < NREAL ? ap->in[0] + (size_t)row * 1024 : ap->in[1] + (size_t)((row - NREAL) & 15) * 1024;
            float* hr = hrow_ptr(out, hmeta, row); f32x4 v[4];
#pragma unroll
            for (int j = 0; j < 4; ++j) { v[j] = ((const f32x4*)src)[lane + 64 * j]; ((f32x4*)hr)[lane + 64 * j] = v[j]; }
            norm_row_store(v, gains, XN + (size_t)row * 1024, lane);
        }
    }
#endif
    GSYNC();

#pragma unroll 1
    for (int layer = 0; layer < 4; ++layer) {
#pragma unroll 1
        for (int stage = 0; stage < 3; ++stage) {
            const int jl = layer >> 1;
#ifdef TESTSKIP
            if (stage == 1 && ((TESTSKIP >> (layer & 1)) & 1)) continue;
#endif
            int oAsel, oK; size_t oBoff; float coef; int gpost_i, gpre_i;
            if (stage != 1) {
                const int f = stage >> 1;
                {
                    KArgP ap = KARGS(); unsigned char* ws = ap->ws; IDS();
                    const bf16_t* Win = WSP(bf16_t, WS_W) + W_IN + (size_t)(layer * 2 + f) * 5632 * 1024; bf16_t* XN = WSP(bf16_t, WS_XN); bf16_t* ACT = WSP(bf16_t, WS_R1);
#if PHM & 2
                    { pg8::Gemm g{XN, Win, 1024, 1024, 1024, 0}; pg8::StaticOrder S; S.init(NREAL, 5632, G, bid); pg8::EpiSwiGLU E{ACT};
                      pg8::gemm_phase<pg8::EpiSwiGLU, pg8::StaticOrder, PG8_ALIGN, PG8_SP2>(ldsl, g, S, E); }
#endif
#if PHM & 4
                    { ThinP P{XN, 1024, Win, 1024, 1024, 88, ACT, nullptr, nullptr, nullptr, nullptr, nullptr}; thin_phase<TK_SWIGLU>(lds, P, tid, wave, lane, bid, G); }
#endif
                }
                GSYNC();
                oAsel = 0; oK = 2816; oBoff = W_OUT + (size_t)(layer * 2 + f) * 1024 * 2816; coef = 0.5f; gpost_i = layer * 6 + (f ? 5 : 1);
                gpre_i = f ? (layer < 3 ? layer * 6 + 6 : -1) : layer * 6 + 2;
            } else if ((layer & 1) == 0) {
                {
                    KArgP ap = KARGS(); unsigned char* ws = ap->ws; IDS();
                    const bf16_t* Wqkv = WSP(bf16_t, WS_W) + W_QKV + (size_t)jl * 1536 * 1024; const float* qg = ap->in[6] + jl * 64; const float* kg = ap->in[7] + jl * 64;
                    bf16_t* XN = WSP(bf16_t, WS_XN); bf16_t* QO = WSP(bf16_t, WS_R1); bf16_t* KB = WSP(bf16_t, WS_K); bf16_t* VB = WSP(bf16_t, WS_V);
#if PHM & 8
                    { pg8::Gemm g{XN, Wqkv, 1024, 1024, 1024, 0}; pg8::StaticOrder S; S.init(NREAL, 1536, G, bid); pg8::EpiQKV E{QO, KB, VB, qg, kg, WSP(float, WS_COS), WSP(float, WS_SIN), ATT_C2};
                      pg8::gemm_phase<pg8::EpiQKV, pg8::StaticOrder, PG8_ALIGN, PG8_SP2>(ldsl, g, S, E); }
#endif
#if PHM & 4
                    { ThinP P{XN, 1024, Wqkv, 1024, 1024, 24, QO, KB, VB, nullptr, qg, kg}; thin_phase<TK_QKV>(lds, P, tid, wave, lane, bid, G); }
#endif
                }
                GSYNC();
#if PHM & 16
                {
                    KArgP ap = KARGS(); unsigned char* ws = ap->ws; IDS();
                    bf16_t* QO = WSP(bf16_t, WS_R1); bf16_t* KB = WSP(bf16_t, WS_K); bf16_t* VB = WSP(bf16_t, WS_V);
                    for (int i = 0;; ++i) {
                        int bh, qb = 0; bool meta = false;
                        if (G == 256) { if (i < 8) { bh = vcu >> 3; qb = (vcu & 7) + 8 * i; } else if (i == 8 && (vcu & 7) == 0) { bh = vcu >> 3; meta = true; } else break; }
                        else { const int uid = i * G + bid; if (uid >= 2080) break; if (uid < 2048) { bh = uid >> 6; qb = uid & 63; } else { bh = uid - 2048; meta = true; } }
                        const int b = bh >> 4, h = bh & 15;
                        const long qrow0 = meta ? (long)(NREAL + b * 16) : (long)b * 16384 + (long)qb * 256;
                        attn_body::attn_unit<8>(b, h, qrow0, meta ? 16 : 256, (const attn_body::bf16*)QO, (const attn_body::bf16*)KB, (const attn_body::bf16*)VB, (attn_body::bf16*)QO, (char*)lds);
                    }
                }
#endif
                GSYNC();
                oAsel = 1; oK = 1024; oBoff = W_O + (size_t)jl * 1024 * 1024; coef = 1.f; gpost_i = layer * 6 + 3; gpre_i = layer * 6 + 4;
            } else {
                {
                    KArgP ap = KARGS(); unsigned char* ws = ap->ws; IDS();
                    const bf16_t* Wrin = WSP(bf16_t, WS_W) + W_RIN + (size_t)jl * 2048 * 1024; bf16_t* XN = WSP(bf16_t, WS_XN); bf16_t* GATE = WSP(bf16_t, WS_Y); bf16_t* XR = WSP(bf16_t, WS_R3);
#if PHM & 32
                    { pg8::Gemm g{XN, Wrin, 1024, 1024, 1024, 0}; pg8::StaticOrder S; S.init(NREAL, 2048, G, bid); pg8::EpiRecIn E{GATE, XR};
                      pg8::gemm_phase<pg8::EpiRecIn, pg8::StaticOrder, PG8_ALIGN, PG8_SP2>(ldsl, g, S, E); }
#endif
#if PHM & 4
                    { ThinP P{XN, 1024, Wrin, 1024, 1024, 32, GATE, XR, nullptr, nullptr, nullptr, nullptr}; thin_phase<TK_RECIN>(lds, P, tid, wave, lane, bid, G); }
#endif
                }
                GSYNC();
#if PHM & 64
                {
                    KArgP ap = KARGS(); unsigned char* ws = ap->ws; IDS();
                    const bf16_t* XR = WSP(bf16_t, WS_R3); bf16_t* XC = WSP(bf16_t, WS_XN);
                    const float* cw = ap->in[10] + (size_t)jl * 4 * 1024; const float* cbias = ap->in[11] + (size_t)jl * 1024;
                    for (int it = gtid; it < NROWS * 128; it += GT) {
                        const int R = it >> 7, ck = (it & 127) * 8; int b, p;
                        if (R < NREAL) { b = R >> 14; p = 16 + (R & 16383); } else { b = (R - NREAL) >> 4; p = (R - NREAL) & 15; }
                        f32x4 a0 = *(const f32x4*)(cbias + ck), a1 = *(const f32x4*)(cbias + ck + 4);
#pragma unroll
                        for (int j = 0; j < 4; ++j) { const int pp = p + j - 2;
                            if (pp >= 0 && pp < 16400) { const int sr = pp < 16 ? NREAL + b * 16 + pp : b * 16384 + pp - 16;
                                const u32x4 x = *(const u32x4*)(XR + (size_t)sr * 1024 + ck); const f32x4 w0 = *(const f32x4*)(cw + j * 1024 + ck), w1 = *(const f32x4*)(cw + j * 1024 + ck + 4);
                                a0[0] += __uint_as_float(x[0] << 16) * w0[0]; a0[1] += __uint_as_float(x[0] & 0xffff0000u) * w0[1]; a0[2] += __uint_as_float(x[1] << 16) * w0[2]; a0[3] += __uint_as_float(x[1] & 0xffff0000u) * w0[3];
                                a1[0] += __uint_as_float(x[2] << 16) * w1[0]; a1[1] += __uint_as_float(x[2] & 0xffff0000u) * w1[1]; a1[2] += __uint_as_float(x[3] << 16) * w1[2]; a1[3] += __uint_as_float(x[3] & 0xffff0000u) * w1[3]; } }
                        u32x4 o; o.x = pk2(a0[0], a0[1]); o.y = pk2(a0[2], a0[3]); o.z = pk2(a1[0], a1[1]); o.w = pk2(a1[2], a1[3]);
                        *(u32x4*)(XC + ((size_t)(ck >> 8) * ROWS_ALLOC + R) * 256 + (ck & 255)) = o;
                    }
                }
#endif
                GSYNC();
                {
                    KArgP ap = KARGS(); unsigned char* ws = ap->ws; IDS();
                    const bf16_t* Wrg = WSP(bf16_t, WS_W) + W_RG + (size_t)jl * 4096 * 256; bf16_t* XC = WSP(bf16_t, WS_XN); unsigned* AB = WSP(unsigned, WS_R1);
#if (PHM & 128) && (!defined(RECTEST) || RECTEST >= 2)
                    { pg8::Gemm g{XC, Wrg, 256, 256, 256, 1}; pg8::StaticOrder S; S.init(NREAL, 4096, G, bid); pg8::EpiGate E{AB};
                      pg8::gemm_phase<pg8::EpiGate, pg8::StaticOrder, PG8_ALIGN, PG8_SP2>(ldsl, g, S, E); }
#endif
#if (PHM & 4) && (!defined(RECTEST) || RECTEST >= 2)
                    { ThinP P{XC, 256, Wrg, 256, 256, 64, nullptr, nullptr, nullptr, AB, nullptr, nullptr}; thin_phase<TK_GATE>(lds, P, tid, wave, lane, bid, G); }
#endif
                }
                GSYNC();
#if (PHM & 256) && (!defined(RECTEST) || RECTEST >= 2)
                {
                    KArgP ap = KARGS(); unsigned char* ws = ap->ws; IDS();
                    const unsigned* AB = WSP(unsigned, WS_R1); const bf16_t* XC = WSP(bf16_t, WS_XN); f32x2_tt* AGG = WSP(f32x2_tt, WS_AGG); const float* lam = ap->in[14] + (size_t)jl * 2 * 1024; const float* gbias = ap->in[13] + (size_t)jl * 4 * 1024;
                    for (int it = gw; it < 2 * 2 * NCHUNK * 16; it += NGW) {
                        const int cgp = it & 15, q = it >> 4, j = q % NCHUNK, db = q / NCHUNK, d = db >> 1, b = db & 1, c = cgp * 64 + lane;
                        const unsigned* ab = AB + ((size_t)d * NROWS + chunk_row0(b, j)) * 1024 + c; f32x2_tt* op = AGG + ((size_t)db * NCHUNK + j) * 1024 + c;
                        const bf16_t* xp = XC + ((size_t)(c >> 8) * ROWS_ALLOC + chunk_row0(b, j)) * 256 + (c & 255); const float sp = sp_of(lam[d * 1024 + c]); const float rb = gbias[(d * 2 + 0) * 1024 + c], ib = gbias[(d * 2 + 1) * 1024 + c];
                        if (j == 0) scanA_item<16>(ab, xp, d, sp, rb, ib, op); else scanA_item<64>(ab, xp, d, sp, rb, ib, op);
                    }
                }
#endif
                GSYNC();
#if (PHM & 512) && (!defined(RECTEST) || RECTEST >= 2)
                {
                    KArgP ap = KARGS(); unsigned char* ws = ap->ws; IDS();
                    if (wave == 0 && bid < 64) {
                        const int idx = bid * 64 + lane, db = idx >> 10, d = db >> 1, c = idx & 1023;
                        const f32x2_tt* ag = WSP(f32x2_tt, WS_AGG) + (size_t)db * NCHUNK * 1024 + c; float* ci = WSP(float, WS_CIN) + (size_t)db * NCHUNK * 1024 + c; float carry = 0.f;
#pragma unroll 1
                        for (int j0 = 0; j0 < 256; j0 += 16) { f32x2_tt v[16];
#pragma unroll
                            for (int k = 0; k < 16; ++k) { const int js = j0 + k; const int jj = d ? NCHUNK - 1 - js : js; v[k] = ag[(size_t)jj * 1024]; }
#pragma unroll
                            for (int k = 0; k < 16; ++k) { const int js = j0 + k; const int jj = d ? NCHUNK - 1 - js : js; ci[(size_t)jj * 1024] = carry; carry = v[k].x * carry + v[k].y; }
                        }
                        ci[(size_t)(d ? 0 : NCHUNK - 1) * 1024] = carry;
                    }
                }
#endif
                GSYNC();
#if PHM & 1024
                {
                    KArgP ap = KARGS(); unsigned char* ws = ap->ws; IDS();
                    const unsigned* AB = WSP(unsigned, WS_R1); const bf16_t* XC = WSP(bf16_t, WS_XN); const float* CIN = WSP(float, WS_CIN); const float* lam = ap->in[14] + (size_t)jl * 2 * 1024; const float* gbias = ap->in[13] + (size_t)jl * 4 * 1024;
                    const bf16_t* GATE = WSP(bf16_t, WS_Y); bf16_t* YS = WSP(bf16_t, WS_R3);
                    for (int it = gw; it < 2 * NCHUNK * 16; it += NGW) {
                        const int cgp = it & 15, q = it >> 4, j = q % NCHUNK, b = q / NCHUNK, c = cgp * 64 + lane; const int r0 = chunk_row0(b, j);
                        const unsigned* abf = AB + ((size_t)r0) * 1024 + c; const unsigned* abb = AB + ((size_t)NROWS + r0) * 1024 + c;
                        const float cf = CIN[((size_t)(0 * 2 + b) * NCHUNK + j) * 1024 + c], cb2 = CIN[((size_t)(1 * 2 + b) * NCHUNK + j) * 1024 + c];
                        const float spf = sp_of(lam[c]), spb = sp_of(lam[1024 + c]); const float rbf = gbias[c], ibf = gbias[1024 + c], rbb = gbias[2048 + c], ibb = gbias[3072 + c];
                        const bf16_t* xp = XC + ((size_t)(c >> 8) * ROWS_ALLOC + r0) * 256 + (c & 255);
#if defined(RECTEST) && RECTEST == 1
                        { const int len = j == 0 ? 16 : 64; for (int t = 0; t < len; ++t) YS[(size_t)(r0 + t) * 1024 + c] = (bf16_t)f2bf(bf2f(xp[(size_t)t * 256]) * bf2f(GATE[(size_t)(r0 + t) * 1024 + c])); continue; }
#endif
#if defined(RECTEST) && RECTEST == 2
                        { const int len = j == 0 ? 16 : 64; for (int t = 0; t < len; ++t) { const unsigned wf = abf[(size_t)t * 1024], wb = abb[(size_t)t * 1024];
                            YS[(size_t)(r0 + t) * 1024 + c] = (bf16_t)f2bf((__uint_as_float(wf << 16) + __uint_as_float(wb & 0xffff0000u) + __uint_as_float(wf & 0xffff0000u) + __uint_as_float(wb << 16) + cf + cb2) * bf2f(GATE[(size_t)(r0 + t) * 1024 + c])); } continue; }
#endif
                        if (j == 0) scanC_item<16>(abf, abb, xp, GATE + (size_t)r0 * 1024 + c, YS + (size_t)r0 * 1024 + c, cf, cb2, spf, spb, rbf, ibf, rbb, ibb);
                        else scanC_item<64>(abf, abb, xp, GATE + (size_t)r0 * 1024 + c, YS + (size_t)r0 * 1024 + c, cf, cb2, spf, spb, rbf, ibf, rbb, ibb);
                    }
                }
#endif
                GSYNC();
                oAsel = 2; oK = 1024; oBoff = W_RO + (size_t)jl * 1024 * 1024; coef = 1.f; gpost_i = layer * 6 + 3; gpre_i = layer * 6 + 4;
            }
            {
                KArgP ap = KARGS(); unsigned char* ws = ap->ws; IDS();
                const bf16_t* oA = oAsel == 2 ? WSP(bf16_t, WS_R3) : WSP(bf16_t, WS_R1); const bf16_t* oBt = WSP(bf16_t, WS_W) + oBoff; bf16_t* Yb = WSP(bf16_t, WS_Y);
#if PHM & 2048
                { pg8::Gemm g{oA, oBt, oK, oK, oK, 0}; pg8::StaticOrder S; S.init(NREAL, 1024, G, bid); pg8::EpiPlain E{Yb};
                  pg8::gemm_phase<pg8::EpiPlain, pg8::StaticOrder, PG8_ALIGN, PG8_SP2>(ldsl, g, S, E); }
#endif
#if PHM & 4
                { ThinP P{oA, oK, oBt, oK, oK, 16, Yb, nullptr, nullptr, nullptr, nullptr, nullptr}; thin_phase<TK_PLAIN>(lds, P, tid, wave, lane, bid, G); }
#endif
            }
            GSYNC();
#if PHM & 4096
            {
                KArgP ap = KARGS(); unsigned char* ws = ap->ws; IDS();
                float* out = ap->out; float* hmeta = WSP(float, WS_HMETA); const bf16_t* Yb = WSP(bf16_t, WS_Y); bf16_t* XN = WSP(bf16_t, WS_XN);
                const float* gpost = ap->in[2] + (size_t)gpost_i * 1024; const float* gpre = gpre_i >= 0 ? ap->in[2] + (size_t)gpre_i * 1024 : nullptr;
                for (int row = gw; row < NROWS; row += NGW) {
                    float* hr = hrow_ptr(out, hmeta, row); const unsigned long long* yr = (const unsigned long long*)(Yb + (size_t)row * 1024) + lane;
                    f32x4 y[4], v[4]; float s = 0.f;
#pragma unroll
                    for (int j = 0; j < 4; ++j) { const unsigned long long w = yr[64 * j]; const unsigned lo = (unsigned)w, hi = (unsigned)(w >> 32);
                        y[j] = (f32x4){__uint_as_float(lo << 16), __uint_as_float(lo & 0xffff0000u), __uint_as_float(hi << 16), __uint_as_float(hi & 0xffff0000u)};
                        v[j] = ((const f32x4*)hr)[lane + 64 * j];
                        s += (y[j].x * y[j].x + y[j].y * y[j].y) + (y[j].z * y[j].z + y[j].w * y[j].w); }
                    const float r = coef * __builtin_amdgcn_rsqf(wave_sum(s) * (1.f / 1024.f) + NORM_EPS);
#pragma unroll
                    for (int j = 0; j < 4; ++j) { const f32x4 gg = ((const f32x4*)gpost)[lane + 64 * j]; v[j] = v[j] + y[j] * r * gg; ((f32x4*)hr)[lane + 64 * j] = v[j]; }
                    if (gpre) norm_row_store(v, gpre, XN + (size_t)row * 1024, lane);
                }
            }
#endif
            GSYNC();
        }
    }
}

extern "C" void kernel_launch(void* const* d_in, const int* in_sizes, int n_in, void* d_out, int out_size, void* d_ws, size_t ws_size, hipStream_t stream) {
    static int grid_blocks = 0;
    if (grid_blocks == 0) {
        if (n_in != 16 || ws_size < WS_END) { fprintf(stderr, "kernel_launch: unexpected n_in %d / ws_size %zu\n", n_in, ws_size); grid_blocks = -1; return; }
        int dev = 0, cus = 0, per_cu = 0;
        (void)hipGetDevice(&dev); (void)hipDeviceGetAttribute(&cus, hipDeviceAttributeMultiprocessorCount, dev);
        if (hipFuncSetAttribute((const void*)fwd_megakernel, hipFuncAttributeMaxDynamicSharedMemorySize, LDS_BYTES) != hipSuccess) { fprintf(stderr, "kernel_launch: hipFuncSetAttribute failed\n"); grid_blocks = -1; return; }
        if (hipOccupancyMaxActiveBlocksPerMultiprocessor(&per_cu, (const void*)fwd_megakernel, 512, LDS_BYTES) != hipSuccess || per_cu < 1) { fprintf(stderr, "kernel_launch: occupancy query says %d\n", per_cu); per_cu = 1; }
        (void)hipGetLastError();
        grid_blocks = cus > 0 ? cus : 256;
    }
    if (grid_blocks < 0) return;
    if (hipMemsetAsync(d_ws, 0, 65536, stream) != hipSuccess) { fprintf(stderr, "kernel_launch: hipMemsetAsync failed\n"); return; }
    Args a{};
    for (int i = 0; i < 16; ++i) a.in[i] = (const float*)d_in[i];
    a.out = (float*)d_out; a.ws = (unsigned char*)d_ws;
    void* kargs[] = {&a};
    hipError_t e = hipLaunchCooperativeKernel((const void*)fwd_megakernel, dim3(grid_blocks), dim3(512), kargs, LDS_BYTES, stream);
    if (e != hipSuccess) fprintf(stderr, "cooperative launch failed: %s (grid %d)\n", hipGetErrorString(e), grid_blocks);
}
```

```cpp
#include <hip/hip_runtime.h>
#include <hip/hip_cooperative_groups.h>
#include <cstdio>
#include <cstdint>
namespace cg = cooperative_groups;

constexpr int NREAL = 32768, NROWS = 32800, ROWS_ALLOC = 33280;
constexpr int DMODEL = 1024, DFF = 2816, LSEQ_ = 16384, NCHUNK = 257;
constexpr float NORM_EPS = 1e-6f;
constexpr float LOG2E = 1.4426950408889634f;

namespace pg8 {

#define PG8_LAS __attribute__((address_space(3)))
typedef unsigned short bf16_t;
typedef short bf16x8 __attribute__((ext_vector_type(8)));
typedef float f32x4 __attribute__((ext_vector_type(4)));
typedef unsigned u32x4 __attribute__((ext_vector_type(4)));
constexpr int BM = 256, BK = 64, HALF = 128, HTB = HALF * BK * 2  , STAGE_BYTES = 8 * HTB, NXCD = 8, WGM = 8;

__host__ __device__ __forceinline__ int lds_byte(int r, int c) { const int st = (r >> 4) * 2 + (c >> 5), rr = r & 15, cc = c & 31, ob = rr * 64 + cc * 2; return st * 1024 + (ob ^ (((ob >> 9) & 1) << 5)); }
__host__ __device__ __forceinline__ void stage_rc(int b, int& R, int& C) { const int st = b / 1024, sb = b % 1024, swz = sb ^ (((sb >> 9) & 1) << 5); R = (st >> 1) * 16 + swz / 64; C = (st & 1) * 32 + (swz % 64) / 2; }
__host__ __device__ __forceinline__ int perm32(int rho) { const int n = rho >> 4, i = rho & 15; return 8 * (i >> 2) + 4 * n + (i & 3); }

struct Unit { int pm, pn; };
struct Gemm { const bf16_t* A; const bf16_t* Bt; int lda, ldb, K, akmode; };

struct StaticOrder {
    int nM, nN, nwg, G, c;
    __host__ __device__ void init(int M, int N, int G_, int c_) { nM = M / BM; nN = N / BM; nwg = nM * nN; G = G_; c = c_; }
    __host__ __device__ bool next(int i, Unit& u) const {
        const long L = (long)i * G + c; if (L >= nwg) return false;
        int wgid = (int)L; { const int q = nwg / NXCD, r = nwg % NXCD, xcd = wgid % NXCD, off = wgid / NXCD; wgid = (xcd < r ? xcd * (q + 1) : r * (q + 1) + (xcd - r) * q) + off; }
        const int nig = WGM * nN, gid = wgid / nig, fm = gid * WGM, gsz = (nM - fm) < WGM ? (nM - fm) : WGM;
        u.pm = fm + ((wgid % nig) % gsz); u.pn = (wgid % nig) / gsz; return true;
    }
    __device__ __forceinline__ void a_ready(const Unit&) const {}
    __device__ __forceinline__ void done(const Unit&) const {}
};


__device__ __forceinline__ unsigned cvt_pk_bf16(float lo, float hi) { unsigned r; asm volatile("v_cvt_pk_bf16_f32 %0, %1, %2" : "=v"(r) : "v"(lo), "v"(hi)); return r; }
__device__ __forceinline__ float sigm(float x) { return __builtin_amdgcn_rcpf(1.f + __builtin_amdgcn_exp2f(-1.4426950408889634f * x)); }
__device__ __forceinline__ float gelu_tanh(float x) { const float z = 0.7978845608028654f * (x + 0.044715f * x * x * x); return x * sigm(2.f * z); }
__device__ __forceinline__ float bf2f(unsigned short b) { return __uint_as_float((unsigned)b << 16); }
__device__ __forceinline__ u32x4 pack8(const f32x4 a, const f32x4 b) { u32x4 w; w.x = cvt_pk_bf16(a[0], a[1]); w.y = cvt_pk_bf16(a[2], a[3]); w.z = cvt_pk_bf16(b[0], b[1]); w.w = cvt_pk_bf16(b[2], b[3]); return w; }

struct EpiSwiGLU {
    static constexpr bool PERM = true, AFTER_DRAIN = false;
    bf16_t* O;
    __device__ __forceinline__ void operator()(const f32x4 (&acc)[2][2][4][2], const Unit& u, int wr, int wc, int fr_in, int fq) const {
        int fr = fr_in; asm volatile("" : "+v"(fr));
        const int row0 = u.pm * BM + wr * 64 + fr, col0 = u.pn * 128 + wc * 32 + 8 * fq;
#pragma unroll
        for (int ai = 0; ai < 2; ++ai)
#pragma unroll
            for (int m = 0; m < 4; ++m) {
                f32x4 v[2];
#pragma unroll
                for (int n = 0; n < 2; ++n)
#pragma unroll
                    for (int j = 0; j < 4; ++j) { const float gt = acc[ai][0][m][n][j]; v[n][j] = gt * sigm(gt) * acc[ai][1][m][n][j]; }
                *(u32x4*)((char*)O + ((unsigned)(row0 + ai * HALF + m * 16) * 2816u + (unsigned)col0) * 2u) = pack8(v[0], v[1]);
            }
    }
};
struct EpiPlain {
    static constexpr bool PERM = true, AFTER_DRAIN = false;
    bf16_t* O;
    __device__ __forceinline__ void operator()(const f32x4 (&acc)[2][2][4][2], const Unit& u, int wr, int wc, int fr_in, int fq) const {
        int fr = fr_in; asm volatile("" : "+v"(fr));
        const int row0 = u.pm * BM + wr * 64 + fr, col0 = u.pn * BM + wc * 32 + 8 * fq;
#pragma unroll
        for (int ai = 0; ai < 2; ++ai)
#pragma unroll
            for (int m = 0; m < 4; ++m)
#pragma unroll
                for (int bj = 0; bj < 2; ++bj)
                    *(u32x4*)((char*)O + ((unsigned)(row0 + ai * HALF + m * 16) * 1024u + (unsigned)(col0 + bj * HALF)) * 2u) = pack8(acc[ai][bj][m][0], acc[ai][bj][m][1]);
    }
};
struct EpiRecIn {
    static constexpr bool PERM = true, AFTER_DRAIN = false;
    bf16_t* G; bf16_t* X;
    __device__ __forceinline__ void operator()(const f32x4 (&acc)[2][2][4][2], const Unit& u, int wr, int wc, int fr_in, int fq) const {
        int fr = fr_in; asm volatile("" : "+v"(fr));
        const int row0 = u.pm * BM + wr * 64 + fr, col0 = (u.pn & 3) * BM + wc * 32 + 8 * fq; const bool isg = u.pn < 4; bf16_t* O = isg ? G : X;
#pragma unroll
        for (int ai = 0; ai < 2; ++ai)
#pragma unroll
            for (int m = 0; m < 4; ++m)
#pragma unroll
                for (int bj = 0; bj < 2; ++bj) {
                    f32x4 v0 = acc[ai][bj][m][0], v1 = acc[ai][bj][m][1];
                    if (isg) {
#pragma unroll
                        for (int j = 0; j < 4; ++j) { v0[j] = gelu_tanh(v0[j]); v1[j] = gelu_tanh(v1[j]); } }
                    *(u32x4*)((char*)O + ((unsigned)(row0 + ai * HALF + m * 16) * 1024u + (unsigned)(col0 + bj * HALF)) * 2u) = pack8(v0, v1);
                }
    }
};
struct EpiQKV {
    static constexpr bool PERM = true, AFTER_DRAIN = false;
    bf16_t *Q, *K, *V; const float *qg, *kg, *cs, *sn; float c2;
    __device__ __forceinline__ void operator()(const f32x4 (&acc)[2][2][4][2], const Unit& u, int wr, int wc, int fr_in, int fq) const {
        int fr = fr_in; asm volatile("" : "+v"(fr));
        const int row0 = u.pm * BM + wr * 64 + fr, pn = u.pn;
        if (pn == 5) {
#pragma unroll
            for (int ai = 0; ai < 2; ++ai)
#pragma unroll
                for (int m = 0; m < 4; ++m)
#pragma unroll
                    for (int bj = 0; bj < 2; ++bj)
                        *(u32x4*)((char*)V + ((unsigned)(row0 + ai * HALF + m * 16) * 256u + (unsigned)(wc * 64 + bj * 32 + 8 * fq)) * 2u) = pack8(acc[ai][bj][m][0], acc[ai][bj][m][1]);
            return;
        }
        const bool isq = pn < 4; const float* gp = isq ? qg : kg; const float sc = isq ? c2 : 1.f;
        bf16_t* O = isq ? Q : K; const int pitch = isq ? 1024 : 256; const int hc = (isq ? (4 * pn + wc) : wc) * 64 + 8 * fq;
#pragma unroll
        for (int ai = 0; ai < 2; ++ai)
#pragma unroll
            for (int m = 0; m < 4; ++m) {
                const int row = row0 + ai * HALF + m * 16;
                float ss = 0.f;
#pragma unroll
                for (int bj = 0; bj < 2; ++bj)
#pragma unroll
                    for (int n = 0; n < 2; ++n) { const f32x4 x = acc[ai][bj][m][n]; ss += (x[0] * x[0] + x[1] * x[1]) + (x[2] * x[2] + x[3] * x[3]); }
                ss += __shfl_xor(ss, 16); ss += __shfl_xor(ss, 32);
                const float rms = __builtin_amdgcn_rsqf(ss * (1.f / 64.f) + 1e-6f);
                const int s = row & 16383;
                f32x4 o1[2], o2[2];
#pragma unroll
                for (int n = 0; n < 2; ++n) {
                    const unsigned to = ((unsigned)s * 32u + (unsigned)(8 * fq + 4 * n)) * 4u; const f32x4 c = *(const f32x4*)((const char*)cs + to), sn4 = *(const f32x4*)((const char*)sn + to);
                    const f32x4 g1 = *(const f32x4*)(gp + 8 * fq + 4 * n), g2 = *(const f32x4*)(gp + 32 + 8 * fq + 4 * n);
                    const f32x4 x1 = acc[ai][0][m][n] * rms * g1, x2 = acc[ai][1][m][n] * rms * g2;
                    o1[n] = (x1 * c - x2 * sn4) * sc; o2[n] = (x1 * sn4 + x2 * c) * sc;
                }
                bf16_t* p = (bf16_t*)((char*)O + ((unsigned)row * (unsigned)pitch + (unsigned)hc) * 2u);
                *(u32x4*)(p) = pack8(o1[0], o1[1]); *(u32x4*)(p + 32) = pack8(o2[0], o2[1]);                asm volatile("" ::: "memory");
            }
    }
};
struct EpiGate {
    static constexpr bool PERM = true, AFTER_DRAIN = false;
    unsigned* AB;
    __device__ __forceinline__ void operator()(const f32x4 (&acc)[2][2][4][2], const Unit& u, int wr, int wc, int fr_in, int fq) const {
        int fr = fr_in; asm volatile("" : "+v"(fr));
        const int row0 = u.pm * BM + wr * 64 + fr, pn = u.pn, d = pn >> 3, ch0 = ((pn >> 1) & 3) * 256 + (pn & 1) * 128 + wc * 32 + 8 * fq;
        unsigned* ab = AB + (size_t)d * NROWS * 1024;
#pragma unroll
        for (int n = 0; n < 2; ++n) {
#pragma unroll
            for (int ai = 0; ai < 2; ++ai)
#pragma unroll
                for (int m = 0; m < 4; ++m) {
                    const int row = row0 + ai * HALF + m * 16;
                    u32x4 w;
#pragma unroll
                    for (int j = 0; j < 4; ++j) w[j] = cvt_pk_bf16(acc[ai][0][m][n][j], acc[ai][1][m][n][j]);
                    *(u32x4*)((char*)ab + ((unsigned)row * 1024u + (unsigned)(ch0 + 4 * n)) * 4u) = w;
                }
        }
    }
};
template <class Epi, class Sched, bool ALIGN_EPI = false, bool SP2 = false>
__device__ __forceinline__ void gemm_phase(PG8_LAS unsigned char* lds, const Gemm g, const Sched& S, const Epi& E) {
    int tid_ = threadIdx.x; asm volatile("" : "+v"(tid_)); const int tid = tid_, wid = __builtin_amdgcn_readfirstlane(tid >> 6), lane = tid & 63, wr = wid >> 2, wc = wid & 3, fr = lane & 15, fq = lane >> 4;
    const int K = g.K, nt = K / BK;
    unsigned voffA[2], voffB[2];
#pragma unroll
    for (int i = 0; i < 2; ++i) { int R, C; stage_rc(tid * 16 + i * 8192, R, C); const int Rb = Epi::PERM ? ((R & ~31) + perm32(R & 31)) : R;
        voffA[i] = (unsigned)(R * g.lda + C) * 2u; voffB[i] = (unsigned)(Rb * g.ldb + C) * 2u; }
    const size_t kstep = (size_t)(BK * 2);
    const size_t hstepA = (size_t)HALF * g.lda * 2, hstepB = (size_t)HALF * g.ldb * 2;
    const size_t tstepA = 2 * hstepA, tstepB = 2 * hstepB;
    const unsigned ldsw = (unsigned)wid * 1024u;
    const int aoff = lds_byte(wr * 64 + fr, fq * 8), boff = lds_byte(wc * 32 + fr, fq * 8);
#define AKOFF(pn) ((size_t)(g.akmode ? ((size_t)(((pn) >> 1) & 3) * ((size_t)33280 * 512)) : 0))
#define PG8_SA(b, h) (((b) * 2 + (h)) * HTB)
#define PG8_SB(b, h) ((4 + (b) * 2 + (h)) * HTB)
#define PG8_STAGE(bufoff, gbase, voff) do { _Pragma("unroll") for (int _i = 0; _i < 2; ++_i) \
        __builtin_amdgcn_global_load_lds((const unsigned*)((const char*)(gbase) + (voff)[_i]), (PG8_LAS unsigned*)(lds + (bufoff) + ldsw + _i * 8192), 16, 0, 0); } while (0)
#define PG8_LDA(dst, b, h) do { _Pragma("unroll") for (int m = 0; m < 4; ++m) _Pragma("unroll") for (int k = 0; k < 2; ++k) dst[m][k] = *(const PG8_LAS bf16x8*)(lds + PG8_SA(b, h) + aoff + m * 2048 + k * 1024); } while (0)
#define PG8_LDB(dst, b, h) do { _Pragma("unroll") for (int n = 0; n < 2; ++n) _Pragma("unroll") for (int k = 0; k < 2; ++k) dst[n][k] = *(const PG8_LAS bf16x8*)(lds + PG8_SB(b, h) + boff + n * 2048 + k * 1024); } while (0)
#define PG8_MMA(ai, bj, At, Bt) do { __builtin_amdgcn_s_setprio(1); _Pragma("unroll") for (int m = 0; m < 4; ++m) _Pragma("unroll") for (int n = 0; n < 2; ++n) _Pragma("unroll") for (int k = 0; k < 2; ++k) \
        acc[ai][bj][m][n] = __builtin_amdgcn_mfma_f32_16x16x32_bf16(Bt[n][k], At[m][k], acc[ai][bj][m][n], 0, 0, 0); __builtin_amdgcn_s_setprio(0); } while (0)
#define PG8_WAIT_V(n) asm volatile("s_waitcnt vmcnt(" #n ")" ::: "memory")
#define PG8_WAIT_L(n) asm volatile("s_waitcnt lgkmcnt(" #n ")" ::: "memory")
#define PG8_BAR __builtin_amdgcn_s_barrier()
#define PG8_SCHED __builtin_amdgcn_sched_barrier(0)
    Unit cur, nxt; int ui = 0;
    if (!S.next(0, cur)) return;
    f32x4 acc[2][2][4][2];
#pragma unroll
    for (int a = 0; a < 2; ++a)
#pragma unroll
        for (int b = 0; b < 2; ++b)
#pragma unroll
            for (int m = 0; m < 4; ++m)
#pragma unroll
                for (int n = 0; n < 2; ++n) acc[a][b][m][n] = (f32x4){0.f, 0.f, 0.f, 0.f};
    bf16x8 At[4][2], B0[2][2], B1[2][2];
    const char* cA = (const char*)g.A + (size_t)cur.pm * tstepA + AKOFF(cur.pn); const char* cB = (const char*)g.Bt + (size_t)cur.pn * tstepB;
    S.a_ready(cur);
    if constexpr (SP2) {
        PG8_STAGE(PG8_SB(0, 0), cB, voffB); PG8_STAGE(PG8_SB(0, 1), cB + hstepB, voffB); PG8_STAGE(PG8_SA(0, 0), cA, voffA); PG8_STAGE(PG8_SA(0, 1), cA + hstepA, voffA);
        if (wr == 1) PG8_BAR;
        PG8_WAIT_V(2); PG8_BAR;
        PG8_STAGE(PG8_SB(1, 0), cB + kstep, voffB); PG8_STAGE(PG8_SA(1, 0), cA + kstep, voffA); PG8_STAGE(PG8_SB(1, 1), cB + hstepB + kstep, voffB);
        PG8_WAIT_V(6); PG8_BAR;
    } else {
        PG8_STAGE(PG8_SB(0, 0), cB, voffB); PG8_STAGE(PG8_SA(0, 0), cA, voffA); PG8_STAGE(PG8_SB(0, 1), cB + hstepB, voffB); PG8_STAGE(PG8_SA(0, 1), cA + hstepA, voffA);
        if (wr == 1) PG8_BAR;
        PG8_WAIT_V(4); PG8_BAR;
        PG8_STAGE(PG8_SB(1, 0), cB + kstep, voffB); PG8_STAGE(PG8_SA(1, 0), cA + kstep, voffA); PG8_STAGE(PG8_SB(1, 1), cB + hstepB + kstep, voffB);
        PG8_WAIT_V(6); PG8_BAR;
    }
    for (;;) {
        const bool has_next = S.next(ui + 1, nxt);
        const char* nA = has_next ? (const char*)g.A + (size_t)nxt.pm * tstepA + AKOFF(nxt.pn) : cA; const char* nB = has_next ? (const char*)g.Bt + (size_t)nxt.pn * tstepB : cB;
        _Pragma("unroll 1") for (int t = 0; t < nt; t += 2) {
            const bool last = (t == nt - 2);
            const char* a1 = cA + (size_t)(t + 1) * kstep;
            const char* a2 = last ? nA : cA + (size_t)(t + 2) * kstep; const char* b2 = last ? nB : cB + (size_t)(t + 2) * kstep;
            const char* a3 = a2 + kstep; const char* b3 = b2 + kstep;
            if (last && has_next) S.a_ready(nxt);
            if constexpr (SP2) {
            PG8_LDB(B0, 0, 0); PG8_LDB(B1, 0, 1); PG8_SCHED; PG8_LDA(At, 0, 0); PG8_STAGE(PG8_SA(1, 1), a1 + hstepA, voffA);
            PG8_WAIT_V(8); PG8_WAIT_L(0); PG8_BAR; PG8_MMA(0, 0, At, B0); PG8_MMA(0, 1, At, B1); PG8_BAR; PG8_SCHED;
            PG8_LDA(At, 0, 1); PG8_STAGE(PG8_SB(0, 0), b2, voffB); PG8_STAGE(PG8_SB(0, 1), b2 + hstepB, voffB); PG8_STAGE(PG8_SA(0, 0), a2, voffA);
            PG8_WAIT_V(8); PG8_WAIT_L(0); PG8_BAR; PG8_MMA(1, 0, At, B0); PG8_MMA(1, 1, At, B1); PG8_BAR; PG8_SCHED;
            PG8_LDB(B0, 1, 0); PG8_LDB(B1, 1, 1); PG8_SCHED; PG8_LDA(At, 1, 0); PG8_STAGE(PG8_SA(0, 1), a2 + hstepA, voffA);
            PG8_WAIT_V(8); PG8_WAIT_L(0); PG8_BAR; PG8_MMA(0, 0, At, B0); PG8_MMA(0, 1, At, B1); PG8_BAR; PG8_SCHED;
            PG8_LDA(At, 1, 1); PG8_STAGE(PG8_SB(1, 0), b3, voffB); PG8_STAGE(PG8_SB(1, 1), b3 + hstepB, voffB); PG8_STAGE(PG8_SA(1, 0), a3, voffA);
            PG8_WAIT_V(8); PG8_WAIT_L(0); PG8_BAR; PG8_MMA(1, 0, At, B0); PG8_MMA(1, 1, At, B1); PG8_BAR; PG8_SCHED;
            } else {
            PG8_LDB(B0, 0, 0); PG8_SCHED; PG8_LDA(At, 0, 0); PG8_STAGE(PG8_SA(1, 1), a1 + hstepA, voffA);
            PG8_WAIT_L(8); PG8_BAR; PG8_WAIT_L(0); PG8_MMA(0, 0, At, B0); PG8_BAR; PG8_SCHED;
            PG8_LDB(B1, 0, 1); PG8_STAGE(PG8_SB(0, 0), b2, voffB);
            PG8_BAR; PG8_WAIT_L(0); PG8_MMA(0, 1, At, B1); PG8_BAR;
            PG8_LDA(At, 0, 1); PG8_STAGE(PG8_SA(0, 0), a2, voffA);
            PG8_BAR; PG8_WAIT_L(0); PG8_MMA(1, 0, At, B0); PG8_BAR; PG8_SCHED;
            PG8_STAGE(PG8_SB(0, 1), b2 + hstepB, voffB);
            PG8_WAIT_V(6); PG8_BAR; PG8_MMA(1, 1, At, B1); PG8_BAR;
            PG8_LDB(B0, 1, 0); PG8_SCHED; PG8_LDA(At, 1, 0); PG8_STAGE(PG8_SA(0, 1), a2 + hstepA, voffA);
            PG8_WAIT_L(8); PG8_BAR; PG8_WAIT_L(0); PG8_MMA(0, 0, At, B0); PG8_BAR; PG8_SCHED;
            PG8_LDB(B1, 1, 1); PG8_STAGE(PG8_SB(1, 0), b3, voffB);
            PG8_BAR; PG8_WAIT_L(0); PG8_MMA(0, 1, At, B1); PG8_BAR;
            PG8_LDA(At, 1, 1); PG8_STAGE(PG8_SA(1, 0), a3, voffA);
            PG8_BAR; PG8_WAIT_L(0); PG8_MMA(1, 0, At, B0); PG8_BAR; PG8_SCHED;
            PG8_STAGE(PG8_SB(1, 1), b3 + hstepB, voffB);
            PG8_WAIT_V(6); PG8_BAR; PG8_MMA(1, 1, At, B1); PG8_BAR;
            }
        }
        if constexpr (ALIGN_EPI) { if (wr == 0) PG8_BAR; }
        if constexpr (!Epi::AFTER_DRAIN) { E(acc, cur, wr, wc, fr, fq); S.done(cur); }
        if (!has_next) break;
#pragma unroll
        for (int a = 0; a < 2; ++a)
#pragma unroll
            for (int b = 0; b < 2; ++b)
#pragma unroll
                for (int m = 0; m < 4; ++m)
#pragma unroll
                    for (int n = 0; n < 2; ++n) acc[a][b][m][n] = (f32x4){0.f, 0.f, 0.f, 0.f};
        cur = nxt; cA = nA; cB = nB; ++ui;
        if constexpr (ALIGN_EPI) { if (wr == 1) PG8_BAR; }
    }
    PG8_WAIT_V(0);
    if constexpr (!ALIGN_EPI) { if (wr == 0) PG8_BAR; }
    PG8_BAR;
    if constexpr (Epi::AFTER_DRAIN) { E.fused(acc, cur, wr, wc, fr, fq, lds, wid, lane); S.done(cur); }
#undef AKOFF
#undef PG8_SA
#undef PG8_SB
#undef PG8_STAGE
#undef PG8_LDA
#undef PG8_LDB
#undef PG8_MMA
#undef PG8_WAIT_V
#undef PG8_WAIT_L
#undef PG8_BAR
#undef PG8_SCHED
}
}

#ifndef PG8_SP2
#define PG8_SP2 true
#endif
#ifndef PG8_ALIGN
#define PG8_ALIGN true
#endif

#include <hip/hip_bf16.h>
#include <cmath>
namespace attn_body {
using bf16=__hip_bfloat16;
using bf16x8=__attribute__((ext_vector_type(8)))short;
using s16x4=__attribute__((ext_vector_type(4)))short;
using f32x16=__attribute__((ext_vector_type(16)))float;
using u32x4=__attribute__((ext_vector_type(4)))unsigned;
constexpr int D=64,QP=1024,KP=256,LSEQ=16384,NREALR=32768;
constexpr int NW=8,QBLK=32,QB=QBLK*NW,KVBLK=64;

__device__ __forceinline__ int crow(int r,int hi){return (r&3)+8*(r>>2)+4*hi;}
#define SBAR() __builtin_amdgcn_sched_barrier(0)
__device__ __forceinline__ void cmask(f32x16&p0,f32x16&p1,int jb,int qrel,int hi){
  const float NEG=-INFINITY; int kb=64*jb+4*hi;
  #pragma unroll
  for(int r=0;r<16;++r){int kv=kb+(r&3)+8*(r>>2); if(kv>qrel)p0[r]=NEG; if(kv+32>qrel)p1[r]=NEG;}
}

constexpr int NSLOT=3, SLOTB=8192;
constexpr int LDS_K=0, LDS_V=NSLOT*SLOTB, LDS_WS=2*NSLOT*SLOTB, LDS_OST=LDS_WS+NW*64*4, LDS_BYTES=LDS_OST+NW*4096;
constexpr float C2=0.125f*1.4426950408889634f;
__device__ __forceinline__ void glds16(const void*gsrc,unsigned lds_dst){unsigned keep;
  asm volatile("s_mov_b32 %0, m0\n\ts_mov_b32 m0, %2\n\ts_nop 0\n\tglobal_load_lds_dwordx4 %1, off\n\ts_mov_b32 m0, %0":"=&s"(keep):"v"(gsrc),"s"(lds_dst):"memory");}
__device__ __forceinline__ float max3f(float a,float b,float c){float r;asm("v_max3_f32 %0, %1, %2, %3":"=v"(r):"v"(a),"v"(b),"v"(c));return r;}
__device__ __forceinline__ float max2f(float a,float b){float r;asm("v_max_f32_e32 %0, %1, %2":"=v"(r):"v"(a),"v"(b));return r;}
__device__ __forceinline__ float fadd_s(float a,float b){float r;asm("v_add_f32_e32 %0, %1, %2":"=v"(r):"v"(a),"v"(b));return r;}
__device__ __forceinline__ float fsub_s(float a,float b){float r;asm("v_sub_f32_e32 %0, %1, %2":"=v"(r):"v"(a),"v"(b));return r;}
typedef float f32x2_t __attribute__((ext_vector_type(2))); typedef __bf16 bf16x2_t __attribute__((ext_vector_type(2)));
__device__ __forceinline__ unsigned cvtpk_s(float lo,float hi){f32x2_t v={lo,hi};bf16x2_t b=__builtin_convertvector(v,bf16x2_t);return __builtin_bit_cast(unsigned,b);}
#define WAIT_BAR(N) asm volatile("s_waitcnt vmcnt(" #N ") lgkmcnt(0)\n\ts_barrier":::"memory")

__device__ __forceinline__ void qkt(f32x16&p0,f32x16&p1,const char*Kslot,const bf16x8*qr,const f32x16&negm,int r32,int hi){
  const char*kb=Kslot+hi*1024+r32*16;
  #pragma unroll
  for(int d0=0;d0<4;++d0){
    const bf16x8 b0=*reinterpret_cast<const bf16x8*>(kb+d0*2048);
    const bf16x8 b1=*reinterpret_cast<const bf16x8*>(kb+d0*2048+512);
    if(d0==0){p0=__builtin_amdgcn_mfma_f32_32x32x16_bf16(b0,qr[0],negm,0,0,0);p1=__builtin_amdgcn_mfma_f32_32x32x16_bf16(b1,qr[0],negm,0,0,0);}
    else{p0=__builtin_amdgcn_mfma_f32_32x32x16_bf16(b0,qr[d0],p0,0,0,0);p1=__builtin_amdgcn_mfma_f32_32x32x16_bf16(b1,qr[d0],p1,0,0,0);}}
}
typedef __attribute__((address_space(3))) const char* lds_cptr;
typedef short v4i16_t __attribute__((ext_vector_type(4)));
__device__ __forceinline__ void kload8(bf16x8*kf,lds_cptr kp){
  kf[0]=*(const __attribute__((address_space(3))) bf16x8*)(kp);      kf[1]=*(const __attribute__((address_space(3))) bf16x8*)(kp+512);
  kf[2]=*(const __attribute__((address_space(3))) bf16x8*)(kp+2048); kf[3]=*(const __attribute__((address_space(3))) bf16x8*)(kp+2560);
  kf[4]=*(const __attribute__((address_space(3))) bf16x8*)(kp+4096); kf[5]=*(const __attribute__((address_space(3))) bf16x8*)(kp+4608);
  kf[6]=*(const __attribute__((address_space(3))) bf16x8*)(kp+6144); kf[7]=*(const __attribute__((address_space(3))) bf16x8*)(kp+6656);
}
__device__ __forceinline__ void kload2(bf16x8*kf,lds_cptr kp,int j){ kf[2*j]=*(const __attribute__((address_space(3))) bf16x8*)(kp+j*2048); kf[2*j+1]=*(const __attribute__((address_space(3))) bf16x8*)(kp+j*2048+512); }
__device__ __forceinline__ s16x4 vtr(lds_cptr p){ return __builtin_bit_cast(s16x4,__builtin_amdgcn_ds_read_tr16_b64_v4i16((__attribute__((address_space(3))) v4i16_t*)p)); }
__device__ __forceinline__ float rowmax(const f32x16&p0,const f32x16&p1){
  float a=max3f(p0[0],p0[1],p1[0]),b=max3f(p0[2],p0[3],p1[1]);a=max3f(a,p1[2],p1[3]);
  #pragma unroll
  for(int r=4;r<16;r+=4){a=max3f(a,p0[r],p0[r+1]);b=max3f(b,p0[r+2],p0[r+3]);a=max3f(a,p1[r],p1[r+1]);b=max3f(b,p1[r+2],p1[r+3]);}
  const float m=max2f(a,b);
  auto rr=__builtin_amdgcn_permlane32_swap(__float_as_uint(m),__float_as_uint(m),false,false);
  return max2f(__uint_as_float(rr[0]),__uint_as_float(rr[1]));
}
__device__ __forceinline__ void pv(f32x16*o,int vb,bf16x8 pa0,bf16x8 pa1,bf16x8 pa2,bf16x8 pa3){
  #pragma unroll
  for(int d0=0;d0<2;++d0){s16x4 lo[4],hi[4];
    #pragma unroll
    for(int ks=0;ks<4;++ks){
      asm volatile("ds_read_b64_tr_b16 %0,%1 offset:%c2":"=&v"(lo[ks]):"v"(vb),"i"(d0*4096+ks*1024):"memory");
      asm volatile("ds_read_b64_tr_b16 %0,%1 offset:%c2":"=&v"(hi[ks]):"v"(vb),"i"(d0*4096+ks*1024+512):"memory");}
    asm volatile("s_waitcnt lgkmcnt(0)":::"memory");SBAR();
    #define PK(k) (bf16x8){lo[k][0],lo[k][1],lo[k][2],lo[k][3],hi[k][0],hi[k][1],hi[k][2],hi[k][3]}
    o[d0]=__builtin_amdgcn_mfma_f32_32x32x16_bf16(pa0,PK(0),o[d0],0,0,0);
    o[d0]=__builtin_amdgcn_mfma_f32_32x32x16_bf16(pa1,PK(1),o[d0],0,0,0);
    o[d0]=__builtin_amdgcn_mfma_f32_32x32x16_bf16(pa2,PK(2),o[d0],0,0,0);
    o[d0]=__builtin_amdgcn_mfma_f32_32x32x16_bf16(pa3,PK(3),o[d0],0,0,0);
    #undef PK
  }
}

#ifndef ATTN_STORE16
#define ATTN_STORE16(p,v) (*(u32x4*)(p)=(v))
#endif
template<int THRL> __device__ __forceinline__ void attn_unit(int b,int h,long qrow0,int nvalid,int t_base,int NT,int lastmode,float*part_o,float*part_ml,const bf16*Q,const bf16*__restrict__ K,const bf16*__restrict__ V,bf16*O,char*shm){
  int tid_=threadIdx.x; asm volatile("":"+v"(tid_)); const int tid=tid_,lane=tid&63,r32=lane&31,hi=lane>>5; const int wid=__builtin_amdgcn_readfirstlane(tid>>6);
  const long rowbase=(long)b*LSEQ; const long metaoff=((long)(NREALR+b*16)-rowbase)*KP;
  const bf16*Qw=Q+(qrow0+wid*QBLK)*QP+h*D;
  const bf16*Kh=K+rowbase*KP+(h>>2)*D,*Vh=V+rowbase*KP+(h>>2)*D;
  const unsigned lds0=(unsigned)(uintptr_t)shm;
  float*wsf=(float*)(shm+LDS_WS)+wid*64;
  const bf16*ksrc=Kh+(long)lane*KP+wid*8;
  const bf16*vsrc=Vh+(long)(16*(wid&3)+(lane>>2))*KP+(wid>>2)*32+(lane&3)*8;
  const unsigned kdst=lds0+LDS_K+wid*1024, vdst=lds0+LDS_V+wid*1024;
  #define TOFF(tt) ((((tt)+t_base)<256)?(long)((tt)+t_base)*KVBLK*KP:metaoff)
  #define DMA_K(t,slot) glds16(ksrc+TOFF(t),(unsigned)__builtin_amdgcn_readfirstlane(kdst+(slot)))
  #define DMA_V(t,slot) glds16(vsrc+TOFF(t),(unsigned)__builtin_amdgcn_readfirstlane(vdst+(slot)))
  const int vb0=(int)(lds0+LDS_V)+((lane>>4)&1)*32+(lane&3)*8+(4*hi+((lane&15)>>2))*64;
  const char*Kbase=shm+LDS_K; bf16x8 kf[8];
  const lds_cptr shm3=(lds_cptr)shm; const lds_cptr kp0=shm3+LDS_K+hi*1024+r32*16; const lds_cptr vp0=shm3+LDS_V+((lane>>4)&1)*32+(lane&3)*8+(4*hi+((lane&15)>>2))*64;
  DMA_K(0,0);DMA_V(0,0);DMA_K(1,SLOTB);
  bf16x8 qr[4];
  #pragma unroll
  for(int d0=0;d0<4;++d0)qr[d0]=*reinterpret_cast<const bf16x8*>(&Qw[(long)r32*QP+d0*16+hi*8]);
  float mhat=0.f,l_reg=0.f;f32x16 o[2];o[0]=f32x16{};o[1]=f32x16{};f32x16 negm=f32x16{};asm volatile("":"+v"(negm));
    #define CMASK(P0,P1,t) do{}while(0)
  bool resc=false;
  #define START(P0,P1) do{ const float rm=rowmax(P0,P1); resc=false; \
    { const float dl=rm; mhat=fadd_s(mhat,dl); \
      _Pragma("unroll") for(int r=0;r<16;++r){P0[r]=fsub_s(P0[r],dl);P1[r]=fsub_s(P1[r],dl);} \
      _Pragma("unroll") for(int r=0;r<16;++r)negm[r]=-mhat; asm volatile("":"+v"(negm)); } \
    _Pragma("unroll") for(int r=0;r<16;++r)P0[r]=__builtin_amdgcn_exp2f(P0[r]); }while(0)
  #define RESC() do{ if(resc){ asm volatile("s_waitcnt lgkmcnt(0)":::"memory"); \
      _Pragma("unroll") for(int d_=0;d_<2;++d_) _Pragma("unroll") for(int r=0;r<16;++r)o[d_][r]*=wsf[crow(r,hi)]; } }while(0)
  f32x16 pA0,pA1,pB0,pB1;
  int sl_prev=0,sl_cur=0,sl_next=SLOTB;
  #define ROT() do{sl_prev=sl_cur;sl_cur=sl_next;sl_next=(sl_next==(NSLOT-1)*SLOTB)?0:sl_next+SLOTB;}while(0)
  DMA_K(2,2*SLOTB);
  WAIT_BAR(3);
  qkt(pA0,pA1,Kbase,qr,negm,r32,hi);asm volatile("s_nop 15\n\ts_nop 7":"+v"(pA0),"+v"(pA1));CMASK(pA0,pA1,0);
  START(pA0,pA1);
  _Pragma("unroll") for(int r=0;r<16;++r)pA1[r]=__builtin_amdgcn_exp2f(pA1[r]);
  WAIT_BAR(0);
  DMA_K(3,0);DMA_V(1,SLOTB);
  ROT();
  kload8(kf,kp0+sl_cur);
  WAIT_BAR(2);
  s16x4 vlo[8],vhi[8]; u32x4 pw0,pw1,pw2,pw3;
  #define PKW(P,B) cvtpk_s(P[B],P[B+1])
  #define PAF(k) __builtin_bit_cast(bf16x8,pw##k)
  #define VFR(i) (bf16x8){vlo[i][0],vlo[i][1],vlo[i][2],vlo[i][3],vhi[i][0],vhi[i][1],vhi[i][2],vhi[i][3]}
  #define PIN(x) asm volatile("":"+v"(x))
  #define MX3(a,b,c) __builtin_fmaxf(__builtin_fmaxf((a),(b)),(c))
  #define GAPA(MF,A0,A1,A2,A3,W0,W1,PW) do{ MF; sacc+=A0; sacc+=A1; sacc+=A2; sacc+=A3; PIN(sacc); W0; W1; PIN(PW); SBAR(); }while(0)
  #define EX(v) __builtin_amdgcn_exp2f(v)
  #define GAPB(MF,X,B) do{ MF; X[B]=EX(X[B]); X[B+1]=EX(X[B+1]); X[B+2]=EX(X[B+2]); X[B+3]=EX(X[B+3]); PIN(X); SBAR(); }while(0)
  #define VRD(i) do{ vlo[i]=vtr(vp_+(((i)>>2)*4096+((i)&3)*1024)); vhi[i]=vtr(vp_+(((i)>>2)*4096+((i)&3)*1024+512)); }while(0)
  #define KRD(G,j) do{ if(G){ kload2(kf,kp0+sl_next,j); SBAR(); } }while(0)
  #define STEP(C0,C1,P0,P1,t,GK,GV,GL) do{ SBAR(); \
    const lds_cptr vp_=vp0+sl_prev; \
    VRD(0); SBAR(); float sacc=(P0[0]+P0[1]); \
    GAPA(C0=__builtin_amdgcn_mfma_f32_32x32x16_bf16(kf[0],qr[0],negm,0,0,0), P0[2],P0[3],P0[4],P0[5],     pw0[0]=PKW(P0,0), pw0[1]=PKW(P0,2), pw0); \
    VRD(4); SBAR(); GAPA(C1=__builtin_amdgcn_mfma_f32_32x32x16_bf16(kf[1],qr[0],negm,0,0,0), P0[6],P0[7],P0[8],P0[9],     pw0[2]=PKW(P0,4), pw0[3]=PKW(P0,6), pw0); \
    VRD(1); SBAR(); GAPA(C0=__builtin_amdgcn_mfma_f32_32x32x16_bf16(kf[2],qr[1],C0,0,0,0),   P0[10],P0[11],P0[12],P0[13], pw1[0]=PKW(P0,8), pw1[1]=PKW(P0,10), pw1); \
    VRD(5); SBAR(); GAPA(C1=__builtin_amdgcn_mfma_f32_32x32x16_bf16(kf[3],qr[1],C1,0,0,0),   P0[14],P0[15],P1[0],P1[1],   pw1[2]=PKW(P0,12),pw1[3]=PKW(P0,14), pw1); \
    VRD(2); SBAR(); GAPA(C0=__builtin_amdgcn_mfma_f32_32x32x16_bf16(kf[4],qr[2],C0,0,0,0),   P1[2],P1[3],P1[4],P1[5],     pw2[0]=PKW(P1,0), pw2[1]=PKW(P1,2), pw2); \
    VRD(6); SBAR(); GAPA(C1=__builtin_amdgcn_mfma_f32_32x32x16_bf16(kf[5],qr[2],C1,0,0,0),   P1[6],P1[7],P1[8],P1[9],     pw2[2]=PKW(P1,4), pw2[3]=PKW(P1,6), pw2); \
    VRD(3); SBAR(); GAPA(C0=__builtin_amdgcn_mfma_f32_32x32x16_bf16(kf[6],qr[3],C0,0,0,0),   P1[10],P1[11],P1[12],P1[13], pw3[0]=PKW(P1,8), pw3[1]=PKW(P1,10), pw3); \
    VRD(7); SBAR(); GAPA(C1=__builtin_amdgcn_mfma_f32_32x32x16_bf16(kf[7],qr[3],C1,0,0,0),   P1[14],P1[15],0.f,0.f,       pw3[2]=PKW(P1,12),pw3[3]=PKW(P1,14), pw3); \
    l_reg+=sacc; \
    if(GK){DMA_K((t)+3,sl_cur);} if(GV){DMA_V((t)+1,sl_next);} \
    CMASK(C0,C1,t); \
    { float a=MX3(C0[0],C0[1],C1[0]),b=MX3(C0[2],C0[3],C1[1]); a=MX3(a,C1[2],C1[3]); \
      _Pragma("unroll") for(int r=4;r<16;r+=4){a=MX3(a,C0[r],C0[r+1]);b=MX3(b,C0[r+2],C0[r+3]);a=MX3(a,C1[r],C1[r+1]);b=MX3(b,C1[r+2],C1[r+3]);} \
      float rm=__builtin_fmaxf(a,b); { auto rr=__builtin_amdgcn_permlane32_swap(__float_as_uint(rm),__float_as_uint(rm),false,false); rm=__builtin_fmaxf(__uint_as_float(rr[0]),__uint_as_float(rr[1])); } \
      resc=false; \
      if(__builtin_expect(__any(rm>(float)THRL),0)){ const float dl=__builtin_fmaxf(rm,0.f); mhat+=dl; \
        _Pragma("unroll") for(int r=0;r<16;++r){C0[r]-=dl;C1[r]-=dl;} \
        _Pragma("unroll") for(int r=0;r<16;++r)negm[r]=-mhat; asm volatile("":"+v"(negm)); \
        const float f=__builtin_amdgcn_exp2f(-dl); l_reg*=f; if(hi==0)wsf[r32]=f; resc=true; } } \
    SBAR(); \
    GAPB(o[0]=__builtin_amdgcn_mfma_f32_32x32x16_bf16(PAF(0),VFR(0),o[0],0,0,0), C0,0); \
    GAPB(o[1]=__builtin_amdgcn_mfma_f32_32x32x16_bf16(PAF(0),VFR(4),o[1],0,0,0), C0,4); \
    KRD(GL,0); GAPB(o[0]=__builtin_amdgcn_mfma_f32_32x32x16_bf16(PAF(1),VFR(1),o[0],0,0,0), C0,8); \
    KRD(GL,1); GAPB(o[1]=__builtin_amdgcn_mfma_f32_32x32x16_bf16(PAF(1),VFR(5),o[1],0,0,0), C0,12); \
    KRD(GL,2); GAPB(o[0]=__builtin_amdgcn_mfma_f32_32x32x16_bf16(PAF(2),VFR(2),o[0],0,0,0), C1,0); \
    KRD(GL,3); GAPB(o[1]=__builtin_amdgcn_mfma_f32_32x32x16_bf16(PAF(2),VFR(6),o[1],0,0,0), C1,4); \
    GAPB(o[0]=__builtin_amdgcn_mfma_f32_32x32x16_bf16(PAF(3),VFR(3),o[0],0,0,0), C1,8); \
    GAPB(o[1]=__builtin_amdgcn_mfma_f32_32x32x16_bf16(PAF(3),VFR(7),o[1],0,0,0), C1,12); \
    }while(0)
  int t=1;
  #undef CMASK
  #define CMASK(P0,P1,t) do{}while(0)
  for(;t+5<NT;t+=2){
    STEP(pB0,pB1,pA0,pA1,t,true,true,true);     WAIT_BAR(2); RESC(); ROT();
    STEP(pA0,pA1,pB0,pB1,t+1,true,true,true);   WAIT_BAR(2); RESC(); ROT();
  }
  #undef CMASK
  #define CMASK(P0,P1,t) do{ if((t)==NT-1){ if(lastmode==2){ _Pragma("unroll") for(int r_=0;r_<8;++r_)P0[r_]=-INFINITY; } _Pragma("unroll") for(int r_=8;r_<16;++r_)P0[r_]=-INFINITY; _Pragma("unroll") for(int r_=0;r_<16;++r_)P1[r_]=-INFINITY; } }while(0)
  #define ENDW(tt) do{ if((tt)+3<NT){WAIT_BAR(2);} else if((tt)+2<NT){WAIT_BAR(1);} else {WAIT_BAR(0);} }while(0)
  for(;t+1<NT;t+=2){
    STEP(pB0,pB1,pA0,pA1,t,(t+3<NT),(t+1<NT),(t+1<NT));       ENDW(t);   RESC(); ROT();
    STEP(pA0,pA1,pB0,pB1,t+1,(t+4<NT),(t+2<NT),(t+2<NT));     ENDW(t+1); RESC(); ROT();
  }
  { float sacc=pA0[0]+pA0[1]; _Pragma("unroll") for(int r=2;r<16;++r)sacc+=pA0[r]; _Pragma("unroll") for(int r=0;r<16;++r)sacc+=pA1[r]; l_reg+=sacc;
    pw0=(u32x4){PKW(pA0,0),PKW(pA0,2),PKW(pA0,4),PKW(pA0,6)};pw1=(u32x4){PKW(pA0,8),PKW(pA0,10),PKW(pA0,12),PKW(pA0,14)};pw2=(u32x4){PKW(pA1,0),PKW(pA1,2),PKW(pA1,4),PKW(pA1,6)};pw3=(u32x4){PKW(pA1,8),PKW(pA1,10),PKW(pA1,12),PKW(pA1,14)};
    SBAR(); pv(o,vb0+sl_prev,PAF(0),PAF(1),PAF(2),PAF(3)); }
  #undef PKW
  #undef PAF
  #undef VFR
  #undef PIN
  #undef MX3
  #undef GAPA
  #undef GAPB
  #undef EX
  #undef VRD
  #undef KRD
  #undef STEP
  #undef ENDW
  {auto rr=__builtin_amdgcn_permlane32_swap(__float_as_uint(l_reg),__float_as_uint(l_reg),false,false);l_reg=__uint_as_float(rr[0])+__uint_as_float(rr[1]);}
  if(hi==0)wsf[32+r32]=l_reg;asm volatile("s_waitcnt lgkmcnt(0)":::"memory");
  if(part_o){ if(wid==0){
    _Pragma("unroll") for(int r=0;r<8;++r){ _Pragma("unroll") for(int d0=0;d0<2;++d0)part_o[crow(r,hi)*64+d0*32+r32]=o[d0][r]; }
    if(hi==0&&r32<16){part_ml[2*r32]=mhat;part_ml[2*r32+1]=l_reg;} } } else {
  float rli[16];
  #pragma unroll
  for(int r=0;r<16;++r)rli[r]=__builtin_amdgcn_rcpf(wsf[32+crow(r,hi)]);
  bf16*Ow=O+(qrow0+wid*QBLK)*QP+h*D; const int nv=nvalid-wid*QBLK;
  { bf16*stg=(bf16*)(shm+LDS_OST)+wid*2048;
    #pragma unroll
    for(int r=0;r<16;++r){const int orow=crow(r,hi);
      #pragma unroll
      for(int d0=0;d0<2;++d0)stg[orow*64+d0*32+r32]=__float2bfloat16(o[d0][r]*rli[r]);}
    asm volatile("s_waitcnt lgkmcnt(0)":::"memory");
    #pragma unroll
    for(int i=0;i<4;++i){const int row=i*8+(lane>>3),ch=lane&7; const u32x4 v=*(const u32x4*)(stg+row*64+ch*8); if(row<nv)ATTN_STORE16(Ow+(long)row*QP+ch*8,v);} } }
  asm volatile("s_waitcnt lgkmcnt(0)\n\ts_barrier":::"memory");
  #undef TOFF
  #undef DMA_K
  #undef DMA_V
  #undef CMASK
  #undef START
  #undef RESC
  #undef ROT
}
constexpr int ATTN_LDS_BYTES=LDS_BYTES;
#undef SBAR
#undef WAIT_BAR
}


#ifndef PG8_SP2
#define PG8_SP2 true
#endif
#ifndef PG8_ALIGN
#define PG8_ALIGN true
#endif
#define LAS __attribute__((address_space(3)))
#ifndef PHM
#define PHM 0xffff
#endif
using pg8::bf16_t; using pg8::f32x4; using pg8::u32x4; using pg8::bf16x8;
typedef float f32x16_t __attribute__((ext_vector_type(16)));
typedef float f32x2_tt __attribute__((ext_vector_type(2)));
constexpr size_t MiB = 1u << 20;
constexpr size_t WS_COS = 1 * MiB, WS_SIN = 3 * MiB, WS_HMETA = 5 * MiB, WS_W = 8 * MiB, WS_XN = 168 * MiB, WS_Y = 234 * MiB, WS_R3 = 300 * MiB, WS_R1 = 366 * MiB,
                 WS_K = WS_R1 + 66 * MiB, WS_V = WS_R1 + 83 * MiB, WS_AGG = 624 * MiB, WS_CIN = 633 * MiB, WS_END = 640 * MiB;
constexpr size_t W_IN = 0, W_OUT = W_IN + (size_t)8 * 5632 * 1024, W_QKV = W_OUT + (size_t)8 * 1024 * 2816, W_O = W_QKV + (size_t)2 * 1536 * 1024,
                 W_RIN = W_O + (size_t)2 * 1024 * 1024, W_RG = W_RIN + (size_t)2 * 2048 * 1024, W_RO = W_RG + (size_t)2 * 4096 * 256, W_END = W_RO + (size_t)2 * 1024 * 1024;
static_assert(W_END * 2 <= 160 * MiB, "weights");
constexpr int LDS_BYTES = 147456;
constexpr float ATT_C2 = 0.125f * 1.4426950408889634f;

__device__ __forceinline__ float wave_sum(float v) {
#pragma unroll
    for (int o = 1; o < 64; o <<= 1) v += __shfl_xor(v, o);
    return v;
}
__device__ __forceinline__ unsigned f2bf(float f) { unsigned u = __builtin_bit_cast(unsigned, f); return (u + 0x7fffu + ((u >> 16) & 1u)) >> 16; }
__device__ __forceinline__ unsigned pk2(float lo, float hi) { return f2bf(lo) | (f2bf(hi) << 16); }
__device__ __forceinline__ float bf2f(unsigned b) { return __uint_as_float(b << 16); }

__device__ __forceinline__ void tr_item(const float* W, int K, int N, bf16_t* WT, int k0, int n0, int dest_row0, float* scr, int lane) {
#pragma unroll 8
    for (int i = 0; i < 32; ++i) { const int kk = 2 * i + (lane >> 5); scr[kk * 33 + (lane & 31)] = W[(size_t)(k0 + kk) * N + n0 + (lane & 31)]; }
    __builtin_amdgcn_s_waitcnt(0); asm volatile("" ::: "memory");
    const int c = lane & 7;
#pragma unroll
    for (int j = 0; j < 4; ++j) { const int n = (lane >> 3) + 8 * j; const float* s = scr + (8 * c) * 33 + n;
        u32x4 o; o.x = pk2(s[0 * 33], s[1 * 33]); o.y = pk2(s[2 * 33], s[3 * 33]); o.z = pk2(s[4 * 33], s[5 * 33]); o.w = pk2(s[6 * 33], s[7 * 33]);
        *(u32x4*)(WT + (size_t)(dest_row0 + n) * K + k0 + 8 * c) = o; }
    __builtin_amdgcn_s_waitcnt(0); asm volatile("" ::: "memory");
}

#define XB_TMO      128
#define XB_XCNT(j)  (256  + 64 * (j))
#define XB_XSUB(j)  (1280 + 64 * (j))
#define XB_XGEN(j)  (2304 + 64 * (j))
#define XB_TOP      3328
#define XB_TOPGEN   3392
#define XCD_BAR_WORDS 3456
#define XB_SPIN_CAP (1u << 18)

__device__ __forceinline__ unsigned xb_ld(unsigned* p)              { return __hip_atomic_load(p, __ATOMIC_RELAXED, __HIP_MEMORY_SCOPE_AGENT); }
__device__ __forceinline__ unsigned xb_add(unsigned* p, unsigned v) { return __hip_atomic_fetch_add(p, v, __ATOMIC_RELAXED, __HIP_MEMORY_SCOPE_AGENT); }
__device__ __forceinline__ unsigned xb_xcc_id() { return (unsigned)__builtin_amdgcn_s_getreg((3 << 11) | 20) & 0xFu; }
#define XB_SPIN(cond, bar) do { unsigned _sp = 0; while (cond) { __builtin_amdgcn_s_sleep(1); \
    if ((++_sp & 255u) == 0u) { if (xb_ld(&(bar)[XB_TMO])) break; if (_sp > XB_SPIN_CAP) { atomicAdd(&(bar)[XB_TMO], 1u); break; } } } } while (0)

struct XcdBarrier {
    unsigned* bar; unsigned x;
    volatile LAS unsigned* st;
};

__device__ __forceinline__ XcdBarrier xcd_barrier_post(unsigned* bar, volatile LAS unsigned* st) {
    XcdBarrier b; b.bar = bar; b.x = xb_xcc_id(); b.st = st;
    if (threadIdx.x == 0) (void)xb_add(&bar[XB_XCNT(b.x)], 1u);
    return b;
}
__device__ __forceinline__ void xcd_barrier_complete(unsigned* bar, unsigned x, unsigned& nloc, unsigned& nx) {
    const unsigned G = gridDim.x * gridDim.y * gridDim.z;
    unsigned sum, cnt, mine, sp = 0u;
    for (;;) {
        sum = 0u; cnt = 0u; mine = 0u;
#pragma unroll
        for (unsigned j = 0; j < 16; ++j) { const unsigned c = xb_ld(&bar[XB_XCNT(j)]); sum += c; cnt += (c > 0u) ? 1u : 0u; mine = (j == x) ? c : mine; }
        if (sum == G) break;
        __builtin_amdgcn_s_sleep(1);
        if ((++sp & 255u) == 0u) { if (xb_ld(&bar[XB_TMO])) break; if (sp > XB_SPIN_CAP) { atomicAdd(&bar[XB_TMO], 1u); break; } }
    }
    nloc = mine > 0u ? mine : 1u; nx = cnt > 0u ? cnt : 1u;
}

__device__ __forceinline__ void xcd_barrier(const XcdBarrier& b) {
    asm volatile("s_waitcnt vmcnt(0)" ::: "memory");
    __syncthreads();
    if (threadIdx.x == 0) {
        unsigned* bar = b.bar;
        __builtin_amdgcn_s_waitcnt(0);
        unsigned nloc = b.st[0], nx = b.st[1];
        if (nloc == 0u) { xcd_barrier_complete(bar, b.x, nloc, nx); b.st[0] = nloc; b.st[1] = nx; }
        const unsigned old = xb_add(&bar[XB_XSUB(b.x)], 1u);
        const unsigned gen = old / nloc;
        if (old + 1u == (gen + 1u) * nloc) {
            __builtin_amdgcn_fence(__ATOMIC_RELEASE, "agent");
            asm volatile("s_waitcnt vmcnt(0)" ::: "memory");
            const unsigned og = xb_add(&bar[XB_TOP], 1u);
            const unsigned tg = og / nx;
            if (og + 1u == (tg + 1u) * nx) xb_add(&bar[XB_TOPGEN], 1u);
            else XB_SPIN(xb_ld(&bar[XB_TOPGEN]) == tg, bar);
            __builtin_amdgcn_fence(__ATOMIC_ACQUIRE, "agent");
            xb_add(&bar[XB_XGEN(b.x)], 1u);
            asm volatile("s_waitcnt vmcnt(0)" ::: "memory");
        } else {
            XB_SPIN(xb_ld(&bar[XB_XGEN(b.x)]) == gen, bar);
            __builtin_amdgcn_fence(__ATOMIC_ACQUIRE, "agent");
            asm volatile("s_waitcnt vmcnt(0)" ::: "memory");
        }
    }
    __syncthreads();
}

struct Args { const float* in[16]; float* out; unsigned char* ws; };

__device__ __forceinline__ float* hrow_ptr(float* out, float* hmeta, int row) { return row < NREAL ? out + (size_t)row * 1024 : hmeta + (size_t)(row - NREAL) * 1024; }

__device__ __forceinline__ void norm_row_store(const f32x4 (&v)[4], const float* g, bf16_t* orow, int lane) {
    float s = 0.f;
#pragma unroll
    for (int j = 0; j < 4; ++j) s += (v[j].x * v[j].x + v[j].y * v[j].y) + (v[j].z * v[j].z + v[j].w * v[j].w);
    const float r = __builtin_amdgcn_rsqf(wave_sum(s) * (1.f / 1024.f) + NORM_EPS);
    unsigned long long* o8 = (unsigned long long*)orow + lane;
#pragma unroll
    for (int j = 0; j < 4; ++j) { const f32x4 gg = ((const f32x4*)g)[lane + 64 * j];
        o8[64 * j] = (unsigned long long)pk2(v[j].x * r * gg.x, v[j].y * r * gg.y) | ((unsigned long long)pk2(v[j].z * r * gg.z, v[j].w * r * gg.w) << 32); }
}

__device__ __forceinline__ int crow_(int r, int hi) { return (r & 3) + 8 * (r >> 2) + 4 * hi; }
__device__ __forceinline__ void thin_tile(float* T, float* part, const bf16_t* A, int lda, const bf16_t* B0, const bf16_t* B1, int ldb, int K, int wave, int lane, int tid) {
    const int r32 = lane & 31, hi = lane >> 5, kc = K >> 3, kbeg = wave * kc;
    const bf16_t* ap = A + (size_t)r32 * lda + kbeg + hi * 8;
    const bf16_t* b0p = B0 + (size_t)r32 * ldb + kbeg + hi * 8;
    const bf16_t* b1p = B1 + (size_t)r32 * ldb + kbeg + hi * 8;
    f32x16_t c0 = {}, c1 = {};
#pragma unroll 1
    for (int k = 0; k < kc; k += 128) {
        bf16x8 a[8], b0[8], b1[8];
#pragma unroll
        for (int i = 0; i < 8; ++i) if (k + 16 * i < kc) { a[i] = *(const bf16x8*)(ap + k + 16 * i); b0[i] = *(const bf16x8*)(b0p + k + 16 * i); b1[i] = *(const bf16x8*)(b1p + k + 16 * i); }
#pragma unroll
        for (int i = 0; i < 8; ++i) if (k + 16 * i < kc) {
            c0 = __builtin_amdgcn_mfma_f32_32x32x16_bf16(a[i], b0[i], c0, 0, 0, 0);
            c1 = __builtin_amdgcn_mfma_f32_32x32x16_bf16(a[i], b1[i], c1, 0, 0, 0); }
    }
#pragma unroll
    for (int r = 0; r < 16; ++r) { const int tok = crow_(r, hi); part[wave * 2048 + tok * 64 + r32] = c0[r]; part[wave * 2048 + tok * 64 + 32 + r32] = c1[r]; }
    __syncthreads();
    for (int i = tid; i < 2048; i += 512) { float s = 0.f;
#pragma unroll
        for (int w = 0; w < 8; ++w) s += part[w * 2048 + i];
        T[i] = s; }
    __syncthreads();
}
enum ThinKind { TK_SWIGLU = 0, TK_PLAIN = 1, TK_RECIN = 2, TK_QKV = 3, TK_GATE = 4 };
struct ThinP { const bf16_t* A; int lda; const bf16_t* Bt; int ldb; int K; int nunits;
               bf16_t* O0; bf16_t* O1; bf16_t* O2; unsigned* AB; const float* p0; const float* p1; };
template <int KIND> __device__ __forceinline__ void thin_phase(unsigned char* lds, const ThinP& P, int tid, int wave, int lane, int bid, int G) {
    float* part = (float*)lds; float* T = (float*)(lds + 65536);
    for (int u = bid; u < P.nunits; u += G) {
        int r0, r1, ak = 0;
        if (KIND == TK_SWIGLU) { const int c0 = 32 * u; r0 = (c0 >> 7) * 256 + (c0 & 127); r1 = r0 + 128; }
        else if (KIND == TK_PLAIN || KIND == TK_RECIN) { r0 = 64 * u; r1 = r0 + 32; }
        else if (KIND == TK_QKV) { r0 = (u >> 2) * 256 + 32 * (u & 3); r1 = r0 + 128; }
        else { const int d = u >> 5, h = (u >> 3) & 3, g32 = u & 7; r0 = (d * 8 + h * 2 + (g32 >> 2)) * 256 + (g32 & 3) * 32; r1 = r0 + 128; ak = h * (ROWS_ALLOC * 256); }
        thin_tile(T, part, P.A + (size_t)NREAL * P.lda + ak, P.lda, P.Bt + (size_t)r0 * P.ldb, P.Bt + (size_t)r1 * P.ldb, P.ldb, P.K, wave, lane, tid);
        if (KIND == TK_SWIGLU) {
            for (int idx = tid; idx < 1024; idx += 512) { const int r = idx >> 5, c = idx & 31; const float gt = T[r * 64 + c], up = T[r * 64 + 32 + c];
                P.O0[(size_t)(NREAL + r) * 2816 + 32 * u + c] = (bf16_t)f2bf(gt * pg8::sigm(gt) * up); }
        } else if (KIND == TK_PLAIN) {
            for (int idx = tid; idx < 2048; idx += 512) { const int r = idx >> 6, c = idx & 63; P.O0[(size_t)(NREAL + r) * 1024 + 64 * u + c] = (bf16_t)f2bf(T[idx]); }
        } else if (KIND == TK_RECIN) {
            for (int idx = tid; idx < 2048; idx += 512) { const int r = idx >> 6, c = idx & 63; const float v = T[idx];
                if (u < 16) P.O0[(size_t)(NREAL + r) * 1024 + 64 * u + c] = (bf16_t)f2bf(pg8::gelu_tanh(v));
                else P.O1[(size_t)(NREAL + r) * 1024 + 64 * (u - 16) + c] = (bf16_t)f2bf(v); }
        } else if (KIND == TK_QKV) {
            for (int idx = tid; idx < 2048; idx += 512) { const int r = idx >> 6, dd = idx & 63; const float v = T[idx];
                if (u < 20) { const float rms = __builtin_amdgcn_rsqf(wave_sum(v * v) * (1.f / 64.f) + NORM_EPS);
                    if (u < 16) P.O0[(size_t)(NREAL + r) * 1024 + 64 * u + dd] = (bf16_t)f2bf(v * rms * P.p0[dd] * ATT_C2);
                    else P.O1[(size_t)(NREAL + r) * 256 + 64 * (u - 16) + dd] = (bf16_t)f2bf(v * rms * P.p1[dd]); }
                else P.O2[(size_t)(NREAL + r) * 256 + 64 * (u - 20) + dd] = (bf16_t)f2bf(v); }
        } else {
            const int d = u >> 5, h = (u >> 3) & 3, g32 = u & 7, cb = h * 256 + g32 * 32;
            for (int idx = tid; idx < 1024; idx += 512) { const int r = idx >> 5, c = idx & 31, ch = cb + c;
                P.AB[((size_t)d * NROWS + NREAL + r) * 1024 + ch] = pk2(T[r * 64 + c], T[r * 64 + 32 + c]); }
        }
        __syncthreads();
    }
}

__device__ __forceinline__ int chunk_row0(int b, int j) { return j == 0 ? NREAL + b * 16 : b * 16384 + (j - 1) * 64; }
__device__ __forceinline__ void ab_from(unsigned w, float xc, float sp, float rb, float ib, float& a, float& b) {
    const float r = pg8::sigm(__uint_as_float(w << 16) + rb), ig = pg8::sigm(__uint_as_float(w & 0xffff0000u) + ib);
    a = __builtin_amdgcn_exp2f(sp * r); b = __builtin_amdgcn_sqrtf((1.f - a) * (1.f + a)) * ig * xc;
}
__device__ __forceinline__ float sp_of(float lam) { const float e = __builtin_amdgcn_exp2f(-LOG2E * lam); return -8.f * LOG2E * (0.6931471805599453f * __builtin_amdgcn_logf(1.f + e)); }
template <int LEN> __device__ __forceinline__ void scanA_item(const unsigned* ab, const bf16_t* xc, int dir, float sp, float rb, float ib, f32x2_tt* outp) {
    constexpr int BT = LEN < 32 ? LEN : 32;
    float h = 0.f, P = 1.f;
#pragma unroll 1
    for (int t0 = 0; t0 < LEN; t0 += BT) {
        unsigned w[BT]; unsigned short x[BT];
#pragma unroll
        for (int t = 0; t < BT; ++t) { const int tt = dir ? LEN - 1 - (t0 + t) : t0 + t; w[t] = ab[(size_t)tt * 1024]; x[t] = xc[(size_t)tt * 256]; }
#pragma unroll
        for (int t = 0; t < BT; ++t) { float a, b; ab_from(w[t], bf2f(x[t]), sp, rb, ib, a, b); h = a * h + b; P *= a; }
    }
    *outp = (f32x2_tt){P, h};
}
template <int LEN> __device__ __forceinline__ void scanC_item(const unsigned* abf, const unsigned* abb, const bf16_t* xc, const bf16_t* gate, bf16_t* y, float cf, float cb, float spf, float spb, float rbf, float ibf, float rbb, float ibb) {
    constexpr int BT = LEN < 32 ? LEN : 32;
    float hf[LEN]; float h = cf;
#pragma unroll
    for (int t0 = 0; t0 < LEN; t0 += BT) {
        unsigned w[BT]; unsigned short x[BT];
#pragma unroll
        for (int t = 0; t < BT; ++t) { w[t] = abf[(size_t)(t0 + t) * 1024]; x[t] = xc[(size_t)(t0 + t) * 256]; }
#pragma unroll
        for (int t = 0; t < BT; ++t) { float a, b; ab_from(w[t], bf2f(x[t]), spf, rbf, ibf, a, b); h = a * h + b; hf[t0 + t] = h; }
        asm volatile("" ::: "memory");
    }
    h = cb;
#pragma unroll
    for (int t0 = LEN - BT; t0 >= 0; t0 -= BT) {
        unsigned w[BT]; unsigned short x[BT], g[BT];
#pragma unroll
        for (int t = 0; t < BT; ++t) { w[t] = abb[(size_t)(t0 + t) * 1024]; x[t] = xc[(size_t)(t0 + t) * 256]; g[t] = gate[(size_t)(t0 + t) * 1024]; }
#pragma unroll
        for (int t = BT - 1; t >= 0; --t) { float a, b; ab_from(w[t], bf2f(x[t]), spb, rbb, ibb, a, b); h = a * h + b;
            y[(size_t)(t0 + t) * 1024] = (bf16_t)f2bf((hf[t0 + t] + h) * bf2f(g[t])); }
        asm volatile("" ::: "memory");
    }
}


typedef const __attribute__((address_space(4))) Args* KArgP;
#define KARGS() ({ KArgP p_ = (KArgP)__builtin_amdgcn_kernarg_segment_ptr(); asm volatile("" : "+s"(p_)); p_; })
#define GSYNC() do { KArgP apb_ = KARGS(); XcdBarrier b_; b_.bar = (unsigned*)(apb_->ws + 16384); b_.x = xb_xcc_id(); b_.st = (volatile LAS unsigned*)(ldsl + 131072 + 32); xcd_barrier(b_); } while (0)
#define WSP(T, off) ((T*)(ws + (off)))
#define IDS() int tid_ = threadIdx.x; asm volatile("" : "+v"(tid_)); const int tid = tid_, lane = tid & 63, wave = __builtin_amdgcn_readfirstlane(tid >> 6); const int G = gridDim.x, bid = blockIdx.x; \
              const int vcu = (G % 8 == 0) ? (bid % 8) * (G / 8) + bid / 8 : bid; const int gw = vcu * 8 + wave, NGW = G * 8; const int gtid = bid * 512 + tid, GT = G * 512; \
              (void)lane; (void)vcu; (void)gw; (void)NGW; (void)gtid; (void)GT;

__global__ void __launch_bounds__(512, 2) fwd_megakernel(Args args_unused) {
    extern __shared__ __attribute__((aligned(16))) unsigned char lds[];
    cg::grid_group grid = cg::this_grid();
    LAS unsigned char* ldsl = (LAS unsigned char*)lds;
    for (int u = threadIdx.x; u < 64; u += 512) ((LAS unsigned*)(ldsl + 131072))[u] = 0u;
    __syncthreads();
    { KArgP ap0 = KARGS(); (void)xcd_barrier_post((unsigned*)(ap0->ws + 16384), (volatile LAS unsigned*)(ldsl + 131072 + 32)); }
    grid.sync();

#if PHM & 1
    {
        KArgP ap = KARGS(); unsigned char* ws = ap->ws; IDS();
        float* scr = (float*)(lds + wave * 16384); bf16_t* Wb = WSP(bf16_t, WS_W);
#ifdef NANFILL
        {
            u32x4* f0 = (u32x4*)(ws + WS_Y); const size_t n16 = (WS_END - WS_Y) / 16; const u32x4 q = {0xffffffffu, 0xffffffffu, 0xffffffffu, 0xffffffffu};
            for (size_t i = gtid; i < n16; i += GT) f0[i] = q;
        }
#endif
        constexpr int IA = 8 * 2816, IB = 8 * 1408, IC = 2 * 768, ID = 2 * 512, IE = 2 * 1024, IF = 32 * 32, IG = 2 * 512, NIT = IA + IB + IC + ID + IE + IF + IG;
        for (int it = gw; it < NIT; it += NGW) {
            int r = it;
            if (r < IA) { const int mat = r / 2816, q = r % 2816, kb = q / 176, nb = q % 176, n0 = 32 * nb, bj = n0 / 2816, c = n0 % 2816;
                tr_item(ap->in[3] + (size_t)mat * 1024 * 5632, 1024, 5632, Wb + W_IN + (size_t)mat * 5632 * 1024, 64 * kb, n0, (c >> 7) * 256 + bj * 128 + (c & 127), scr, lane); continue; } r -= IA;
            if (r < IB) { const int mat = r / 1408, q = r % 1408, kb = q / 32, nb = q % 32;
                tr_item(ap->in[4] + (size_t)mat * 2816 * 1024, 2816, 1024, Wb + W_OUT + (size_t)mat * 1024 * 2816, 64 * kb, 32 * nb, 32 * nb, scr, lane); continue; } r -= IB;
            if (r < IC) { const int mat = r / 768, q = r % 768, kb = q / 48, nb = q % 48, n0 = 32 * nb, tile = n0 >> 8, rr = n0 & 255;
                tr_item(ap->in[5] + (size_t)mat * 1024 * 1536, 1024, 1536, Wb + W_QKV + (size_t)mat * 1536 * 1024, 64 * kb, n0, tile * 256 + 128 * ((rr & 63) >> 5) + 32 * (rr >> 6), scr, lane); continue; } r -= IC;
            if (r < ID) { const int mat = r / 512, q = r % 512, kb = q / 32, nb = q % 32;
                tr_item(ap->in[8] + (size_t)mat * 1024 * 1024, 1024, 1024, Wb + W_O + (size_t)mat * 1024 * 1024, 64 * kb, 32 * nb, 32 * nb, scr, lane); continue; } r -= ID;
            if (r < IE) { const int mat = r / 1024, q = r % 1024, kb = q / 64, nb = q % 64;
                tr_item(ap->in[9] + (size_t)mat * 1024 * 2048, 1024, 2048, Wb + W_RIN + (size_t)mat * 2048 * 1024, 64 * kb, 32 * nb, 32 * nb, scr, lane); continue; } r -= IE;
            if (r < IF) { const int sub = r >> 5, q = r & 31, kb = q >> 3, nb = q & 7, n0 = 32 * nb, jl = sub >> 4, d = (sub >> 3) & 1, g = (sub >> 2) & 1, h = sub & 3;
                tr_item(ap->in[12] + (size_t)sub * 256 * 256, 256, 256, Wb + W_RG + (size_t)jl * 4096 * 256, 64 * kb, n0, (d * 8 + h * 2 + (n0 >> 7)) * 256 + g * 128 + (n0 & 127), scr, lane); continue; } r -= IF;
            { const int mat = r / 512, q = r % 512, kb = q / 32, nb = q % 32;
                tr_item(ap->in[15] + (size_t)mat * 1024 * 1024, 1024, 1024, Wb + W_RO + (size_t)mat * 1024 * 1024, 64 * kb, 32 * nb, 32 * nb, scr, lane); }
        }
        float* tcos = WSP(float, WS_COS); float* tsin = WSP(float, WS_SIN);
        for (int idx = gtid; idx < 16384 * 32; idx += GT) { const int s = idx >> 5, j = idx & 31, jj = j & 15; const float pos = (float)(j < 16 ? (s >> 6) : (s & 63));
            const float inv = __builtin_amdgcn_exp2f(-(float)jj * (13.287712379549449f / 16.f)); const float th = pos * inv;
            const double turns = (double)th * 0.15915494309189535; const float fr = (float)(turns - __builtin_floor(turns));
            tcos[idx] = __builtin_amdgcn_cosf(fr); tsin[idx] = __builtin_amdgcn_sinf(fr); }
        float* out = ap->out; float* hmeta = WSP(float, WS_HMETA); bf16_t* XN = WSP(bf16_t, WS_XN); const float* gains = ap->in[2];
        for (int row = gw; row < NROWS; row += NGW) {
            const float* src = row < NREAL ? ap->in[0] + (size_t)row * 1024 : ap->in[1] + (size_t)((row - NREAL) & 15) * 1024;
            float* hr = hrow_ptr(out, hmeta, row); f32x4 v[4];
#pragma unroll
            for (int j = 0; j < 4; ++j) { v[j] = ((const f32x4*)src)[lane + 64 * j]; ((f32x4*)hr)[lane + 64 * j] = v[j]; }
            norm_row_store(v, gains, XN + (size_t)row * 1024, lane);
        }
    }
#endif
    GSYNC();

#pragma unroll 1
    for (int layer = 0; layer < 4; ++layer) {
#pragma unroll 1
        for (int stage = 0; stage < 3; ++stage) {
            const int jl = layer >> 1;
#ifdef TESTSKIP
            if (stage == 1 && ((TESTSKIP >> (layer & 1)) & 1)) continue;
#endif
            int oAsel, oK; size_t oBoff; float coef; int gpost_i, gpre_i;
            if (stage != 1) {
                const int f = stage >> 1;
                {
                    KArgP ap = KARGS(); unsigned char* ws = ap->ws; IDS();
                    const bf16_t* Win = WSP(bf16_t, WS_W) + W_IN + (size_t)(layer * 2 + f) * 5632 * 1024; bf16_t* XN = WSP(bf16_t, WS_XN); bf16_t* ACT = WSP(bf16_t, WS_R1);
#if PHM & 2
                    { pg8::Gemm g{XN, Win, 1024, 1024, 1024, 0}; pg8::StaticOrder S; S.init(NREAL, 5632, G, bid); pg8::EpiSwiGLU E{ACT};
                      pg8::gemm_phase<pg8::EpiSwiGLU, pg8::StaticOrder, PG8_ALIGN, PG8_SP2>(ldsl, g, S, E); }
#endif
#if PHM & 4
                    { ThinP P{XN, 1024, Win, 1024, 1024, 88, ACT, nullptr, nullptr, nullptr, nullptr, nullptr}; thin_phase<TK_SWIGLU>(lds, P, tid, wave, lane, bid, G); }
#endif
                }
                GSYNC();
                oAsel = 0; oK = 2816; oBoff = W_OUT + (size_t)(layer * 2 + f) * 1024 * 2816; coef = 0.5f; gpost_i = layer * 6 + (f ? 5 : 1);
                gpre_i = f ? (layer < 3 ? layer * 6 + 6 : -1) : layer * 6 + 2;
            } else if ((layer & 1) == 0) {
                {
                    KArgP ap = KARGS(); unsigned char* ws = ap->ws; IDS();
                    const bf16_t* Wqkv = WSP(bf16_t, WS_W) + W_QKV + (size_t)jl * 1536 * 1024; const float* qg = ap->in[6] + jl * 64; const float* kg = ap->in[7] + jl * 64;
                    bf16_t* XN = WSP(bf16_t, WS_XN); bf16_t* QO = WSP(bf16_t, WS_R1); bf16_t* KB = WSP(bf16_t, WS_K); bf16_t* VB = WSP(bf16_t, WS_V);
#if PHM & 8
                    { pg8::Gemm g{XN, Wqkv, 1024, 1024, 1024, 0}; pg8::StaticOrder S; S.init(NREAL, 1536, G, bid); pg8::EpiQKV E{QO, KB, VB, qg, kg, WSP(float, WS_COS), WSP(float, WS_SIN), ATT_C2};
                      pg8::gemm_phase<pg8::EpiQKV, pg8::StaticOrder, PG8_ALIGN, PG8_SP2>(ldsl, g, S, E); }
#endif
#if PHM & 4
                    { ThinP P{XN, 1024, Wqkv, 1024, 1024, 24, QO, KB, VB, nullptr, qg, kg}; thin_phase<TK_QKV>(lds, P, tid, wave, lane, bid, G); }
#endif
                }
                GSYNC();
#if PHM & 16
                {
                    KArgP ap = KARGS(); unsigned char* ws = ap->ws; IDS();
                    bf16_t* QO = WSP(bf16_t, WS_R1); bf16_t* KB = WSP(bf16_t, WS_K); bf16_t* VB = WSP(bf16_t, WS_V);
                    float* PART_O = WSP(float, WS_AGG); float* PART_ML = WSP(float, WS_AGG + 2 * MiB);
                    for (int i = 0;; ++i) {
                        int bh, qb = 0, tb = 0, nt = 257, lm = 1; bool meta = false; float* po = nullptr; float* pml = nullptr;
                        if (G == 256) { if (i < 8) { bh = vcu >> 3; qb = (vcu & 7) + 8 * i; }
                                        else if (i == 8) { bh = vcu >> 3; meta = true; const int pc = vcu & 7; tb = 32 * pc; nt = 33; lm = (pc == 7) ? 1 : 2;
                                                           po = PART_O + (size_t)((bh * 8 + pc) * 16) * 64; pml = PART_ML + (size_t)((bh * 8 + pc) * 16) * 2; }
                                        else break; }
                        else { const int uid = i * G + bid; if (uid >= 2080) break; if (uid < 2048) { bh = uid >> 6; qb = uid & 63; } else { bh = uid - 2048; meta = true; } }
                        const int b = bh >> 4, h = bh & 15;
                        const long qrow0 = meta ? (long)(NREAL + b * 16) : (long)b * 16384 + (long)qb * 256;
                        attn_body::attn_unit<8>(b, h, qrow0, meta ? 16 : 256, tb, nt, lm, po, pml, (const attn_body::bf16*)QO, (const attn_body::bf16*)KB, (const attn_body::bf16*)VB, (attn_body::bf16*)QO, (char*)lds);
                    }
                }
#endif
                GSYNC();
                {
                    KArgP ap = KARGS(); unsigned char* ws = ap->ws; IDS();
                    if (G == 256) {
                        const float* PART_O = WSP(float, WS_AGG); const float* PART_ML = WSP(float, WS_AGG + 2 * MiB); bf16_t* QO = WSP(bf16_t, WS_R1);
                        for (int idx = gtid; idx < 32 * 16 * 64; idx += GT) { const int bh = idx >> 10, q = (idx >> 6) & 15, d = idx & 63;
                            float mp[8], M = -INFINITY;
#pragma unroll
                            for (int pc = 0; pc < 8; ++pc) { mp[pc] = PART_ML[(size_t)((bh * 8 + pc) * 16 + q) * 2]; M = fmaxf(M, mp[pc]); }
                            float num = 0.f, den = 0.f;
#pragma unroll
                            for (int pc = 0; pc < 8; ++pc) { const float w = __builtin_amdgcn_exp2f(mp[pc] - M); num += w * PART_O[(size_t)((bh * 8 + pc) * 16 + q) * 64 + d]; den += w * PART_ML[(size_t)((bh * 8 + pc) * 16 + q) * 2 + 1]; }
                            QO[(size_t)(NREAL + (bh >> 4) * 16 + q) * 1024 + (bh & 15) * 64 + d] = (bf16_t)f2bf(num / den); }
                    }
                }
                GSYNC();
                oAsel = 1; oK = 1024; oBoff = W_O + (size_t)jl * 1024 * 1024; coef = 1.f; gpost_i = layer * 6 + 3; gpre_i = layer * 6 + 4;
            } else {
                {
                    KArgP ap = KARGS(); unsigned char* ws = ap->ws; IDS();
                    const bf16_t* Wrin = WSP(bf16_t, WS_W) + W_RIN + (size_t)jl * 2048 * 1024; bf16_t* XN = WSP(bf16_t, WS_XN); bf16_t* GATE = WSP(bf16_t, WS_Y); bf16_t* XR = WSP(bf16_t, WS_R3);
#if PHM & 32
                    { pg8::Gemm g{XN, Wrin, 1024, 1024, 1024, 0}; pg8::StaticOrder S; S.init(NREAL, 2048, G, bid); pg8::EpiRecIn E{GATE, XR};
                      pg8::gemm_phase<pg8::EpiRecIn, pg8::StaticOrder, PG8_ALIGN, PG8_SP2>(ldsl, g, S, E); }
#endif
#if PHM & 4
                    { ThinP P{XN, 1024, Wrin, 1024, 1024, 32, GATE, XR, nullptr, nullptr, nullptr, nullptr}; thin_phase<TK_RECIN>(lds, P, tid, wave, lane, bid, G); }
#endif
                }
                GSYNC();
#if PHM & 64
                {
                    KArgP ap = KARGS(); unsigned char* ws = ap->ws; IDS();
                    const bf16_t* XR = WSP(bf16_t, WS_R3); bf16_t* XC = WSP(bf16_t, WS_XN);
                    const float* cw = ap->in[10] + (size_t)jl * 4 * 1024; const float* cbias = ap->in[11] + (size_t)jl * 1024;
                    for (int it = gtid; it < NROWS * 128; it += GT) {
                        const int R = it >> 7, ck = (it & 127) * 8; int b, p;
                        if (R < NREAL) { b = R >> 14; p = 16 + (R & 16383); } else { b = (R - NREAL) >> 4; p = (R - NREAL) & 15; }
                        f32x4 a0 = *(const f32x4*)(cbias + ck), a1 = *(const f32x4*)(cbias + ck + 4);
#pragma unroll
                        for (int j = 0; j < 4; ++j) { const int pp = p + j - 2;
                            if (pp >= 0 && pp < 16400) { const int sr = pp < 16 ? NREAL + b * 16 + pp : b * 16384 + pp - 16;
                                const u32x4 x = *(const u32x4*)(XR + (size_t)sr * 1024 + ck); const f32x4 w0 = *(const f32x4*)(cw + j * 1024 + ck), w1 = *(const f32x4*)(cw + j * 1024 + ck + 4);
                                a0[0] += __uint_as_float(x[0] << 16) * w0[0]; a0[1] += __uint_as_float(x[0] & 0xffff0000u) * w0[1]; a0[2] += __uint_as_float(x[1] << 16) * w0[2]; a0[3] += __uint_as_float(x[1] & 0xffff0000u) * w0[3];
                                a1[0] += __uint_as_float(x[2] << 16) * w1[0]; a1[1] += __uint_as_float(x[2] & 0xffff0000u) * w1[1]; a1[2] += __uint_as_float(x[3] << 16) * w1[2]; a1[3] += __uint_as_float(x[3] & 0xffff0000u) * w1[3]; } }
                        u32x4 o; o.x = pk2(a0[0], a0[1]); o.y = pk2(a0[2], a0[3]); o.z = pk2(a1[0], a1[1]); o.w = pk2(a1[2], a1[3]);
                        *(u32x4*)(XC + ((size_t)(ck >> 8) * ROWS_ALLOC + R) * 256 + (ck & 255)) = o;
                    }
                }
#endif
                GSYNC();
                {
                    KArgP ap = KARGS(); unsigned char* ws = ap->ws; IDS();
                    const bf16_t* Wrg = WSP(bf16_t, WS_W) + W_RG + (size_t)jl * 4096 * 256; bf16_t* XC = WSP(bf16_t, WS_XN); unsigned* AB = WSP(unsigned, WS_R1);
#if (PHM & 128) && (!defined(RECTEST) || RECTEST >= 2)
                    { pg8::Gemm g{XC, Wrg, 256, 256, 256, 1}; pg8::StaticOrder S; S.init(NREAL, 4096, G, bid); pg8::EpiGate E{AB};
                      pg8::gemm_phase<pg8::EpiGate, pg8::StaticOrder, PG8_ALIGN, PG8_SP2>(ldsl, g, S, E); }
#endif
#if (PHM & 4) && (!defined(RECTEST) || RECTEST >= 2)
                    { ThinP P{XC, 256, Wrg, 256, 256, 64, nullptr, nullptr, nullptr, AB, nullptr, nullptr}; thin_phase<TK_GATE>(lds, P, tid, wave, lane, bid, G); }
#endif
                }
                GSYNC();
#if (PHM & 256) && (!defined(RECTEST) || RECTEST >= 2)
                {
                    KArgP ap = KARGS(); unsigned char* ws = ap->ws; IDS();
                    const unsigned* AB = WSP(unsigned, WS_R1); const bf16_t* XC = WSP(bf16_t, WS_XN); f32x2_tt* AGG = WSP(f32x2_tt, WS_AGG); const float* lam = ap->in[14] + (size_t)jl * 2 * 1024; const float* gbias = ap->in[13] + (size_t)jl * 4 * 1024;
                    for (int it = gw; it < 2 * 2 * NCHUNK * 16; it += NGW) {
                        const int cgp = it & 15, q = it >> 4, j = q % NCHUNK, db = q / NCHUNK, d = db >> 1, b = db & 1, c = cgp * 64 + lane;
                        const unsigned* ab = AB + ((size_t)d * NROWS + chunk_row0(b, j)) * 1024 + c; f32x2_tt* op = AGG + ((size_t)db * NCHUNK + j) * 1024 + c;
                        const bf16_t* xp = XC + ((size_t)(c >> 8) * ROWS_ALLOC + chunk_row0(b, j)) * 256 + (c & 255); const float sp = sp_of(lam[d * 1024 + c]); const float rb = gbias[(d * 2 + 0) * 1024 + c], ib = gbias[(d * 2 + 1) * 1024 + c];
                        if (j == 0) scanA_item<16>(ab, xp, d, sp, rb, ib, op); else scanA_item<64>(ab, xp, d, sp, rb, ib, op);
                    }
                }
#endif
                GSYNC();
#if (PHM & 512) && (!defined(RECTEST) || RECTEST >= 2)
                {
                    KArgP ap = KARGS(); unsigned char* ws = ap->ws; IDS();
                    if (wave == 0 && bid < 64) {
                        const int idx = bid * 64 + lane, db = idx >> 10, d = db >> 1, c = idx & 1023;
                        const f32x2_tt* ag = WSP(f32x2_tt, WS_AGG) + (size_t)db * NCHUNK * 1024 + c; float* ci = WSP(float, WS_CIN) + (size_t)db * NCHUNK * 1024 + c; float carry = 0.f;
#pragma unroll 1
                        for (int j0 = 0; j0 < 256; j0 += 16) { f32x2_tt v[16];
#pragma unroll
                            for (int k = 0; k < 16; ++k) { const int js = j0 + k; const int jj = d ? NCHUNK - 1 - js : js; v[k] = ag[(size_t)jj * 1024]; }
#pragma unroll
                            for (int k = 0; k < 16; ++k) { const int js = j0 + k; const int jj = d ? NCHUNK - 1 - js : js; ci[(size_t)jj * 1024] = carry; carry = v[k].x * carry + v[k].y; }
                        }
                        ci[(size_t)(d ? 0 : NCHUNK - 1) * 1024] = carry;
                    }
                }
#endif
                GSYNC();
#if PHM & 1024
                {
                    KArgP ap = KARGS(); unsigned char* ws = ap->ws; IDS();
                    const unsigned* AB = WSP(unsigned, WS_R1); const bf16_t* XC = WSP(bf16_t, WS_XN); const float* CIN = WSP(float, WS_CIN); const float* lam = ap->in[14] + (size_t)jl * 2 * 1024; const float* gbias = ap->in[13] + (size_t)jl * 4 * 1024;
                    const bf16_t* GATE = WSP(bf16_t, WS_Y); bf16_t* YS = WSP(bf16_t, WS_R3);
                    for (int it = gw; it < 2 * NCHUNK * 16; it += NGW) {
                        const int cgp = it & 15, q = it >> 4, j = q % NCHUNK, b = q / NCHUNK, c = cgp * 64 + lane; const int r0 = chunk_row0(b, j);
                        const unsigned* abf = AB + ((size_t)r0) * 1024 + c; const unsigned* abb = AB + ((size_t)NROWS + r0) * 1024 + c;
                        const float cf = CIN[((size_t)(0 * 2 + b) * NCHUNK + j) * 1024 + c], cb2 = CIN[((size_t)(1 * 2 + b) * NCHUNK + j) * 1024 + c];
                        const float spf = sp_of(lam[c]), spb = sp_of(lam[1024 + c]); const float rbf = gbias[c], ibf = gbias[1024 + c], rbb = gbias[2048 + c], ibb = gbias[3072 + c];
                        const bf16_t* xp = XC + ((size_t)(c >> 8) * ROWS_ALLOC + r0) * 256 + (c & 255);
#if defined(RECTEST) && RECTEST == 1
                        { const int len = j == 0 ? 16 : 64; for (int t = 0; t < len; ++t) YS[(size_t)(r0 + t) * 1024 + c] = (bf16_t)f2bf(bf2f(xp[(size_t)t * 256]) * bf2f(GATE[(size_t)(r0 + t) * 1024 + c])); continue; }
#endif
#if defined(RECTEST) && RECTEST == 2
                        { const int len = j == 0 ? 16 : 64; for (int t = 0; t < len; ++t) { const unsigned wf = abf[(size_t)t * 1024], wb = abb[(size_t)t * 1024];
                            YS[(size_t)(r0 + t) * 1024 + c] = (bf16_t)f2bf((__uint_as_float(wf << 16) + __uint_as_float(wb & 0xffff0000u) + __uint_as_float(wf & 0xffff0000u) + __uint_as_float(wb << 16) + cf + cb2) * bf2f(GATE[(size_t)(r0 + t) * 1024 + c])); } continue; }
#endif
                        if (j == 0) scanC_item<16>(abf, abb, xp, GATE + (size_t)r0 * 1024 + c, YS + (size_t)r0 * 1024 + c, cf, cb2, spf, spb, rbf, ibf, rbb, ibb);
                        else scanC_item<64>(abf, abb, xp, GATE + (size_t)r0 * 1024 + c, YS + (size_t)r0 * 1024 + c, cf, cb2, spf, spb, rbf, ibf, rbb, ibb);
                    }
                }
#endif
                GSYNC();
                oAsel = 2; oK = 1024; oBoff = W_RO + (size_t)jl * 1024 * 1024; coef = 1.f; gpost_i = layer * 6 + 3; gpre_i = layer * 6 + 4;
            }
            {
                KArgP ap = KARGS(); unsigned char* ws = ap->ws; IDS();
                const bf16_t* oA = oAsel == 2 ? WSP(bf16_t, WS_R3) : WSP(bf16_t, WS_R1); const bf16_t* oBt = WSP(bf16_t, WS_W) + oBoff; bf16_t* Yb = WSP(bf16_t, WS_Y);
#if PHM & 2048
                { pg8::Gemm g{oA, oBt, oK, oK, oK, 0}; pg8::StaticOrder S; S.init(NREAL, 1024, G, bid); pg8::EpiPlain E{Yb};
                  pg8::gemm_phase<pg8::EpiPlain, pg8::StaticOrder, PG8_ALIGN, PG8_SP2>(ldsl, g, S, E); }
#endif
#if PHM & 4
                { ThinP P{oA, oK, oBt, oK, oK, 16, Yb, nullptr, nullptr, nullptr, nullptr, nullptr}; thin_phase<TK_PLAIN>(lds, P, tid, wave, lane, bid, G); }
#endif
            }
            GSYNC();
#if PHM & 4096
            {
                KArgP ap = KARGS(); unsigned char* ws = ap->ws; IDS();
                float* out = ap->out; float* hmeta = WSP(float, WS_HMETA); const bf16_t* Yb = WSP(bf16_t, WS_Y); bf16_t* XN = WSP(bf16_t, WS_XN);
                const float* gpost = ap->in[2] + (size_t)gpost_i * 1024; const float* gpre = gpre_i >= 0 ? ap->in[2] + (size_t)gpre_i * 1024 : nullptr;
                for (int row = gw; row < NROWS; row += NGW) {
                    float* hr = hrow_ptr(out, hmeta, row); const unsigned long long* yr = (const unsigned long long*)(Yb + (size_t)row * 1024) + lane;
                    f32x4 y[4], v[4]; float s = 0.f;
#pragma unroll
                    for (int j = 0; j < 4; ++j) { const unsigned long long w = yr[64 * j]; const unsigned lo = (unsigned)w, hi = (unsigned)(w >> 32);
                        y[j] = (f32x4){__uint_as_float(lo << 16), __uint_as_float(lo & 0xffff0000u), __uint_as_float(hi << 16), __uint_as_float(hi & 0xffff0000u)};
                        v[j] = ((const f32x4*)hr)[lane + 64 * j];
                        s += (y[j].x * y[j].x + y[j].y * y[j].y) + (y[j].z * y[j].z + y[j].w * y[j].w); }
                    const float r = coef * __builtin_amdgcn_rsqf(wave_sum(s) * (1.f / 1024.f) + NORM_EPS);
#pragma unroll
                    for (int j = 0; j < 4; ++j) { const f32x4 gg = ((const f32x4*)gpost)[lane + 64 * j]; v[j] = v[j] + y[j] * r * gg; ((f32x4*)hr)[lane + 64 * j] = v[j]; }
                    if (gpre) norm_row_store(v, gpre, XN + (size_t)row * 1024, lane);
                }
            }
#endif
            GSYNC();
        }
    }
}

extern "C" void kernel_launch(void* const* d_in, const int* in_sizes, int n_in, void* d_out, int out_size, void* d_ws, size_t ws_size, hipStream_t stream) {
    static int grid_blocks = 0;
    if (grid_blocks == 0) {
        if (n_in != 16 || ws_size < WS_END) { fprintf(stderr, "kernel_launch: unexpected n_in %d / ws_size %zu\n", n_in, ws_size); grid_blocks = -1; return; }
        int dev = 0, cus = 0, per_cu = 0;
        (void)hipGetDevice(&dev); (void)hipDeviceGetAttribute(&cus, hipDeviceAttributeMultiprocessorCount, dev);
        if (hipFuncSetAttribute((const void*)fwd_megakernel, hipFuncAttributeMaxDynamicSharedMemorySize, LDS_BYTES) != hipSuccess) { fprintf(stderr, "kernel_launch: hipFuncSetAttribute failed\n"); grid_blocks = -1; return; }
        if (hipOccupancyMaxActiveBlocksPerMultiprocessor(&per_cu, (const void*)fwd_megakernel, 512, LDS_BYTES) != hipSuccess || per_cu < 1) { fprintf(stderr, "kernel_launch: occupancy query says %d\n", per_cu); per_cu = 1; }
        (void)hipGetLastError();
        grid_blocks = cus > 0 ? cus : 256;
    }
    if (grid_blocks < 0) return;
    if (hipMemsetAsync(d_ws, 0, 65536, stream) != hipSuccess) { fprintf(stderr, "kernel_launch: hipMemsetAsync failed\n"); return; }
    Args a{};
    for (int i = 0; i < 16; ++i) a.in[i] = (const float*)d_in[i];
    a.out = (float*)d_out; a.ws = (unsigned char*)d_ws;
    void* kargs[] = {&a};
    hipError_t e = hipLaunchCooperativeKernel((const void*)fwd_megakernel, dim3(grid_blocks), dim3(512), kargs, LDS_BYTES, stream);
    if (e != hipSuccess) fprintf(stderr, "cooperative launch failed: %s (grid %d)\n", hipGetErrorString(e), grid_blocks);
}
```

```cpp
#include <hip/hip_runtime.h>
#include <hip/hip_cooperative_groups.h>
#include <cstdio>
#include <cstdint>
namespace cg = cooperative_groups;

constexpr int NREAL = 32768, NROWS = 32800, ROWS_ALLOC = 33280;
constexpr int DMODEL = 1024, DFF = 2816, LSEQ_ = 16384, NCHUNK = 257;
constexpr float NORM_EPS = 1e-6f;
constexpr float LOG2E = 1.4426950408889634f;

namespace pg8 {

#define PG8_LAS __attribute__((address_space(3)))
typedef unsigned short bf16_t;
typedef short bf16x8 __attribute__((ext_vector_type(8)));
typedef float f32x4 __attribute__((ext_vector_type(4)));
typedef unsigned u32x4 __attribute__((ext_vector_type(4)));
constexpr int BM = 256, BK = 64, HALF = 128, HTB = HALF * BK * 2  , STAGE_BYTES = 8 * HTB, NXCD = 8, WGM = 8;

__host__ __device__ __forceinline__ int lds_byte(int r, int c) { const int st = (r >> 4) * 2 + (c >> 5), rr = r & 15, cc = c & 31, ob = rr * 64 + cc * 2; return st * 1024 + (ob ^ (((ob >> 9) & 1) << 5)); }
__host__ __device__ __forceinline__ void stage_rc(int b, int& R, int& C) { const int st = b / 1024, sb = b % 1024, swz = sb ^ (((sb >> 9) & 1) << 5); R = (st >> 1) * 16 + swz / 64; C = (st & 1) * 32 + (swz % 64) / 2; }
__host__ __device__ __forceinline__ int perm32(int rho) { const int n = rho >> 4, i = rho & 15; return 8 * (i >> 2) + 4 * n + (i & 3); }

struct Unit { int pm, pn; };
struct Gemm { const bf16_t* A; const bf16_t* Bt; int lda, ldb, K, akmode; };

struct StaticOrder {
    int nM, nN, nwg, G, c;
    __host__ __device__ void init(int M, int N, int G_, int c_) { nM = M / BM; nN = N / BM; nwg = nM * nN; G = G_; c = c_; }
    __host__ __device__ bool next(int i, Unit& u) const {
        const long L = (long)i * G + c; if (L >= nwg) return false;
        int wgid = (int)L; { const int q = nwg / NXCD, r = nwg % NXCD, xcd = wgid % NXCD, off = wgid / NXCD; wgid = (xcd < r ? xcd * (q + 1) : r * (q + 1) + (xcd - r) * q) + off; }
        const int nig = WGM * nN, gid = wgid / nig, fm = gid * WGM, gsz = (nM - fm) < WGM ? (nM - fm) : WGM;
        u.pm = fm + ((wgid % nig) % gsz); u.pn = (wgid % nig) / gsz; return true;
    }
    __device__ __forceinline__ void a_ready(const Unit&) const {}
    __device__ __forceinline__ void done(const Unit&) const {}
};


typedef float f32x2_cv __attribute__((ext_vector_type(2))); typedef __bf16 bf16x2_cv __attribute__((ext_vector_type(2)));
__device__ __forceinline__ unsigned cvt_pk_bf16(float lo, float hi) { const f32x2_cv v = {lo, hi}; return __builtin_bit_cast(unsigned, __builtin_convertvector(v, bf16x2_cv)); }
__device__ __forceinline__ float sigm(float x) { return __builtin_amdgcn_rcpf(1.f + __builtin_amdgcn_exp2f(-1.4426950408889634f * x)); }
__device__ __forceinline__ float gelu_tanh(float x) { const float z = 0.7978845608028654f * (x + 0.044715f * x * x * x); return x * sigm(2.f * z); }
__device__ __forceinline__ float bf2f(unsigned short b) { return __uint_as_float((unsigned)b << 16); }
__device__ __forceinline__ u32x4 pack8(const f32x4 a, const f32x4 b) { u32x4 w; w.x = cvt_pk_bf16(a[0], a[1]); w.y = cvt_pk_bf16(a[2], a[3]); w.z = cvt_pk_bf16(b[0], b[1]); w.w = cvt_pk_bf16(b[2], b[3]); return w; }
#ifndef WT_STORES
#define WT_STORES 0
#endif
__device__ __forceinline__ void st16(void* p, const u32x4 v) {
#if WT_STORES
    asm volatile("global_store_dwordx4 %0, %1, off sc1\n\ts_nop 1" :: "v"(p), "v"(v) : "memory");
#else
    *(u32x4*)p = v;
#endif
}

struct EpiSwiGLU {
    static constexpr bool PERM = true, AFTER_DRAIN = false;
    bf16_t* O;
    __device__ __forceinline__ void operator()(const f32x4 (&acc)[2][2][4][2], const Unit& u, int wr, int wc, int fr_in, int fq) const {
        int fr = fr_in; asm volatile("" : "+v"(fr));
        const int row0 = u.pm * BM + wr * 64 + fr, col0 = u.pn * 128 + wc * 32 + 8 * fq;
#pragma unroll
        for (int ai = 0; ai < 2; ++ai)
#pragma unroll
            for (int m = 0; m < 4; ++m) {
                f32x4 v[2];
#pragma unroll
                for (int n = 0; n < 2; ++n)
#pragma unroll
                    for (int j = 0; j < 4; ++j) { const float gt = acc[ai][0][m][n][j]; v[n][j] = gt * sigm(gt) * acc[ai][1][m][n][j]; }
                st16((char*)O + ((unsigned)(row0 + ai * HALF + m * 16) * 2816u + (unsigned)col0) * 2u, pack8(v[0], v[1]));
            }
    }
};
struct EpiPlain {
    static constexpr bool PERM = true, AFTER_DRAIN = false;
    bf16_t* O;
    __device__ __forceinline__ void operator()(const f32x4 (&acc)[2][2][4][2], const Unit& u, int wr, int wc, int fr_in, int fq) const {
        int fr = fr_in; asm volatile("" : "+v"(fr));
        const int row0 = u.pm * BM + wr * 64 + fr, col0 = u.pn * BM + wc * 32 + 8 * fq;
#pragma unroll
        for (int ai = 0; ai < 2; ++ai)
#pragma unroll
            for (int m = 0; m < 4; ++m)
#pragma unroll
                for (int bj = 0; bj < 2; ++bj)
                    st16((char*)O + ((unsigned)(row0 + ai * HALF + m * 16) * 1024u + (unsigned)(col0 + bj * HALF)) * 2u, pack8(acc[ai][bj][m][0], acc[ai][bj][m][1]));
    }
};
struct EpiRecIn {
    static constexpr bool PERM = true, AFTER_DRAIN = false;
    bf16_t* G; bf16_t* X;
    __device__ __forceinline__ void operator()(const f32x4 (&acc)[2][2][4][2], const Unit& u, int wr, int wc, int fr_in, int fq) const {
        int fr = fr_in; asm volatile("" : "+v"(fr));
        const int row0 = u.pm * BM + wr * 64 + fr, col0 = (u.pn & 3) * BM + wc * 32 + 8 * fq; const bool isg = u.pn < 4; bf16_t* O = isg ? G : X;
#pragma unroll
        for (int ai = 0; ai < 2; ++ai)
#pragma unroll
            for (int m = 0; m < 4; ++m)
#pragma unroll
                for (int bj = 0; bj < 2; ++bj) {
                    f32x4 v0 = acc[ai][bj][m][0], v1 = acc[ai][bj][m][1];
                    if (isg) {
#pragma unroll
                        for (int j = 0; j < 4; ++j) { v0[j] = gelu_tanh(v0[j]); v1[j] = gelu_tanh(v1[j]); } }
                    st16((char*)O + ((unsigned)(row0 + ai * HALF + m * 16) * 1024u + (unsigned)(col0 + bj * HALF)) * 2u, pack8(v0, v1));
                }
    }
};
struct EpiQKV {
    static constexpr bool PERM = true, AFTER_DRAIN = false;
    bf16_t *Q, *K, *V; const float *qg, *kg, *cs, *sn; float c2;
    __device__ __forceinline__ void operator()(const f32x4 (&acc)[2][2][4][2], const Unit& u, int wr, int wc, int fr_in, int fq) const {
        int fr = fr_in; asm volatile("" : "+v"(fr));
        const int row0 = u.pm * BM + wr * 64 + fr, pn = u.pn;
        if (pn == 5) {
#pragma unroll
            for (int ai = 0; ai < 2; ++ai)
#pragma unroll
                for (int m = 0; m < 4; ++m)
#pragma unroll
                    for (int bj = 0; bj < 2; ++bj)
                        st16((char*)V + ((unsigned)(row0 + ai * HALF + m * 16) * 256u + (unsigned)(wc * 64 + bj * 32 + 8 * fq)) * 2u, pack8(acc[ai][bj][m][0], acc[ai][bj][m][1]));
            return;
        }
        const bool isq = pn < 4; const float* gp = isq ? qg : kg; const float sc = isq ? c2 : 1.f;
        bf16_t* O = isq ? Q : K; const int pitch = isq ? 1024 : 256; const int hc = (isq ? (4 * pn + wc) : wc) * 64 + 8 * fq;
#pragma unroll
        for (int ai = 0; ai < 2; ++ai)
#pragma unroll
            for (int m = 0; m < 4; ++m) {
                const int row = row0 + ai * HALF + m * 16;
                float ss = 0.f;
#pragma unroll
                for (int bj = 0; bj < 2; ++bj)
#pragma unroll
                    for (int n = 0; n < 2; ++n) { const f32x4 x = acc[ai][bj][m][n]; ss += (x[0] * x[0] + x[1] * x[1]) + (x[2] * x[2] + x[3] * x[3]); }
                ss += __shfl_xor(ss, 16); ss += __shfl_xor(ss, 32);
                const float rms = __builtin_amdgcn_rsqf(ss * (1.f / 64.f) + 1e-6f);
                const int s = row & 16383;
                f32x4 o1[2], o2[2];
#pragma unroll
                for (int n = 0; n < 2; ++n) {
                    const unsigned to = ((unsigned)s * 32u + (unsigned)(8 * fq + 4 * n)) * 4u; const f32x4 c = *(const f32x4*)((const char*)cs + to), sn4 = *(const f32x4*)((const char*)sn + to);
                    const f32x4 g1 = *(const f32x4*)(gp + 8 * fq + 4 * n), g2 = *(const f32x4*)(gp + 32 + 8 * fq + 4 * n);
                    const f32x4 x1 = acc[ai][0][m][n] * rms * g1, x2 = acc[ai][1][m][n] * rms * g2;
                    o1[n] = (x1 * c - x2 * sn4) * sc; o2[n] = (x1 * sn4 + x2 * c) * sc;
                }
                bf16_t* p = (bf16_t*)((char*)O + ((unsigned)row * (unsigned)pitch + (unsigned)hc) * 2u);
                st16(p, pack8(o1[0], o1[1])); st16(p + 32, pack8(o2[0], o2[1]));
                if (m & 1) asm volatile("" ::: "memory");
            }
    }
};
__device__ __forceinline__ unsigned q8pair(float r, float ig) {
    const unsigned a = (unsigned)__builtin_rintf(r * 255.f), b = (unsigned)__builtin_rintf(ig * 255.f);
    return a | (b << 8);
}
struct EpiGate {
    static constexpr bool PERM = true, AFTER_DRAIN = false;
    unsigned short* AB; const float* gb;
    __device__ __forceinline__ void operator()(const f32x4 (&acc)[2][2][4][2], const Unit& u, int wr, int wc, int fr_in, int fq) const {
        int fr = fr_in; asm volatile("" : "+v"(fr));
        const int row0 = u.pm * BM + wr * 64 + fr, pn = u.pn, d = pn >> 3, ch0 = ((pn >> 1) & 3) * 256 + (pn & 1) * 128 + wc * 32 + 8 * fq;
        unsigned short* ab = AB + (size_t)d * NROWS * 1024;
        f32x4 rb[2], ib[2];
#pragma unroll
        for (int n = 0; n < 2; ++n) { rb[n] = *(const f32x4*)(gb + (d * 2 + 0) * 1024 + ch0 + 4 * n); ib[n] = *(const f32x4*)(gb + (d * 2 + 1) * 1024 + ch0 + 4 * n); }
#pragma unroll
        for (int ai = 0; ai < 2; ++ai)
#pragma unroll
            for (int m = 0; m < 4; ++m) {
                const int row = row0 + ai * HALF + m * 16;
                u32x4 w;
#pragma unroll
                for (int n = 0; n < 2; ++n)
#pragma unroll
                    for (int jj = 0; jj < 2; ++jj)
                        w[n * 2 + jj] = q8pair(sigm(acc[ai][0][m][n][2 * jj] + rb[n][2 * jj]), sigm(acc[ai][1][m][n][2 * jj] + ib[n][2 * jj]))
                                      | (q8pair(sigm(acc[ai][0][m][n][2 * jj + 1] + rb[n][2 * jj + 1]), sigm(acc[ai][1][m][n][2 * jj + 1] + ib[n][2 * jj + 1])) << 16);
                st16((char*)ab + ((unsigned)row * 1024u + (unsigned)ch0) * 2u, w);
            }
    }
};

struct PanelSS {
    float* xbuf;
    unsigned* cnt;
    __device__ __forceinline__ void run(const f32x4 (&v)[2][2][4][2], const Unit& u, int wr, int wc, int fr, int fq, PG8_LAS unsigned char* lds, int wid, int lane) const {
        PG8_LAS float* P = (PG8_LAS float*)lds;
        PG8_LAS float* S = (PG8_LAS float*)(lds + 8192);
#pragma unroll
        for (int ai = 0; ai < 2; ++ai)
#pragma unroll
            for (int m = 0; m < 4; ++m) {
                float s = 0.f;
#pragma unroll
                for (int bj = 0; bj < 2; ++bj)
#pragma unroll
                    for (int n = 0; n < 2; ++n) { const f32x4 x = v[ai][bj][m][n]; s += (x[0] * x[0] + x[1] * x[1]) + (x[2] * x[2] + x[3] * x[3]); }
                s += __shfl_xor(s, 16); s += __shfl_xor(s, 32);
                if (fq == 0) P[(ai * HALF + wr * 64 + m * 16 + fr) * 4 + wc] = s;
            }
        asm volatile("s_waitcnt lgkmcnt(0)" ::: "memory"); __builtin_amdgcn_s_barrier(); asm volatile("" ::: "memory");
        const int row = wid * 32 + (lane & 31);
        if (lane < 32) {
            const float t = (P[row * 4 + 0] + P[row * 4 + 1]) + (P[row * 4 + 2] + P[row * 4 + 3]);
            __hip_atomic_store(xbuf + ((size_t)(u.pm * BM + row) * 4 + u.pn), t, __ATOMIC_RELAXED, __HIP_MEMORY_SCOPE_AGENT);
        }
        asm volatile("s_waitcnt vmcnt(0)" ::: "memory");
        if (lane == 0) __hip_atomic_fetch_add(cnt + 64 * u.pm, 1u, __ATOMIC_RELAXED, __HIP_MEMORY_SCOPE_AGENT);
        if (wid == 0) {
            const unsigned long long t0 = __builtin_amdgcn_s_memrealtime();
            for (;;) {
                if ((unsigned)__builtin_amdgcn_readfirstlane(__hip_atomic_load(cnt + 64 * u.pm, __ATOMIC_RELAXED, __HIP_MEMORY_SCOPE_AGENT)) >= 32u) break;
                if (__builtin_amdgcn_s_memrealtime() - t0 > 2000000ull) break;
                __builtin_amdgcn_s_sleep(2);
            }
            __builtin_amdgcn_fence(__ATOMIC_ACQUIRE, "agent");
        }
        asm volatile("s_waitcnt vmcnt(0) lgkmcnt(0)" ::: "memory"); __builtin_amdgcn_s_barrier(); asm volatile("" ::: "memory");
        if (lane < 32) {
            const float* slot = xbuf + (size_t)(u.pm * BM + row) * 4; float t = 0.f;
#pragma unroll
            for (int k = 0; k < 4; ++k) t += __hip_atomic_load(slot + k, __ATOMIC_RELAXED, __HIP_MEMORY_SCOPE_AGENT);
            S[row] = __builtin_amdgcn_rsqf(t * (1.f / 1024.f) + 1e-6f);
        }
        asm volatile("s_waitcnt lgkmcnt(0)" ::: "memory"); __builtin_amdgcn_s_barrier(); asm volatile("" ::: "memory");
    }
};
struct EpiNR {
    static constexpr bool PERM = false, AFTER_DRAIN = true;
    float* out; bf16_t* xn; float* hs; const float* gprev; const float* gpost; const float* gpre; float coef; PanelSS st1, st2;
    __device__ __forceinline__ void fused(f32x4 (&acc)[2][2][4][2], const Unit& u, int wr, int wc, int fr_in, int fq, PG8_LAS unsigned char* lds, int wid, int lane) const {
        typedef unsigned u32x2v __attribute__((ext_vector_type(2)));
        int fr = fr_in; asm volatile("" : "+v"(fr));
        const PG8_LAS float* S = (const PG8_LAS float*)(lds + 8192);
        const int col0 = u.pn * BM + wc * 32 + 4 * fq;
        st1.run(acc, u, wr, wc, fr, fq, lds, wid, lane);
#pragma unroll
        for (int ai = 0; ai < 2; ++ai)
#pragma unroll
            for (int m = 0; m < 4; ++m) { const int r = ai * HALF + wr * 64 + m * 16 + fr; const float rs = S[r] * coef; const float hsr = hs[u.pm * BM + r]; const unsigned off = ((unsigned)(u.pm * BM + r) * 1024u + (unsigned)col0);
#pragma unroll
                for (int bj = 0; bj < 2; ++bj)
#pragma unroll
                    for (int n = 0; n < 2; ++n) { const u32x2v xw = *(const u32x2v*)((const char*)xn + (off + bj * HALF + n * 16) * 2u);
                        const f32x4 gp = *(const f32x4*)(gprev + col0 + bj * HALF + n * 16), g = *(const f32x4*)(gpost + col0 + bj * HALF + n * 16);
                        const f32x4 bs = (f32x4){__uint_as_float(xw.x << 16) * __builtin_amdgcn_rcpf(gp[0]), __uint_as_float(xw.x & 0xffff0000u) * __builtin_amdgcn_rcpf(gp[1]), __uint_as_float(xw.y << 16) * __builtin_amdgcn_rcpf(gp[2]), __uint_as_float(xw.y & 0xffff0000u) * __builtin_amdgcn_rcpf(gp[3])} * hsr;
                        acc[ai][bj][m][n] = bs + acc[ai][bj][m][n] * rs * g; }
                asm volatile("" : "+v"(acc[ai][0][m][0]), "+v"(acc[ai][0][m][1]), "+v"(acc[ai][1][m][0]), "+v"(acc[ai][1][m][1]));
                asm volatile("" ::: "memory"); }
        if (gpre) st2.run(acc, u, wr, wc, fr, fq, lds, wid, lane);
#pragma unroll
        for (int ai = 0; ai < 2; ++ai)
#pragma unroll
            for (int m = 0; m < 4; ++m) { const int r = ai * HALF + wr * 64 + m * 16 + fr; const float rs = gpre ? S[r] : 0.f; const unsigned off = ((unsigned)(u.pm * BM + r) * 1024u + (unsigned)col0);
#pragma unroll
                for (int bj = 0; bj < 2; ++bj)
#pragma unroll
                    for (int n = 0; n < 2; ++n) { const f32x4 x1 = acc[ai][bj][m][n];
                        if (gpre) { const f32x4 g = *(const f32x4*)(gpre + col0 + bj * HALF + n * 16); const f32x4 o = x1 * rs * g; u32x2v w; w.x = cvt_pk_bf16(o[0], o[1]); w.y = cvt_pk_bf16(o[2], o[3]);
                            *(u32x2v*)((char*)xn + (off + bj * HALF + n * 16) * 2u) = w; }
                        else *(f32x4*)((char*)out + (off + bj * HALF + n * 16) * 4u) = x1; }
                if (gpre && u.pn == 0 && wc == 0 && fq == 0) hs[u.pm * BM + r] = __builtin_amdgcn_rcpf(rs);
                asm volatile("" ::: "memory"); }
    }
};
struct RoundOrder {
    StaticOrder base; int round;
    __device__ bool next(int i, Unit& u) const { return i == 0 ? base.next(round, u) : false; }
    __device__ __forceinline__ void a_ready(const Unit&) const {}
    __device__ __forceinline__ void done(const Unit&) const {}
};
template <class Epi, class Sched, bool ALIGN_EPI = false, bool SP2 = false>
__device__ __forceinline__ void gemm_phase(PG8_LAS unsigned char* lds, const Gemm g, const Sched& S, const Epi& E) {
    int tid_ = threadIdx.x; asm volatile("" : "+v"(tid_)); const int tid = tid_, wid = __builtin_amdgcn_readfirstlane(tid >> 6), lane = tid & 63, wr = wid >> 2, wc = wid & 3, fr = lane & 15, fq = lane >> 4;
    const int K = g.K, nt = K / BK;
    unsigned voffA[2], voffB[2];
#pragma unroll
    for (int i = 0; i < 2; ++i) { int R, C; stage_rc(tid * 16 + i * 8192, R, C); const int Rb = Epi::PERM ? ((R & ~31) + perm32(R & 31)) : R;
        voffA[i] = (unsigned)(R * g.lda + C) * 2u; voffB[i] = (unsigned)(Rb * g.ldb + C) * 2u; }
    const size_t kstep = (size_t)(BK * 2);
    const size_t hstepA = (size_t)HALF * g.lda * 2, hstepB = (size_t)HALF * g.ldb * 2;
    const size_t tstepA = 2 * hstepA, tstepB = 2 * hstepB;
    const unsigned ldsw = (unsigned)wid * 1024u;
    const int aoff = lds_byte(wr * 64 + fr, fq * 8), boff = lds_byte(wc * 32 + fr, fq * 8);
#define AKOFF(pn) ((size_t)(g.akmode ? ((size_t)(((pn) >> 1) & 3) * ((size_t)33280 * 512)) : 0))
#define PG8_SA(b, h) (((b) * 2 + (h)) * HTB)
#define PG8_SB(b, h) ((4 + (b) * 2 + (h)) * HTB)
#define PG8_STAGE(bufoff, gbase, voff) do { _Pragma("unroll") for (int _i = 0; _i < 2; ++_i) \
        __builtin_amdgcn_global_load_lds((const unsigned*)((const char*)(gbase) + (voff)[_i]), (PG8_LAS unsigned*)(lds + (bufoff) + ldsw + _i * 8192), 16, 0, 0); } while (0)
#define PG8_LDA(dst, b, h) do { _Pragma("unroll") for (int m = 0; m < 4; ++m) _Pragma("unroll") for (int k = 0; k < 2; ++k) dst[m][k] = *(const PG8_LAS bf16x8*)(lds + PG8_SA(b, h) + aoff + m * 2048 + k * 1024); } while (0)
#define PG8_LDB(dst, b, h) do { _Pragma("unroll") for (int n = 0; n < 2; ++n) _Pragma("unroll") for (int k = 0; k < 2; ++k) dst[n][k] = *(const PG8_LAS bf16x8*)(lds + PG8_SB(b, h) + boff + n * 2048 + k * 1024); } while (0)
#define PG8_MMA(ai, bj, At, Bt) do { __builtin_amdgcn_s_setprio(1); _Pragma("unroll") for (int m = 0; m < 4; ++m) _Pragma("unroll") for (int n = 0; n < 2; ++n) _Pragma("unroll") for (int k = 0; k < 2; ++k) \
        acc[ai][bj][m][n] = __builtin_amdgcn_mfma_f32_16x16x32_bf16(Bt[n][k], At[m][k], acc[ai][bj][m][n], 0, 0, 0); __builtin_amdgcn_s_setprio(0); } while (0)
#define PG8_WAIT_V(n) asm volatile("s_waitcnt vmcnt(" #n ")" ::: "memory")
#define PG8_WAIT_L(n) asm volatile("s_waitcnt lgkmcnt(" #n ")" ::: "memory")
#define PG8_BAR __builtin_amdgcn_s_barrier()
#define PG8_SCHED __builtin_amdgcn_sched_barrier(0)
    Unit cur, nxt; int ui = 0;
    if (!S.next(0, cur)) return;
    f32x4 acc[2][2][4][2];
#pragma unroll
    for (int a = 0; a < 2; ++a)
#pragma unroll
        for (int b = 0; b < 2; ++b)
#pragma unroll
            for (int m = 0; m < 4; ++m)
#pragma unroll
                for (int n = 0; n < 2; ++n) acc[a][b][m][n] = (f32x4){0.f, 0.f, 0.f, 0.f};
    bf16x8 At[4][2], B0[2][2], B1[2][2];
    const char* cA = (const char*)g.A + (size_t)cur.pm * tstepA + AKOFF(cur.pn); const char* cB = (const char*)g.Bt + (size_t)cur.pn * tstepB;
    S.a_ready(cur);
    if constexpr (SP2) {
        PG8_STAGE(PG8_SB(0, 0), cB, voffB); PG8_STAGE(PG8_SB(0, 1), cB + hstepB, voffB); PG8_STAGE(PG8_SA(0, 0), cA, voffA); PG8_STAGE(PG8_SA(0, 1), cA + hstepA, voffA);
        if (wr == 1) PG8_BAR;
        PG8_WAIT_V(2); PG8_BAR;
        PG8_STAGE(PG8_SB(1, 0), cB + kstep, voffB); PG8_STAGE(PG8_SA(1, 0), cA + kstep, voffA); PG8_STAGE(PG8_SB(1, 1), cB + hstepB + kstep, voffB);
        PG8_WAIT_V(6); PG8_BAR;
    } else {
        PG8_STAGE(PG8_SB(0, 0), cB, voffB); PG8_STAGE(PG8_SA(0, 0), cA, voffA); PG8_STAGE(PG8_SB(0, 1), cB + hstepB, voffB); PG8_STAGE(PG8_SA(0, 1), cA + hstepA, voffA);
        if (wr == 1) PG8_BAR;
        PG8_WAIT_V(4); PG8_BAR;
        PG8_STAGE(PG8_SB(1, 0), cB + kstep, voffB); PG8_STAGE(PG8_SA(1, 0), cA + kstep, voffA); PG8_STAGE(PG8_SB(1, 1), cB + hstepB + kstep, voffB);
        PG8_WAIT_V(6); PG8_BAR;
    }
    for (;;) {
        const bool has_next = S.next(ui + 1, nxt);
        const char* nA = has_next ? (const char*)g.A + (size_t)nxt.pm * tstepA + AKOFF(nxt.pn) : cA; const char* nB = has_next ? (const char*)g.Bt + (size_t)nxt.pn * tstepB : cB;
        _Pragma("unroll 1") for (int t = 0; t < nt; t += 2) {
            const bool last = (t == nt - 2);
            const char* a1 = cA + (size_t)(t + 1) * kstep;
            const char* a2 = last ? nA : cA + (size_t)(t + 2) * kstep; const char* b2 = last ? nB : cB + (size_t)(t + 2) * kstep;
            const char* a3 = a2 + kstep; const char* b3 = b2 + kstep;
            if (last && has_next) S.a_ready(nxt);
            if constexpr (SP2) {
            PG8_LDB(B0, 0, 0); PG8_LDB(B1, 0, 1); PG8_SCHED; PG8_LDA(At, 0, 0); PG8_STAGE(PG8_SA(1, 1), a1 + hstepA, voffA);
            PG8_WAIT_V(8); PG8_WAIT_L(0); PG8_BAR; PG8_MMA(0, 0, At, B0); PG8_MMA(0, 1, At, B1); PG8_BAR; PG8_SCHED;
            PG8_LDA(At, 0, 1); PG8_STAGE(PG8_SB(0, 0), b2, voffB); PG8_STAGE(PG8_SB(0, 1), b2 + hstepB, voffB); PG8_STAGE(PG8_SA(0, 0), a2, voffA);
            PG8_WAIT_V(8); PG8_WAIT_L(0); PG8_BAR; PG8_MMA(1, 0, At, B0); PG8_MMA(1, 1, At, B1); PG8_BAR; PG8_SCHED;
            PG8_LDB(B0, 1, 0); PG8_LDB(B1, 1, 1); PG8_SCHED; PG8_LDA(At, 1, 0); PG8_STAGE(PG8_SA(0, 1), a2 + hstepA, voffA);
            PG8_WAIT_V(8); PG8_WAIT_L(0); PG8_BAR; PG8_MMA(0, 0, At, B0); PG8_MMA(0, 1, At, B1); PG8_BAR; PG8_SCHED;
            PG8_LDA(At, 1, 1); PG8_STAGE(PG8_SB(1, 0), b3, voffB); PG8_STAGE(PG8_SB(1, 1), b3 + hstepB, voffB); PG8_STAGE(PG8_SA(1, 0), a3, voffA);
            PG8_WAIT_V(8); PG8_WAIT_L(0); PG8_BAR; PG8_MMA(1, 0, At, B0); PG8_MMA(1, 1, At, B1); PG8_BAR; PG8_SCHED;
            } else {
            PG8_LDB(B0, 0, 0); PG8_SCHED; PG8_LDA(At, 0, 0); PG8_STAGE(PG8_SA(1, 1), a1 + hstepA, voffA);
            PG8_WAIT_L(8); PG8_BAR; PG8_WAIT_L(0); PG8_MMA(0, 0, At, B0); PG8_BAR; PG8_SCHED;
            PG8_LDB(B1, 0, 1); PG8_STAGE(PG8_SB(0, 0), b2, voffB);
            PG8_BAR; PG8_WAIT_L(0); PG8_MMA(0, 1, At, B1); PG8_BAR;
            PG8_LDA(At, 0, 1); PG8_STAGE(PG8_SA(0, 0), a2, voffA);
            PG8_BAR; PG8_WAIT_L(0); PG8_MMA(1, 0, At, B0); PG8_BAR; PG8_SCHED;
            PG8_STAGE(PG8_SB(0, 1), b2 + hstepB, voffB);
            PG8_WAIT_V(6); PG8_BAR; PG8_MMA(1, 1, At, B1); PG8_BAR;
            PG8_LDB(B0, 1, 0); PG8_SCHED; PG8_LDA(At, 1, 0); PG8_STAGE(PG8_SA(0, 1), a2 + hstepA, voffA);
            PG8_WAIT_L(8); PG8_BAR; PG8_WAIT_L(0); PG8_MMA(0, 0, At, B0); PG8_BAR; PG8_SCHED;
            PG8_LDB(B1, 1, 1); PG8_STAGE(PG8_SB(1, 0), b3, voffB);
            PG8_BAR; PG8_WAIT_L(0); PG8_MMA(0, 1, At, B1); PG8_BAR;
            PG8_LDA(At, 1, 1); PG8_STAGE(PG8_SA(1, 0), a3, voffA);
            PG8_BAR; PG8_WAIT_L(0); PG8_MMA(1, 0, At, B0); PG8_BAR; PG8_SCHED;
            PG8_STAGE(PG8_SB(1, 1), b3 + hstepB, voffB);
            PG8_WAIT_V(6); PG8_BAR; PG8_MMA(1, 1, At, B1); PG8_BAR;
            }
        }
        if constexpr (ALIGN_EPI) { if (wr == 0) PG8_BAR; }
        if constexpr (!Epi::AFTER_DRAIN) { E(acc, cur, wr, wc, fr, fq); S.done(cur); }
        if (!has_next) break;
#pragma unroll
        for (int a = 0; a < 2; ++a)
#pragma unroll
            for (int b = 0; b < 2; ++b)
#pragma unroll
                for (int m = 0; m < 4; ++m)
#pragma unroll
                    for (int n = 0; n < 2; ++n) acc[a][b][m][n] = (f32x4){0.f, 0.f, 0.f, 0.f};
        cur = nxt; cA = nA; cB = nB; ++ui;
        if constexpr (ALIGN_EPI) { if (wr == 1) PG8_BAR; }
    }
    PG8_WAIT_V(0);
    if constexpr (!ALIGN_EPI) { if (wr == 0) PG8_BAR; }
    PG8_BAR;
    if constexpr (Epi::AFTER_DRAIN) { E.fused(acc, cur, wr, wc, fr, fq, lds, wid, lane); S.done(cur); }
#undef AKOFF
#undef PG8_SA
#undef PG8_SB
#undef PG8_STAGE
#undef PG8_LDA
#undef PG8_LDB
#undef PG8_MMA
#undef PG8_WAIT_V
#undef PG8_WAIT_L
#undef PG8_BAR
#undef PG8_SCHED
}
}

#ifndef PG8_SP2
#define PG8_SP2 true
#endif
#ifndef PG8_ALIGN
#define PG8_ALIGN true
#endif

#include <hip/hip_bf16.h>
#include <cmath>
namespace attn_body {
using bf16=__hip_bfloat16;
using bf16x8=__attribute__((ext_vector_type(8)))short;
using s16x4=__attribute__((ext_vector_type(4)))short;
using f32x16=__attribute__((ext_vector_type(16)))float;
using u32x4=__attribute__((ext_vector_type(4)))unsigned;
constexpr int D=64,QP=1024,KP=256,LSEQ=16384,NREALR=32768;
constexpr int NW=8,QBLK=32,QB=QBLK*NW,KVBLK=64;

__device__ __forceinline__ int crow(int r,int hi){return (r&3)+8*(r>>2)+4*hi;}
#define SBAR() __builtin_amdgcn_sched_barrier(0)
__device__ __forceinline__ void cmask(f32x16&p0,f32x16&p1,int jb,int qrel,int hi){
  const float NEG=-INFINITY; int kb=64*jb+4*hi;
  #pragma unroll
  for(int r=0;r<16;++r){int kv=kb+(r&3)+8*(r>>2); if(kv>qrel)p0[r]=NEG; if(kv+32>qrel)p1[r]=NEG;}
}

constexpr int NSLOT=3, SLOTB=8192;
constexpr int LDS_K=0, LDS_V=NSLOT*SLOTB, LDS_WS=2*NSLOT*SLOTB, LDS_OST=LDS_WS+NW*64*4, LDS_BYTES=LDS_OST+NW*4096;
constexpr float C2=0.125f*1.4426950408889634f;
__device__ __forceinline__ void glds16(const void*gsrc,unsigned lds_dst){unsigned keep;
  asm volatile("s_mov_b32 %0, m0\n\ts_mov_b32 m0, %2\n\ts_nop 0\n\tglobal_load_lds_dwordx4 %1, off\n\ts_mov_b32 m0, %0":"=&s"(keep):"v"(gsrc),"s"(lds_dst):"memory");}
__device__ __forceinline__ float max3f(float a,float b,float c){float r;asm("v_max3_f32 %0, %1, %2, %3":"=v"(r):"v"(a),"v"(b),"v"(c));return r;}
__device__ __forceinline__ float max2f(float a,float b){float r;asm("v_max_f32_e32 %0, %1, %2":"=v"(r):"v"(a),"v"(b));return r;}
__device__ __forceinline__ float fadd_s(float a,float b){float r;asm("v_add_f32_e32 %0, %1, %2":"=v"(r):"v"(a),"v"(b));return r;}
__device__ __forceinline__ float fsub_s(float a,float b){float r;asm("v_sub_f32_e32 %0, %1, %2":"=v"(r):"v"(a),"v"(b));return r;}
typedef float f32x2_t __attribute__((ext_vector_type(2))); typedef __bf16 bf16x2_t __attribute__((ext_vector_type(2)));
__device__ __forceinline__ unsigned cvtpk_s(float lo,float hi){f32x2_t v={lo,hi};bf16x2_t b=__builtin_convertvector(v,bf16x2_t);return __builtin_bit_cast(unsigned,b);}
#define WAIT_BAR(N) asm volatile("s_waitcnt vmcnt(" #N ") lgkmcnt(0)\n\ts_barrier":::"memory")

__device__ __forceinline__ void qkt(f32x16&p0,f32x16&p1,const char*Kslot,const bf16x8*qr,const f32x16&negm,int r32,int hi){
  const char*kb=Kslot+hi*1024+r32*16;
  #pragma unroll
  for(int d0=0;d0<4;++d0){
    const bf16x8 b0=*reinterpret_cast<const bf16x8*>(kb+d0*2048);
    const bf16x8 b1=*reinterpret_cast<const bf16x8*>(kb+d0*2048+512);
    if(d0==0){p0=__builtin_amdgcn_mfma_f32_32x32x16_bf16(b0,qr[0],negm,0,0,0);p1=__builtin_amdgcn_mfma_f32_32x32x16_bf16(b1,qr[0],negm,0,0,0);}
    else{p0=__builtin_amdgcn_mfma_f32_32x32x16_bf16(b0,qr[d0],p0,0,0,0);p1=__builtin_amdgcn_mfma_f32_32x32x16_bf16(b1,qr[d0],p1,0,0,0);}}
}
typedef __attribute__((address_space(3))) const char* lds_cptr;
typedef short v4i16_t __attribute__((ext_vector_type(4)));
__device__ __forceinline__ void kload8(bf16x8*kf,lds_cptr kp){
  kf[0]=*(const __attribute__((address_space(3))) bf16x8*)(kp);      kf[1]=*(const __attribute__((address_space(3))) bf16x8*)(kp+512);
  kf[2]=*(const __attribute__((address_space(3))) bf16x8*)(kp+2048); kf[3]=*(const __attribute__((address_space(3))) bf16x8*)(kp+2560);
  kf[4]=*(const __attribute__((address_space(3))) bf16x8*)(kp+4096); kf[5]=*(const __attribute__((address_space(3))) bf16x8*)(kp+4608);
  kf[6]=*(const __attribute__((address_space(3))) bf16x8*)(kp+6144); kf[7]=*(const __attribute__((address_space(3))) bf16x8*)(kp+6656);
}
__device__ __forceinline__ void kload2(bf16x8*kf,lds_cptr kp,int j){ kf[2*j]=*(const __attribute__((address_space(3))) bf16x8*)(kp+j*2048); kf[2*j+1]=*(const __attribute__((address_space(3))) bf16x8*)(kp+j*2048+512); }
__device__ __forceinline__ s16x4 vtr(lds_cptr p){ return __builtin_bit_cast(s16x4,__builtin_amdgcn_ds_read_tr16_b64_v4i16((__attribute__((address_space(3))) v4i16_t*)p)); }
__device__ __forceinline__ float rowmax(const f32x16&p0,const f32x16&p1){
  float a=max3f(p0[0],p0[1],p1[0]),b=max3f(p0[2],p0[3],p1[1]);a=max3f(a,p1[2],p1[3]);
  #pragma unroll
  for(int r=4;r<16;r+=4){a=max3f(a,p0[r],p0[r+1]);b=max3f(b,p0[r+2],p0[r+3]);a=max3f(a,p1[r],p1[r+1]);b=max3f(b,p1[r+2],p1[r+3]);}
  const float m=max2f(a,b);
  auto rr=__builtin_amdgcn_permlane32_swap(__float_as_uint(m),__float_as_uint(m),false,false);
  return max2f(__uint_as_float(rr[0]),__uint_as_float(rr[1]));
}
__device__ __forceinline__ void pv(f32x16*o,int vb,bf16x8 pa0,bf16x8 pa1,bf16x8 pa2,bf16x8 pa3){
  #pragma unroll
  for(int d0=0;d0<2;++d0){s16x4 lo[4],hi[4];
    #pragma unroll
    for(int ks=0;ks<4;++ks){
      asm volatile("ds_read_b64_tr_b16 %0,%1 offset:%c2":"=&v"(lo[ks]):"v"(vb),"i"(d0*4096+ks*1024):"memory");
      asm volatile("ds_read_b64_tr_b16 %0,%1 offset:%c2":"=&v"(hi[ks]):"v"(vb),"i"(d0*4096+ks*1024+512):"memory");}
    asm volatile("s_waitcnt lgkmcnt(0)":::"memory");SBAR();
    #define PK(k) (bf16x8){lo[k][0],lo[k][1],lo[k][2],lo[k][3],hi[k][0],hi[k][1],hi[k][2],hi[k][3]}
    o[d0]=__builtin_amdgcn_mfma_f32_32x32x16_bf16(pa0,PK(0),o[d0],0,0,0);
    o[d0]=__builtin_amdgcn_mfma_f32_32x32x16_bf16(pa1,PK(1),o[d0],0,0,0);
    o[d0]=__builtin_amdgcn_mfma_f32_32x32x16_bf16(pa2,PK(2),o[d0],0,0,0);
    o[d0]=__builtin_amdgcn_mfma_f32_32x32x16_bf16(pa3,PK(3),o[d0],0,0,0);
    #undef PK
  }
}

#ifndef ATTN_STORE16
#define ATTN_STORE16(p,v) (*(u32x4*)(p)=(v))
#endif
template<int THRL> __device__ __forceinline__ void attn_unit(int b,int h,long qrow0,int nvalid,int t_base,int NT,int lastmode,float*part_o,float*part_ml,const bf16*Q,const bf16*__restrict__ K,const bf16*__restrict__ V,bf16*O,char*shm){
  int tid_=threadIdx.x; asm volatile("":"+v"(tid_)); const int tid=tid_,lane=tid&63,r32=lane&31,hi=lane>>5; const int wid=__builtin_amdgcn_readfirstlane(tid>>6);
  const long rowbase=(long)b*LSEQ; const long metaoff=((long)(NREALR+b*16)-rowbase)*KP;
  const bf16*Qw=Q+(qrow0+wid*QBLK)*QP+h*D;
  const bf16*Kh=K+rowbase*KP+(h>>2)*D,*Vh=V+rowbase*KP+(h>>2)*D;
  const unsigned lds0=(unsigned)(uintptr_t)shm;
  float*wsf=(float*)(shm+LDS_WS)+wid*64;
  const bf16*ksrc=Kh+(long)lane*KP+wid*8;
  const bf16*vsrc=Vh+(long)(16*(wid&3)+(lane>>2))*KP+(wid>>2)*32+(lane&3)*8;
  const unsigned kdst=lds0+LDS_K+wid*1024, vdst=lds0+LDS_V+wid*1024;
  #define TOFF(tt) ((((tt)+t_base)<256)?(long)((tt)+t_base)*KVBLK*KP:metaoff)
  #define DMA_K(t,slot) glds16(ksrc+TOFF(t),(unsigned)__builtin_amdgcn_readfirstlane(kdst+(slot)))
  #define DMA_V(t,slot) glds16(vsrc+TOFF(t),(unsigned)__builtin_amdgcn_readfirstlane(vdst+(slot)))
  const int vb0=(int)(lds0+LDS_V)+((lane>>4)&1)*32+(lane&3)*8+(4*hi+((lane&15)>>2))*64;
  const char*Kbase=shm+LDS_K; bf16x8 kf[8];
  const lds_cptr shm3=(lds_cptr)shm; const lds_cptr kp0=shm3+LDS_K+hi*1024+r32*16; const lds_cptr vp0=shm3+LDS_V+((lane>>4)&1)*32+(lane&3)*8+(4*hi+((lane&15)>>2))*64;
  DMA_K(0,0);DMA_V(0,0);DMA_K(1,SLOTB);
  bf16x8 qr[4];
  #pragma unroll
  for(int d0=0;d0<4;++d0)qr[d0]=*reinterpret_cast<const bf16x8*>(&Qw[(long)r32*QP+d0*16+hi*8]);
  float mhat=0.f,l_reg=0.f;f32x16 o[2];o[0]=f32x16{};o[1]=f32x16{};f32x16 negm=f32x16{};asm volatile("":"+v"(negm));
    #define CMASK(P0,P1,t) do{}while(0)
  bool resc=false;
  #define START(P0,P1) do{ const float rm=rowmax(P0,P1); resc=false; \
    { const float dl=rm; mhat=fadd_s(mhat,dl); \
      _Pragma("unroll") for(int r=0;r<16;++r){P0[r]=fsub_s(P0[r],dl);P1[r]=fsub_s(P1[r],dl);} \
      _Pragma("unroll") for(int r=0;r<16;++r)negm[r]=-mhat; asm volatile("":"+v"(negm)); } \
    _Pragma("unroll") for(int r=0;r<16;++r)P0[r]=__builtin_amdgcn_exp2f(P0[r]); }while(0)
  #define RESC() do{ if(resc){ asm volatile("s_waitcnt lgkmcnt(0)":::"memory"); \
      _Pragma("unroll") for(int d_=0;d_<2;++d_) _Pragma("unroll") for(int r=0;r<16;++r)o[d_][r]*=wsf[crow(r,hi)]; } }while(0)
  f32x16 pA0,pA1,pB0,pB1;
  int sl_prev=0,sl_cur=0,sl_next=SLOTB;
  #define ROT() do{sl_prev=sl_cur;sl_cur=sl_next;sl_next=(sl_next==(NSLOT-1)*SLOTB)?0:sl_next+SLOTB;}while(0)
  DMA_K(2,2*SLOTB);
  WAIT_BAR(3);
  qkt(pA0,pA1,Kbase,qr,negm,r32,hi);asm volatile("s_nop 15\n\ts_nop 7":"+v"(pA0),"+v"(pA1));CMASK(pA0,pA1,0);
  START(pA0,pA1);
  _Pragma("unroll") for(int r=0;r<16;++r)pA1[r]=__builtin_amdgcn_exp2f(pA1[r]);
  WAIT_BAR(0);
  DMA_K(3,0);DMA_V(1,SLOTB);
  ROT();
  kload8(kf,kp0+sl_cur);
  WAIT_BAR(2);
  s16x4 vlo[8],vhi[8]; u32x4 pw0,pw1,pw2,pw3;
  #define PKW(P,B) cvtpk_s(P[B],P[B+1])
  #define PAF(k) __builtin_bit_cast(bf16x8,pw##k)
  #define VFR(i) (bf16x8){vlo[i][0],vlo[i][1],vlo[i][2],vlo[i][3],vhi[i][0],vhi[i][1],vhi[i][2],vhi[i][3]}
  #define PIN(x) asm volatile("":"+v"(x))
  #define MX3(a,b,c) __builtin_fmaxf(__builtin_fmaxf((a),(b)),(c))
  #define GAPA(MF,A0,A1,A2,A3,W0,W1,PW) do{ MF; sacc+=A0; sacc+=A1; sacc+=A2; sacc+=A3; PIN(sacc); W0; W1; PIN(PW); SBAR(); }while(0)
  #define EX(v) __builtin_amdgcn_exp2f(v)
  #define GAPB(MF,X,B) do{ MF; X[B]=EX(X[B]); X[B+1]=EX(X[B+1]); X[B+2]=EX(X[B+2]); X[B+3]=EX(X[B+3]); PIN(X); SBAR(); }while(0)
  #define VRD(i) do{ vlo[i]=vtr(vp_+(((i)>>2)*4096+((i)&3)*1024)); vhi[i]=vtr(vp_+(((i)>>2)*4096+((i)&3)*1024+512)); }while(0)
  #define KRD(G,j) do{ if(G){ kload2(kf,kp0+sl_next,j); SBAR(); } }while(0)
  #define STEP(C0,C1,P0,P1,t,GK,GV,GL) do{ SBAR(); \
    const lds_cptr vp_=vp0+sl_prev; \
    VRD(0); SBAR(); float sacc=(P0[0]+P0[1]); \
    GAPA(C0=__builtin_amdgcn_mfma_f32_32x32x16_bf16(kf[0],qr[0],negm,0,0,0), P0[2],P0[3],P0[4],P0[5],     pw0[0]=PKW(P0,0), pw0[1]=PKW(P0,2), pw0); \
    VRD(4); SBAR(); GAPA(C1=__builtin_amdgcn_mfma_f32_32x32x16_bf16(kf[1],qr[0],negm,0,0,0), P0[6],P0[7],P0[8],P0[9],     pw0[2]=PKW(P0,4), pw0[3]=PKW(P0,6), pw0); \
    VRD(1); SBAR(); GAPA(C0=__builtin_amdgcn_mfma_f32_32x32x16_bf16(kf[2],qr[1],C0,0,0,0),   P0[10],P0[11],P0[12],P0[13], pw1[0]=PKW(P0,8), pw1[1]=PKW(P0,10), pw1); \
    VRD(5); SBAR(); GAPA(C1=__builtin_amdgcn_mfma_f32_32x32x16_bf16(kf[3],qr[1],C1,0,0,0),   P0[14],P0[15],P1[0],P1[1],   pw1[2]=PKW(P0,12),pw1[3]=PKW(P0,14), pw1); \
    VRD(2); SBAR(); GAPA(C0=__builtin_amdgcn_mfma_f32_32x32x16_bf16(kf[4],qr[2],C0,0,0,0),   P1[2],P1[3],P1[4],P1[5],     pw2[0]=PKW(P1,0), pw2[1]=PKW(P1,2), pw2); \
    VRD(6); SBAR(); GAPA(C1=__builtin_amdgcn_mfma_f32_32x32x16_bf16(kf[5],qr[2],C1,0,0,0),   P1[6],P1[7],P1[8],P1[9],     pw2[2]=PKW(P1,4), pw2[3]=PKW(P1,6), pw2); \
    VRD(3); SBAR(); GAPA(C0=__builtin_amdgcn_mfma_f32_32x32x16_bf16(kf[6],qr[3],C0,0,0,0),   P1[10],P1[11],P1[12],P1[13], pw3[0]=PKW(P1,8), pw3[1]=PKW(P1,10), pw3); \
    VRD(7); SBAR(); GAPA(C1=__builtin_amdgcn_mfma_f32_32x32x16_bf16(kf[7],qr[3],C1,0,0,0),   P1[14],P1[15],0.f,0.f,       pw3[2]=PKW(P1,12),pw3[3]=PKW(P1,14), pw3); \
    l_reg+=sacc; \
    if(GK){DMA_K((t)+3,sl_cur);} if(GV){DMA_V((t)+1,sl_next);} \
    CMASK(C0,C1,t); \
    { float a=MX3(C0[0],C0[1],C1[0]),b=MX3(C0[2],C0[3],C1[1]); a=MX3(a,C1[2],C1[3]); \
      _Pragma("unroll") for(int r=4;r<16;r+=4){a=MX3(a,C0[r],C0[r+1]);b=MX3(b,C0[r+2],C0[r+3]);a=MX3(a,C1[r],C1[r+1]);b=MX3(b,C1[r+2],C1[r+3]);} \
      float rm=__builtin_fmaxf(a,b); { auto rr=__builtin_amdgcn_permlane32_swap(__float_as_uint(rm),__float_as_uint(rm),false,false); rm=__builtin_fmaxf(__uint_as_float(rr[0]),__uint_as_float(rr[1])); } \
      resc=false; \
      if(__builtin_expect(__any(rm>(float)THRL),0)){ const float dl=__builtin_fmaxf(rm,0.f); mhat+=dl; \
        _Pragma("unroll") for(int r=0;r<16;++r){C0[r]-=dl;C1[r]-=dl;} \
        _Pragma("unroll") for(int r=0;r<16;++r)negm[r]=-mhat; asm volatile("":"+v"(negm)); \
        const float f=__builtin_amdgcn_exp2f(-dl); l_reg*=f; if(hi==0)wsf[r32]=f; resc=true; } } \
    SBAR(); \
    GAPB(o[0]=__builtin_amdgcn_mfma_f32_32x32x16_bf16(PAF(0),VFR(0),o[0],0,0,0), C0,0); \
    GAPB(o[1]=__builtin_amdgcn_mfma_f32_32x32x16_bf16(PAF(0),VFR(4),o[1],0,0,0), C0,4); \
    KRD(GL,0); GAPB(o[0]=__builtin_amdgcn_mfma_f32_32x32x16_bf16(PAF(1),VFR(1),o[0],0,0,0), C0,8); \
    KRD(GL,1); GAPB(o[1]=__builtin_amdgcn_mfma_f32_32x32x16_bf16(PAF(1),VFR(5),o[1],0,0,0), C0,12); \
    KRD(GL,2); GAPB(o[0]=__builtin_amdgcn_mfma_f32_32x32x16_bf16(PAF(2),VFR(2),o[0],0,0,0), C1,0); \
    KRD(GL,3); GAPB(o[1]=__builtin_amdgcn_mfma_f32_32x32x16_bf16(PAF(2),VFR(6),o[1],0,0,0), C1,4); \
    GAPB(o[0]=__builtin_amdgcn_mfma_f32_32x32x16_bf16(PAF(3),VFR(3),o[0],0,0,0), C1,8); \
    GAPB(o[1]=__builtin_amdgcn_mfma_f32_32x32x16_bf16(PAF(3),VFR(7),o[1],0,0,0), C1,12); \
    }while(0)
  int t=1;
  #undef CMASK
  #define CMASK(P0,P1,t) do{}while(0)
  for(;t+5<NT;t+=2){
    STEP(pB0,pB1,pA0,pA1,t,true,true,true);     WAIT_BAR(2); RESC(); ROT();
    STEP(pA0,pA1,pB0,pB1,t+1,true,true,true);   WAIT_BAR(2); RESC(); ROT();
  }
  #undef CMASK
  #define CMASK(P0,P1,t) do{ if((t)==NT-1){ if(lastmode==2){ _Pragma("unroll") for(int r_=0;r_<8;++r_)P0[r_]=-INFINITY; } _Pragma("unroll") for(int r_=8;r_<16;++r_)P0[r_]=-INFINITY; _Pragma("unroll") for(int r_=0;r_<16;++r_)P1[r_]=-INFINITY; } }while(0)
  #define ENDW(tt) do{ if((tt)+3<NT){WAIT_BAR(2);} else if((tt)+2<NT){WAIT_BAR(1);} else {WAIT_BAR(0);} }while(0)
  for(;t+1<NT;t+=2){
    STEP(pB0,pB1,pA0,pA1,t,(t+3<NT),(t+1<NT),(t+1<NT));       ENDW(t);   RESC(); ROT();
    STEP(pA0,pA1,pB0,pB1,t+1,(t+4<NT),(t+2<NT),(t+2<NT));     ENDW(t+1); RESC(); ROT();
  }
  { float sacc=pA0[0]+pA0[1]; _Pragma("unroll") for(int r=2;r<16;++r)sacc+=pA0[r]; _Pragma("unroll") for(int r=0;r<16;++r)sacc+=pA1[r]; l_reg+=sacc;
    pw0=(u32x4){PKW(pA0,0),PKW(pA0,2),PKW(pA0,4),PKW(pA0,6)};pw1=(u32x4){PKW(pA0,8),PKW(pA0,10),PKW(pA0,12),PKW(pA0,14)};pw2=(u32x4){PKW(pA1,0),PKW(pA1,2),PKW(pA1,4),PKW(pA1,6)};pw3=(u32x4){PKW(pA1,8),PKW(pA1,10),PKW(pA1,12),PKW(pA1,14)};
    SBAR(); pv(o,vb0+sl_prev,PAF(0),PAF(1),PAF(2),PAF(3)); }
  #undef PKW
  #undef PAF
  #undef VFR
  #undef PIN
  #undef MX3
  #undef GAPA
  #undef GAPB
  #undef EX
  #undef VRD
  #undef KRD
  #undef STEP
  #undef ENDW
  {auto rr=__builtin_amdgcn_permlane32_swap(__float_as_uint(l_reg),__float_as_uint(l_reg),false,false);l_reg=__uint_as_float(rr[0])+__uint_as_float(rr[1]);}
  if(hi==0)wsf[32+r32]=l_reg;asm volatile("s_waitcnt lgkmcnt(0)":::"memory");
  if(part_o){ if(wid==0){
    _Pragma("unroll") for(int r=0;r<8;++r){ _Pragma("unroll") for(int d0=0;d0<2;++d0)part_o[crow(r,hi)*64+d0*32+r32]=o[d0][r]; }
    if(hi==0&&r32<16){part_ml[2*r32]=mhat;part_ml[2*r32+1]=l_reg;} } } else {
  float rli[16];
  #pragma unroll
  for(int r=0;r<16;++r)rli[r]=__builtin_amdgcn_rcpf(wsf[32+crow(r,hi)]);
  bf16*Ow=O+(qrow0+wid*QBLK)*QP+h*D; const int nv=nvalid-wid*QBLK;
  { bf16*stg=(bf16*)(shm+LDS_OST)+wid*2048;
    #pragma unroll
    for(int r=0;r<16;++r){const int orow=crow(r,hi);
      #pragma unroll
      for(int d0=0;d0<2;++d0)stg[orow*64+d0*32+r32]=__float2bfloat16(o[d0][r]*rli[r]);}
    asm volatile("s_waitcnt lgkmcnt(0)":::"memory");
    #pragma unroll
    for(int i=0;i<4;++i){const int row=i*8+(lane>>3),ch=lane&7; const u32x4 v=*(const u32x4*)(stg+row*64+ch*8); if(row<nv)ATTN_STORE16(Ow+(long)row*QP+ch*8,v);} } }
  asm volatile("s_waitcnt lgkmcnt(0)\n\ts_barrier":::"memory");
  #undef TOFF
  #undef DMA_K
  #undef DMA_V
  #undef CMASK
  #undef START
  #undef RESC
  #undef ROT
}
constexpr int ATTN_LDS_BYTES=LDS_BYTES;
#undef SBAR
#undef WAIT_BAR
}


#ifndef PG8_SP2
#define PG8_SP2 true
#endif
#ifndef PG8_ALIGN
#define PG8_ALIGN true
#endif
#define LAS __attribute__((address_space(3)))
#ifndef PHM
#define PHM 0xffff
#endif
using pg8::bf16_t; using pg8::f32x4; using pg8::u32x4; using pg8::bf16x8;
typedef float f32x16_t __attribute__((ext_vector_type(16)));
typedef float f32x2_tt __attribute__((ext_vector_type(2)));
constexpr size_t MiB = 1u << 20;
constexpr size_t WS_COS = 1 * MiB, WS_SIN = 3 * MiB, WS_W = 5 * MiB, WS_XN = 163 * MiB, WS_Y = 229 * MiB, WS_R3 = 295 * MiB, WS_R1 = 361 * MiB,
                 WS_K = WS_R1 + 66 * MiB, WS_V = WS_R1 + 83 * MiB, WS_AGG = 619 * MiB, WS_CIN = 628 * MiB, WS_XB = 635 * MiB, WS_HB = 637 * MiB, WS_END = 702 * MiB;
constexpr size_t WS_CNT = 65536;
constexpr size_t W_IN = 0, W_OUT = W_IN + (size_t)8 * 5632 * 1024, W_QKV = W_OUT + (size_t)8 * 1024 * 2816, W_O = W_QKV + (size_t)2 * 1536 * 1024,
                 W_RIN = W_O + (size_t)2 * 1024 * 1024, W_RG = W_RIN + (size_t)2 * 2048 * 1024, W_RO = W_RG + (size_t)2 * 4096 * 256, W_END = W_RO + (size_t)2 * 1024 * 1024;
static_assert(W_END * 2 <= 158 * MiB, "weights");
constexpr int LDS_BYTES = 147456;
constexpr float ATT_C2 = 0.125f * 1.4426950408889634f;

__device__ __forceinline__ float wave_sum(float v) {
#pragma unroll
    for (int o = 1; o < 64; o <<= 1) v += __shfl_xor(v, o);
    return v;
}
__device__ __forceinline__ unsigned f2bf(float f) { unsigned u = __builtin_bit_cast(unsigned, f); return (u + 0x7fffu + ((u >> 16) & 1u)) >> 16; }
__device__ __forceinline__ unsigned pk2(float lo, float hi) { return f2bf(lo) | (f2bf(hi) << 16); }
__device__ __forceinline__ float bf2f(unsigned b) { return __uint_as_float(b << 16); }

struct TrD { const float* W; bf16_t* WT; int K, N, k0, n0, dr0; };
__device__ __forceinline__ void tr_load(float (&r)[32], const TrD& d, int lane) {
#pragma unroll
    for (int i = 0; i < 32; ++i) { const int kk = 2 * i + (lane >> 5); r[i] = d.W[(size_t)(d.k0 + kk) * d.N + d.n0 + (lane & 31)]; }
}
__device__ __forceinline__ void tr_finish(const float (&r)[32], const TrD& d, float* scr, int lane) {
#pragma unroll
    for (int i = 0; i < 32; ++i) { const int kk = 2 * i + (lane >> 5); scr[kk * 33 + (lane & 31)] = r[i]; }
    __builtin_amdgcn_s_waitcnt(0); asm volatile("" ::: "memory");
    const int c = lane & 7;
#pragma unroll
    for (int j = 0; j < 4; ++j) { const int n = (lane >> 3) + 8 * j; const float* s = scr + (8 * c) * 33 + n;
        u32x4 o; o.x = pk2(s[0 * 33], s[1 * 33]); o.y = pk2(s[2 * 33], s[3 * 33]); o.z = pk2(s[4 * 33], s[5 * 33]); o.w = pk2(s[6 * 33], s[7 * 33]);
        *(u32x4*)(d.WT + (size_t)(d.dr0 + n) * d.K + d.k0 + 8 * c) = o; }
    asm volatile("s_waitcnt lgkmcnt(0)" ::: "memory");
}

#define XB_TMO      128
#define XB_XCNT(j)  (256  + 64 * (j))
#define XB_XSUB(j)  (1280 + 64 * (j))
#define XB_XGEN(j)  (2304 + 64 * (j))
#define XB_TOP      3328
#define XB_TOPGEN   3392
#define XCD_BAR_WORDS 3456
#define XB_SPIN_CAP (1u << 18)

__device__ __forceinline__ unsigned xb_ld(unsigned* p)              { return __hip_atomic_load(p, __ATOMIC_RELAXED, __HIP_MEMORY_SCOPE_AGENT); }
__device__ __forceinline__ unsigned xb_add(unsigned* p, unsigned v) { return __hip_atomic_fetch_add(p, v, __ATOMIC_RELAXED, __HIP_MEMORY_SCOPE_AGENT); }
__device__ __forceinline__ unsigned xb_xcc_id() { return (unsigned)__builtin_amdgcn_s_getreg((3 << 11) | 20) & 0xFu; }
#define XB_SPIN(cond, bar) do { unsigned _sp = 0; while (cond) { __builtin_amdgcn_s_sleep(1); \
    if ((++_sp & 255u) == 0u) { if (xb_ld(&(bar)[XB_TMO])) break; if (_sp > XB_SPIN_CAP) { atomicAdd(&(bar)[XB_TMO], 1u); break; } } } } while (0)

struct XcdBarrier {
    unsigned* bar; unsigned x;
    volatile LAS unsigned* st;
};

__device__ __forceinline__ XcdBarrier xcd_barrier_post(unsigned* bar, volatile LAS unsigned* st) {
    XcdBarrier b; b.bar = bar; b.x = xb_xcc_id(); b.st = st;
    if (threadIdx.x == 0) (void)xb_add(&bar[XB_XCNT(b.x)], 1u);
    return b;
}
__device__ __forceinline__ void xcd_barrier_complete(unsigned* bar, unsigned x, unsigned& nloc, unsigned& nx) {
    const unsigned G = gridDim.x * gridDim.y * gridDim.z;
    unsigned sum, cnt, mine, sp = 0u;
    for (;;) {
        sum = 0u; cnt = 0u; mine = 0u;
#pragma unroll
        for (unsigned j = 0; j < 16; ++j) { const unsigned c = xb_ld(&bar[XB_XCNT(j)]); sum += c; cnt += (c > 0u) ? 1u : 0u; mine = (j == x) ? c : mine; }
        if (sum == G) break;
        __builtin_amdgcn_s_sleep(1);
        if ((++sp & 255u) == 0u) { if (xb_ld(&bar[XB_TMO])) break; if (sp > XB_SPIN_CAP) { atomicAdd(&bar[XB_TMO], 1u); break; } }
    }
    nloc = mine > 0u ? mine : 1u; nx = cnt > 0u ? cnt : 1u;
}

__device__ __forceinline__ void xcd_barrier(const XcdBarrier& b) {
    asm volatile("s_waitcnt vmcnt(0)" ::: "memory");
    __syncthreads();
    if (threadIdx.x == 0) {
        unsigned* bar = b.bar;
        __builtin_amdgcn_s_waitcnt(0);
        unsigned nloc = b.st[0], nx = b.st[1];
        if (nloc == 0u) { xcd_barrier_complete(bar, b.x, nloc, nx); b.st[0] = nloc; b.st[1] = nx; }
        const unsigned old = xb_add(&bar[XB_XSUB(b.x)], 1u);
        const unsigned gen = old / nloc;
        if (old + 1u == (gen + 1u) * nloc) {
            __builtin_amdgcn_fence(__ATOMIC_RELEASE, "agent");
            asm volatile("s_waitcnt vmcnt(0)" ::: "memory");
            const unsigned og = xb_add(&bar[XB_TOP], 1u);
            const unsigned tg = og / nx;
            if (og + 1u == (tg + 1u) * nx) xb_add(&bar[XB_TOPGEN], 1u);
            else XB_SPIN(xb_ld(&bar[XB_TOPGEN]) == tg, bar);
            __builtin_amdgcn_fence(__ATOMIC_ACQUIRE, "agent");
            xb_add(&bar[XB_XGEN(b.x)], 1u);
            asm volatile("s_waitcnt vmcnt(0)" ::: "memory");
        } else {
            XB_SPIN(xb_ld(&bar[XB_XGEN(b.x)]) == gen, bar);
            __builtin_amdgcn_fence(__ATOMIC_ACQUIRE, "agent");
            asm volatile("s_waitcnt vmcnt(0)" ::: "memory");
        }
    }
    __syncthreads();
}

struct Args { const float* in[16]; float* out; unsigned char* ws; };

__device__ __forceinline__ float* hrow_ptr(float* out, float* hmeta, int row) { return row < NREAL ? out + (size_t)row * 1024 : hmeta + (size_t)(row - NREAL) * 1024; }

__device__ __forceinline__ float norm_row_store(const f32x4 (&v)[4], const float* g, bf16_t* orow, int lane) {
    float s = 0.f;
#pragma unroll
    for (int j = 0; j < 4; ++j) s += (v[j].x * v[j].x + v[j].y * v[j].y) + (v[j].z * v[j].z + v[j].w * v[j].w);
    const float r = __builtin_amdgcn_rsqf(wave_sum(s) * (1.f / 1024.f) + NORM_EPS);
    unsigned long long* o8 = (unsigned long long*)orow + lane;
#pragma unroll
    for (int j = 0; j < 4; ++j) { const f32x4 gg = ((const f32x4*)g)[lane + 64 * j];
        o8[64 * j] = (unsigned long long)pk2(v[j].x * r * gg.x, v[j].y * r * gg.y) | ((unsigned long long)pk2(v[j].z * r * gg.z, v[j].w * r * gg.w) << 32); }
    return r;
}

__device__ __forceinline__ float norm_row_store_g(const f32x4 (&v)[4], const f32x4 (&gg)[4], bf16_t* orow, int lane) {
    float s = 0.f;
#pragma unroll
    for (int j = 0; j < 4; ++j) s += (v[j].x * v[j].x + v[j].y * v[j].y) + (v[j].z * v[j].z + v[j].w * v[j].w);
    const float r = __builtin_amdgcn_rsqf(wave_sum(s) * (1.f / 1024.f) + NORM_EPS);
    unsigned long long* o8 = (unsigned long long*)orow + lane;
#pragma unroll
    for (int j = 0; j < 4; ++j) o8[64 * j] = (unsigned long long)pk2(v[j].x * r * gg[j].x, v[j].y * r * gg[j].y) | ((unsigned long long)pk2(v[j].z * r * gg[j].z, v[j].w * r * gg[j].w) << 32);
    return r;
}

__device__ __forceinline__ int crow_(int r, int hi) { return (r & 3) + 8 * (r >> 2) + 4 * hi; }
__device__ __forceinline__ void thin_tile(float* T, float* part, const bf16_t* A, int lda, const bf16_t* B0, const bf16_t* B1, int ldb, int K, int wave, int lane, int tid) {
    const int r32 = lane & 31, hi = lane >> 5, kc = K >> 3, kbeg = wave * kc;
    const bf16_t* ap = A + (size_t)r32 * lda + kbeg + hi * 8;
    const bf16_t* b0p = B0 + (size_t)r32 * ldb + kbeg + hi * 8;
    const bf16_t* b1p = B1 + (size_t)r32 * ldb + kbeg + hi * 8;
    f32x16_t c0 = {}, c1 = {};
#pragma unroll 1
    for (int k = 0; k < kc; k += 128) {
        bf16x8 a[8], b0[8], b1[8];
#pragma unroll
        for (int i = 0; i < 8; ++i) if (k + 16 * i < kc) { a[i] = *(const bf16x8*)(ap + k + 16 * i); b0[i] = *(const bf16x8*)(b0p + k + 16 * i); b1[i] = *(const bf16x8*)(b1p + k + 16 * i); }
#pragma unroll
        for (int i = 0; i < 8; ++i) if (k + 16 * i < kc) {
            c0 = __builtin_amdgcn_mfma_f32_32x32x16_bf16(a[i], b0[i], c0, 0, 0, 0);
            c1 = __builtin_amdgcn_mfma_f32_32x32x16_bf16(a[i], b1[i], c1, 0, 0, 0); }
    }
#pragma unroll
    for (int r = 0; r < 16; ++r) { const int tok = crow_(r, hi); part[wave * 2048 + tok * 64 + r32] = c0[r]; part[wave * 2048 + tok * 64 + 32 + r32] = c1[r]; }
    __syncthreads();
    for (int i = tid; i < 2048; i += 512) { float s = 0.f;
#pragma unroll
        for (int w = 0; w < 8; ++w) s += part[w * 2048 + i];
        T[i] = s; }
    __syncthreads();
}
enum ThinKind { TK_SWIGLU = 0, TK_PLAIN = 1, TK_RECIN = 2, TK_QKV = 3, TK_GATE = 4 };
struct ThinP { const bf16_t* A; int lda; const bf16_t* Bt; int ldb; int K; int nunits;
               bf16_t* O0; bf16_t* O1; bf16_t* O2; unsigned short* AB; const float* p0; const float* p1; };
template <int KIND> __device__ __forceinline__ void thin_phase(unsigned char* lds, const ThinP& P, int tid, int wave, int lane, int bid, int G) {
    float* part = (float*)lds; float* T = (float*)(lds + 65536);
    for (int u = bid; u < P.nunits; u += G) {
        int r0, r1, ak = 0;
        if (KIND == TK_SWIGLU) { const int c0 = 32 * u; r0 = (c0 >> 7) * 256 + (c0 & 127); r1 = r0 + 128; }
        else if (KIND == TK_PLAIN || KIND == TK_RECIN) { r0 = 64 * u; r1 = r0 + 32; }
        else if (KIND == TK_QKV) { r0 = (u >> 2) * 256 + 32 * (u & 3); r1 = r0 + 128; }
        else { const int d = u >> 5, h = (u >> 3) & 3, g32 = u & 7; r0 = (d * 8 + h * 2 + (g32 >> 2)) * 256 + (g32 & 3) * 32; r1 = r0 + 128; ak = h * (ROWS_ALLOC * 256); }
        thin_tile(T, part, P.A + (size_t)NREAL * P.lda + ak, P.lda, P.Bt + (size_t)r0 * P.ldb, P.Bt + (size_t)r1 * P.ldb, P.ldb, P.K, wave, lane, tid);
        if (KIND == TK_SWIGLU) {
            for (int idx = tid; idx < 1024; idx += 512) { const int r = idx >> 5, c = idx & 31; const float gt = T[r * 64 + c], up = T[r * 64 + 32 + c];
                P.O0[(size_t)(NREAL + r) * 2816 + 32 * u + c] = (bf16_t)f2bf(gt * pg8::sigm(gt) * up); }
        } else if (KIND == TK_PLAIN) {
            for (int idx = tid; idx < 2048; idx += 512) { const int r = idx >> 6, c = idx & 63; P.O0[(size_t)(NREAL + r) * 1024 + 64 * u + c] = (bf16_t)f2bf(T[idx]); }
        } else if (KIND == TK_RECIN) {
            for (int idx = tid; idx < 2048; idx += 512) { const int r = idx >> 6, c = idx & 63; const float v = T[idx];
                if (u < 16) P.O0[(size_t)(NREAL + r) * 1024 + 64 * u + c] = (bf16_t)f2bf(pg8::gelu_tanh(v));
                else P.O1[(size_t)(NREAL + r) * 1024 + 64 * (u - 16) + c] = (bf16_t)f2bf(v); }
        } else if (KIND == TK_QKV) {
            for (int idx = tid; idx < 2048; idx += 512) { const int r = idx >> 6, dd = idx & 63; const float v = T[idx];
                if (u < 20) { const float rms = __builtin_amdgcn_rsqf(wave_sum(v * v) * (1.f / 64.f) + NORM_EPS);
                    if (u < 16) P.O0[(size_t)(NREAL + r) * 1024 + 64 * u + dd] = (bf16_t)f2bf(v * rms * P.p0[dd] * ATT_C2);
                    else P.O1[(size_t)(NREAL + r) * 256 + 64 * (u - 16) + dd] = (bf16_t)f2bf(v * rms * P.p1[dd]); }
                else P.O2[(size_t)(NREAL + r) * 256 + 64 * (u - 20) + dd] = (bf16_t)f2bf(v); }
        } else {
            const int d = u >> 5, h = (u >> 3) & 3, g32 = u & 7, cb = h * 256 + g32 * 32;
            for (int idx = tid; idx < 1024; idx += 512) { const int r = idx >> 5, c = idx & 31, ch = cb + c;
                P.AB[((size_t)d * NROWS + NREAL + r) * 1024 + ch] = (unsigned short)pg8::q8pair(pg8::sigm(T[r * 64 + c] + P.p0[(d * 2 + 0) * 1024 + ch]), pg8::sigm(T[r * 64 + 32 + c] + P.p0[(d * 2 + 1) * 1024 + ch])); }
        }
        __syncthreads();
    }
}

__device__ __forceinline__ int chunk_row0(int b, int j) { return j == 0 ? NREAL + b * 16 : b * 16384 + (j - 1) * 64; }
__device__ __forceinline__ void ab_from(unsigned w, float xc, float sp, float& a, float& b) {
    const float r = (float)(w & 0xffu) * (1.f / 255.f), ig = (float)((w >> 8) & 0xffu) * (1.f / 255.f);
    a = __builtin_amdgcn_exp2f(sp * r); b = __builtin_amdgcn_sqrtf(__builtin_fmaf(-a, a, 1.f)) * (ig * xc);
}
__device__ __forceinline__ float sp_of(float lam) { const float e = __builtin_amdgcn_exp2f(-LOG2E * lam); return -8.f * LOG2E * (0.6931471805599453f * __builtin_amdgcn_logf(1.f + e)); }
template <int LEN> __device__ __forceinline__ void scanA_item(const unsigned short* ab, const bf16_t* xc, int dir, float sp, float rb, float ib, f32x2_tt* outp) {
    constexpr int BT = LEN < 32 ? LEN : 32;
    float h = 0.f, P = 1.f;
#pragma unroll 1
    for (int t0 = 0; t0 < LEN; t0 += BT) {
        unsigned w[BT]; unsigned short x[BT];
#pragma unroll
        for (int t = 0; t < BT; ++t) { const int tt = dir ? LEN - 1 - (t0 + t) : t0 + t; w[t] = ab[(size_t)tt * 1024]; x[t] = xc[(size_t)tt * 256]; }
#pragma unroll
        for (int t = 0; t < BT; ++t) { float a, b; ab_from(w[t], bf2f(x[t]), sp, a, b); h = a * h + b; P *= a; }
    }
    *outp = (f32x2_tt){P, h};
}
template <int LEN> __device__ __forceinline__ void scanC_item(const unsigned short* abf, const unsigned short* abb, const bf16_t* xc, const bf16_t* gate, bf16_t* y, float cf, float cb, float spf, float spb, float rbf, float ibf, float rbb, float ibb) {
    constexpr int BT = LEN < 16 ? LEN : 16;
    float hf[LEN]; float h = cf;
#pragma unroll
    for (int t0 = 0; t0 < LEN; t0 += BT) {
        unsigned w[BT]; unsigned short x[BT];
#pragma unroll
        for (int t = 0; t < BT; ++t) { w[t] = abf[(size_t)(t0 + t) * 1024]; x[t] = xc[(size_t)(t0 + t) * 256]; }
#pragma unroll
        for (int t = 0; t < BT; ++t) { float a, b; ab_from(w[t], bf2f(x[t]), spf, a, b); h = a * h + b; hf[t0 + t] = h; }
        asm volatile("" ::: "memory");
    }
    h = cb;
#pragma unroll
    for (int t0 = LEN - BT; t0 >= 0; t0 -= BT) {
        unsigned w[BT]; unsigned short x[BT], g[BT];
#pragma unroll
        for (int t = 0; t < BT; ++t) { w[t] = abb[(size_t)(t0 + t) * 1024]; x[t] = xc[(size_t)(t0 + t) * 256]; g[t] = gate[(size_t)(t0 + t) * 1024]; }
#pragma unroll
        for (int t = BT - 1; t >= 0; --t) { float a, b; ab_from(w[t], bf2f(x[t]), spb, a, b); h = a * h + b;
            y[(size_t)(t0 + t) * 1024] = (bf16_t)f2bf((hf[t0 + t] + h) * bf2f(g[t])); }
        asm volatile("" ::: "memory");
    }
}


template <int LEN> __device__ __forceinline__ void scanA2_item(const unsigned* ab, const unsigned* xc, int dir, float sp0, float sp1, f32x4* outp) {
    constexpr int BT = LEN < 32 ? LEN : 32;
    float h0 = 0.f, P0 = 1.f, h1 = 0.f, P1 = 1.f;
#pragma unroll 1
    for (int t0 = 0; t0 < LEN; t0 += BT) {
        unsigned w[BT], x[BT];
#pragma unroll
        for (int t = 0; t < BT; ++t) { const int tt = dir ? LEN - 1 - (t0 + t) : t0 + t; w[t] = ab[(size_t)tt * 512]; x[t] = xc[(size_t)tt * 128]; }
#pragma unroll
        for (int t = 0; t < BT; ++t) { float a, b; ab_from(w[t] & 0xffffu, __uint_as_float(x[t] << 16), sp0, a, b); h0 = a * h0 + b; P0 *= a;
                                       ab_from(w[t] >> 16, __uint_as_float(x[t] & 0xffff0000u), sp1, a, b); h1 = a * h1 + b; P1 *= a; }
    }
    *outp = (f32x4){P0, h0, P1, h1};
}
template <int LEN> __device__ __forceinline__ void scanC2_item(const unsigned* abf, const unsigned* abb, const unsigned* xc, const unsigned* gate, unsigned* y, f32x2_tt cf, f32x2_tt cb, f32x2_tt spf, f32x2_tt spb) {
    constexpr int BT = LEN < 16 ? LEN : 16;
    float hf0[LEN], hf1[LEN]; float h0 = cf.x, h1 = cf.y;
#pragma unroll
    for (int t0 = 0; t0 < LEN; t0 += BT) {
        unsigned w[BT], x[BT];
#pragma unroll
        for (int t = 0; t < BT; ++t) { w[t] = abf[(size_t)(t0 + t) * 512]; x[t] = xc[(size_t)(t0 + t) * 128]; }
#pragma unroll
        for (int t = 0; t < BT; ++t) { float a, b; ab_from(w[t] & 0xffffu, __uint_as_float(x[t] << 16), spf.x, a, b); h0 = a * h0 + b; hf0[t0 + t] = h0;
                                       ab_from(w[t] >> 16, __uint_as_float(x[t] & 0xffff0000u), spf.y, a, b); h1 = a * h1 + b; hf1[t0 + t] = h1; }
        asm volatile("" ::: "memory");
    }
    h0 = cb.x; h1 = cb.y;
#pragma unroll
    for (int t0 = LEN - BT; t0 >= 0; t0 -= BT) {
        unsigned w[BT], x[BT], g[BT];
#pragma unroll
        for (int t = 0; t < BT; ++t) { w[t] = abb[(size_t)(t0 + t) * 512]; x[t] = xc[(size_t)(t0 + t) * 128]; g[t] = gate[(size_t)(t0 + t) * 512]; }
#pragma unroll
        for (int t = BT - 1; t >= 0; --t) { float a, b; ab_from(w[t] & 0xffffu, __uint_as_float(x[t] << 16), spb.x, a, b); h0 = a * h0 + b;
            ab_from(w[t] >> 16, __uint_as_float(x[t] & 0xffff0000u), spb.y, a, b); h1 = a * h1 + b;
            y[(size_t)(t0 + t) * 512] = pk2((hf0[t0 + t] + h0) * __uint_as_float(g[t] << 16), (hf1[t0 + t] + h1) * __uint_as_float(g[t] & 0xffff0000u)); }
        asm volatile("" ::: "memory");
    }
}

typedef const __attribute__((address_space(4))) Args* KArgP;
#define KARGS() ({ KArgP p_ = (KArgP)__builtin_amdgcn_kernarg_segment_ptr(); asm volatile("" : "+s"(p_)); p_; })
#define GSYNC() do { KArgP apb_ = KARGS(); XcdBarrier b_; b_.bar = (unsigned*)(apb_->ws + 16384); b_.x = xb_xcc_id(); b_.st = (volatile LAS unsigned*)(ldsl + 131072 + 32); xcd_barrier(b_); } while (0)
#define WSP(T, off) ((T*)(ws + (off)))
#ifndef DEFER_CONV
#define DEFER_CONV 0
#endif
#define IDS() int tid_ = threadIdx.x; asm volatile("" : "+v"(tid_)); const int tid = tid_, lane = tid & 63, wave = __builtin_amdgcn_readfirstlane(tid >> 6); const int G = gridDim.x, bid = blockIdx.x; \
              const int vcu = (G % 8 == 0) ? (bid % 8) * (G / 8) + bid / 8 : bid; const int gw = vcu * 8 + wave, NGW = G * 8; const int gtid = bid * 512 + tid, GT = G * 512; \
              (void)lane; (void)vcu; (void)gw; (void)NGW; (void)gtid; (void)GT;

constexpr int IA = 8 * 2816, IB = 8 * 1408, IC = 2 * 768, ID = 2 * 512, IE = 2 * 1024, IF = 32 * 32, IG = 2 * 512, NIT = IA + IB + IC + ID + IE + IF + IG;
constexpr int N_EARLY = 2 * 2816 + 2 * 1408 + 768 + 512, N_DEFER = NIT - N_EARLY;
__device__ __forceinline__ int tr_early_item(int e) { return e < 5632 ? e : e < 8448 ? IA + (e - 5632) : e < 9216 ? IA + IB + (e - 8448) : IA + IB + IC + (e - 9216); }
__device__ __forceinline__ int tr_defer_item(int d) { return d < 16896 ? 5632 + d : d < 25344 ? IA + 2816 + (d - 16896) : d < 26112 ? IA + IB + 768 + (d - 25344) : d < 26624 ? IA + IB + IC + 512 + (d - 26112) : IA + IB + IC + ID + (d - 26624); }
static_assert(N_EARLY == 9728 && N_DEFER == 30720, "conversion item split");
__device__ __forceinline__ TrD tr_decode(KArgP ap, bf16_t* Wb, int r) {
            if (r < IA) { const int mat = r / 2816, q = r % 2816, kb = q / 176, nb = q % 176, n0 = 32 * nb, bj = n0 / 2816, c = n0 % 2816;
                return TrD{ap->in[3] + (size_t)mat * 1024 * 5632, Wb + W_IN + (size_t)mat * 5632 * 1024, 1024, 5632, 64 * kb, n0, (c >> 7) * 256 + bj * 128 + (c & 127)}; } r -= IA;
            if (r < IB) { const int mat = r / 1408, q = r % 1408, kb = q / 32, nb = q % 32;
                return TrD{ap->in[4] + (size_t)mat * 2816 * 1024, Wb + W_OUT + (size_t)mat * 1024 * 2816, 2816, 1024, 64 * kb, 32 * nb, 32 * nb}; } r -= IB;
            if (r < IC) { const int mat = r / 768, q = r % 768, kb = q / 48, nb = q % 48, n0 = 32 * nb, tile = n0 >> 8, rr = n0 & 255;
                return TrD{ap->in[5] + (size_t)mat * 1024 * 1536, Wb + W_QKV + (size_t)mat * 1536 * 1024, 1024, 1536, 64 * kb, n0, tile * 256 + 128 * ((rr & 63) >> 5) + 32 * (rr >> 6)}; } r -= IC;
            if (r < ID) { const int mat = r / 512, q = r % 512, kb = q / 32, nb = q % 32;
                return TrD{ap->in[8] + (size_t)mat * 1024 * 1024, Wb + W_O + (size_t)mat * 1024 * 1024, 1024, 1024, 64 * kb, 32 * nb, 32 * nb}; } r -= ID;
            if (r < IE) { const int mat = r / 1024, q = r % 1024, kb = q / 64, nb = q % 64;
                return TrD{ap->in[9] + (size_t)mat * 1024 * 2048, Wb + W_RIN + (size_t)mat * 2048 * 1024, 1024, 2048, 64 * kb, 32 * nb, 32 * nb}; } r -= IE;
            if (r < IF) { const int sub = r >> 5, q = r & 31, kb = q >> 3, nb = q & 7, n0 = 32 * nb, jl = sub >> 4, d = (sub >> 3) & 1, g = (sub >> 2) & 1, h = sub & 3;
                return TrD{ap->in[12] + (size_t)sub * 256 * 256, Wb + W_RG + (size_t)jl * 4096 * 256, 256, 256, 64 * kb, n0, (d * 8 + h * 2 + (n0 >> 7)) * 256 + g * 128 + (n0 & 127)}; } r -= IF;
            { const int mat = r / 512, q = r % 512, kb = q / 32, nb = q % 32;
                return TrD{ap->in[15] + (size_t)mat * 1024 * 1024, Wb + W_RO + (size_t)mat * 1024 * 1024, 1024, 1024, 64 * kb, 32 * nb, 32 * nb}; }
        }

__global__ void __launch_bounds__(512, 2) fwd_megakernel(Args args_unused) {
    extern __shared__ __attribute__((aligned(16))) unsigned char lds[];
    cg::grid_group grid = cg::this_grid();
    LAS unsigned char* ldsl = (LAS unsigned char*)lds;
    for (int u = threadIdx.x; u < 64; u += 512) ((LAS unsigned*)(ldsl + 131072))[u] = 0u;
    __syncthreads();
    { KArgP ap0 = KARGS(); (void)xcd_barrier_post((unsigned*)(ap0->ws + 16384), (volatile LAS unsigned*)(ldsl + 131072 + 32)); }
    grid.sync();

#if PHM & 1
    {
        KArgP ap = KARGS(); unsigned char* ws = ap->ws; IDS();
        float* scr = (float*)(lds + wave * 16384); bf16_t* Wb = WSP(bf16_t, WS_W);
#ifdef NANFILL
        {
            u32x4* f0 = (u32x4*)(ws + WS_Y); const size_t n16 = (WS_END - WS_Y) / 16; const u32x4 q = {0xffffffffu, 0xffffffffu, 0xffffffffu, 0xffffffffu};
            for (size_t i = gtid; i < n16; i += GT) f0[i] = q;
        }
#endif
        const bool defer_ = DEFER_CONV && G == 256; const int n_pro = defer_ ? N_EARLY : NIT;
#pragma unroll 1
        for (int it = gw; it < n_pro; it += 2 * NGW) {
            const bool hasb = it + NGW < n_pro; const int ib_ = hasb ? it + NGW : it;
            const TrD da = tr_decode(ap, Wb, defer_ ? tr_early_item(it) : it), db = tr_decode(ap, Wb, defer_ ? tr_early_item(ib_) : ib_);
            float ra[32], rb[32]; tr_load(ra, da, lane); tr_load(rb, db, lane);
            tr_finish(ra, da, scr, lane);
            if (hasb) tr_finish(rb, db, scr, lane);
        }
        __builtin_amdgcn_s_waitcnt(0);
        float* tcos = WSP(float, WS_COS); float* tsin = WSP(float, WS_SIN);
        for (int idx = gtid; idx < 16384 * 32; idx += GT) { const int s = idx >> 5, j = idx & 31, jj = j & 15; const float pos = (float)(j < 16 ? (s >> 6) : (s & 63));
            const float inv = __builtin_amdgcn_exp2f(-(float)jj * (13.287712379549449f / 16.f)); const float th = pos * inv;
            const double turns = (double)th * 0.15915494309189535; const float fr = (float)(turns - __builtin_floor(turns));
            tcos[idx] = __builtin_amdgcn_cosf(fr); tsin[idx] = __builtin_amdgcn_sinf(fr); }
        float* HS = WSP(float, WS_XB + 1 * MiB); bf16_t* XN = WSP(bf16_t, WS_XN); const float* gains = ap->in[2];
#pragma unroll 1
        for (int row = gw; row < NROWS; row += 2 * NGW) {
            f32x4 vv[2][4];
#pragma unroll
            for (int q = 0; q < 2; ++q) { const int rq = (row + q * NGW < NROWS) ? row + q * NGW : row;
                const float* src = rq < NREAL ? ap->in[0] + (size_t)rq * 1024 : ap->in[1] + (size_t)((rq - NREAL) & 15) * 1024;
#pragma unroll
                for (int j = 0; j < 4; ++j) vv[q][j] = ((const f32x4*)src)[lane + 64 * j]; }
#pragma unroll
            for (int q = 0; q < 2; ++q) { const int rr = row + q * NGW; if (rr >= NROWS) break;
                const float rstd = norm_row_store(vv[q], gains, XN + (size_t)rr * 1024, lane); if (lane == 0) HS[rr] = __builtin_amdgcn_rcpf(rstd); }
        }
    }
#endif
    GSYNC();

#pragma unroll 1
    for (int layer = 0; layer < 4; ++layer) {
#pragma unroll 1
        for (int stage = 0; stage < 3; ++stage) {
            const int jl = layer >> 1;
#ifdef TESTSKIP
            if (stage == 1 && ((TESTSKIP >> (layer & 1)) & 1)) continue;
#endif
            int oAsel, oK; size_t oBoff; float coef; int gpost_i, gpre_i;
            if (stage != 1) {
                const int f = stage >> 1;
                {
                    KArgP ap = KARGS(); unsigned char* ws = ap->ws; IDS();
                    const bf16_t* Win = WSP(bf16_t, WS_W) + W_IN + (size_t)(layer * 2 + f) * 5632 * 1024; bf16_t* XN = WSP(bf16_t, WS_XN); bf16_t* ACT = WSP(bf16_t, WS_R1);
#if PHM & 2
                    { pg8::Gemm g{XN, Win, 1024, 1024, 1024, 0}; pg8::StaticOrder S; S.init(NREAL, 5632, G, bid); pg8::EpiSwiGLU E{ACT};
                      pg8::gemm_phase<pg8::EpiSwiGLU, pg8::StaticOrder, PG8_ALIGN, PG8_SP2>(ldsl, g, S, E); }
#endif
#if PHM & 4
                    { ThinP P{XN, 1024, Win, 1024, 1024, 88, ACT, nullptr, nullptr, nullptr, nullptr, nullptr}; thin_phase<TK_SWIGLU>(lds, P, tid, wave, lane, bid, G); }
#endif
                }
                GSYNC();
                oAsel = 0; oK = 2816; oBoff = W_OUT + (size_t)(layer * 2 + f) * 1024 * 2816; coef = 0.5f; gpost_i = layer * 6 + (f ? 5 : 1);
                gpre_i = f ? (layer < 3 ? layer * 6 + 6 : -1) : layer * 6 + 2;
            } else if ((layer & 1) == 0) {
                {
                    KArgP ap = KARGS(); unsigned char* ws = ap->ws; IDS();
                    const bf16_t* Wqkv = WSP(bf16_t, WS_W) + W_QKV + (size_t)jl * 1536 * 1024; const float* qg = ap->in[6] + jl * 64; const float* kg = ap->in[7] + jl * 64;
                    bf16_t* XN = WSP(bf16_t, WS_XN); bf16_t* QO = WSP(bf16_t, WS_R1); bf16_t* KB = WSP(bf16_t, WS_K); bf16_t* VB = WSP(bf16_t, WS_V);
#if PHM & 8
                    { pg8::Gemm g{XN, Wqkv, 1024, 1024, 1024, 0}; pg8::StaticOrder S; S.init(NREAL, 1536, G, bid); pg8::EpiQKV E{QO, KB, VB, qg, kg, WSP(float, WS_COS), WSP(float, WS_SIN), ATT_C2};
                      pg8::gemm_phase<pg8::EpiQKV, pg8::StaticOrder, PG8_ALIGN, PG8_SP2>(ldsl, g, S, E); }
#endif
#if PHM & 4
                    { ThinP P{XN, 1024, Wqkv, 1024, 1024, 24, QO, KB, VB, nullptr, qg, kg}; thin_phase<TK_QKV>(lds, P, tid, wave, lane, bid, G); }
#endif
                }
                GSYNC();
#if PHM & 16
                {
                    KArgP ap = KARGS(); unsigned char* ws = ap->ws; IDS();
                    bf16_t* QO = WSP(bf16_t, WS_R1); bf16_t* KB = WSP(bf16_t, WS_K); bf16_t* VB = WSP(bf16_t, WS_V);
                    float* PART_O = WSP(float, WS_AGG); float* PART_ML = WSP(float, WS_AGG + 2 * MiB);
                    for (int i = 0;; ++i) {
                        int bh, qb = 0, tb = 0, nt = 257, lm = 1; bool meta = false; float* po = nullptr; float* pml = nullptr;
                        if (G == 256) { if (i < 8) { bh = vcu >> 3; qb = (vcu & 7) + 8 * i; }
                                        else if (i == 8) { bh = vcu >> 3; meta = true; const int pc = vcu & 7; tb = 32 * pc; nt = 33; lm = (pc == 7) ? 1 : 2;
                                                           po = PART_O + (size_t)((bh * 8 + pc) * 16) * 64; pml = PART_ML + (size_t)((bh * 8 + pc) * 16) * 2; }
                                        else break; }
                        else { const int uid = i * G + bid; if (uid >= 2080) break; if (uid < 2048) { bh = uid >> 6; qb = uid & 63; } else { bh = uid - 2048; meta = true; } }
                        const int b = bh >> 4, h = bh & 15;
                        const long qrow0 = meta ? (long)(NREAL + b * 16) : (long)b * 16384 + (long)qb * 256;
                        attn_body::attn_unit<8>(b, h, qrow0, meta ? 16 : 256, tb, nt, lm, po, pml, (const attn_body::bf16*)QO, (const attn_body::bf16*)KB, (const attn_body::bf16*)VB, (attn_body::bf16*)QO, (char*)lds);
                        if (DEFER_CONV && layer == 0 && G == 256) {
                            const int d0 = ((i * 256 + bid) * 8 + wave) * 2;
                            if (d0 < N_DEFER) { bf16_t* Wb = WSP(bf16_t, WS_W); float* scr = (float*)(lds + wave * 16384);
                                const bool hasb = d0 + 1 < N_DEFER; const TrD da = tr_decode(ap, Wb, tr_defer_item(d0)), db = tr_decode(ap, Wb, tr_defer_item(hasb ? d0 + 1 : d0));
                                float ra[32], rb[32]; tr_load(ra, da, lane); tr_load(rb, db, lane);
                                tr_finish(ra, da, scr, lane);
                                if (hasb) tr_finish(rb, db, scr, lane); }
                            __syncthreads();
                        }
                    }
                }
#endif
                GSYNC();
                {
                    KArgP ap = KARGS(); unsigned char* ws = ap->ws; IDS();
                    if (G == 256) {
                        const float* PART_O = WSP(float, WS_AGG); const float* PART_ML = WSP(float, WS_AGG + 2 * MiB); bf16_t* QO = WSP(bf16_t, WS_R1);
                        for (int idx = gtid; idx < 32 * 16 * 64; idx += GT) { const int bh = idx >> 10, q = (idx >> 6) & 15, d = idx & 63;
                            float mp[8], M = -INFINITY;
#pragma unroll
                            for (int pc = 0; pc < 8; ++pc) { mp[pc] = PART_ML[(size_t)((bh * 8 + pc) * 16 + q) * 2]; M = fmaxf(M, mp[pc]); }
                            float num = 0.f, den = 0.f;
#pragma unroll
                            for (int pc = 0; pc < 8; ++pc) { const float w = __builtin_amdgcn_exp2f(mp[pc] - M); num += w * PART_O[(size_t)((bh * 8 + pc) * 16 + q) * 64 + d]; den += w * PART_ML[(size_t)((bh * 8 + pc) * 16 + q) * 2 + 1]; }
                            QO[(size_t)(NREAL + (bh >> 4) * 16 + q) * 1024 + (bh & 15) * 64 + d] = (bf16_t)f2bf(num / den); }
                    }
                }
                GSYNC();
                oAsel = 1; oK = 1024; oBoff = W_O + (size_t)jl * 1024 * 1024; coef = 1.f; gpost_i = layer * 6 + 3; gpre_i = layer * 6 + 4;
            } else {
                {
                    KArgP ap = KARGS(); unsigned char* ws = ap->ws; IDS();
                    const bf16_t* Wrin = WSP(bf16_t, WS_W) + W_RIN + (size_t)jl * 2048 * 1024; bf16_t* XN = WSP(bf16_t, WS_XN); bf16_t* GATE = WSP(bf16_t, WS_Y); bf16_t* XR = WSP(bf16_t, WS_R3);
#if PHM & 32
                    { pg8::Gemm g{XN, Wrin, 1024, 1024, 1024, 0}; pg8::StaticOrder S; S.init(NREAL, 2048, G, bid); pg8::EpiRecIn E{GATE, XR};
                      pg8::gemm_phase<pg8::EpiRecIn, pg8::StaticOrder, PG8_ALIGN, PG8_SP2>(ldsl, g, S, E); }
#endif
#if PHM & 4
                    { ThinP P{XN, 1024, Wrin, 1024, 1024, 32, GATE, XR, nullptr, nullptr, nullptr, nullptr}; thin_phase<TK_RECIN>(lds, P, tid, wave, lane, bid, G); }
#endif
                }
                GSYNC();
#if PHM & 64
                {
                    KArgP ap = KARGS(); unsigned char* ws = ap->ws; IDS();
                    const bf16_t* XR = WSP(bf16_t, WS_R3); bf16_t* XC = WSP(bf16_t, WS_HB);
                    const float* cw = ap->in[10] + (size_t)jl * 4 * 1024; const float* cbias = ap->in[11] + (size_t)jl * 1024;
                    const int ckc = (gtid & 127) * 8;
                    const f32x4 cb0 = *(const f32x4*)(cbias + ckc), cb1 = *(const f32x4*)(cbias + ckc + 4); f32x4 cw0[4], cw1[4];
#pragma unroll
                    for (int j = 0; j < 4; ++j) { cw0[j] = *(const f32x4*)(cw + j * 1024 + ckc); cw1[j] = *(const f32x4*)(cw + j * 1024 + ckc + 4); }
#pragma unroll 1
                    for (int it0 = gtid; it0 < NROWS * 128; it0 += 2 * GT) {
                        u32x4 xv[2][4]; float wm[2][4]; int Rq[2], ckq[2];
#pragma unroll
                        for (int q = 0; q < 2; ++q) { const int it = (it0 + q * GT < NROWS * 128) ? it0 + q * GT : it0; const int R = it >> 7, ck = (it & 127) * 8; int b, p;
                            if (R < NREAL) { b = R >> 14; p = 16 + (R & 16383); } else { b = (R - NREAL) >> 4; p = (R - NREAL) & 15; }
                            Rq[q] = R; ckq[q] = ck;
#pragma unroll
                            for (int j = 0; j < 4; ++j) { const int pp = p + j - 2; const bool ok = pp >= 0 && pp < 16400; const int sr = ok ? (pp < 16 ? NREAL + b * 16 + pp : b * 16384 + pp - 16) : R;
                                xv[q][j] = *(const u32x4*)(XR + (size_t)sr * 1024 + ck); wm[q][j] = ok ? 1.f : 0.f; } }
#pragma unroll
                        for (int q = 0; q < 2; ++q) { if (q == 1 && it0 + GT >= NROWS * 128) break; const int R = Rq[q], ck = ckq[q];
                            f32x4 a0 = cb0, a1 = cb1;
#pragma unroll
                            for (int j = 0; j < 4; ++j) { const u32x4 x = xv[q][j]; const f32x4 w0 = cw0[j] * wm[q][j], w1 = cw1[j] * wm[q][j];
                                a0[0] += __uint_as_float(x[0] << 16) * w0[0]; a0[1] += __uint_as_float(x[0] & 0xffff0000u) * w0[1]; a0[2] += __uint_as_float(x[1] << 16) * w0[2]; a0[3] += __uint_as_float(x[1] & 0xffff0000u) * w0[3];
                                a1[0] += __uint_as_float(x[2] << 16) * w1[0]; a1[1] += __uint_as_float(x[2] & 0xffff0000u) * w1[1]; a1[2] += __uint_as_float(x[3] << 16) * w1[2]; a1[3] += __uint_as_float(x[3] & 0xffff0000u) * w1[3]; }
                            u32x4 o; o.x = pk2(a0[0], a0[1]); o.y = pk2(a0[2], a0[3]); o.z = pk2(a1[0], a1[1]); o.w = pk2(a1[2], a1[3]);
                            *(u32x4*)(XC + ((size_t)(ck >> 8) * ROWS_ALLOC + R) * 256 + (ck & 255)) = o; }
                    }
                }
#endif
                GSYNC();
                {
                    KArgP ap = KARGS(); unsigned char* ws = ap->ws; IDS();
                    const bf16_t* Wrg = WSP(bf16_t, WS_W) + W_RG + (size_t)jl * 4096 * 256; bf16_t* XC = WSP(bf16_t, WS_HB); unsigned short* AB = WSP(unsigned short, WS_R1);
                    const float* gbias = ap->in[13] + (size_t)jl * 4 * 1024;
#if (PHM & 128) && (!defined(RECTEST) || RECTEST >= 2)
                    { pg8::Gemm g{XC, Wrg, 256, 256, 256, 1}; pg8::StaticOrder S; S.init(NREAL, 4096, G, bid); pg8::EpiGate E{AB, gbias};
                      pg8::gemm_phase<pg8::EpiGate, pg8::StaticOrder, PG8_ALIGN, PG8_SP2>(ldsl, g, S, E); }
#endif
#if (PHM & 4) && (!defined(RECTEST) || RECTEST >= 2)
                    { ThinP P{XC, 256, Wrg, 256, 256, 64, nullptr, nullptr, nullptr, AB, gbias, nullptr}; thin_phase<TK_GATE>(lds, P, tid, wave, lane, bid, G); }
#endif
                }
                GSYNC();
#if (PHM & 256) && (!defined(RECTEST) || RECTEST >= 2)
                {
                    KArgP ap = KARGS(); unsigned char* ws = ap->ws; IDS();
                    const unsigned short* AB = WSP(unsigned short, WS_R1); const bf16_t* XC = WSP(bf16_t, WS_HB); f32x2_tt* AGG = WSP(f32x2_tt, WS_AGG); const float* lam = ap->in[14] + (size_t)jl * 2 * 1024; const float* gbias = ap->in[13] + (size_t)jl * 4 * 1024;
                    for (int it = gw; it < 2 * 2 * NCHUNK * 8; it += NGW) {
                        const int cgp = it & 7, q = it >> 3; int j, db; if (it < 8192) { db = q >> 8; j = 1 + (q & 255); } else { db = q & 3; j = 0; }
                        const int d = db >> 1, b = db & 1, c = cgp * 128 + 2 * lane;
                        const unsigned* ab = (const unsigned*)(AB + ((size_t)d * NROWS + chunk_row0(b, j)) * 1024 + c); f32x4* op = (f32x4*)(AGG + ((size_t)db * NCHUNK + j) * 1024 + c);
                        const unsigned* xp = (const unsigned*)(XC + ((size_t)(c >> 8) * ROWS_ALLOC + chunk_row0(b, j)) * 256 + (c & 255)); const float sp0 = sp_of(lam[d * 1024 + c]), sp1 = sp_of(lam[d * 1024 + c + 1]);
                        if (j == 0) scanA2_item<16>(ab, xp, d, sp0, sp1, op); else scanA2_item<64>(ab, xp, d, sp0, sp1, op);
                    }
                }
#endif
                GSYNC();
#if (PHM & 512) && (!defined(RECTEST) || RECTEST >= 2)
                {
                    KArgP ap = KARGS(); unsigned char* ws = ap->ws; IDS();
                    if (wave == 0 && bid < 64) {
                        const int idx = bid * 64 + lane, db = idx >> 10, d = db >> 1, c = idx & 1023;
                        const f32x2_tt* ag = WSP(f32x2_tt, WS_AGG) + (size_t)db * NCHUNK * 1024 + c; float* ci = WSP(float, WS_CIN) + (size_t)db * NCHUNK * 1024 + c; float carry = 0.f;
#pragma unroll 1
                        for (int j0 = 0; j0 < 256; j0 += 16) { f32x2_tt v[16];
#pragma unroll
                            for (int k = 0; k < 16; ++k) { const int js = j0 + k; const int jj = d ? NCHUNK - 1 - js : js; v[k] = ag[(size_t)jj * 1024]; }
#pragma unroll
                            for (int k = 0; k < 16; ++k) { const int js = j0 + k; const int jj = d ? NCHUNK - 1 - js : js; ci[(size_t)jj * 1024] = carry; carry = v[k].x * carry + v[k].y; }
                        }
                        ci[(size_t)(d ? 0 : NCHUNK - 1) * 1024] = carry;
                    }
                }
#endif
                GSYNC();
#if PHM & 1024
                {
                    KArgP ap = KARGS(); unsigned char* ws = ap->ws; IDS();
                    const unsigned short* AB = WSP(unsigned short, WS_R1); const bf16_t* XC = WSP(bf16_t, WS_HB); const float* CIN = WSP(float, WS_CIN); const float* lam = ap->in[14] + (size_t)jl * 2 * 1024; const float* gbias = ap->in[13] + (size_t)jl * 4 * 1024;
                    const bf16_t* GATE = WSP(bf16_t, WS_Y); bf16_t* YS = WSP(bf16_t, WS_R3);
                    for (int it = gw; it < 2 * NCHUNK * 8; it += NGW) {
                        const int ln = (int)__builtin_amdgcn_mbcnt_hi(~0u, __builtin_amdgcn_mbcnt_lo(~0u, 0u));
                        const int cgp = it & 7, q = it >> 3; int j, b; if (it < 4096) { b = q >> 8; j = 1 + (q & 255); } else { b = q & 1; j = 0; }
                        const int c = cgp * 128 + 2 * ln; const int r0 = chunk_row0(b, j);
                        const unsigned* abf = (const unsigned*)(AB + ((size_t)r0) * 1024 + c); const unsigned* abb = (const unsigned*)(AB + ((size_t)NROWS + r0) * 1024 + c);
                        const f32x2_tt cf = *(const f32x2_tt*)(CIN + ((size_t)(0 * 2 + b) * NCHUNK + j) * 1024 + c), cb2 = *(const f32x2_tt*)(CIN + ((size_t)(1 * 2 + b) * NCHUNK + j) * 1024 + c);
                        const f32x2_tt spf = {sp_of(lam[c]), sp_of(lam[c + 1])}, spb = {sp_of(lam[1024 + c]), sp_of(lam[1024 + c + 1])};
                        const unsigned* xp = (const unsigned*)(XC + ((size_t)(c >> 8) * ROWS_ALLOC + r0) * 256 + (c & 255));
                        if (j == 0) scanC2_item<16>(abf, abb, xp, (const unsigned*)(GATE + (size_t)r0 * 1024 + c), (unsigned*)(YS + (size_t)r0 * 1024 + c), cf, cb2, spf, spb);
                        else scanC2_item<64>(abf, abb, xp, (const unsigned*)(GATE + (size_t)r0 * 1024 + c), (unsigned*)(YS + (size_t)r0 * 1024 + c), cf, cb2, spf, spb);
                    }
                }
#endif
                GSYNC();
                oAsel = 2; oK = 1024; oBoff = W_RO + (size_t)jl * 1024 * 1024; coef = 1.f; gpost_i = layer * 6 + 3; gpre_i = layer * 6 + 4;
            }
            {
                KArgP ap = KARGS(); unsigned char* ws = ap->ws; IDS();
                const bf16_t* oA = oAsel == 2 ? WSP(bf16_t, WS_R3) : WSP(bf16_t, WS_R1); const bf16_t* oBt = WSP(bf16_t, WS_W) + oBoff; bf16_t* Yb = WSP(bf16_t, WS_Y);
#if PHM & 2048
#ifdef FUSE_NR
                {
                    const int nri = layer * 3 + stage;
                    pg8::PanelSS st1{WSP(float, WS_XB), (unsigned*)(ws + WS_CNT) + (size_t)(2 * nri) * 128 * 64}, st2{WSP(float, WS_XB + 512 * 1024), (unsigned*)(ws + WS_CNT) + (size_t)(2 * nri + 1) * 128 * 64};
                    pg8::EpiNR E{ap->out, WSP(bf16_t, WS_XN), WSP(float, WS_XB + 1 * MiB), ap->in[2] + (size_t)(layer * 6 + 2 * stage) * 1024, ap->in[2] + (size_t)gpost_i * 1024, gpre_i >= 0 ? ap->in[2] + (size_t)gpre_i * 1024 : nullptr, coef, st1, st2};
                    pg8::Gemm g{oA, oBt, oK, oK, oK, 0};
#pragma unroll 1
                    for (int round = 0; round < 2; ++round) { pg8::RoundOrder S; S.base.init(NREAL, 1024, G, bid); S.round = round;
                        pg8::gemm_phase<pg8::EpiNR, pg8::RoundOrder, false, PG8_SP2>(ldsl, g, S, E); }
                }
#else
                { pg8::Gemm g{oA, oBt, oK, oK, oK, 0}; pg8::StaticOrder S; S.init(NREAL, 1024, G, bid); pg8::EpiPlain E{Yb};
                  pg8::gemm_phase<pg8::EpiPlain, pg8::StaticOrder, PG8_ALIGN, PG8_SP2>(ldsl, g, S, E); }
#endif
#endif
#if PHM & 4
                { ThinP P{oA, oK, oBt, oK, oK, 16, Yb, nullptr, nullptr, nullptr, nullptr, nullptr}; thin_phase<TK_PLAIN>(lds, P, tid, wave, lane, bid, G); }
#endif
            }
            GSYNC();
#if PHM & 4096
            {
                KArgP ap = KARGS(); unsigned char* ws = ap->ws; IDS();
                float* out = ap->out; float* HS = WSP(float, WS_XB + 1 * MiB); const bf16_t* Yb = WSP(bf16_t, WS_Y); bf16_t* XN = WSP(bf16_t, WS_XN);
                const float* gpost = ap->in[2] + (size_t)gpost_i * 1024; const float* gpre = gpre_i >= 0 ? ap->in[2] + (size_t)gpre_i * 1024 : nullptr;
                const float* gprev = ap->in[2] + (size_t)(layer * 6 + 2 * stage) * 1024;
                f32x4 ig[4], gpo[4], gpr[4];
#pragma unroll
                for (int j = 0; j < 4; ++j) { const int gi = 2 * (lane + 64 * (j >> 1)) + (j & 1); const f32x4 gg = ((const f32x4*)gprev)[gi];
                    ig[j] = (f32x4){__builtin_amdgcn_rcpf(gg.x), __builtin_amdgcn_rcpf(gg.y), __builtin_amdgcn_rcpf(gg.z), __builtin_amdgcn_rcpf(gg.w)};
                    gpo[j] = ((const f32x4*)gpost)[gi]; gpr[j] = gpre ? ((const f32x4*)gpre)[gi] : (f32x4){0.f, 0.f, 0.f, 0.f}; }
                constexpr int NRR = 2;
#pragma unroll 1
#ifdef FUSE_NR
                for (int row = NREAL + gw; row < NROWS; row += NRR * NGW) {
#else
                for (int row = gw; row < NROWS; row += NRR * NGW) {
#endif
                    u32x4 yw[NRR][2], hw_[NRR][2]; float hsq[NRR];
#pragma unroll
                    for (int q = 0; q < NRR; ++q) { const int rq = (row + q * NGW < NROWS) ? row + q * NGW : row; hsq[q] = __hip_atomic_load(HS + rq, __ATOMIC_RELAXED, __HIP_MEMORY_SCOPE_AGENT);
#pragma unroll
                        for (int jp = 0; jp < 2; ++jp) { yw[q][jp] = ((const u32x4*)(Yb + (size_t)rq * 1024))[lane + 64 * jp]; hw_[q][jp] = ((const u32x4*)(XN + (size_t)rq * 1024))[lane + 64 * jp]; } }
#pragma unroll
                    for (int q = 0; q < NRR; ++q) {
                        const int rr = row + q * NGW; if (rr >= NROWS) break;
                        f32x4 y[4], v[4]; float s = 0.f; const float hs = hsq[q];
#pragma unroll
                        for (int j = 0; j < 4; ++j) { const unsigned lo = yw[q][j >> 1][2 * (j & 1)], hi = yw[q][j >> 1][2 * (j & 1) + 1], hlo = hw_[q][j >> 1][2 * (j & 1)], hhi = hw_[q][j >> 1][2 * (j & 1) + 1];
                            y[j] = (f32x4){__uint_as_float(lo << 16), __uint_as_float(lo & 0xffff0000u), __uint_as_float(hi << 16), __uint_as_float(hi & 0xffff0000u)};
                            v[j] = (f32x4){__uint_as_float(hlo << 16), __uint_as_float(hlo & 0xffff0000u), __uint_as_float(hhi << 16), __uint_as_float(hhi & 0xffff0000u)} * hs * ig[j];
                            s += (y[j].x * y[j].x + y[j].y * y[j].y) + (y[j].z * y[j].z + y[j].w * y[j].w); }
                        const float r = coef * __builtin_amdgcn_rsqf(wave_sum(s) * (1.f / 1024.f) + NORM_EPS);
                        float s2 = 0.f;
#pragma unroll
                        for (int j = 0; j < 4; ++j) { v[j] = v[j] + y[j] * r * gpo[j]; s2 += (v[j].x * v[j].x + v[j].y * v[j].y) + (v[j].z * v[j].z + v[j].w * v[j].w); }
                        if (gpre) {
                            const float rstd = __builtin_amdgcn_rsqf(wave_sum(s2) * (1.f / 1024.f) + NORM_EPS);
#pragma unroll
                            for (int jp = 0; jp < 2; ++jp) { const f32x4 a0 = v[2 * jp] * rstd * gpr[2 * jp], a1 = v[2 * jp + 1] * rstd * gpr[2 * jp + 1];
                                u32x4 o; o.x = pk2(a0.x, a0.y); o.y = pk2(a0.z, a0.w); o.z = pk2(a1.x, a1.y); o.w = pk2(a1.z, a1.w);
                                ((u32x4*)(XN + (size_t)rr * 1024))[lane + 64 * jp] = o; }
                            if (lane == 0) HS[rr] = __builtin_amdgcn_rcpf(rstd);
                        } else if (rr < NREAL) {
#pragma unroll
                            for (int j = 0; j < 4; ++j) ((f32x4*)(out + (size_t)rr * 1024))[2 * (lane + 64 * (j >> 1)) + (j & 1)] = v[j];
                        }
                    }
                }
            }
#endif
            GSYNC();
        }
    }
}

extern "C" void kernel_launch(void* const* d_in, const int* in_sizes, int n_in, void* d_out, int out_size, void* d_ws, size_t ws_size, hipStream_t stream) {
    static int grid_blocks = 0;
    if (grid_blocks == 0) {
        if (n_in != 16 || ws_size < WS_END) { fprintf(stderr, "kernel_launch: unexpected n_in %d / ws_size %zu\n", n_in, ws_size); grid_blocks = -1; return; }
        int dev = 0, cus = 0, per_cu = 0;
        (void)hipGetDevice(&dev); (void)hipDeviceGetAttribute(&cus, hipDeviceAttributeMultiprocessorCount, dev);
        if (hipFuncSetAttribute((const void*)fwd_megakernel, hipFuncAttributeMaxDynamicSharedMemorySize, LDS_BYTES) != hipSuccess) { fprintf(stderr, "kernel_launch: hipFuncSetAttribute failed\n"); grid_blocks = -1; return; }
        if (hipOccupancyMaxActiveBlocksPerMultiprocessor(&per_cu, (const void*)fwd_megakernel, 512, LDS_BYTES) != hipSuccess || per_cu < 1) { fprintf(stderr, "kernel_launch: occupancy query says %d\n", per_cu); per_cu = 1; }
        (void)hipGetLastError();
        grid_blocks = cus > 0 ? cus : 256;
    }
    if (grid_blocks < 0) return;
    if (hipMemsetAsync(d_ws, 0, 1048576, stream) != hipSuccess) { fprintf(stderr, "kernel_launch: hipMemsetAsync failed\n"); return; }
    Args a{};
    for (int i = 0; i < 16; ++i) a.in[i] = (const float*)d_in[i];
    a.out = (float*)d_out; a.ws = (unsigned char*)d_ws;
    void* kargs[] = {&a};
    hipError_t e = hipLaunchCooperativeKernel((const void*)fwd_megakernel, dim3(grid_blocks), dim3(512), kargs, LDS_BYTES, stream);
    if (e != hipSuccess) fprintf(stderr, "cooperative launch failed: %s (grid %d)\n", hipGetErrorString(e), grid_blocks);
}
```

```cpp
#include <hip/hip_runtime.h>
#include <hip/hip_cooperative_groups.h>
#include <cstdio>
#include <cstdint>
namespace cg = cooperative_groups;

constexpr int NREAL = 32768, NROWS = 32800, ROWS_ALLOC = 33280;
constexpr int DMODEL = 1024, DFF = 2816, LSEQ_ = 16384, NCHUNK = 257;
constexpr float NORM_EPS = 1e-6f;
constexpr float LOG2E = 1.4426950408889634f;

namespace pg8 {

#define PG8_LAS __attribute__((address_space(3)))
typedef unsigned short bf16_t;
typedef short bf16x8 __attribute__((ext_vector_type(8)));
typedef float f32x4 __attribute__((ext_vector_type(4)));
typedef unsigned u32x4 __attribute__((ext_vector_type(4)));
constexpr int BM = 256, BK = 64, HALF = 128, HTB = HALF * BK * 2  , STAGE_BYTES = 8 * HTB, NXCD = 8, WGM = 8;

__host__ __device__ __forceinline__ int lds_byte(int r, int c) { const int st = (r >> 4) * 2 + (c >> 5), rr = r & 15, cc = c & 31, ob = rr * 64 + cc * 2; return st * 1024 + (ob ^ (((ob >> 9) & 1) << 5)); }
__host__ __device__ __forceinline__ void stage_rc(int b, int& R, int& C) { const int st = b / 1024, sb = b % 1024, swz = sb ^ (((sb >> 9) & 1) << 5); R = (st >> 1) * 16 + swz / 64; C = (st & 1) * 32 + (swz % 64) / 2; }
__host__ __device__ __forceinline__ int perm32(int rho) { const int n = rho >> 4, i = rho & 15; return 8 * (i >> 2) + 4 * n + (i & 3); }

struct Unit { int pm, pn; };
struct Gemm { const bf16_t* A; const bf16_t* Bt; int lda, ldb, K, akmode; };

struct StaticOrder {
    int nM, nN, nwg, G, c;
    __host__ __device__ void init(int M, int N, int G_, int c_) { nM = M / BM; nN = N / BM; nwg = nM * nN; G = G_; c = c_; }
    __host__ __device__ bool next(int i, Unit& u) const {
        const long L = (long)i * G + c; if (L >= nwg) return false;
        int wgid = (int)L; { const int q = nwg / NXCD, r = nwg % NXCD, xcd = wgid % NXCD, off = wgid / NXCD; wgid = (xcd < r ? xcd * (q + 1) : r * (q + 1) + (xcd - r) * q) + off; }
        const int nig = WGM * nN, gid = wgid / nig, fm = gid * WGM, gsz = (nM - fm) < WGM ? (nM - fm) : WGM;
        u.pm = fm + ((wgid % nig) % gsz); u.pn = (wgid % nig) / gsz; return true;
    }
    __device__ __forceinline__ void a_ready(const Unit&) const {}
    __device__ __forceinline__ void done(const Unit&) const {}
};


typedef float f32x2_cv __attribute__((ext_vector_type(2))); typedef __bf16 bf16x2_cv __attribute__((ext_vector_type(2)));
__device__ __forceinline__ unsigned cvt_pk_bf16(float lo, float hi) { const f32x2_cv v = {lo, hi}; return __builtin_bit_cast(unsigned, __builtin_convertvector(v, bf16x2_cv)); }
__device__ __forceinline__ float sigm(float x) { return __builtin_amdgcn_rcpf(1.f + __builtin_amdgcn_exp2f(-1.4426950408889634f * x)); }
__device__ __forceinline__ float gelu_tanh(float x) { const float z = 0.7978845608028654f * (x + 0.044715f * x * x * x); return x * sigm(2.f * z); }
__device__ __forceinline__ float bf2f(unsigned short b) { return __uint_as_float((unsigned)b << 16); }
__device__ __forceinline__ u32x4 pack8(const f32x4 a, const f32x4 b) { u32x4 w; w.x = cvt_pk_bf16(a[0], a[1]); w.y = cvt_pk_bf16(a[2], a[3]); w.z = cvt_pk_bf16(b[0], b[1]); w.w = cvt_pk_bf16(b[2], b[3]); return w; }
#ifndef WT_STORES
#define WT_STORES 0
#endif
__device__ __forceinline__ void st16(void* p, const u32x4 v) {
#if WT_STORES
    asm volatile("global_store_dwordx4 %0, %1, off sc1\n\ts_nop 1" :: "v"(p), "v"(v) : "memory");
#else
    *(u32x4*)p = v;
#endif
}

struct EpiSwiGLU {
    static constexpr bool PERM = true, AFTER_DRAIN = false;
    bf16_t* O;
    __device__ __forceinline__ void operator()(const f32x4 (&acc)[2][2][4][2], const Unit& u, int wr, int wc, int fr_in, int fq) const {
        int fr = fr_in; asm volatile("" : "+v"(fr));
        const int row0 = u.pm * BM + wr * 64 + fr, col0 = u.pn * 128 + wc * 32 + 8 * fq;
#pragma unroll
        for (int ai = 0; ai < 2; ++ai)
#pragma unroll
            for (int m = 0; m < 4; ++m) {
                f32x4 v[2];
#pragma unroll
                for (int n = 0; n < 2; ++n)
#pragma unroll
                    for (int j = 0; j < 4; ++j) { const float gt = acc[ai][0][m][n][j]; v[n][j] = gt * sigm(gt) * acc[ai][1][m][n][j]; }
                st16((char*)O + ((unsigned)(row0 + ai * HALF + m * 16) * 2816u + (unsigned)col0) * 2u, pack8(v[0], v[1]));
            }
    }
};
struct EpiPlain {
    static constexpr bool PERM = true, AFTER_DRAIN = false;
    bf16_t* O;
    __device__ __forceinline__ void operator()(const f32x4 (&acc)[2][2][4][2], const Unit& u, int wr, int wc, int fr_in, int fq) const {
        int fr = fr_in; asm volatile("" : "+v"(fr));
        const int row0 = u.pm * BM + wr * 64 + fr, col0 = u.pn * BM + wc * 32 + 8 * fq;
#pragma unroll
        for (int ai = 0; ai < 2; ++ai)
#pragma unroll
            for (int m = 0; m < 4; ++m)
#pragma unroll
                for (int bj = 0; bj < 2; ++bj)
                    st16((char*)O + ((unsigned)(row0 + ai * HALF + m * 16) * 1024u + (unsigned)(col0 + bj * HALF)) * 2u, pack8(acc[ai][bj][m][0], acc[ai][bj][m][1]));
    }
};
struct EpiRecIn {
    static constexpr bool PERM = true, AFTER_DRAIN = false;
    bf16_t* G; bf16_t* X;
    __device__ __forceinline__ void operator()(const f32x4 (&acc)[2][2][4][2], const Unit& u, int wr, int wc, int fr_in, int fq) const {
        int fr = fr_in; asm volatile("" : "+v"(fr));
        const int row0 = u.pm * BM + wr * 64 + fr, col0 = (u.pn & 3) * BM + wc * 32 + 8 * fq; const bool isg = u.pn < 4; bf16_t* O = isg ? G : X;
#pragma unroll
        for (int ai = 0; ai < 2; ++ai)
#pragma unroll
            for (int m = 0; m < 4; ++m)
#pragma unroll
                for (int bj = 0; bj < 2; ++bj) {
                    f32x4 v0 = acc[ai][bj][m][0], v1 = acc[ai][bj][m][1];
                    if (isg) {
#pragma unroll
                        for (int j = 0; j < 4; ++j) { v0[j] = gelu_tanh(v0[j]); v1[j] = gelu_tanh(v1[j]); } }
                    st16((char*)O + ((unsigned)(row0 + ai * HALF + m * 16) * 1024u + (unsigned)(col0 + bj * HALF)) * 2u, pack8(v0, v1));
                }
    }
};
struct EpiQKV {
    static constexpr bool PERM = true, AFTER_DRAIN = false;
    bf16_t *Q, *K, *V; const float *qg, *kg, *cs, *sn; float c2;
    __device__ __forceinline__ void operator()(const f32x4 (&acc)[2][2][4][2], const Unit& u, int wr, int wc, int fr_in, int fq) const {
        int fr = fr_in; asm volatile("" : "+v"(fr));
        const int row0 = u.pm * BM + wr * 64 + fr, pn = u.pn;
        if (pn == 5) {
#pragma unroll
            for (int ai = 0; ai < 2; ++ai)
#pragma unroll
                for (int m = 0; m < 4; ++m)
#pragma unroll
                    for (int bj = 0; bj < 2; ++bj)
                        st16((char*)V + ((unsigned)(row0 + ai * HALF + m * 16) * 256u + (unsigned)(wc * 64 + bj * 32 + 8 * fq)) * 2u, pack8(acc[ai][bj][m][0], acc[ai][bj][m][1]));
            return;
        }
        const bool isq = pn < 4; const float* gp = isq ? qg : kg; const float sc = isq ? c2 : 1.f;
        bf16_t* O = isq ? Q : K; const int pitch = isq ? 1024 : 256; const int hc = (isq ? (4 * pn + wc) : wc) * 64 + 8 * fq;
        f32x4 gq[2][2];
#pragma unroll
        for (int n = 0; n < 2; ++n) { gq[0][n] = *(const f32x4*)(gp + 8 * fq + 4 * n); gq[1][n] = *(const f32x4*)(gp + 32 + 8 * fq + 4 * n); }
#pragma unroll
        for (int ai = 0; ai < 2; ++ai)
#pragma unroll
            for (int m = 0; m < 4; ++m) {
                const int row = row0 + ai * HALF + m * 16;
                float ss = 0.f;
#pragma unroll
                for (int bj = 0; bj < 2; ++bj)
#pragma unroll
                    for (int n = 0; n < 2; ++n) { const f32x4 x = acc[ai][bj][m][n]; ss += (x[0] * x[0] + x[1] * x[1]) + (x[2] * x[2] + x[3] * x[3]); }
                ss += __shfl_xor(ss, 16); ss += __shfl_xor(ss, 32);
                const float rms = __builtin_amdgcn_rsqf(ss * (1.f / 64.f) + 1e-6f);
                const int s = row & 16383;
                f32x4 o1[2], o2[2];
#pragma unroll
                for (int n = 0; n < 2; ++n) {
                    const unsigned to = ((unsigned)s * 32u + (unsigned)(8 * fq + 4 * n)) * 4u; const f32x4 c = *(const f32x4*)((const char*)cs + to), sn4 = *(const f32x4*)((const char*)sn + to);
                    const f32x4 g1 = gq[0][n], g2 = gq[1][n];
                    const f32x4 x1 = acc[ai][0][m][n] * rms * g1, x2 = acc[ai][1][m][n] * rms * g2;
                    o1[n] = (x1 * c - x2 * sn4) * sc; o2[n] = (x1 * sn4 + x2 * c) * sc;
                }
                bf16_t* p = (bf16_t*)((char*)O + ((unsigned)row * (unsigned)pitch + (unsigned)hc) * 2u);
                st16(p, pack8(o1[0], o1[1])); st16(p + 32, pack8(o2[0], o2[1]));                asm volatile("" ::: "memory");
            }
    }
};
__device__ __forceinline__ unsigned q8pair(float r, float ig) {
    const unsigned a = (unsigned)__builtin_rintf(r * 255.f), b = (unsigned)__builtin_rintf(ig * 255.f);
    return a | (b << 8);
}
struct EpiGate {
    static constexpr bool PERM = true, AFTER_DRAIN = false;
    unsigned short* AB; const float* gb;
    __device__ __forceinline__ void operator()(const f32x4 (&acc)[2][2][4][2], const Unit& u, int wr, int wc, int fr_in, int fq) const {
        int fr = fr_in; asm volatile("" : "+v"(fr));
        const int row0 = u.pm * BM + wr * 64 + fr, pn = u.pn, d = pn >> 3, ch0 = ((pn >> 1) & 3) * 256 + (pn & 1) * 128 + wc * 32 + 8 * fq;
        unsigned short* ab = AB + (size_t)d * NROWS * 1024;
        f32x4 rb[2], ib[2];
#pragma unroll
        for (int n = 0; n < 2; ++n) { rb[n] = *(const f32x4*)(gb + (d * 2 + 0) * 1024 + ch0 + 4 * n); ib[n] = *(const f32x4*)(gb + (d * 2 + 1) * 1024 + ch0 + 4 * n); }
#pragma unroll
        for (int ai = 0; ai < 2; ++ai)
#pragma unroll
            for (int m = 0; m < 4; ++m) {
                const int row = row0 + ai * HALF + m * 16;
                u32x4 w;
#pragma unroll
                for (int n = 0; n < 2; ++n)
#pragma unroll
                    for (int jj = 0; jj < 2; ++jj)
                        w[n * 2 + jj] = q8pair(sigm(acc[ai][0][m][n][2 * jj] + rb[n][2 * jj]), sigm(acc[ai][1][m][n][2 * jj] + ib[n][2 * jj]))
                                      | (q8pair(sigm(acc[ai][0][m][n][2 * jj + 1] + rb[n][2 * jj + 1]), sigm(acc[ai][1][m][n][2 * jj + 1] + ib[n][2 * jj + 1])) << 16);
                st16((char*)ab + ((unsigned)row * 1024u + (unsigned)ch0) * 2u, w);
            }
    }
};

struct PanelSS {
    float* xbuf;
    unsigned* cnt;
    __device__ __forceinline__ void run(const f32x4 (&v)[2][2][4][2], const Unit& u, int wr, int wc, int fr, int fq, PG8_LAS unsigned char* lds, int wid, int lane) const {
        PG8_LAS float* P = (PG8_LAS float*)lds;
        PG8_LAS float* S = (PG8_LAS float*)(lds + 8192);
#pragma unroll
        for (int ai = 0; ai < 2; ++ai)
#pragma unroll
            for (int m = 0; m < 4; ++m) {
                float s = 0.f;
#pragma unroll
                for (int bj = 0; bj < 2; ++bj)
#pragma unroll
                    for (int n = 0; n < 2; ++n) { const f32x4 x = v[ai][bj][m][n]; s += (x[0] * x[0] + x[1] * x[1]) + (x[2] * x[2] + x[3] * x[3]); }
                s += __shfl_xor(s, 16); s += __shfl_xor(s, 32);
                if (fq == 0) P[(ai * HALF + wr * 64 + m * 16 + fr) * 4 + wc] = s;
            }
        asm volatile("s_waitcnt lgkmcnt(0)" ::: "memory"); __builtin_amdgcn_s_barrier(); asm volatile("" ::: "memory");
        const int row = wid * 32 + (lane & 31);
        if (lane < 32) {
            const float t = (P[row * 4 + 0] + P[row * 4 + 1]) + (P[row * 4 + 2] + P[row * 4 + 3]);
            __hip_atomic_store(xbuf + ((size_t)(u.pm * BM + row) * 4 + u.pn), t, __ATOMIC_RELAXED, __HIP_MEMORY_SCOPE_AGENT);
        }
        asm volatile("s_waitcnt vmcnt(0)" ::: "memory");
        if (lane == 0) __hip_atomic_fetch_add(cnt + 64 * u.pm, 1u, __ATOMIC_RELAXED, __HIP_MEMORY_SCOPE_AGENT);
        if (wid == 0) {
            const unsigned long long t0 = __builtin_amdgcn_s_memrealtime();
            for (;;) {
                if ((unsigned)__builtin_amdgcn_readfirstlane(__hip_atomic_load(cnt + 64 * u.pm, __ATOMIC_RELAXED, __HIP_MEMORY_SCOPE_AGENT)) >= 32u) break;
                if (__builtin_amdgcn_s_memrealtime() - t0 > 2000000ull) break;
                __builtin_amdgcn_s_sleep(2);
            }
            __builtin_amdgcn_fence(__ATOMIC_ACQUIRE, "agent");
        }
        asm volatile("s_waitcnt vmcnt(0) lgkmcnt(0)" ::: "memory"); __builtin_amdgcn_s_barrier(); asm volatile("" ::: "memory");
        if (lane < 32) {
            const float* slot = xbuf + (size_t)(u.pm * BM + row) * 4; float t = 0.f;
#pragma unroll
            for (int k = 0; k < 4; ++k) t += __hip_atomic_load(slot + k, __ATOMIC_RELAXED, __HIP_MEMORY_SCOPE_AGENT);
            S[row] = __builtin_amdgcn_rsqf(t * (1.f / 1024.f) + 1e-6f);
        }
        asm volatile("s_waitcnt lgkmcnt(0)" ::: "memory"); __builtin_amdgcn_s_barrier(); asm volatile("" ::: "memory");
    }
};
struct EpiNR {
    static constexpr bool PERM = false, AFTER_DRAIN = true;
    float* out; bf16_t* xn; float* hs; const float* gprev; const float* gpost; const float* gpre; float coef; PanelSS st1, st2;
    __device__ __forceinline__ void fused(f32x4 (&acc)[2][2][4][2], const Unit& u, int wr, int wc, int fr_in, int fq, PG8_LAS unsigned char* lds, int wid, int lane) const {
        typedef unsigned u32x2v __attribute__((ext_vector_type(2)));
        int fr = fr_in; asm volatile("" : "+v"(fr));
        const PG8_LAS float* S = (const PG8_LAS float*)(lds + 8192);
        const int col0 = u.pn * BM + wc * 32 + 4 * fq;
        st1.run(acc, u, wr, wc, fr, fq, lds, wid, lane);
#pragma unroll
        for (int ai = 0; ai < 2; ++ai)
#pragma unroll
            for (int m = 0; m < 4; ++m) { const int r = ai * HALF + wr * 64 + m * 16 + fr; const float rs = S[r] * coef; const float hsr = hs[u.pm * BM + r]; const unsigned off = ((unsigned)(u.pm * BM + r) * 1024u + (unsigned)col0);
#pragma unroll
                for (int bj = 0; bj < 2; ++bj)
#pragma unroll
                    for (int n = 0; n < 2; ++n) { const u32x2v xw = *(const u32x2v*)((const char*)xn + (off + bj * HALF + n * 16) * 2u);
                        const f32x4 gp = *(const f32x4*)(gprev + col0 + bj * HALF + n * 16), g = *(const f32x4*)(gpost + col0 + bj * HALF + n * 16);
                        const f32x4 bs = (f32x4){__uint_as_float(xw.x << 16) * __builtin_amdgcn_rcpf(gp[0]), __uint_as_float(xw.x & 0xffff0000u) * __builtin_amdgcn_rcpf(gp[1]), __uint_as_float(xw.y << 16) * __builtin_amdgcn_rcpf(gp[2]), __uint_as_float(xw.y & 0xffff0000u) * __builtin_amdgcn_rcpf(gp[3])} * hsr;
                        acc[ai][bj][m][n] = bs + acc[ai][bj][m][n] * rs * g; }
                asm volatile("" : "+v"(acc[ai][0][m][0]), "+v"(acc[ai][0][m][1]), "+v"(acc[ai][1][m][0]), "+v"(acc[ai][1][m][1]));
                asm volatile("" ::: "memory"); }
        if (gpre) st2.run(acc, u, wr, wc, fr, fq, lds, wid, lane);
#pragma unroll
        for (int ai = 0; ai < 2; ++ai)
#pragma unroll
            for (int m = 0; m < 4; ++m) { const int r = ai * HALF + wr * 64 + m * 16 + fr; const float rs = gpre ? S[r] : 0.f; const unsigned off = ((unsigned)(u.pm * BM + r) * 1024u + (unsigned)col0);
#pragma unroll
                for (int bj = 0; bj < 2; ++bj)
#pragma unroll
                    for (int n = 0; n < 2; ++n) { const f32x4 x1 = acc[ai][bj][m][n];
                        if (gpre) { const f32x4 g = *(const f32x4*)(gpre + col0 + bj * HALF + n * 16); const f32x4 o = x1 * rs * g; u32x2v w; w.x = cvt_pk_bf16(o[0], o[1]); w.y = cvt_pk_bf16(o[2], o[3]);
                            *(u32x2v*)((char*)xn + (off + bj * HALF + n * 16) * 2u) = w; }
                        else *(f32x4*)((char*)out + (off + bj * HALF + n * 16) * 4u) = x1; }
                if (gpre && u.pn == 0 && wc == 0 && fq == 0) hs[u.pm * BM + r] = __builtin_amdgcn_rcpf(rs);
                asm volatile("" ::: "memory"); }
    }
};
struct RoundOrder {
    StaticOrder base; int round;
    __device__ bool next(int i, Unit& u) const { return i == 0 ? base.next(round, u) : false; }
    __device__ __forceinline__ void a_ready(const Unit&) const {}
    __device__ __forceinline__ void done(const Unit&) const {}
};
template <class Epi, class Sched, bool ALIGN_EPI = false, bool SP2 = false>
__device__ __forceinline__ void gemm_phase(PG8_LAS unsigned char* lds, const Gemm g, const Sched& S, const Epi& E) {
    int tid_ = threadIdx.x; asm volatile("" : "+v"(tid_)); const int tid = tid_, wid = __builtin_amdgcn_readfirstlane(tid >> 6), lane = tid & 63, wr = wid >> 2, wc = wid & 3, fr = lane & 15, fq = lane >> 4;
    const int K = g.K, nt = K / BK;
    unsigned voffA[2], voffB[2];
#pragma unroll
    for (int i = 0; i < 2; ++i) { int R, C; stage_rc(tid * 16 + i * 8192, R, C); const int Rb = Epi::PERM ? ((R & ~31) + perm32(R & 31)) : R;
        voffA[i] = (unsigned)(R * g.lda + C) * 2u; voffB[i] = (unsigned)(Rb * g.ldb + C) * 2u; }
    const size_t kstep = (size_t)(BK * 2);
    const size_t hstepA = (size_t)HALF * g.lda * 2, hstepB = (size_t)HALF * g.ldb * 2;
    const size_t tstepA = 2 * hstepA, tstepB = 2 * hstepB;
    const unsigned ldsw = (unsigned)wid * 1024u;
    const int aoff = lds_byte(wr * 64 + fr, fq * 8), boff = lds_byte(wc * 32 + fr, fq * 8);
#define AKOFF(pn) ((size_t)(g.akmode ? ((size_t)(((pn) >> 1) & 3) * ((size_t)33280 * 512)) : 0))
#define PG8_SA(b, h) (((b) * 2 + (h)) * HTB)
#define PG8_SB(b, h) ((4 + (b) * 2 + (h)) * HTB)
#define PG8_STAGE(bufoff, gbase, voff) do { _Pragma("unroll") for (int _i = 0; _i < 2; ++_i) \
        __builtin_amdgcn_global_load_lds((const unsigned*)((const char*)(gbase) + (voff)[_i]), (PG8_LAS unsigned*)(lds + (bufoff) + ldsw + _i * 8192), 16, 0, 0); } while (0)
#define PG8_LDA(dst, b, h) do { _Pragma("unroll") for (int m = 0; m < 4; ++m) _Pragma("unroll") for (int k = 0; k < 2; ++k) dst[m][k] = *(const PG8_LAS bf16x8*)(lds + PG8_SA(b, h) + aoff + m * 2048 + k * 1024); } while (0)
#define PG8_LDB(dst, b, h) do { _Pragma("unroll") for (int n = 0; n < 2; ++n) _Pragma("unroll") for (int k = 0; k < 2; ++k) dst[n][k] = *(const PG8_LAS bf16x8*)(lds + PG8_SB(b, h) + boff + n * 2048 + k * 1024); } while (0)
#define PG8_MMA(ai, bj, At, Bt) do { __builtin_amdgcn_s_setprio(1); _Pragma("unroll") for (int m = 0; m < 4; ++m) _Pragma("unroll") for (int n = 0; n < 2; ++n) _Pragma("unroll") for (int k = 0; k < 2; ++k) \
        acc[ai][bj][m][n] = __builtin_amdgcn_mfma_f32_16x16x32_bf16(Bt[n][k], At[m][k], acc[ai][bj][m][n], 0, 0, 0); __builtin_amdgcn_s_setprio(0); } while (0)
#define PG8_WAIT_V(n) asm volatile("s_waitcnt vmcnt(" #n ")" ::: "memory")
#define PG8_WAIT_L(n) asm volatile("s_waitcnt lgkmcnt(" #n ")" ::: "memory")
#define PG8_BAR __builtin_amdgcn_s_barrier()
#define PG8_SCHED __builtin_amdgcn_sched_barrier(0)
    Unit cur, nxt; int ui = 0;
    if (!S.next(0, cur)) return;
    f32x4 acc[2][2][4][2];
#pragma unroll
    for (int a = 0; a < 2; ++a)
#pragma unroll
        for (int b = 0; b < 2; ++b)
#pragma unroll
            for (int m = 0; m < 4; ++m)
#pragma unroll
                for (int n = 0; n < 2; ++n) acc[a][b][m][n] = (f32x4){0.f, 0.f, 0.f, 0.f};
    bf16x8 At[4][2], B0[2][2], B1[2][2];
    const char* cA = (const char*)g.A + (size_t)cur.pm * tstepA + AKOFF(cur.pn); const char* cB = (const char*)g.Bt + (size_t)cur.pn * tstepB;
    S.a_ready(cur);
    if constexpr (SP2) {
        PG8_STAGE(PG8_SB(0, 0), cB, voffB); PG8_STAGE(PG8_SB(0, 1), cB + hstepB, voffB); PG8_STAGE(PG8_SA(0, 0), cA, voffA); PG8_STAGE(PG8_SA(0, 1), cA + hstepA, voffA);
        if (wr == 1) PG8_BAR;
        PG8_WAIT_V(2); PG8_BAR;
        PG8_STAGE(PG8_SB(1, 0), cB + kstep, voffB); PG8_STAGE(PG8_SA(1, 0), cA + kstep, voffA); PG8_STAGE(PG8_SB(1, 1), cB + hstepB + kstep, voffB);
        PG8_WAIT_V(6); PG8_BAR;
    } else {
        PG8_STAGE(PG8_SB(0, 0), cB, voffB); PG8_STAGE(PG8_SA(0, 0), cA, voffA); PG8_STAGE(PG8_SB(0, 1), cB + hstepB, voffB); PG8_STAGE(PG8_SA(0, 1), cA + hstepA, voffA);
        if (wr == 1) PG8_BAR;
        PG8_WAIT_V(4); PG8_BAR;
        PG8_STAGE(PG8_SB(1, 0), cB + kstep, voffB); PG8_STAGE(PG8_SA(1, 0), cA + kstep, voffA); PG8_STAGE(PG8_SB(1, 1), cB + hstepB + kstep, voffB);
        PG8_WAIT_V(6); PG8_BAR;
    }
    for (;;) {
        const bool has_next = S.next(ui + 1, nxt);
        const char* nA = has_next ? (const char*)g.A + (size_t)nxt.pm * tstepA + AKOFF(nxt.pn) : cA; const char* nB = has_next ? (const char*)g.Bt + (size_t)nxt.pn * tstepB : cB;
        _Pragma("unroll 1") for (int t = 0; t < nt; t += 2) {
            const bool last = (t == nt - 2);
            const char* a1 = cA + (size_t)(t + 1) * kstep;
            const char* a2 = last ? nA : cA + (size_t)(t + 2) * kstep; const char* b2 = last ? nB : cB + (size_t)(t + 2) * kstep;
            const char* a3 = a2 + kstep; const char* b3 = b2 + kstep;
            if (last && has_next) S.a_ready(nxt);
            if constexpr (SP2) {
            PG8_LDB(B0, 0, 0); PG8_LDB(B1, 0, 1); PG8_SCHED; PG8_LDA(At, 0, 0); PG8_STAGE(PG8_SA(1, 1), a1 + hstepA, voffA);
            PG8_WAIT_V(8); PG8_WAIT_L(0); PG8_BAR; PG8_MMA(0, 0, At, B0); PG8_MMA(0, 1, At, B1); PG8_BAR; PG8_SCHED;
            PG8_LDA(At, 0, 1); PG8_STAGE(PG8_SB(0, 0), b2, voffB); PG8_STAGE(PG8_SB(0, 1), b2 + hstepB, voffB); PG8_STAGE(PG8_SA(0, 0), a2, voffA);
            PG8_WAIT_V(8); PG8_WAIT_L(0); PG8_BAR; PG8_MMA(1, 0, At, B0); PG8_MMA(1, 1, At, B1); PG8_BAR; PG8_SCHED;
            PG8_LDB(B0, 1, 0); PG8_LDB(B1, 1, 1); PG8_SCHED; PG8_LDA(At, 1, 0); PG8_STAGE(PG8_SA(0, 1), a2 + hstepA, voffA);
            PG8_WAIT_V(8); PG8_WAIT_L(0); PG8_BAR; PG8_MMA(0, 0, At, B0); PG8_MMA(0, 1, At, B1); PG8_BAR; PG8_SCHED;
            PG8_LDA(At, 1, 1); PG8_STAGE(PG8_SB(1, 0), b3, voffB); PG8_STAGE(PG8_SB(1, 1), b3 + hstepB, voffB); PG8_STAGE(PG8_SA(1, 0), a3, voffA);
            PG8_WAIT_V(8); PG8_WAIT_L(0); PG8_BAR; PG8_MMA(1, 0, At, B0); PG8_MMA(1, 1, At, B1); PG8_BAR; PG8_SCHED;
            } else {
            PG8_LDB(B0, 0, 0); PG8_SCHED; PG8_LDA(At, 0, 0); PG8_STAGE(PG8_SA(1, 1), a1 + hstepA, voffA);
            PG8_WAIT_L(8); PG8_BAR; PG8_WAIT_L(0); PG8_MMA(0, 0, At, B0); PG8_BAR; PG8_SCHED;
            PG8_LDB(B1, 0, 1); PG8_STAGE(PG8_SB(0, 0), b2, voffB);
            PG8_BAR; PG8_WAIT_L(0); PG8_MMA(0, 1, At, B1); PG8_BAR;
            PG8_LDA(At, 0, 1); PG8_STAGE(PG8_SA(0, 0), a2, voffA);
            PG8_BAR; PG8_WAIT_L(0); PG8_MMA(1, 0, At, B0); PG8_BAR; PG8_SCHED;
            PG8_STAGE(PG8_SB(0, 1), b2 + hstepB, voffB);
            PG8_WAIT_V(6); PG8_BAR; PG8_MMA(1, 1, At, B1); PG8_BAR;
            PG8_LDB(B0, 1, 0); PG8_SCHED; PG8_LDA(At, 1, 0); PG8_STAGE(PG8_SA(0, 1), a2 + hstepA, voffA);
            PG8_WAIT_L(8); PG8_BAR; PG8_WAIT_L(0); PG8_MMA(0, 0, At, B0); PG8_BAR; PG8_SCHED;
            PG8_LDB(B1, 1, 1); PG8_STAGE(PG8_SB(1, 0), b3, voffB);
            PG8_BAR; PG8_WAIT_L(0); PG8_MMA(0, 1, At, B1); PG8_BAR;
            PG8_LDA(At, 1, 1); PG8_STAGE(PG8_SA(1, 0), a3, voffA);
            PG8_BAR; PG8_WAIT_L(0); PG8_MMA(1, 0, At, B0); PG8_BAR; PG8_SCHED;
            PG8_STAGE(PG8_SB(1, 1), b3 + hstepB, voffB);
            PG8_WAIT_V(6); PG8_BAR; PG8_MMA(1, 1, At, B1); PG8_BAR;
            }
        }
        if constexpr (ALIGN_EPI) { if (wr == 0) PG8_BAR; }
        if constexpr (!Epi::AFTER_DRAIN) { E(acc, cur, wr, wc, fr, fq); S.done(cur); }
        if (!has_next) break;
#pragma unroll
        for (int a = 0; a < 2; ++a)
#pragma unroll
            for (int b = 0; b < 2; ++b)
#pragma unroll
                for (int m = 0; m < 4; ++m)
#pragma unroll
                    for (int n = 0; n < 2; ++n) acc[a][b][m][n] = (f32x4){0.f, 0.f, 0.f, 0.f};
        cur = nxt; cA = nA; cB = nB; ++ui;
        if constexpr (ALIGN_EPI) { if (wr == 1) PG8_BAR; }
    }
    PG8_WAIT_V(0);
    if constexpr (!ALIGN_EPI) { if (wr == 0) PG8_BAR; }
    PG8_BAR;
    if constexpr (Epi::AFTER_DRAIN) { E.fused(acc, cur, wr, wc, fr, fq, lds, wid, lane); S.done(cur); }
#undef AKOFF
#undef PG8_SA
#undef PG8_SB
#undef PG8_STAGE
#undef PG8_LDA
#undef PG8_LDB
#undef PG8_MMA
#undef PG8_WAIT_V
#undef PG8_WAIT_L
#undef PG8_BAR
#undef PG8_SCHED
}
}

#ifndef PG8_SP2
#define PG8_SP2 true
#endif
#ifndef PG8_ALIGN
#define PG8_ALIGN true
#endif

#include <hip/hip_bf16.h>
#include <cmath>
namespace attn_body {
using bf16=__hip_bfloat16;
using bf16x8=__attribute__((ext_vector_type(8)))short;
using s16x4=__attribute__((ext_vector_type(4)))short;
using f32x16=__attribute__((ext_vector_type(16)))float;
using u32x4=__attribute__((ext_vector_type(4)))unsigned;
constexpr int D=64,QP=1024,KP=256,LSEQ=16384,NREALR=32768;
constexpr int NW=8,QBLK=32,QB=QBLK*NW,KVBLK=64;

__device__ __forceinline__ int crow(int r,int hi){return (r&3)+8*(r>>2)+4*hi;}
#define SBAR() __builtin_amdgcn_sched_barrier(0)
__device__ __forceinline__ void cmask(f32x16&p0,f32x16&p1,int jb,int qrel,int hi){
  const float NEG=-INFINITY; int kb=64*jb+4*hi;
  #pragma unroll
  for(int r=0;r<16;++r){int kv=kb+(r&3)+8*(r>>2); if(kv>qrel)p0[r]=NEG; if(kv+32>qrel)p1[r]=NEG;}
}

constexpr int NSLOT=3, SLOTB=8192;
constexpr int LDS_K=0, LDS_V=NSLOT*SLOTB, LDS_WS=2*NSLOT*SLOTB, LDS_OST=LDS_WS+NW*64*4, LDS_BYTES=LDS_OST+NW*4096;
constexpr float C2=0.125f*1.4426950408889634f;
__device__ __forceinline__ void glds16(const void*gsrc,unsigned lds_dst){unsigned keep;
  asm volatile("s_mov_b32 %0, m0\n\ts_mov_b32 m0, %2\n\ts_nop 0\n\tglobal_load_lds_dwordx4 %1, off\n\ts_mov_b32 m0, %0":"=&s"(keep):"v"(gsrc),"s"(lds_dst):"memory");}
__device__ __forceinline__ float max3f(float a,float b,float c){float r;asm("v_max3_f32 %0, %1, %2, %3":"=v"(r):"v"(a),"v"(b),"v"(c));return r;}
__device__ __forceinline__ float max2f(float a,float b){float r;asm("v_max_f32_e32 %0, %1, %2":"=v"(r):"v"(a),"v"(b));return r;}
__device__ __forceinline__ float fadd_s(float a,float b){float r;asm("v_add_f32_e32 %0, %1, %2":"=v"(r):"v"(a),"v"(b));return r;}
__device__ __forceinline__ float fsub_s(float a,float b){float r;asm("v_sub_f32_e32 %0, %1, %2":"=v"(r):"v"(a),"v"(b));return r;}
typedef float f32x2_t __attribute__((ext_vector_type(2))); typedef __bf16 bf16x2_t __attribute__((ext_vector_type(2)));
__device__ __forceinline__ unsigned cvtpk_s(float lo,float hi){f32x2_t v={lo,hi};bf16x2_t b=__builtin_convertvector(v,bf16x2_t);return __builtin_bit_cast(unsigned,b);}
#define WAIT_BAR(N) asm volatile("s_waitcnt vmcnt(" #N ") lgkmcnt(0)\n\ts_barrier":::"memory")

__device__ __forceinline__ void qkt(f32x16&p0,f32x16&p1,const char*Kslot,const bf16x8*qr,const f32x16&negm,int r32,int hi){
  const char*kb=Kslot+hi*1024+r32*16;
  #pragma unroll
  for(int d0=0;d0<4;++d0){
    const bf16x8 b0=*reinterpret_cast<const bf16x8*>(kb+d0*2048);
    const bf16x8 b1=*reinterpret_cast<const bf16x8*>(kb+d0*2048+512);
    if(d0==0){p0=__builtin_amdgcn_mfma_f32_32x32x16_bf16(b0,qr[0],negm,0,0,0);p1=__builtin_amdgcn_mfma_f32_32x32x16_bf16(b1,qr[0],negm,0,0,0);}
    else{p0=__builtin_amdgcn_mfma_f32_32x32x16_bf16(b0,qr[d0],p0,0,0,0);p1=__builtin_amdgcn_mfma_f32_32x32x16_bf16(b1,qr[d0],p1,0,0,0);}}
}
typedef __attribute__((address_space(3))) const char* lds_cptr;
typedef short v4i16_t __attribute__((ext_vector_type(4)));
__device__ __forceinline__ void kload8(bf16x8*kf,lds_cptr kp){
  kf[0]=*(const __attribute__((address_space(3))) bf16x8*)(kp);      kf[1]=*(const __attribute__((address_space(3))) bf16x8*)(kp+512);
  kf[2]=*(const __attribute__((address_space(3))) bf16x8*)(kp+2048); kf[3]=*(const __attribute__((address_space(3))) bf16x8*)(kp+2560);
  kf[4]=*(const __attribute__((address_space(3))) bf16x8*)(kp+4096); kf[5]=*(const __attribute__((address_space(3))) bf16x8*)(kp+4608);
  kf[6]=*(const __attribute__((address_space(3))) bf16x8*)(kp+6144); kf[7]=*(const __attribute__((address_space(3))) bf16x8*)(kp+6656);
}
__device__ __forceinline__ void kload2(bf16x8*kf,lds_cptr kp,int j){ kf[2*j]=*(const __attribute__((address_space(3))) bf16x8*)(kp+j*2048); kf[2*j+1]=*(const __attribute__((address_space(3))) bf16x8*)(kp+j*2048+512); }
__device__ __forceinline__ s16x4 vtr(lds_cptr p){ return __builtin_bit_cast(s16x4,__builtin_amdgcn_ds_read_tr16_b64_v4i16((__attribute__((address_space(3))) v4i16_t*)p)); }
__device__ __forceinline__ float rowmax(const f32x16&p0,const f32x16&p1){
  float a=max3f(p0[0],p0[1],p1[0]),b=max3f(p0[2],p0[3],p1[1]);a=max3f(a,p1[2],p1[3]);
  #pragma unroll
  for(int r=4;r<16;r+=4){a=max3f(a,p0[r],p0[r+1]);b=max3f(b,p0[r+2],p0[r+3]);a=max3f(a,p1[r],p1[r+1]);b=max3f(b,p1[r+2],p1[r+3]);}
  const float m=max2f(a,b);
  auto rr=__builtin_amdgcn_permlane32_swap(__float_as_uint(m),__float_as_uint(m),false,false);
  return max2f(__uint_as_float(rr[0]),__uint_as_float(rr[1]));
}
__device__ __forceinline__ void pv(f32x16*o,int vb,bf16x8 pa0,bf16x8 pa1,bf16x8 pa2,bf16x8 pa3){
  #pragma unroll
  for(int d0=0;d0<2;++d0){s16x4 lo[4],hi[4];
    #pragma unroll
    for(int ks=0;ks<4;++ks){
      asm volatile("ds_read_b64_tr_b16 %0,%1 offset:%c2":"=&v"(lo[ks]):"v"(vb),"i"(d0*4096+ks*1024):"memory");
      asm volatile("ds_read_b64_tr_b16 %0,%1 offset:%c2":"=&v"(hi[ks]):"v"(vb),"i"(d0*4096+ks*1024+512):"memory");}
    asm volatile("s_waitcnt lgkmcnt(0)":::"memory");SBAR();
    #define PK(k) (bf16x8){lo[k][0],lo[k][1],lo[k][2],lo[k][3],hi[k][0],hi[k][1],hi[k][2],hi[k][3]}
    o[d0]=__builtin_amdgcn_mfma_f32_32x32x16_bf16(pa0,PK(0),o[d0],0,0,0);
    o[d0]=__builtin_amdgcn_mfma_f32_32x32x16_bf16(pa1,PK(1),o[d0],0,0,0);
    o[d0]=__builtin_amdgcn_mfma_f32_32x32x16_bf16(pa2,PK(2),o[d0],0,0,0);
    o[d0]=__builtin_amdgcn_mfma_f32_32x32x16_bf16(pa3,PK(3),o[d0],0,0,0);
    #undef PK
  }
}

#ifndef ATTN_STORE16
#define ATTN_STORE16(p,v) (*(u32x4*)(p)=(v))
#endif
template<int THRL> __device__ __forceinline__ void attn_unit(int b,int h,long qrow0,int nvalid,int t_base,int NT,int lastmode,float*part_o,float*part_ml,const bf16*Q,const bf16*__restrict__ K,const bf16*__restrict__ V,bf16*O,char*shm){
  int tid_=threadIdx.x; asm volatile("":"+v"(tid_)); const int tid=tid_,lane=tid&63,r32=lane&31,hi=lane>>5; const int wid=__builtin_amdgcn_readfirstlane(tid>>6);
  const long rowbase=(long)b*LSEQ; const long metaoff=((long)(NREALR+b*16)-rowbase)*KP;
  const bf16*Qw=Q+(qrow0+wid*QBLK)*QP+h*D;
  const bf16*Kh=K+rowbase*KP+(h>>2)*D,*Vh=V+rowbase*KP+(h>>2)*D;
  const unsigned lds0=(unsigned)(uintptr_t)shm;
  float*wsf=(float*)(shm+LDS_WS)+wid*64;
  const bf16*ksrc=Kh+(long)lane*KP+wid*8;
  const bf16*vsrc=Vh+(long)(16*(wid&3)+(lane>>2))*KP+(wid>>2)*32+(lane&3)*8;
  const unsigned kdst=lds0+LDS_K+wid*1024, vdst=lds0+LDS_V+wid*1024;
  #define TOFF(tt) ((((tt)+t_base)<256)?(long)((tt)+t_base)*KVBLK*KP:metaoff)
  #define DMA_K(t,slot) glds16(ksrc+TOFF(t),(unsigned)__builtin_amdgcn_readfirstlane(kdst+(slot)))
  #define DMA_V(t,slot) glds16(vsrc+TOFF(t),(unsigned)__builtin_amdgcn_readfirstlane(vdst+(slot)))
  const int vb0=(int)(lds0+LDS_V)+((lane>>4)&1)*32+(lane&3)*8+(4*hi+((lane&15)>>2))*64;
  const char*Kbase=shm+LDS_K; bf16x8 kf[8];
  const lds_cptr shm3=(lds_cptr)shm; const lds_cptr kp0=shm3+LDS_K+hi*1024+r32*16; const lds_cptr vp0=shm3+LDS_V+((lane>>4)&1)*32+(lane&3)*8+(4*hi+((lane&15)>>2))*64;
  DMA_K(0,0);DMA_V(0,0);DMA_K(1,SLOTB);
  bf16x8 qr[4];
  #pragma unroll
  for(int d0=0;d0<4;++d0)qr[d0]=*reinterpret_cast<const bf16x8*>(&Qw[(long)r32*QP+d0*16+hi*8]);
  float mhat=0.f,l_reg=0.f;f32x16 o[2];o[0]=f32x16{};o[1]=f32x16{};f32x16 negm=f32x16{};asm volatile("":"+v"(negm));
    #define CMASK(P0,P1,t) do{}while(0)
  bool resc=false;
  #define START(P0,P1) do{ const float rm=rowmax(P0,P1); resc=false; \
    { const float dl=rm; mhat=fadd_s(mhat,dl); \
      _Pragma("unroll") for(int r=0;r<16;++r){P0[r]=fsub_s(P0[r],dl);P1[r]=fsub_s(P1[r],dl);} \
      _Pragma("unroll") for(int r=0;r<16;++r)negm[r]=-mhat; asm volatile("":"+v"(negm)); } \
    _Pragma("unroll") for(int r=0;r<16;++r)P0[r]=__builtin_amdgcn_exp2f(P0[r]); }while(0)
  #define RESC() do{ if(resc){ asm volatile("s_waitcnt lgkmcnt(0)":::"memory"); \
      _Pragma("unroll") for(int d_=0;d_<2;++d_) _Pragma("unroll") for(int r=0;r<16;++r)o[d_][r]*=wsf[crow(r,hi)]; } }while(0)
  f32x16 pA0,pA1,pB0,pB1;
  int sl_prev=0,sl_cur=0,sl_next=SLOTB;
  #define ROT() do{sl_prev=sl_cur;sl_cur=sl_next;sl_next=(sl_next==(NSLOT-1)*SLOTB)?0:sl_next+SLOTB;}while(0)
  DMA_K(2,2*SLOTB);
  WAIT_BAR(3);
  qkt(pA0,pA1,Kbase,qr,negm,r32,hi);asm volatile("s_nop 15\n\ts_nop 7":"+v"(pA0),"+v"(pA1));CMASK(pA0,pA1,0);
  START(pA0,pA1);
  _Pragma("unroll") for(int r=0;r<16;++r)pA1[r]=__builtin_amdgcn_exp2f(pA1[r]);
  WAIT_BAR(0);
  DMA_K(3,0);DMA_V(1,SLOTB);
  ROT();
  kload8(kf,kp0+sl_cur);
  WAIT_BAR(2);
  s16x4 vlo[8],vhi[8]; u32x4 pw0,pw1,pw2,pw3;
  #define PKW(P,B) cvtpk_s(P[B],P[B+1])
  #define PAF(k) __builtin_bit_cast(bf16x8,pw##k)
  #define VFR(i) (bf16x8){vlo[i][0],vlo[i][1],vlo[i][2],vlo[i][3],vhi[i][0],vhi[i][1],vhi[i][2],vhi[i][3]}
  #define PIN(x) asm volatile("":"+v"(x))
  #define MX3(a,b,c) __builtin_fmaxf(__builtin_fmaxf((a),(b)),(c))
  #define GAPA(MF,A0,A1,A2,A3,W0,W1,PW) do{ MF; sacc+=A0; sacc+=A1; sacc+=A2; sacc+=A3; PIN(sacc); W0; W1; PIN(PW); SBAR(); }while(0)
  #define EX(v) __builtin_amdgcn_exp2f(v)
  #define GAPB(MF,X,B) do{ MF; X[B]=EX(X[B]); X[B+1]=EX(X[B+1]); X[B+2]=EX(X[B+2]); X[B+3]=EX(X[B+3]); PIN(X); SBAR(); }while(0)
  #define VRD(i) do{ vlo[i]=vtr(vp_+(((i)>>2)*4096+((i)&3)*1024)); vhi[i]=vtr(vp_+(((i)>>2)*4096+((i)&3)*1024+512)); }while(0)
  #define KRD(G,j) do{ if(G){ kload2(kf,kp0+sl_next,j); SBAR(); } }while(0)
  #define STEP(C0,C1,P0,P1,t,GK,GV,GL) do{ SBAR(); \
    const lds_cptr vp_=vp0+sl_prev; \
    VRD(0); SBAR(); float sacc=(P0[0]+P0[1]); \
    GAPA(C0=__builtin_amdgcn_mfma_f32_32x32x16_bf16(kf[0],qr[0],negm,0,0,0), P0[2],P0[3],P0[4],P0[5],     pw0[0]=PKW(P0,0), pw0[1]=PKW(P0,2), pw0); \
    VRD(4); SBAR(); GAPA(C1=__builtin_amdgcn_mfma_f32_32x32x16_bf16(kf[1],qr[0],negm,0,0,0), P0[6],P0[7],P0[8],P0[9],     pw0[2]=PKW(P0,4), pw0[3]=PKW(P0,6), pw0); \
    VRD(1); SBAR(); GAPA(C0=__builtin_amdgcn_mfma_f32_32x32x16_bf16(kf[2],qr[1],C0,0,0,0),   P0[10],P0[11],P0[12],P0[13], pw1[0]=PKW(P0,8), pw1[1]=PKW(P0,10), pw1); \
    VRD(5); SBAR(); GAPA(C1=__builtin_amdgcn_mfma_f32_32x32x16_bf16(kf[3],qr[1],C1,0,0,0),   P0[14],P0[15],P1[0],P1[1],   pw1[2]=PKW(P0,12),pw1[3]=PKW(P0,14), pw1); \
    VRD(2); SBAR(); GAPA(C0=__builtin_amdgcn_mfma_f32_32x32x16_bf16(kf[4],qr[2],C0,0,0,0),   P1[2],P1[3],P1[4],P1[5],     pw2[0]=PKW(P1,0), pw2[1]=PKW(P1,2), pw2); \
    VRD(6); SBAR(); GAPA(C1=__builtin_amdgcn_mfma_f32_32x32x16_bf16(kf[5],qr[2],C1,0,0,0),   P1[6],P1[7],P1[8],P1[9],     pw2[2]=PKW(P1,4), pw2[3]=PKW(P1,6), pw2); \
    VRD(3); SBAR(); GAPA(C0=__builtin_amdgcn_mfma_f32_32x32x16_bf16(kf[6],qr[3],C0,0,0,0),   P1[10],P1[11],P1[12],P1[13], pw3[0]=PKW(P1,8), pw3[1]=PKW(P1,10), pw3); \
    VRD(7); SBAR(); GAPA(C1=__builtin_amdgcn_mfma_f32_32x32x16_bf16(kf[7],qr[3],C1,0,0,0),   P1[14],P1[15],0.f,0.f,       pw3[2]=PKW(P1,12),pw3[3]=PKW(P1,14), pw3); \
    l_reg+=sacc; \
    if(GK){DMA_K((t)+3,sl_cur);} if(GV){DMA_V((t)+1,sl_next);} \
    CMASK(C0,C1,t); \
    { float a=MX3(C0[0],C0[1],C1[0]),b=MX3(C0[2],C0[3],C1[1]); a=MX3(a,C1[2],C1[3]); \
      _Pragma("unroll") for(int r=4;r<16;r+=4){a=MX3(a,C0[r],C0[r+1]);b=MX3(b,C0[r+2],C0[r+3]);a=MX3(a,C1[r],C1[r+1]);b=MX3(b,C1[r+2],C1[r+3]);} \
      float rm=__builtin_fmaxf(a,b); { auto rr=__builtin_amdgcn_permlane32_swap(__float_as_uint(rm),__float_as_uint(rm),false,false); rm=__builtin_fmaxf(__uint_as_float(rr[0]),__uint_as_float(rr[1])); } \
      resc=false; \
      if(__builtin_expect(__any(rm>(float)THRL),0)){ const float dl=__builtin_fmaxf(rm,0.f); mhat+=dl; \
        _Pragma("unroll") for(int r=0;r<16;++r){C0[r]-=dl;C1[r]-=dl;} \
        _Pragma("unroll") for(int r=0;r<16;++r)negm[r]=-mhat; asm volatile("":"+v"(negm)); \
        const float f=__builtin_amdgcn_exp2f(-dl); l_reg*=f; if(hi==0)wsf[r32]=f; resc=true; } } \
    SBAR(); \
    GAPB(o[0]=__builtin_amdgcn_mfma_f32_32x32x16_bf16(PAF(0),VFR(0),o[0],0,0,0), C0,0); \
    GAPB(o[1]=__builtin_amdgcn_mfma_f32_32x32x16_bf16(PAF(0),VFR(4),o[1],0,0,0), C0,4); \
    KRD(GL,0); GAPB(o[0]=__builtin_amdgcn_mfma_f32_32x32x16_bf16(PAF(1),VFR(1),o[0],0,0,0), C0,8); \
    KRD(GL,1); GAPB(o[1]=__builtin_amdgcn_mfma_f32_32x32x16_bf16(PAF(1),VFR(5),o[1],0,0,0), C0,12); \
    KRD(GL,2); GAPB(o[0]=__builtin_amdgcn_mfma_f32_32x32x16_bf16(PAF(2),VFR(2),o[0],0,0,0), C1,0); \
    KRD(GL,3); GAPB(o[1]=__builtin_amdgcn_mfma_f32_32x32x16_bf16(PAF(2),VFR(6),o[1],0,0,0), C1,4); \
    GAPB(o[0]=__builtin_amdgcn_mfma_f32_32x32x16_bf16(PAF(3),VFR(3),o[0],0,0,0), C1,8); \
    GAPB(o[1]=__builtin_amdgcn_mfma_f32_32x32x16_bf16(PAF(3),VFR(7),o[1],0,0,0), C1,12); \
    }while(0)
  int t=1;
  #undef CMASK
  #define CMASK(P0,P1,t) do{}while(0)
  for(;t+5<NT;t+=2){
    STEP(pB0,pB1,pA0,pA1,t,true,true,true);     WAIT_BAR(2); RESC(); ROT();
    STEP(pA0,pA1,pB0,pB1,t+1,true,true,true);   WAIT_BAR(2); RESC(); ROT();
  }
  #undef CMASK
  #define CMASK(P0,P1,t) do{ if((t)==NT-1){ if(lastmode==2){ _Pragma("unroll") for(int r_=0;r_<8;++r_)P0[r_]=-INFINITY; } _Pragma("unroll") for(int r_=8;r_<16;++r_)P0[r_]=-INFINITY; _Pragma("unroll") for(int r_=0;r_<16;++r_)P1[r_]=-INFINITY; } }while(0)
  #define ENDW(tt) do{ if((tt)+3<NT){WAIT_BAR(2);} else if((tt)+2<NT){WAIT_BAR(1);} else {WAIT_BAR(0);} }while(0)
  for(;t+1<NT;t+=2){
    STEP(pB0,pB1,pA0,pA1,t,(t+3<NT),(t+1<NT),(t+1<NT));       ENDW(t);   RESC(); ROT();
    STEP(pA0,pA1,pB0,pB1,t+1,(t+4<NT),(t+2<NT),(t+2<NT));     ENDW(t+1); RESC(); ROT();
  }
  { float sacc=pA0[0]+pA0[1]; _Pragma("unroll") for(int r=2;r<16;++r)sacc+=pA0[r]; _Pragma("unroll") for(int r=0;r<16;++r)sacc+=pA1[r]; l_reg+=sacc;
    pw0=(u32x4){PKW(pA0,0),PKW(pA0,2),PKW(pA0,4),PKW(pA0,6)};pw1=(u32x4){PKW(pA0,8),PKW(pA0,10),PKW(pA0,12),PKW(pA0,14)};pw2=(u32x4){PKW(pA1,0),PKW(pA1,2),PKW(pA1,4),PKW(pA1,6)};pw3=(u32x4){PKW(pA1,8),PKW(pA1,10),PKW(pA1,12),PKW(pA1,14)};
    SBAR(); pv(o,vb0+sl_prev,PAF(0),PAF(1),PAF(2),PAF(3)); }
  #undef PKW
  #undef PAF
  #undef VFR
  #undef PIN
  #undef MX3
  #undef GAPA
  #undef GAPB
  #undef EX
  #undef VRD
  #undef KRD
  #undef STEP
  #undef ENDW
  {auto rr=__builtin_amdgcn_permlane32_swap(__float_as_uint(l_reg),__float_as_uint(l_reg),false,false);l_reg=__uint_as_float(rr[0])+__uint_as_float(rr[1]);}
  if(hi==0)wsf[32+r32]=l_reg;asm volatile("s_waitcnt lgkmcnt(0)":::"memory");
  if(part_o){ if(wid==0){
    _Pragma("unroll") for(int r=0;r<8;++r){ _Pragma("unroll") for(int d0=0;d0<2;++d0)part_o[crow(r,hi)*64+d0*32+r32]=o[d0][r]; }
    if(hi==0&&r32<16){part_ml[2*r32]=mhat;part_ml[2*r32+1]=l_reg;} } } else {
  float rli[16];
  #pragma unroll
  for(int r=0;r<16;++r)rli[r]=__builtin_amdgcn_rcpf(wsf[32+crow(r,hi)]);
  bf16*Ow=O+(qrow0+wid*QBLK)*QP+h*D; const int nv=nvalid-wid*QBLK;
  { bf16*stg=(bf16*)(shm+LDS_OST)+wid*2048;
    #pragma unroll
    for(int r=0;r<16;++r){const int orow=crow(r,hi);
      #pragma unroll
      for(int d0=0;d0<2;++d0)stg[orow*64+d0*32+r32]=__float2bfloat16(o[d0][r]*rli[r]);}
    asm volatile("s_waitcnt lgkmcnt(0)":::"memory");
    #pragma unroll
    for(int i=0;i<4;++i){const int row=i*8+(lane>>3),ch=lane&7; const u32x4 v=*(const u32x4*)(stg+row*64+ch*8); if(row<nv)ATTN_STORE16(Ow+(long)row*QP+ch*8,v);} } }
  asm volatile("s_waitcnt lgkmcnt(0)\n\ts_barrier":::"memory");
  #undef TOFF
  #undef DMA_K
  #undef DMA_V
  #undef CMASK
  #undef START
  #undef RESC
  #undef ROT
}
constexpr int ATTN_LDS_BYTES=LDS_BYTES;
#undef SBAR
#undef WAIT_BAR
}


#ifndef PG8_SP2
#define PG8_SP2 true
#endif
#ifndef PG8_ALIGN
#define PG8_ALIGN true
#endif
#define LAS __attribute__((address_space(3)))
#ifndef PHM
#define PHM 0xffff
#endif
using pg8::bf16_t; using pg8::f32x4; using pg8::u32x4; using pg8::bf16x8;
typedef float f32x16_t __attribute__((ext_vector_type(16)));
typedef float f32x2_tt __attribute__((ext_vector_type(2)));
constexpr size_t MiB = 1u << 20;
constexpr size_t WS_COS = 1 * MiB, WS_SIN = 3 * MiB, WS_W = 5 * MiB, WS_XN = 163 * MiB, WS_Y = 229 * MiB, WS_R3 = 295 * MiB, WS_R1 = 361 * MiB,
                 WS_K = WS_R1 + 66 * MiB, WS_V = WS_R1 + 83 * MiB, WS_AGG = 619 * MiB, WS_CIN = 628 * MiB, WS_XB = 635 * MiB, WS_HB = 637 * MiB, WS_END = 702 * MiB;
constexpr size_t WS_CNT = 65536;
constexpr size_t W_IN = 0, W_OUT = W_IN + (size_t)8 * 5632 * 1024, W_QKV = W_OUT + (size_t)8 * 1024 * 2816, W_O = W_QKV + (size_t)2 * 1536 * 1024,
                 W_RIN = W_O + (size_t)2 * 1024 * 1024, W_RG = W_RIN + (size_t)2 * 2048 * 1024, W_RO = W_RG + (size_t)2 * 4096 * 256, W_END = W_RO + (size_t)2 * 1024 * 1024;
static_assert(W_END * 2 <= 158 * MiB, "weights");
constexpr int LDS_BYTES = 147456;
constexpr float ATT_C2 = 0.125f * 1.4426950408889634f;

__device__ __forceinline__ float wave_sum(float v) {
#pragma unroll
    for (int o = 1; o < 64; o <<= 1) v += __shfl_xor(v, o);
    return v;
}
__device__ __forceinline__ unsigned f2bf(float f) { unsigned u = __builtin_bit_cast(unsigned, f); return (u + 0x7fffu + ((u >> 16) & 1u)) >> 16; }
__device__ __forceinline__ unsigned pk2(float lo, float hi) { return f2bf(lo) | (f2bf(hi) << 16); }
__device__ __forceinline__ float bf2f(unsigned b) { return __uint_as_float(b << 16); }

struct TrD { const float* W; bf16_t* WT; int K, N, k0, n0, dr0; };
__device__ __forceinline__ void tr_load(float (&r)[32], const TrD& d, int lane) {
#pragma unroll
    for (int i = 0; i < 32; ++i) { const int kk = 2 * i + (lane >> 5); r[i] = d.W[(size_t)(d.k0 + kk) * d.N + d.n0 + (lane & 31)]; }
}
__device__ __forceinline__ void tr_finish(const float (&r)[32], const TrD& d, float* scr, int lane) {
#pragma unroll
    for (int i = 0; i < 32; ++i) { const int kk = 2 * i + (lane >> 5); scr[kk * 33 + (lane & 31)] = r[i]; }
    __builtin_amdgcn_s_waitcnt(0); asm volatile("" ::: "memory");
    const int c = lane & 7;
#pragma unroll
    for (int j = 0; j < 4; ++j) { const int n = (lane >> 3) + 8 * j; const float* s = scr + (8 * c) * 33 + n;
        u32x4 o; o.x = pk2(s[0 * 33], s[1 * 33]); o.y = pk2(s[2 * 33], s[3 * 33]); o.z = pk2(s[4 * 33], s[5 * 33]); o.w = pk2(s[6 * 33], s[7 * 33]);
        *(u32x4*)(d.WT + (size_t)(d.dr0 + n) * d.K + d.k0 + 8 * c) = o; }
    asm volatile("s_waitcnt lgkmcnt(0)" ::: "memory");
}

#define XB_TMO      128
#define XB_XCNT(j)  (256  + 64 * (j))
#define XB_XSUB(j)  (1280 + 64 * (j))
#define XB_XGEN(j)  (2304 + 64 * (j))
#define XB_TOP      3328
#define XB_TOPGEN   3392
#define XCD_BAR_WORDS 3456
#define XB_SPIN_CAP (1u << 18)

__device__ __forceinline__ unsigned xb_ld(unsigned* p)              { return __hip_atomic_load(p, __ATOMIC_RELAXED, __HIP_MEMORY_SCOPE_AGENT); }
__device__ __forceinline__ unsigned xb_add(unsigned* p, unsigned v) { return __hip_atomic_fetch_add(p, v, __ATOMIC_RELAXED, __HIP_MEMORY_SCOPE_AGENT); }
__device__ __forceinline__ unsigned xb_xcc_id() { return (unsigned)__builtin_amdgcn_s_getreg((3 << 11) | 20) & 0xFu; }
#define XB_SPIN(cond, bar) do { unsigned _sp = 0; while (cond) { __builtin_amdgcn_s_sleep(1); \
    if ((++_sp & 255u) == 0u) { if (xb_ld(&(bar)[XB_TMO])) break; if (_sp > XB_SPIN_CAP) { atomicAdd(&(bar)[XB_TMO], 1u); break; } } } } while (0)

struct XcdBarrier {
    unsigned* bar; unsigned x;
    volatile LAS unsigned* st;
};

__device__ __forceinline__ XcdBarrier xcd_barrier_post(unsigned* bar, volatile LAS unsigned* st) {
    XcdBarrier b; b.bar = bar; b.x = xb_xcc_id(); b.st = st;
    if (threadIdx.x == 0) (void)xb_add(&bar[XB_XCNT(b.x)], 1u);
    return b;
}
__device__ __forceinline__ void xcd_barrier_complete(unsigned* bar, unsigned x, unsigned& nloc, unsigned& nx) {
    const unsigned G = gridDim.x * gridDim.y * gridDim.z;
    unsigned sum, cnt, mine, sp = 0u;
    for (;;) {
        sum = 0u; cnt = 0u; mine = 0u;
#pragma unroll
        for (unsigned j = 0; j < 16; ++j) { const unsigned c = xb_ld(&bar[XB_XCNT(j)]); sum += c; cnt += (c > 0u) ? 1u : 0u; mine = (j == x) ? c : mine; }
        if (sum == G) break;
        __builtin_amdgcn_s_sleep(1);
        if ((++sp & 255u) == 0u) { if (xb_ld(&bar[XB_TMO])) break; if (sp > XB_SPIN_CAP) { atomicAdd(&bar[XB_TMO], 1u); break; } }
    }
    nloc = mine > 0u ? mine : 1u; nx = cnt > 0u ? cnt : 1u;
}

__device__ __forceinline__ void xcd_barrier(const XcdBarrier& b) {
    asm volatile("s_waitcnt vmcnt(0)" ::: "memory");
    __syncthreads();
    if (threadIdx.x == 0) {
        unsigned* bar = b.bar;
        __builtin_amdgcn_s_waitcnt(0);
        unsigned nloc = b.st[0], nx = b.st[1];
        if (nloc == 0u) { xcd_barrier_complete(bar, b.x, nloc, nx); b.st[0] = nloc; b.st[1] = nx; }
        const unsigned old = xb_add(&bar[XB_XSUB(b.x)], 1u);
        const unsigned gen = old / nloc;
        if (old + 1u == (gen + 1u) * nloc) {
            __builtin_amdgcn_fence(__ATOMIC_RELEASE, "agent");
            asm volatile("s_waitcnt vmcnt(0)" ::: "memory");
            const unsigned og = xb_add(&bar[XB_TOP], 1u);
            const unsigned tg = og / nx;
            if (og + 1u == (tg + 1u) * nx) xb_add(&bar[XB_TOPGEN], 1u);
            else XB_SPIN(xb_ld(&bar[XB_TOPGEN]) == tg, bar);
            __builtin_amdgcn_fence(__ATOMIC_ACQUIRE, "agent");
            xb_add(&bar[XB_XGEN(b.x)], 1u);
            asm volatile("s_waitcnt vmcnt(0)" ::: "memory");
        } else {
            XB_SPIN(xb_ld(&bar[XB_XGEN(b.x)]) == gen, bar);
            __builtin_amdgcn_fence(__ATOMIC_ACQUIRE, "agent");
            asm volatile("s_waitcnt vmcnt(0)" ::: "memory");
        }
    }
    __syncthreads();
}

struct Args { const float* in[16]; float* out; unsigned char* ws; };

__device__ __forceinline__ float* hrow_ptr(float* out, float* hmeta, int row) { return row < NREAL ? out + (size_t)row * 1024 : hmeta + (size_t)(row - NREAL) * 1024; }

__device__ __forceinline__ float norm_row_store(const f32x4 (&v)[4], const float* g, bf16_t* orow, int lane) {
    float s = 0.f;
#pragma unroll
    for (int j = 0; j < 4; ++j) s += (v[j].x * v[j].x + v[j].y * v[j].y) + (v[j].z * v[j].z + v[j].w * v[j].w);
    const float r = __builtin_amdgcn_rsqf(wave_sum(s) * (1.f / 1024.f) + NORM_EPS);
    unsigned long long* o8 = (unsigned long long*)orow + lane;
#pragma unroll
    for (int j = 0; j < 4; ++j) { const f32x4 gg = ((const f32x4*)g)[lane + 64 * j];
        o8[64 * j] = (unsigned long long)pk2(v[j].x * r * gg.x, v[j].y * r * gg.y) | ((unsigned long long)pk2(v[j].z * r * gg.z, v[j].w * r * gg.w) << 32); }
    return r;
}

__device__ __forceinline__ float norm_row_store_g(const f32x4 (&v)[4], const f32x4 (&gg)[4], bf16_t* orow, int lane) {
    float s = 0.f;
#pragma unroll
    for (int j = 0; j < 4; ++j) s += (v[j].x * v[j].x + v[j].y * v[j].y) + (v[j].z * v[j].z + v[j].w * v[j].w);
    const float r = __builtin_amdgcn_rsqf(wave_sum(s) * (1.f / 1024.f) + NORM_EPS);
    unsigned long long* o8 = (unsigned long long*)orow + lane;
#pragma unroll
    for (int j = 0; j < 4; ++j) o8[64 * j] = (unsigned long long)pk2(v[j].x * r * gg[j].x, v[j].y * r * gg[j].y) | ((unsigned long long)pk2(v[j].z * r * gg[j].z, v[j].w * r * gg[j].w) << 32);
    return r;
}

__device__ __forceinline__ int crow_(int r, int hi) { return (r & 3) + 8 * (r >> 2) + 4 * hi; }
__device__ __forceinline__ void thin_tile(float* T, float* part, const bf16_t* A, int lda, const bf16_t* B0, const bf16_t* B1, int ldb, int K, int wave, int lane, int tid) {
    const int r32 = lane & 31, hi = lane >> 5, kc = K >> 3, kbeg = wave * kc;
    const bf16_t* ap = A + (size_t)r32 * lda + kbeg + hi * 8;
    const bf16_t* b0p = B0 + (size_t)r32 * ldb + kbeg + hi * 8;
    const bf16_t* b1p = B1 + (size_t)r32 * ldb + kbeg + hi * 8;
    f32x16_t c0 = {}, c1 = {};
#pragma unroll 1
    for (int k = 0; k < kc; k += 128) {
        bf16x8 a[8], b0[8], b1[8];
#pragma unroll
        for (int i = 0; i < 8; ++i) if (k + 16 * i < kc) { a[i] = *(const bf16x8*)(ap + k + 16 * i); b0[i] = *(const bf16x8*)(b0p + k + 16 * i); b1[i] = *(const bf16x8*)(b1p + k + 16 * i); }
#pragma unroll
        for (int i = 0; i < 8; ++i) if (k + 16 * i < kc) {
            c0 = __builtin_amdgcn_mfma_f32_32x32x16_bf16(a[i], b0[i], c0, 0, 0, 0);
            c1 = __builtin_amdgcn_mfma_f32_32x32x16_bf16(a[i], b1[i], c1, 0, 0, 0); }
    }
#pragma unroll
    for (int r = 0; r < 16; ++r) { const int tok = crow_(r, hi); part[wave * 2048 + tok * 64 + r32] = c0[r]; part[wave * 2048 + tok * 64 + 32 + r32] = c1[r]; }
    __syncthreads();
    for (int i = tid; i < 2048; i += 512) { float s = 0.f;
#pragma unroll
        for (int w = 0; w < 8; ++w) s += part[w * 2048 + i];
        T[i] = s; }
    __syncthreads();
}
enum ThinKind { TK_SWIGLU = 0, TK_PLAIN = 1, TK_RECIN = 2, TK_QKV = 3, TK_GATE = 4 };
struct ThinP { const bf16_t* A; int lda; const bf16_t* Bt; int ldb; int K; int nunits;
               bf16_t* O0; bf16_t* O1; bf16_t* O2; unsigned short* AB; const float* p0; const float* p1; };
template <int KIND> __device__ __forceinline__ void thin_phase(unsigned char* lds, const ThinP& P, int tid, int wave, int lane, int bid, int G) {
    float* part = (float*)lds; float* T = (float*)(lds + 65536);
    for (int u = bid; u < P.nunits; u += G) {
        int r0, r1, ak = 0;
        if (KIND == TK_SWIGLU) { const int c0 = 32 * u; r0 = (c0 >> 7) * 256 + (c0 & 127); r1 = r0 + 128; }
        else if (KIND == TK_PLAIN || KIND == TK_RECIN) { r0 = 64 * u; r1 = r0 + 32; }
        else if (KIND == TK_QKV) { r0 = (u >> 2) * 256 + 32 * (u & 3); r1 = r0 + 128; }
        else { const int d = u >> 5, h = (u >> 3) & 3, g32 = u & 7; r0 = (d * 8 + h * 2 + (g32 >> 2)) * 256 + (g32 & 3) * 32; r1 = r0 + 128; ak = h * (ROWS_ALLOC * 256); }
        thin_tile(T, part, P.A + (size_t)NREAL * P.lda + ak, P.lda, P.Bt + (size_t)r0 * P.ldb, P.Bt + (size_t)r1 * P.ldb, P.ldb, P.K, wave, lane, tid);
        if (KIND == TK_SWIGLU) {
            for (int idx = tid; idx < 1024; idx += 512) { const int r = idx >> 5, c = idx & 31; const float gt = T[r * 64 + c], up = T[r * 64 + 32 + c];
                P.O0[(size_t)(NREAL + r) * 2816 + 32 * u + c] = (bf16_t)f2bf(gt * pg8::sigm(gt) * up); }
        } else if (KIND == TK_PLAIN) {
            for (int idx = tid; idx < 2048; idx += 512) { const int r = idx >> 6, c = idx & 63; P.O0[(size_t)(NREAL + r) * 1024 + 64 * u + c] = (bf16_t)f2bf(T[idx]); }
        } else if (KIND == TK_RECIN) {
            for (int idx = tid; idx < 2048; idx += 512) { const int r = idx >> 6, c = idx & 63; const float v = T[idx];
                if (u < 16) P.O0[(size_t)(NREAL + r) * 1024 + 64 * u + c] = (bf16_t)f2bf(pg8::gelu_tanh(v));
                else P.O1[(size_t)(NREAL + r) * 1024 + 64 * (u - 16) + c] = (bf16_t)f2bf(v); }
        } else if (KIND == TK_QKV) {
            for (int idx = tid; idx < 2048; idx += 512) { const int r = idx >> 6, dd = idx & 63; const float v = T[idx];
                if (u < 20) { const float rms = __builtin_amdgcn_rsqf(wave_sum(v * v) * (1.f / 64.f) + NORM_EPS);
                    if (u < 16) P.O0[(size_t)(NREAL + r) * 1024 + 64 * u + dd] = (bf16_t)f2bf(v * rms * P.p0[dd] * ATT_C2);
                    else P.O1[(size_t)(NREAL + r) * 256 + 64 * (u - 16) + dd] = (bf16_t)f2bf(v * rms * P.p1[dd]); }
                else P.O2[(size_t)(NREAL + r) * 256 + 64 * (u - 20) + dd] = (bf16_t)f2bf(v); }
        } else {
            const int d = u >> 5, h = (u >> 3) & 3, g32 = u & 7, cb = h * 256 + g32 * 32;
            for (int idx = tid; idx < 1024; idx += 512) { const int r = idx >> 5, c = idx & 31, ch = cb + c;
                P.AB[((size_t)d * NROWS + NREAL + r) * 1024 + ch] = (unsigned short)pg8::q8pair(pg8::sigm(T[r * 64 + c] + P.p0[(d * 2 + 0) * 1024 + ch]), pg8::sigm(T[r * 64 + 32 + c] + P.p0[(d * 2 + 1) * 1024 + ch])); }
        }
        __syncthreads();
    }
}

__device__ __forceinline__ int chunk_row0(int b, int j) { return j == 0 ? NREAL + b * 16 : b * 16384 + (j - 1) * 64; }
__device__ __forceinline__ void ab_from(unsigned w, float xc, float sp, float& a, float& b) {
    const float r = (float)(w & 0xffu) * (1.f / 255.f), ig = (float)((w >> 8) & 0xffu) * (1.f / 255.f);
    a = __builtin_amdgcn_exp2f(sp * r); b = __builtin_amdgcn_sqrtf(__builtin_fmaf(-a, a, 1.f)) * (ig * xc);
}
__device__ __forceinline__ float sp_of(float lam) { const float e = __builtin_amdgcn_exp2f(-LOG2E * lam); return -8.f * LOG2E * (0.6931471805599453f * __builtin_amdgcn_logf(1.f + e)); }
template <int LEN> __device__ __forceinline__ void scanA_item(const unsigned short* ab, const bf16_t* xc, int dir, float sp, float rb, float ib, f32x2_tt* outp) {
    constexpr int BT = LEN < 32 ? LEN : 32;
    float h = 0.f, P = 1.f;
#pragma unroll 1
    for (int t0 = 0; t0 < LEN; t0 += BT) {
        unsigned w[BT]; unsigned short x[BT];
#pragma unroll
        for (int t = 0; t < BT; ++t) { const int tt = dir ? LEN - 1 - (t0 + t) : t0 + t; w[t] = ab[(size_t)tt * 1024]; x[t] = xc[(size_t)tt * 256]; }
#pragma unroll
        for (int t = 0; t < BT; ++t) { float a, b; ab_from(w[t], bf2f(x[t]), sp, a, b); h = a * h + b; P *= a; }
    }
    *outp = (f32x2_tt){P, h};
}
template <int LEN> __device__ __forceinline__ void scanC_item(const unsigned short* abf, const unsigned short* abb, const bf16_t* xc, const bf16_t* gate, bf16_t* y, float cf, float cb, float spf, float spb, float rbf, float ibf, float rbb, float ibb) {
    constexpr int BT = LEN < 16 ? LEN : 16;
    float hf[LEN]; float h = cf;
#pragma unroll
    for (int t0 = 0; t0 < LEN; t0 += BT) {
        unsigned w[BT]; unsigned short x[BT];
#pragma unroll
        for (int t = 0; t < BT; ++t) { w[t] = abf[(size_t)(t0 + t) * 1024]; x[t] = xc[(size_t)(t0 + t) * 256]; }
#pragma unroll
        for (int t = 0; t < BT; ++t) { float a, b; ab_from(w[t], bf2f(x[t]), spf, a, b); h = a * h + b; hf[t0 + t] = h; }
        asm volatile("" ::: "memory");
    }
    h = cb;
#pragma unroll
    for (int t0 = LEN - BT; t0 >= 0; t0 -= BT) {
        unsigned w[BT]; unsigned short x[BT], g[BT];
#pragma unroll
        for (int t = 0; t < BT; ++t) { w[t] = abb[(size_t)(t0 + t) * 1024]; x[t] = xc[(size_t)(t0 + t) * 256]; g[t] = gate[(size_t)(t0 + t) * 1024]; }
#pragma unroll
        for (int t = BT - 1; t >= 0; --t) { float a, b; ab_from(w[t], bf2f(x[t]), spb, a, b); h = a * h + b;
            y[(size_t)(t0 + t) * 1024] = (bf16_t)f2bf((hf[t0 + t] + h) * bf2f(g[t])); }
        asm volatile("" ::: "memory");
    }
}


template <int LEN> __device__ __forceinline__ void scanA2_item(const unsigned* ab, const unsigned* xc, int dir, float sp0, float sp1, f32x4* outp) {
    constexpr int BT = LEN < 32 ? LEN : 32;
    float h0 = 0.f, P0 = 1.f, h1 = 0.f, P1 = 1.f;
#pragma unroll 1
    for (int t0 = 0; t0 < LEN; t0 += BT) {
        unsigned w[BT], x[BT];
#pragma unroll
        for (int t = 0; t < BT; ++t) { const int tt = dir ? LEN - 1 - (t0 + t) : t0 + t; w[t] = ab[(size_t)tt * 512]; x[t] = xc[(size_t)tt * 128]; }
#pragma unroll
        for (int t = 0; t < BT; ++t) { float a, b; ab_from(w[t] & 0xffffu, __uint_as_float(x[t] << 16), sp0, a, b); h0 = a * h0 + b; P0 *= a;
                                       ab_from(w[t] >> 16, __uint_as_float(x[t] & 0xffff0000u), sp1, a, b); h1 = a * h1 + b; P1 *= a; }
    }
    *outp = (f32x4){P0, h0, P1, h1};
}
template <int LEN> __device__ __forceinline__ void scanC2_item(const unsigned* abf, const unsigned* abb, const unsigned* xc, const unsigned* gate, unsigned* y, f32x2_tt cf, f32x2_tt cb, f32x2_tt spf, f32x2_tt spb) {
    constexpr int BT = LEN < 16 ? LEN : 16;
    float hf0[LEN], hf1[LEN]; float h0 = cf.x, h1 = cf.y;
#pragma unroll
    for (int t0 = 0; t0 < LEN; t0 += BT) {
        unsigned w[BT], x[BT];
#pragma unroll
        for (int t = 0; t < BT; ++t) { w[t] = abf[(size_t)(t0 + t) * 512]; x[t] = xc[(size_t)(t0 + t) * 128]; }
#pragma unroll
        for (int t = 0; t < BT; ++t) { float a, b; ab_from(w[t] & 0xffffu, __uint_as_float(x[t] << 16), spf.x, a, b); h0 = a * h0 + b; hf0[t0 + t] = h0;
                                       ab_from(w[t] >> 16, __uint_as_float(x[t] & 0xffff0000u), spf.y, a, b); h1 = a * h1 + b; hf1[t0 + t] = h1; }
        asm volatile("" ::: "memory");
    }
    h0 = cb.x; h1 = cb.y;
#pragma unroll
    for (int t0 = LEN - BT; t0 >= 0; t0 -= BT) {
        unsigned w[BT], x[BT], g[BT];
#pragma unroll
        for (int t = 0; t < BT; ++t) { w[t] = abb[(size_t)(t0 + t) * 512]; x[t] = xc[(size_t)(t0 + t) * 128]; g[t] = gate[(size_t)(t0 + t) * 512]; }
#pragma unroll
        for (int t = BT - 1; t >= 0; --t) { float a, b; ab_from(w[t] & 0xffffu, __uint_as_float(x[t] << 16), spb.x, a, b); h0 = a * h0 + b;
            ab_from(w[t] >> 16, __uint_as_float(x[t] & 0xffff0000u), spb.y, a, b); h1 = a * h1 + b;
            y[(size_t)(t0 + t) * 512] = pk2((hf0[t0 + t] + h0) * __uint_as_float(g[t] << 16), (hf1[t0 + t] + h1) * __uint_as_float(g[t] & 0xffff0000u)); }
        asm volatile("" ::: "memory");
    }
}

typedef const __attribute__((address_space(4))) Args* KArgP;
#define KARGS() ({ KArgP p_ = (KArgP)__builtin_amdgcn_kernarg_segment_ptr(); asm volatile("" : "+s"(p_)); p_; })
#define GSYNC() do { KArgP apb_ = KARGS(); XcdBarrier b_; b_.bar = (unsigned*)(apb_->ws + 16384); b_.x = xb_xcc_id(); b_.st = (volatile LAS unsigned*)(ldsl + 131072 + 32); xcd_barrier(b_); } while (0)
#define WSP(T, off) ((T*)(ws + (off)))
#ifndef DEFER_CONV
#define DEFER_CONV 0
#endif
#define IDS() int tid_ = threadIdx.x; asm volatile("" : "+v"(tid_)); const int tid = tid_, lane = tid & 63, wave = __builtin_amdgcn_readfirstlane(tid >> 6); const int G = gridDim.x, bid = blockIdx.x; \
              const int vcu = (G % 8 == 0) ? (bid % 8) * (G / 8) + bid / 8 : bid; const int gw = vcu * 8 + wave, NGW = G * 8; const int gtid = bid * 512 + tid, GT = G * 512; \
              (void)lane; (void)vcu; (void)gw; (void)NGW; (void)gtid; (void)GT;

constexpr int IA = 8 * 2816, IB = 8 * 1408, IC = 2 * 768, ID = 2 * 512, IE = 2 * 1024, IF = 32 * 32, IG = 2 * 512, NIT = IA + IB + IC + ID + IE + IF + IG;
constexpr int N_EARLY = 2 * 2816 + 2 * 1408 + 768 + 512, N_DEFER = NIT - N_EARLY;
__device__ __forceinline__ int tr_early_item(int e) { return e < 5632 ? e : e < 8448 ? IA + (e - 5632) : e < 9216 ? IA + IB + (e - 8448) : IA + IB + IC + (e - 9216); }
__device__ __forceinline__ int tr_defer_item(int d) { return d < 16896 ? 5632 + d : d < 25344 ? IA + 2816 + (d - 16896) : d < 26112 ? IA + IB + 768 + (d - 25344) : d < 26624 ? IA + IB + IC + 512 + (d - 26112) : IA + IB + IC + ID + (d - 26624); }
static_assert(N_EARLY == 9728 && N_DEFER == 30720, "conversion item split");
__device__ __forceinline__ TrD tr_decode(KArgP ap, bf16_t* Wb, int r) {
            if (r < IA) { const int mat = r / 2816, q = r % 2816, kb = q / 176, nb = q % 176, n0 = 32 * nb, bj = n0 / 2816, c = n0 % 2816;
                return TrD{ap->in[3] + (size_t)mat * 1024 * 5632, Wb + W_IN + (size_t)mat * 5632 * 1024, 1024, 5632, 64 * kb, n0, (c >> 7) * 256 + bj * 128 + (c & 127)}; } r -= IA;
            if (r < IB) { const int mat = r / 1408, q = r % 1408, kb = q / 32, nb = q % 32;
                return TrD{ap->in[4] + (size_t)mat * 2816 * 1024, Wb + W_OUT + (size_t)mat * 1024 * 2816, 2816, 1024, 64 * kb, 32 * nb, 32 * nb}; } r -= IB;
            if (r < IC) { const int mat = r / 768, q = r % 768, kb = q / 48, nb = q % 48, n0 = 32 * nb, tile = n0 >> 8, rr = n0 & 255;
                return TrD{ap->in[5] + (size_t)mat * 1024 * 1536, Wb + W_QKV + (size_t)mat * 1536 * 1024, 1024, 1536, 64 * kb, n0, tile * 256 + 128 * ((rr & 63) >> 5) + 32 * (rr >> 6)}; } r -= IC;
            if (r < ID) { const int mat = r / 512, q = r % 512, kb = q / 32, nb = q % 32;
                return TrD{ap->in[8] + (size_t)mat * 1024 * 1024, Wb + W_O + (size_t)mat * 1024 * 1024, 1024, 1024, 64 * kb, 32 * nb, 32 * nb}; } r -= ID;
            if (r < IE) { const int mat = r / 1024, q = r % 1024, kb = q / 64, nb = q % 64;
                return TrD{ap->in[9] + (size_t)mat * 1024 * 2048, Wb + W_RIN + (size_t)mat * 2048 * 1024, 1024, 2048, 64 * kb, 32 * nb, 32 * nb}; } r -= IE;
            if (r < IF) { const int sub = r >> 5, q = r & 31, kb = q >> 3, nb = q & 7, n0 = 32 * nb, jl = sub >> 4, d = (sub >> 3) & 1, g = (sub >> 2) & 1, h = sub & 3;
                return TrD{ap->in[12] + (size_t)sub * 256 * 256, Wb + W_RG + (size_t)jl * 4096 * 256, 256, 256, 64 * kb, n0, (d * 8 + h * 2 + (n0 >> 7)) * 256 + g * 128 + (n0 & 127)}; } r -= IF;
            { const int mat = r / 512, q = r % 512, kb = q / 32, nb = q % 32;
                return TrD{ap->in[15] + (size_t)mat * 1024 * 1024, Wb + W_RO + (size_t)mat * 1024 * 1024, 1024, 1024, 64 * kb, 32 * nb, 32 * nb}; }
        }

__global__ void __launch_bounds__(512, 2) fwd_megakernel(Args args_unused) {
    extern __shared__ __attribute__((aligned(16))) unsigned char lds[];
    cg::grid_group grid = cg::this_grid();
    LAS unsigned char* ldsl = (LAS unsigned char*)lds;
    for (int u = threadIdx.x; u < 64; u += 512) ((LAS unsigned*)(ldsl + 131072))[u] = 0u;
    __syncthreads();
    { KArgP ap0 = KARGS(); (void)xcd_barrier_post((unsigned*)(ap0->ws + 16384), (volatile LAS unsigned*)(ldsl + 131072 + 32)); }
    grid.sync();

#if PHM & 1
    {
        KArgP ap = KARGS(); unsigned char* ws = ap->ws; IDS();
        float* scr = (float*)(lds + wave * 16384); bf16_t* Wb = WSP(bf16_t, WS_W);
#ifdef NANFILL
        {
            u32x4* f0 = (u32x4*)(ws + WS_Y); const size_t n16 = (WS_END - WS_Y) / 16; const u32x4 q = {0xffffffffu, 0xffffffffu, 0xffffffffu, 0xffffffffu};
            for (size_t i = gtid; i < n16; i += GT) f0[i] = q;
        }
#endif
        const bool defer_ = DEFER_CONV && G == 256; const int n_pro = defer_ ? N_EARLY : NIT;
#pragma unroll 1
        for (int it = gw; it < n_pro; it += 2 * NGW) {
            const bool hasb = it + NGW < n_pro; const int ib_ = hasb ? it + NGW : it;
            const TrD da = tr_decode(ap, Wb, defer_ ? tr_early_item(it) : it), db = tr_decode(ap, Wb, defer_ ? tr_early_item(ib_) : ib_);
            float ra[32], rb[32]; tr_load(ra, da, lane); tr_load(rb, db, lane);
            tr_finish(ra, da, scr, lane);
            if (hasb) tr_finish(rb, db, scr, lane);
        }
        __builtin_amdgcn_s_waitcnt(0);
        float* tcos = WSP(float, WS_COS); float* tsin = WSP(float, WS_SIN);
        for (int idx = gtid; idx < 16384 * 32; idx += GT) { const int s = idx >> 5, j = idx & 31, jj = j & 15; const float pos = (float)(j < 16 ? (s >> 6) : (s & 63));
            const float inv = __builtin_amdgcn_exp2f(-(float)jj * (13.287712379549449f / 16.f)); const float th = pos * inv;
            const double turns = (double)th * 0.15915494309189535; const float fr = (float)(turns - __builtin_floor(turns));
            tcos[idx] = __builtin_amdgcn_cosf(fr); tsin[idx] = __builtin_amdgcn_sinf(fr); }
        float* HS = WSP(float, WS_XB + 1 * MiB); bf16_t* XN = WSP(bf16_t, WS_XN); const float* gains = ap->in[2];
        f32x4 g0v[4];
#pragma unroll
        for (int j = 0; j < 4; ++j) g0v[j] = ((const f32x4*)gains)[lane + 64 * j];
#pragma unroll 1
        for (int row = gw; row < NROWS; row += 2 * NGW) {
            f32x4 vv[2][4];
#pragma unroll
            for (int q = 0; q < 2; ++q) { const int rq = (row + q * NGW < NROWS) ? row + q * NGW : row;
                const float* src = rq < NREAL ? ap->in[0] + (size_t)rq * 1024 : ap->in[1] + (size_t)((rq - NREAL) & 15) * 1024;
#pragma unroll
                for (int j = 0; j < 4; ++j) vv[q][j] = ((const f32x4*)src)[lane + 64 * j]; }
#pragma unroll
            for (int q = 0; q < 2; ++q) { const int rr = row + q * NGW; if (rr >= NROWS) break;
                const float rstd = norm_row_store_g(vv[q], g0v, XN + (size_t)rr * 1024, lane); if (lane == 0) HS[rr] = __builtin_amdgcn_rcpf(rstd); }
        }
    }
#endif
    GSYNC();

#pragma unroll 1
    for (int layer = 0; layer < 4; ++layer) {
#pragma unroll 1
        for (int stage = 0; stage < 3; ++stage) {
            const int jl = layer >> 1;
#ifdef TESTSKIP
            if (stage == 1 && ((TESTSKIP >> (layer & 1)) & 1)) continue;
#endif
            int oAsel, oK; size_t oBoff; float coef; int gpost_i, gpre_i;
            if (stage != 1) {
                const int f = stage >> 1;
                {
                    KArgP ap = KARGS(); unsigned char* ws = ap->ws; IDS();
                    const bf16_t* Win = WSP(bf16_t, WS_W) + W_IN + (size_t)(layer * 2 + f) * 5632 * 1024; bf16_t* XN = WSP(bf16_t, WS_XN); bf16_t* ACT = WSP(bf16_t, WS_R1);
#if PHM & 2
                    { pg8::Gemm g{XN, Win, 1024, 1024, 1024, 0}; pg8::StaticOrder S; S.init(NREAL, 5632, G, bid); pg8::EpiSwiGLU E{ACT};
                      pg8::gemm_phase<pg8::EpiSwiGLU, pg8::StaticOrder, PG8_ALIGN, PG8_SP2>(ldsl, g, S, E); }
#endif
#if PHM & 4
                    { ThinP P{XN, 1024, Win, 1024, 1024, 88, ACT, nullptr, nullptr, nullptr, nullptr, nullptr}; thin_phase<TK_SWIGLU>(lds, P, tid, wave, lane, bid, G); }
#endif
                }
                GSYNC();
                oAsel = 0; oK = 2816; oBoff = W_OUT + (size_t)(layer * 2 + f) * 1024 * 2816; coef = 0.5f; gpost_i = layer * 6 + (f ? 5 : 1);
                gpre_i = f ? (layer < 3 ? layer * 6 + 6 : -1) : layer * 6 + 2;
            } else if ((layer & 1) == 0) {
                {
                    KArgP ap = KARGS(); unsigned char* ws = ap->ws; IDS();
                    const bf16_t* Wqkv = WSP(bf16_t, WS_W) + W_QKV + (size_t)jl * 1536 * 1024; const float* qg = ap->in[6] + jl * 64; const float* kg = ap->in[7] + jl * 64;
                    bf16_t* XN = WSP(bf16_t, WS_XN); bf16_t* QO = WSP(bf16_t, WS_R1); bf16_t* KB = WSP(bf16_t, WS_K); bf16_t* VB = WSP(bf16_t, WS_V);
#if PHM & 8
                    { pg8::Gemm g{XN, Wqkv, 1024, 1024, 1024, 0}; pg8::StaticOrder S; S.init(NREAL, 1536, G, bid); pg8::EpiQKV E{QO, KB, VB, qg, kg, WSP(float, WS_COS), WSP(float, WS_SIN), ATT_C2};
                      pg8::gemm_phase<pg8::EpiQKV, pg8::StaticOrder, PG8_ALIGN, PG8_SP2>(ldsl, g, S, E); }
#endif
#if PHM & 4
                    { ThinP P{XN, 1024, Wqkv, 1024, 1024, 24, QO, KB, VB, nullptr, qg, kg}; thin_phase<TK_QKV>(lds, P, tid, wave, lane, bid, G); }
#endif
                }
                GSYNC();
#if PHM & 16
                {
                    KArgP ap = KARGS(); unsigned char* ws = ap->ws; IDS();
                    bf16_t* QO = WSP(bf16_t, WS_R1); bf16_t* KB = WSP(bf16_t, WS_K); bf16_t* VB = WSP(bf16_t, WS_V);
                    float* PART_O = WSP(float, WS_AGG); float* PART_ML = WSP(float, WS_AGG + 2 * MiB);
                    for (int i = 0;; ++i) {
                        int bh, qb = 0, tb = 0, nt = 257, lm = 1; bool meta = false; float* po = nullptr; float* pml = nullptr;
                        if (G == 256) { if (i < 8) { bh = vcu >> 3; qb = (vcu & 7) + 8 * i; }
                                        else if (i == 8) { bh = vcu >> 3; meta = true; const int pc = vcu & 7; tb = 32 * pc; nt = 33; lm = (pc == 7) ? 1 : 2;
                                                           po = PART_O + (size_t)((bh * 8 + pc) * 16) * 64; pml = PART_ML + (size_t)((bh * 8 + pc) * 16) * 2; }
                                        else break; }
                        else { const int uid = i * G + bid; if (uid >= 2080) break; if (uid < 2048) { bh = uid >> 6; qb = uid & 63; } else { bh = uid - 2048; meta = true; } }
                        const int b = bh >> 4, h = bh & 15;
                        const long qrow0 = meta ? (long)(NREAL + b * 16) : (long)b * 16384 + (long)qb * 256;
                        attn_body::attn_unit<8>(b, h, qrow0, meta ? 16 : 256, tb, nt, lm, po, pml, (const attn_body::bf16*)QO, (const attn_body::bf16*)KB, (const attn_body::bf16*)VB, (attn_body::bf16*)QO, (char*)lds);
                        if (DEFER_CONV && layer == 0 && G == 256) {
                            const int d0 = ((i * 256 + bid) * 8 + wave) * 2;
                            if (d0 < N_DEFER) { bf16_t* Wb = WSP(bf16_t, WS_W); float* scr = (float*)(lds + wave * 16384);
                                const bool hasb = d0 + 1 < N_DEFER; const TrD da = tr_decode(ap, Wb, tr_defer_item(d0)), db = tr_decode(ap, Wb, tr_defer_item(hasb ? d0 + 1 : d0));
                                float ra[32], rb[32]; tr_load(ra, da, lane); tr_load(rb, db, lane);
                                tr_finish(ra, da, scr, lane);
                                if (hasb) tr_finish(rb, db, scr, lane); }
                            __syncthreads();
                        }
                    }
                }
#endif
                GSYNC();
                {
                    KArgP ap = KARGS(); unsigned char* ws = ap->ws; IDS();
                    if (G == 256) {
                        const float* PART_O = WSP(float, WS_AGG); const float* PART_ML = WSP(float, WS_AGG + 2 * MiB); bf16_t* QO = WSP(bf16_t, WS_R1);
                        for (int idx = gtid; idx < 32 * 16 * 64; idx += GT) { const int bh = idx >> 10, q = (idx >> 6) & 15, d = idx & 63;
                            float mp[8], M = -INFINITY;
#pragma unroll
                            for (int pc = 0; pc < 8; ++pc) { mp[pc] = PART_ML[(size_t)((bh * 8 + pc) * 16 + q) * 2]; M = fmaxf(M, mp[pc]); }
                            float num = 0.f, den = 0.f;
#pragma unroll
                            for (int pc = 0; pc < 8; ++pc) { const float w = __builtin_amdgcn_exp2f(mp[pc] - M); num += w * PART_O[(size_t)((bh * 8 + pc) * 16 + q) * 64 + d]; den += w * PART_ML[(size_t)((bh * 8 + pc) * 16 + q) * 2 + 1]; }
                            QO[(size_t)(NREAL + (bh >> 4) * 16 + q) * 1024 + (bh & 15) * 64 + d] = (bf16_t)f2bf(num / den); }
                    }
                }
                GSYNC();
                oAsel = 1; oK = 1024; oBoff = W_O + (size_t)jl * 1024 * 1024; coef = 1.f; gpost_i = layer * 6 + 3; gpre_i = layer * 6 + 4;
            } else {
                {
                    KArgP ap = KARGS(); unsigned char* ws = ap->ws; IDS();
                    const bf16_t* Wrin = WSP(bf16_t, WS_W) + W_RIN + (size_t)jl * 2048 * 1024; bf16_t* XN = WSP(bf16_t, WS_XN); bf16_t* GATE = WSP(bf16_t, WS_Y); bf16_t* XR = WSP(bf16_t, WS_R3);
#if PHM & 32
                    { pg8::Gemm g{XN, Wrin, 1024, 1024, 1024, 0}; pg8::StaticOrder S; S.init(NREAL, 2048, G, bid); pg8::EpiRecIn E{GATE, XR};
                      pg8::gemm_phase<pg8::EpiRecIn, pg8::StaticOrder, PG8_ALIGN, PG8_SP2>(ldsl, g, S, E); }
#endif
#if PHM & 4
                    { ThinP P{XN, 1024, Wrin, 1024, 1024, 32, GATE, XR, nullptr, nullptr, nullptr, nullptr}; thin_phase<TK_RECIN>(lds, P, tid, wave, lane, bid, G); }
#endif
                }
                GSYNC();
#if PHM & 64
                {
                    KArgP ap = KARGS(); unsigned char* ws = ap->ws; IDS();
                    const bf16_t* XR = WSP(bf16_t, WS_R3); bf16_t* XC = WSP(bf16_t, WS_HB);
                    const float* cw = ap->in[10] + (size_t)jl * 4 * 1024; const float* cbias = ap->in[11] + (size_t)jl * 1024;
                    const int ckc = (gtid & 127) * 8;
                    const f32x4 cb0 = *(const f32x4*)(cbias + ckc), cb1 = *(const f32x4*)(cbias + ckc + 4); f32x4 cw0[4], cw1[4];
#pragma unroll
                    for (int j = 0; j < 4; ++j) { cw0[j] = *(const f32x4*)(cw + j * 1024 + ckc); cw1[j] = *(const f32x4*)(cw + j * 1024 + ckc + 4); }
#pragma unroll 1
                    for (int it0 = gtid; it0 < NROWS * 128; it0 += 2 * GT) {
                        u32x4 xv[2][4]; float wm[2][4]; int Rq[2], ckq[2];
#pragma unroll
                        for (int q = 0; q < 2; ++q) { const int it = (it0 + q * GT < NROWS * 128) ? it0 + q * GT : it0; const int R = it >> 7, ck = (it & 127) * 8; int b, p;
                            if (R < NREAL) { b = R >> 14; p = 16 + (R & 16383); } else { b = (R - NREAL) >> 4; p = (R - NREAL) & 15; }
                            Rq[q] = R; ckq[q] = ck;
#pragma unroll
                            for (int j = 0; j < 4; ++j) { const int pp = p + j - 2; const bool ok = pp >= 0 && pp < 16400; const int sr = ok ? (pp < 16 ? NREAL + b * 16 + pp : b * 16384 + pp - 16) : R;
                                xv[q][j] = *(const u32x4*)(XR + (size_t)sr * 1024 + ck); wm[q][j] = ok ? 1.f : 0.f; } }
#pragma unroll
                        for (int q = 0; q < 2; ++q) { if (q == 1 && it0 + GT >= NROWS * 128) break; const int R = Rq[q], ck = ckq[q];
                            f32x4 a0 = cb0, a1 = cb1;
#pragma unroll
                            for (int j = 0; j < 4; ++j) { const u32x4 x = xv[q][j]; const f32x4 w0 = cw0[j] * wm[q][j], w1 = cw1[j] * wm[q][j];
                                a0[0] += __uint_as_float(x[0] << 16) * w0[0]; a0[1] += __uint_as_float(x[0] & 0xffff0000u) * w0[1]; a0[2] += __uint_as_float(x[1] << 16) * w0[2]; a0[3] += __uint_as_float(x[1] & 0xffff0000u) * w0[3];
                                a1[0] += __uint_as_float(x[2] << 16) * w1[0]; a1[1] += __uint_as_float(x[2] & 0xffff0000u) * w1[1]; a1[2] += __uint_as_float(x[3] << 16) * w1[2]; a1[3] += __uint_as_float(x[3] & 0xffff0000u) * w1[3]; }
                            u32x4 o; o.x = pk2(a0[0], a0[1]); o.y = pk2(a0[2], a0[3]); o.z = pk2(a1[0], a1[1]); o.w = pk2(a1[2], a1[3]);
                            *(u32x4*)(XC + ((size_t)(ck >> 8) * ROWS_ALLOC + R) * 256 + (ck & 255)) = o; }
                    }
                }
#endif
                GSYNC();
                {
                    KArgP ap = KARGS(); unsigned char* ws = ap->ws; IDS();
                    const bf16_t* Wrg = WSP(bf16_t, WS_W) + W_RG + (size_t)jl * 4096 * 256; bf16_t* XC = WSP(bf16_t, WS_HB); unsigned short* AB = WSP(unsigned short, WS_R1);
                    const float* gbias = ap->in[13] + (size_t)jl * 4 * 1024;
#if (PHM & 128) && (!defined(RECTEST) || RECTEST >= 2)
                    { pg8::Gemm g{XC, Wrg, 256, 256, 256, 1}; pg8::StaticOrder S; S.init(NREAL, 4096, G, bid); pg8::EpiGate E{AB, gbias};
                      pg8::gemm_phase<pg8::EpiGate, pg8::StaticOrder, PG8_ALIGN, PG8_SP2>(ldsl, g, S, E); }
#endif
#if (PHM & 4) && (!defined(RECTEST) || RECTEST >= 2)
                    { ThinP P{XC, 256, Wrg, 256, 256, 64, nullptr, nullptr, nullptr, AB, gbias, nullptr}; thin_phase<TK_GATE>(lds, P, tid, wave, lane, bid, G); }
#endif
                }
                GSYNC();
#if (PHM & 256) && (!defined(RECTEST) || RECTEST >= 2)
                {
                    KArgP ap = KARGS(); unsigned char* ws = ap->ws; IDS();
                    const unsigned short* AB = WSP(unsigned short, WS_R1); const bf16_t* XC = WSP(bf16_t, WS_HB); f32x2_tt* AGG = WSP(f32x2_tt, WS_AGG); const float* lam = ap->in[14] + (size_t)jl * 2 * 1024; const float* gbias = ap->in[13] + (size_t)jl * 4 * 1024;
                    for (int it = gw; it < 2 * 2 * NCHUNK * 8; it += NGW) {
                        const int cgp = it & 7, q = it >> 3; int j, db; if (it < 8192) { db = q >> 8; j = 1 + (q & 255); } else { db = q & 3; j = 0; }
                        const int d = db >> 1, b = db & 1, c = cgp * 128 + 2 * lane;
                        const unsigned* ab = (const unsigned*)(AB + ((size_t)d * NROWS + chunk_row0(b, j)) * 1024 + c); f32x4* op = (f32x4*)(AGG + ((size_t)db * NCHUNK + j) * 1024 + c);
                        const unsigned* xp = (const unsigned*)(XC + ((size_t)(c >> 8) * ROWS_ALLOC + chunk_row0(b, j)) * 256 + (c & 255)); const float sp0 = sp_of(lam[d * 1024 + c]), sp1 = sp_of(lam[d * 1024 + c + 1]);
                        if (j == 0) scanA2_item<16>(ab, xp, d, sp0, sp1, op); else scanA2_item<64>(ab, xp, d, sp0, sp1, op);
                    }
                }
#endif
                GSYNC();
#if (PHM & 512) && (!defined(RECTEST) || RECTEST >= 2)
                {
                    KArgP ap = KARGS(); unsigned char* ws = ap->ws; IDS();
                    if (wave == 0 && bid < 64) {
                        const int idx = bid * 64 + lane, db = idx >> 10, d = db >> 1, c = idx & 1023;
                        const f32x2_tt* ag = WSP(f32x2_tt, WS_AGG) + (size_t)db * NCHUNK * 1024 + c; float* ci = WSP(float, WS_CIN) + (size_t)db * NCHUNK * 1024 + c; float carry = 0.f;
#pragma unroll 1
                        for (int j0 = 0; j0 < 256; j0 += 16) { f32x2_tt v[16];
#pragma unroll
                            for (int k = 0; k < 16; ++k) { const int js = j0 + k; const int jj = d ? NCHUNK - 1 - js : js; v[k] = ag[(size_t)jj * 1024]; }
#pragma unroll
                            for (int k = 0; k < 16; ++k) { const int js = j0 + k; const int jj = d ? NCHUNK - 1 - js : js; ci[(size_t)jj * 1024] = carry; carry = v[k].x * carry + v[k].y; }
                        }
                        ci[(size_t)(d ? 0 : NCHUNK - 1) * 1024] = carry;
                    }
                }
#endif
                GSYNC();
#if PHM & 1024
                {
                    KArgP ap = KARGS(); unsigned char* ws = ap->ws; IDS();
                    const unsigned short* AB = WSP(unsigned short, WS_R1); const bf16_t* XC = WSP(bf16_t, WS_HB); const float* CIN = WSP(float, WS_CIN); const float* lam = ap->in[14] + (size_t)jl * 2 * 1024; const float* gbias = ap->in[13] + (size_t)jl * 4 * 1024;
                    const bf16_t* GATE = WSP(bf16_t, WS_Y); bf16_t* YS = WSP(bf16_t, WS_R3);
                    for (int it = gw; it < 2 * NCHUNK * 8; it += NGW) {
                        const int ln = (int)__builtin_amdgcn_mbcnt_hi(~0u, __builtin_amdgcn_mbcnt_lo(~0u, 0u));
                        const int cgp = it & 7, q = it >> 3; int j, b; if (it < 4096) { b = q >> 8; j = 1 + (q & 255); } else { b = q & 1; j = 0; }
                        const int c = cgp * 128 + 2 * ln; const int r0 = chunk_row0(b, j);
                        const unsigned* abf = (const unsigned*)(AB + ((size_t)r0) * 1024 + c); const unsigned* abb = (const unsigned*)(AB + ((size_t)NROWS + r0) * 1024 + c);
                        const f32x2_tt cf = *(const f32x2_tt*)(CIN + ((size_t)(0 * 2 + b) * NCHUNK + j) * 1024 + c), cb2 = *(const f32x2_tt*)(CIN + ((size_t)(1 * 2 + b) * NCHUNK + j) * 1024 + c);
                        const f32x2_tt spf = {sp_of(lam[c]), sp_of(lam[c + 1])}, spb = {sp_of(lam[1024 + c]), sp_of(lam[1024 + c + 1])};
                        const unsigned* xp = (const unsigned*)(XC + ((size_t)(c >> 8) * ROWS_ALLOC + r0) * 256 + (c & 255));
                        if (j == 0) scanC2_item<16>(abf, abb, xp, (const unsigned*)(GATE + (size_t)r0 * 1024 + c), (unsigned*)(YS + (size_t)r0 * 1024 + c), cf, cb2, spf, spb);
                        else scanC2_item<64>(abf, abb, xp, (const unsigned*)(GATE + (size_t)r0 * 1024 + c), (unsigned*)(YS + (size_t)r0 * 1024 + c), cf, cb2, spf, spb);
                    }
                }
#endif
                GSYNC();
                oAsel = 2; oK = 1024; oBoff = W_RO + (size_t)jl * 1024 * 1024; coef = 1.f; gpost_i = layer * 6 + 3; gpre_i = layer * 6 + 4;
            }
            {
                KArgP ap = KARGS(); unsigned char* ws = ap->ws; IDS();
                const bf16_t* oA = oAsel == 2 ? WSP(bf16_t, WS_R3) : WSP(bf16_t, WS_R1); const bf16_t* oBt = WSP(bf16_t, WS_W) + oBoff; bf16_t* Yb = WSP(bf16_t, WS_Y);
#if PHM & 2048
#ifdef FUSE_NR
                {
                    const int nri = layer * 3 + stage;
                    pg8::PanelSS st1{WSP(float, WS_XB), (unsigned*)(ws + WS_CNT) + (size_t)(2 * nri) * 128 * 64}, st2{WSP(float, WS_XB + 512 * 1024), (unsigned*)(ws + WS_CNT) + (size_t)(2 * nri + 1) * 128 * 64};
                    pg8::EpiNR E{ap->out, WSP(bf16_t, WS_XN), WSP(float, WS_XB + 1 * MiB), ap->in[2] + (size_t)(layer * 6 + 2 * stage) * 1024, ap->in[2] + (size_t)gpost_i * 1024, gpre_i >= 0 ? ap->in[2] + (size_t)gpre_i * 1024 : nullptr, coef, st1, st2};
                    pg8::Gemm g{oA, oBt, oK, oK, oK, 0};
#pragma unroll 1
                    for (int round = 0; round < 2; ++round) { pg8::RoundOrder S; S.base.init(NREAL, 1024, G, bid); S.round = round;
                        pg8::gemm_phase<pg8::EpiNR, pg8::RoundOrder, false, PG8_SP2>(ldsl, g, S, E); }
                }
#else
                { pg8::Gemm g{oA, oBt, oK, oK, oK, 0}; pg8::StaticOrder S; S.init(NREAL, 1024, G, bid); pg8::EpiPlain E{Yb};
                  pg8::gemm_phase<pg8::EpiPlain, pg8::StaticOrder, PG8_ALIGN, PG8_SP2>(ldsl, g, S, E); }
#endif
#endif
#if PHM & 4
                { ThinP P{oA, oK, oBt, oK, oK, 16, Yb, nullptr, nullptr, nullptr, nullptr, nullptr}; thin_phase<TK_PLAIN>(lds, P, tid, wave, lane, bid, G); }
#endif
            }
            GSYNC();
#if PHM & 4096
            {
                KArgP ap = KARGS(); unsigned char* ws = ap->ws; IDS();
                float* out = ap->out; float* HS = WSP(float, WS_XB + 1 * MiB); const bf16_t* Yb = WSP(bf16_t, WS_Y); bf16_t* XN = WSP(bf16_t, WS_XN);
                const float* gpost = ap->in[2] + (size_t)gpost_i * 1024; const float* gpre = gpre_i >= 0 ? ap->in[2] + (size_t)gpre_i * 1024 : nullptr;
                const float* gprev = ap->in[2] + (size_t)(layer * 6 + 2 * stage) * 1024;
                f32x4 ig[4], gpo[4], gpr[4];
#pragma unroll
                for (int j = 0; j < 4; ++j) { const int gi = 2 * (lane + 64 * (j >> 1)) + (j & 1); const f32x4 gg = ((const f32x4*)gprev)[gi];
                    ig[j] = (f32x4){__builtin_amdgcn_rcpf(gg.x), __builtin_amdgcn_rcpf(gg.y), __builtin_amdgcn_rcpf(gg.z), __builtin_amdgcn_rcpf(gg.w)};
                    gpo[j] = ((const f32x4*)gpost)[gi]; gpr[j] = gpre ? ((const f32x4*)gpre)[gi] : (f32x4){0.f, 0.f, 0.f, 0.f}; }
                constexpr int NRR = 2;
#pragma unroll 1
#ifdef FUSE_NR
                for (int row = NREAL + gw; row < NROWS; row += NRR * NGW) {
#else
                for (int row = gw; row < NROWS; row += NRR * NGW) {
#endif
                    u32x4 yw[NRR][2], hw_[NRR][2]; float hsq[NRR];
#pragma unroll
                    for (int q = 0; q < NRR; ++q) { const int rq = (row + q * NGW < NROWS) ? row + q * NGW : row; hsq[q] = __hip_atomic_load(HS + rq, __ATOMIC_RELAXED, __HIP_MEMORY_SCOPE_AGENT);
#pragma unroll
                        for (int jp = 0; jp < 2; ++jp) { yw[q][jp] = ((const u32x4*)(Yb + (size_t)rq * 1024))[lane + 64 * jp]; hw_[q][jp] = ((const u32x4*)(XN + (size_t)rq * 1024))[lane + 64 * jp]; } }
#pragma unroll
                    for (int q = 0; q < NRR; ++q) {
                        const int rr = row + q * NGW; if (rr >= NROWS) break;
                        f32x4 y[4], v[4]; float s = 0.f; const float hs = hsq[q];
#pragma unroll
                        for (int j = 0; j < 4; ++j) { const unsigned lo = yw[q][j >> 1][2 * (j & 1)], hi = yw[q][j >> 1][2 * (j & 1) + 1], hlo = hw_[q][j >> 1][2 * (j & 1)], hhi = hw_[q][j >> 1][2 * (j & 1) + 1];
                            y[j] = (f32x4){__uint_as_float(lo << 16), __uint_as_float(lo & 0xffff0000u), __uint_as_float(hi << 16), __uint_as_float(hi & 0xffff0000u)};
                            v[j] = (f32x4){__uint_as_float(hlo << 16), __uint_as_float(hlo & 0xffff0000u), __uint_as_float(hhi << 16), __uint_as_float(hhi & 0xffff0000u)} * hs * ig[j];
                            s += (y[j].x * y[j].x + y[j].y * y[j].y) + (y[j].z * y[j].z + y[j].w * y[j].w); }
                        const float r = coef * __builtin_amdgcn_rsqf(wave_sum(s) * (1.f / 1024.f) + NORM_EPS);
                        float s2 = 0.f;
#pragma unroll
                        for (int j = 0; j < 4; ++j) { v[j] = v[j] + y[j] * r * gpo[j]; s2 += (v[j].x * v[j].x + v[j].y * v[j].y) + (v[j].z * v[j].z + v[j].w * v[j].w); }
                        if (gpre) {
                            const float rstd = __builtin_amdgcn_rsqf(wave_sum(s2) * (1.f / 1024.f) + NORM_EPS);
#pragma unroll
                            for (int jp = 0; jp < 2; ++jp) { const f32x4 a0 = v[2 * jp] * rstd * gpr[2 * jp], a1 = v[2 * jp + 1] * rstd * gpr[2 * jp + 1];
                                u32x4 o; o.x = pk2(a0.x, a0.y); o.y = pk2(a0.z, a0.w); o.z = pk2(a1.x, a1.y); o.w = pk2(a1.z, a1.w);
                                ((u32x4*)(XN + (size_t)rr * 1024))[lane + 64 * jp] = o; }
                            if (lane == 0) HS[rr] = __builtin_amdgcn_rcpf(rstd);
                        } else if (rr < NREAL) {
#pragma unroll
                            for (int j = 0; j < 4; ++j) ((f32x4*)(out + (size_t)rr * 1024))[2 * (lane + 64 * (j >> 1)) + (j & 1)] = v[j];
                        }
                    }
                }
            }
#endif
            GSYNC();
        }
    }
}

extern "C" void kernel_launch(void* const* d_in, const int* in_sizes, int n_in, void* d_out, int out_size, void* d_ws, size_t ws_size, hipStream_t stream) {
    static int grid_blocks = 0;
    if (grid_blocks == 0) {
        if (n_in != 16 || ws_size < WS_END) { fprintf(stderr, "kernel_launch: unexpected n_in %d / ws_size %zu\n", n_in, ws_size); grid_blocks = -1; return; }
        int dev = 0, cus = 0, per_cu = 0;
        (void)hipGetDevice(&dev); (void)hipDeviceGetAttribute(&cus, hipDeviceAttributeMultiprocessorCount, dev);
        if (hipFuncSetAttribute((const void*)fwd_megakernel, hipFuncAttributeMaxDynamicSharedMemorySize, LDS_BYTES) != hipSuccess) { fprintf(stderr, "kernel_launch: hipFuncSetAttribute failed\n"); grid_blocks = -1; return; }
        if (hipOccupancyMaxActiveBlocksPerMultiprocessor(&per_cu, (const void*)fwd_megakernel, 512, LDS_BYTES) != hipSuccess || per_cu < 1) { fprintf(stderr, "kernel_launch: occupancy query says %d\n", per_cu); per_cu = 1; }
        (void)hipGetLastError();
        grid_blocks = cus > 0 ? cus : 256;
    }
    if (grid_blocks < 0) return;
    if (hipMemsetAsync(d_ws, 0, 1048576, stream) != hipSuccess) { fprintf(stderr, "kernel_launch: hipMemsetAsync failed\n"); return; }
    Args a{};
    for (int i = 0; i < 16; ++i) a.in[i] = (const float*)d_in[i];
    a.out = (float*)d_out; a.ws = (unsigned char*)d_ws;
    void* kargs[] = {&a};
    hipError_t e = hipLaunchCooperativeKernel((const void*)fwd_megakernel, dim3(grid_blocks), dim3(512), kargs, LDS_BYTES, stream);
    if (e != hipSuccess) fprintf(stderr, "cooperative launch failed: %s (grid %d)\n", hipGetErrorString(e), grid_blocks);
}
```

```cpp
#include <hip/hip_runtime.h>
#include <hip/hip_cooperative_groups.h>
#include <cstdio>
#include <cstdint>
namespace cg = cooperative_groups;

constexpr int NREAL = 32768, NROWS = 32800, ROWS_ALLOC = 33280;
constexpr int DMODEL = 1024, DFF = 2816, LSEQ_ = 16384, NCHUNK = 257;
constexpr float NORM_EPS = 1e-6f;
constexpr float LOG2E = 1.4426950408889634f;

namespace pg8 {

#define PG8_LAS __attribute__((address_space(3)))
typedef unsigned short bf16_t;
typedef short bf16x8 __attribute__((ext_vector_type(8)));
typedef float f32x4 __attribute__((ext_vector_type(4)));
typedef unsigned u32x4 __attribute__((ext_vector_type(4)));
constexpr int BM = 256, BK = 64, HALF = 128, HTB = HALF * BK * 2  , STAGE_BYTES = 8 * HTB, NXCD = 8, WGM = 8;

__host__ __device__ __forceinline__ int lds_byte(int r, int c) { const int st = (r >> 4) * 2 + (c >> 5), rr = r & 15, cc = c & 31, ob = rr * 64 + cc * 2; return st * 1024 + (ob ^ (((ob >> 9) & 1) << 5)); }
__host__ __device__ __forceinline__ void stage_rc(int b, int& R, int& C) { const int st = b / 1024, sb = b % 1024, swz = sb ^ (((sb >> 9) & 1) << 5); R = (st >> 1) * 16 + swz / 64; C = (st & 1) * 32 + (swz % 64) / 2; }
__host__ __device__ __forceinline__ int perm32(int rho) { const int n = rho >> 4, i = rho & 15; return 8 * (i >> 2) + 4 * n + (i & 3); }

struct Unit { int pm, pn; };
struct Gemm { const bf16_t* A; const bf16_t* Bt; int lda, ldb, K, akmode; };

struct StaticOrder {
    int nM, nN, nwg, G, c;
    __host__ __device__ void init(int M, int N, int G_, int c_) { nM = M / BM; nN = N / BM; nwg = nM * nN; G = G_; c = c_; }
    __host__ __device__ bool next(int i, Unit& u) const {
        const long L = (long)i * G + c; if (L >= nwg) return false;
        int wgid = (int)L; { const int q = nwg / NXCD, r = nwg % NXCD, xcd = wgid % NXCD, off = wgid / NXCD; wgid = (xcd < r ? xcd * (q + 1) : r * (q + 1) + (xcd - r) * q) + off; }
        const int nig = WGM * nN, gid = wgid / nig, fm = gid * WGM, gsz = (nM - fm) < WGM ? (nM - fm) : WGM;
        u.pm = fm + ((wgid % nig) % gsz); u.pn = (wgid % nig) / gsz; return true;
    }
    __device__ __forceinline__ void a_ready(const Unit&) const {}
    __device__ __forceinline__ void done(const Unit&) const {}
};


typedef float f32x2_cv __attribute__((ext_vector_type(2))); typedef __bf16 bf16x2_cv __attribute__((ext_vector_type(2)));
__device__ __forceinline__ unsigned cvt_pk_bf16(float lo, float hi) { const f32x2_cv v = {lo, hi}; return __builtin_bit_cast(unsigned, __builtin_convertvector(v, bf16x2_cv)); }
__device__ __forceinline__ float sigm(float x) { return __builtin_amdgcn_rcpf(1.f + __builtin_amdgcn_exp2f(-1.4426950408889634f * x)); }
__device__ __forceinline__ float gelu_tanh(float x) { const float z = 0.7978845608028654f * (x + 0.044715f * x * x * x); return x * sigm(2.f * z); }
__device__ __forceinline__ float bf2f(unsigned short b) { return __uint_as_float((unsigned)b << 16); }
__device__ __forceinline__ u32x4 pack8(const f32x4 a, const f32x4 b) { u32x4 w; w.x = cvt_pk_bf16(a[0], a[1]); w.y = cvt_pk_bf16(a[2], a[3]); w.z = cvt_pk_bf16(b[0], b[1]); w.w = cvt_pk_bf16(b[2], b[3]); return w; }
#ifndef WT_STORES
#define WT_STORES 0
#endif
__device__ __forceinline__ void st16(void* p, const u32x4 v) {
#if WT_STORES
    asm volatile("global_store_dwordx4 %0, %1, off sc1\n\ts_nop 1" :: "v"(p), "v"(v) : "memory");
#else
    *(u32x4*)p = v;
#endif
}

struct EpiSwiGLU {
    static constexpr bool PERM = true, AFTER_DRAIN = false;
    bf16_t* O;
    __device__ __forceinline__ void operator()(const f32x4 (&acc)[2][2][4][2], const Unit& u, int wr, int wc, int fr_in, int fq) const {
        int fr = fr_in; asm volatile("" : "+v"(fr));
        const int row0 = u.pm * BM + wr * 64 + fr, col0 = u.pn * 128 + wc * 32 + 8 * fq;
#pragma unroll
        for (int ai = 0; ai < 2; ++ai)
#pragma unroll
            for (int m = 0; m < 4; ++m) {
                f32x4 v[2];
#pragma unroll
                for (int n = 0; n < 2; ++n)
#pragma unroll
                    for (int j = 0; j < 4; ++j) { const float gt = acc[ai][0][m][n][j]; v[n][j] = gt * sigm(gt) * acc[ai][1][m][n][j]; }
                st16((char*)O + ((unsigned)(row0 + ai * HALF + m * 16) * 2816u + (unsigned)col0) * 2u, pack8(v[0], v[1]));
            }
    }
};
struct EpiPlain {
    static constexpr bool PERM = true, AFTER_DRAIN = false;
    bf16_t* O;
    __device__ __forceinline__ void operator()(const f32x4 (&acc)[2][2][4][2], const Unit& u, int wr, int wc, int fr_in, int fq) const {
        int fr = fr_in; asm volatile("" : "+v"(fr));
        const int row0 = u.pm * BM + wr * 64 + fr, col0 = u.pn * BM + wc * 32 + 8 * fq;
#pragma unroll
        for (int ai = 0; ai < 2; ++ai)
#pragma unroll
            for (int m = 0; m < 4; ++m)
#pragma unroll
                for (int bj = 0; bj < 2; ++bj)
                    st16((char*)O + ((unsigned)(row0 + ai * HALF + m * 16) * 1024u + (unsigned)(col0 + bj * HALF)) * 2u, pack8(acc[ai][bj][m][0], acc[ai][bj][m][1]));
    }
};
struct EpiRecIn {
    static constexpr bool PERM = true, AFTER_DRAIN = false;
    bf16_t* G; bf16_t* X;
    __device__ __forceinline__ void operator()(const f32x4 (&acc)[2][2][4][2], const Unit& u, int wr, int wc, int fr_in, int fq) const {
        int fr = fr_in; asm volatile("" : "+v"(fr));
        const int row0 = u.pm * BM + wr * 64 + fr, col0 = (u.pn & 3) * BM + wc * 32 + 8 * fq; const bool isg = u.pn < 4; bf16_t* O = isg ? G : X;
#pragma unroll
        for (int ai = 0; ai < 2; ++ai)
#pragma unroll
            for (int m = 0; m < 4; ++m)
#pragma unroll
                for (int bj = 0; bj < 2; ++bj) {
                    f32x4 v0 = acc[ai][bj][m][0], v1 = acc[ai][bj][m][1];
                    if (isg) {
#pragma unroll
                        for (int j = 0; j < 4; ++j) { v0[j] = gelu_tanh(v0[j]); v1[j] = gelu_tanh(v1[j]); } }
                    st16((char*)O + ((unsigned)(row0 + ai * HALF + m * 16) * 1024u + (unsigned)(col0 + bj * HALF)) * 2u, pack8(v0, v1));
                }
    }
};
struct EpiQKV {
    static constexpr bool PERM = true, AFTER_DRAIN = false;
    bf16_t *Q, *K, *V; const float *qg, *kg, *cs, *sn; float c2;
    __device__ __forceinline__ void operator()(const f32x4 (&acc)[2][2][4][2], const Unit& u, int wr, int wc, int fr_in, int fq) const {
        int fr = fr_in; asm volatile("" : "+v"(fr));
        const int row0 = u.pm * BM + wr * 64 + fr, pn = u.pn;
        if (pn == 5) {
#pragma unroll
            for (int ai = 0; ai < 2; ++ai)
#pragma unroll
                for (int m = 0; m < 4; ++m)
#pragma unroll
                    for (int bj = 0; bj < 2; ++bj)
                        st16((char*)V + ((unsigned)(row0 + ai * HALF + m * 16) * 256u + (unsigned)(wc * 64 + bj * 32 + 8 * fq)) * 2u, pack8(acc[ai][bj][m][0], acc[ai][bj][m][1]));
            return;
        }
        const bool isq = pn < 4; const float* gp = isq ? qg : kg; const float sc = isq ? c2 : 1.f;
        bf16_t* O = isq ? Q : K; const int pitch = isq ? 1024 : 256; const int hc = (isq ? (4 * pn + wc) : wc) * 64 + 8 * fq;
        f32x4 gq[2][2];
#pragma unroll
        for (int n = 0; n < 2; ++n) { gq[0][n] = *(const f32x4*)(gp + 8 * fq + 4 * n); gq[1][n] = *(const f32x4*)(gp + 32 + 8 * fq + 4 * n); }
#pragma unroll
        for (int ai = 0; ai < 2; ++ai)
#pragma unroll
            for (int m = 0; m < 4; ++m) {
                const int row = row0 + ai * HALF + m * 16;
                float ss = 0.f;
#pragma unroll
                for (int bj = 0; bj < 2; ++bj)
#pragma unroll
                    for (int n = 0; n < 2; ++n) { const f32x4 x = acc[ai][bj][m][n]; ss += (x[0] * x[0] + x[1] * x[1]) + (x[2] * x[2] + x[3] * x[3]); }
                ss += __shfl_xor(ss, 16); ss += __shfl_xor(ss, 32);
                const float rms = __builtin_amdgcn_rsqf(ss * (1.f / 64.f) + 1e-6f);
                const int s = row & 16383;
                f32x4 o1[2], o2[2];
#pragma unroll
                for (int n = 0; n < 2; ++n) {
                    const unsigned to = ((unsigned)s * 32u + (unsigned)(8 * fq + 4 * n)) * 4u; const f32x4 c = *(const f32x4*)((const char*)cs + to), sn4 = *(const f32x4*)((const char*)sn + to);
                    const f32x4 g1 = gq[0][n], g2 = gq[1][n];
                    const f32x4 x1 = acc[ai][0][m][n] * rms * g1, x2 = acc[ai][1][m][n] * rms * g2;
                    o1[n] = (x1 * c - x2 * sn4) * sc; o2[n] = (x1 * sn4 + x2 * c) * sc;
                }
                bf16_t* p = (bf16_t*)((char*)O + ((unsigned)row * (unsigned)pitch + (unsigned)hc) * 2u);
                st16(p, pack8(o1[0], o1[1])); st16(p + 32, pack8(o2[0], o2[1]));                asm volatile("" ::: "memory");
            }
    }
};
__device__ __forceinline__ unsigned q8pair(float r, float ig) {
    const unsigned a = (unsigned)__builtin_rintf(r * 255.f), b = (unsigned)__builtin_rintf(ig * 255.f);
    return a | (b << 8);
}
struct EpiGate {
    static constexpr bool PERM = true, AFTER_DRAIN = false;
    unsigned short* AB; const float* gb;
    __device__ __forceinline__ void operator()(const f32x4 (&acc)[2][2][4][2], const Unit& u, int wr, int wc, int fr_in, int fq) const {
        int fr = fr_in; asm volatile("" : "+v"(fr));
        const int row0 = u.pm * BM + wr * 64 + fr, pn = u.pn, d = pn >> 3, ch0 = ((pn >> 1) & 3) * 256 + (pn & 1) * 128 + wc * 32 + 8 * fq;
        unsigned short* ab = AB + (size_t)d * NROWS * 1024;
        f32x4 rb[2], ib[2];
#pragma unroll
        for (int n = 0; n < 2; ++n) { rb[n] = *(const f32x4*)(gb + (d * 2 + 0) * 1024 + ch0 + 4 * n); ib[n] = *(const f32x4*)(gb + (d * 2 + 1) * 1024 + ch0 + 4 * n); }
#pragma unroll
        for (int ai = 0; ai < 2; ++ai)
#pragma unroll
            for (int m = 0; m < 4; ++m) {
                const int row = row0 + ai * HALF + m * 16;
                u32x4 w;
#pragma unroll
                for (int n = 0; n < 2; ++n)
#pragma unroll
                    for (int jj = 0; jj < 2; ++jj)
                        w[n * 2 + jj] = q8pair(sigm(acc[ai][0][m][n][2 * jj] + rb[n][2 * jj]), sigm(acc[ai][1][m][n][2 * jj] + ib[n][2 * jj]))
                                      | (q8pair(sigm(acc[ai][0][m][n][2 * jj + 1] + rb[n][2 * jj + 1]), sigm(acc[ai][1][m][n][2 * jj + 1] + ib[n][2 * jj + 1])) << 16);
                st16((char*)ab + ((unsigned)row * 1024u + (unsigned)ch0) * 2u, w);
            }
    }
};

struct PanelSS {
    float* xbuf;
    unsigned* cnt;
    __device__ __forceinline__ void run(const f32x4 (&v)[2][2][4][2], const Unit& u, int wr, int wc, int fr, int fq, PG8_LAS unsigned char* lds, int wid, int lane) const {
        PG8_LAS float* P = (PG8_LAS float*)lds;
        PG8_LAS float* S = (PG8_LAS float*)(lds + 8192);
#pragma unroll
        for (int ai = 0; ai < 2; ++ai)
#pragma unroll
            for (int m = 0; m < 4; ++m) {
                float s = 0.f;
#pragma unroll
                for (int bj = 0; bj < 2; ++bj)
#pragma unroll
                    for (int n = 0; n < 2; ++n) { const f32x4 x = v[ai][bj][m][n]; s += (x[0] * x[0] + x[1] * x[1]) + (x[2] * x[2] + x[3] * x[3]); }
                s += __shfl_xor(s, 16); s += __shfl_xor(s, 32);
                if (fq == 0) P[(ai * HALF + wr * 64 + m * 16 + fr) * 4 + wc] = s;
            }
        asm volatile("s_waitcnt lgkmcnt(0)" ::: "memory"); __builtin_amdgcn_s_barrier(); asm volatile("" ::: "memory");
        const int row = wid * 32 + (lane & 31);
        if (lane < 32) {
            const float t = (P[row * 4 + 0] + P[row * 4 + 1]) + (P[row * 4 + 2] + P[row * 4 + 3]);
            __hip_atomic_store(xbuf + ((size_t)(u.pm * BM + row) * 4 + u.pn), t, __ATOMIC_RELAXED, __HIP_MEMORY_SCOPE_AGENT);
        }
        asm volatile("s_waitcnt vmcnt(0)" ::: "memory");
        if (lane == 0) __hip_atomic_fetch_add(cnt + 64 * u.pm, 1u, __ATOMIC_RELAXED, __HIP_MEMORY_SCOPE_AGENT);
        if (wid == 0) {
            const unsigned long long t0 = __builtin_amdgcn_s_memrealtime();
            for (;;) {
                if ((unsigned)__builtin_amdgcn_readfirstlane(__hip_atomic_load(cnt + 64 * u.pm, __ATOMIC_RELAXED, __HIP_MEMORY_SCOPE_AGENT)) >= 32u) break;
                if (__builtin_amdgcn_s_memrealtime() - t0 > 2000000ull) break;
                __builtin_amdgcn_s_sleep(2);
            }
            __builtin_amdgcn_fence(__ATOMIC_ACQUIRE, "agent");
        }
        asm volatile("s_waitcnt vmcnt(0) lgkmcnt(0)" ::: "memory"); __builtin_amdgcn_s_barrier(); asm volatile("" ::: "memory");
        if (lane < 32) {
            const float* slot = xbuf + (size_t)(u.pm * BM + row) * 4; float t = 0.f;
#pragma unroll
            for (int k = 0; k < 4; ++k) t += __hip_atomic_load(slot + k, __ATOMIC_RELAXED, __HIP_MEMORY_SCOPE_AGENT);
            S[row] = __builtin_amdgcn_rsqf(t * (1.f / 1024.f) + 1e-6f);
        }
        asm volatile("s_waitcnt lgkmcnt(0)" ::: "memory"); __builtin_amdgcn_s_barrier(); asm volatile("" ::: "memory");
    }
};
struct EpiNR {
    static constexpr bool PERM = false, AFTER_DRAIN = true;
    float* out; bf16_t* xn; float* hs; const float* gprev; const float* gpost; const float* gpre; float coef; PanelSS st1, st2;
    __device__ __forceinline__ void fused(f32x4 (&acc)[2][2][4][2], const Unit& u, int wr, int wc, int fr_in, int fq, PG8_LAS unsigned char* lds, int wid, int lane) const {
        typedef unsigned u32x2v __attribute__((ext_vector_type(2)));
        int fr = fr_in; asm volatile("" : "+v"(fr));
        const PG8_LAS float* S = (const PG8_LAS float*)(lds + 8192);
        const int col0 = u.pn * BM + wc * 32 + 4 * fq;
        st1.run(acc, u, wr, wc, fr, fq, lds, wid, lane);
#pragma unroll
        for (int ai = 0; ai < 2; ++ai)
#pragma unroll
            for (int m = 0; m < 4; ++m) { const int r = ai * HALF + wr * 64 + m * 16 + fr; const float rs = S[r] * coef; const float hsr = hs[u.pm * BM + r]; const unsigned off = ((unsigned)(u.pm * BM + r) * 1024u + (unsigned)col0);
#pragma unroll
                for (int bj = 0; bj < 2; ++bj)
#pragma unroll
                    for (int n = 0; n < 2; ++n) { const u32x2v xw = *(const u32x2v*)((const char*)xn + (off + bj * HALF + n * 16) * 2u);
                        const f32x4 gp = *(const f32x4*)(gprev + col0 + bj * HALF + n * 16), g = *(const f32x4*)(gpost + col0 + bj * HALF + n * 16);
                        const f32x4 bs = (f32x4){__uint_as_float(xw.x << 16) * __builtin_amdgcn_rcpf(gp[0]), __uint_as_float(xw.x & 0xffff0000u) * __builtin_amdgcn_rcpf(gp[1]), __uint_as_float(xw.y << 16) * __builtin_amdgcn_rcpf(gp[2]), __uint_as_float(xw.y & 0xffff0000u) * __builtin_amdgcn_rcpf(gp[3])} * hsr;
                        acc[ai][bj][m][n] = bs + acc[ai][bj][m][n] * rs * g; }
                asm volatile("" : "+v"(acc[ai][0][m][0]), "+v"(acc[ai][0][m][1]), "+v"(acc[ai][1][m][0]), "+v"(acc[ai][1][m][1]));
                asm volatile("" ::: "memory"); }
        if (gpre) st2.run(acc, u, wr, wc, fr, fq, lds, wid, lane);
#pragma unroll
        for (int ai = 0; ai < 2; ++ai)
#pragma unroll
            for (int m = 0; m < 4; ++m) { const int r = ai * HALF + wr * 64 + m * 16 + fr; const float rs = gpre ? S[r] : 0.f; const unsigned off = ((unsigned)(u.pm * BM + r) * 1024u + (unsigned)col0);
#pragma unroll
                for (int bj = 0; bj < 2; ++bj)
#pragma unroll
                    for (int n = 0; n < 2; ++n) { const f32x4 x1 = acc[ai][bj][m][n];
                        if (gpre) { const f32x4 g = *(const f32x4*)(gpre + col0 + bj * HALF + n * 16); const f32x4 o = x1 * rs * g; u32x2v w; w.x = cvt_pk_bf16(o[0], o[1]); w.y = cvt_pk_bf16(o[2], o[3]);
                            *(u32x2v*)((char*)xn + (off + bj * HALF + n * 16) * 2u) = w; }
                        else *(f32x4*)((char*)out + (off + bj * HALF + n * 16) * 4u) = x1; }
                if (gpre && u.pn == 0 && wc == 0 && fq == 0) hs[u.pm * BM + r] = __builtin_amdgcn_rcpf(rs);
                asm volatile("" ::: "memory"); }
    }
};
struct RoundOrder {
    StaticOrder base; int round;
    __device__ bool next(int i, Unit& u) const { return i == 0 ? base.next(round, u) : false; }
    __device__ __forceinline__ void a_ready(const Unit&) const {}
    __device__ __forceinline__ void done(const Unit&) const {}
};
template <class Epi, class Sched, bool ALIGN_EPI = false, bool SP2 = false>
__device__ __forceinline__ void gemm_phase(PG8_LAS unsigned char* lds, const Gemm g, const Sched& S, const Epi& E) {
    int tid_ = threadIdx.x; asm volatile("" : "+v"(tid_)); const int tid = tid_, wid = __builtin_amdgcn_readfirstlane(tid >> 6), lane = tid & 63, wr = wid >> 2, wc = wid & 3, fr = lane & 15, fq = lane >> 4;
    const int K = g.K, nt = K / BK;
    unsigned voffA[2], voffB[2];
#pragma unroll
    for (int i = 0; i < 2; ++i) { int R, C; stage_rc(tid * 16 + i * 8192, R, C); const int Rb = Epi::PERM ? ((R & ~31) + perm32(R & 31)) : R;
        voffA[i] = (unsigned)(R * g.lda + C) * 2u; voffB[i] = (unsigned)(Rb * g.ldb + C) * 2u; }
    const size_t kstep = (size_t)(BK * 2);
    const size_t hstepA = (size_t)HALF * g.lda * 2, hstepB = (size_t)HALF * g.ldb * 2;
    const size_t tstepA = 2 * hstepA, tstepB = 2 * hstepB;
    const unsigned ldsw = (unsigned)wid * 1024u;
    const int aoff = lds_byte(wr * 64 + fr, fq * 8), boff = lds_byte(wc * 32 + fr, fq * 8);
#define AKOFF(pn) ((size_t)(g.akmode ? ((size_t)(((pn) >> 1) & 3) * ((size_t)33280 * 512)) : 0))
#define PG8_SA(b, h) (((b) * 2 + (h)) * HTB)
#define PG8_SB(b, h) ((4 + (b) * 2 + (h)) * HTB)
#define PG8_STAGE(bufoff, gbase, voff) do { _Pragma("unroll") for (int _i = 0; _i < 2; ++_i) \
        __builtin_amdgcn_global_load_lds((const unsigned*)((const char*)(gbase) + (voff)[_i]), (PG8_LAS unsigned*)(lds + (bufoff) + ldsw + _i * 8192), 16, 0, 0); } while (0)
#define PG8_LDA(dst, b, h) do { _Pragma("unroll") for (int m = 0; m < 4; ++m) _Pragma("unroll") for (int k = 0; k < 2; ++k) dst[m][k] = *(const PG8_LAS bf16x8*)(lds + PG8_SA(b, h) + aoff + m * 2048 + k * 1024); } while (0)
#define PG8_LDB(dst, b, h) do { _Pragma("unroll") for (int n = 0; n < 2; ++n) _Pragma("unroll") for (int k = 0; k < 2; ++k) dst[n][k] = *(const PG8_LAS bf16x8*)(lds + PG8_SB(b, h) + boff + n * 2048 + k * 1024); } while (0)
#define PG8_MMA(ai, bj, At, Bt) do { __builtin_amdgcn_s_setprio(1); _Pragma("unroll") for (int m = 0; m < 4; ++m) _Pragma("unroll") for (int n = 0; n < 2; ++n) _Pragma("unroll") for (int k = 0; k < 2; ++k) \
        acc[ai][bj][m][n] = __builtin_amdgcn_mfma_f32_16x16x32_bf16(Bt[n][k], At[m][k], acc[ai][bj][m][n], 0, 0, 0); __builtin_amdgcn_s_setprio(0); } while (0)
#define PG8_WAIT_V(n) asm volatile("s_waitcnt vmcnt(" #n ")" ::: "memory")
#define PG8_WAIT_L(n) asm volatile("s_waitcnt lgkmcnt(" #n ")" ::: "memory")
#define PG8_BAR __builtin_amdgcn_s_barrier()
#define PG8_SCHED __builtin_amdgcn_sched_barrier(0)
    Unit cur, nxt; int ui = 0;
    if (!S.next(0, cur)) return;
    f32x4 acc[2][2][4][2];
#pragma unroll
    for (int a = 0; a < 2; ++a)
#pragma unroll
        for (int b = 0; b < 2; ++b)
#pragma unroll
            for (int m = 0; m < 4; ++m)
#pragma unroll
                for (int n = 0; n < 2; ++n) acc[a][b][m][n] = (f32x4){0.f, 0.f, 0.f, 0.f};
    bf16x8 At[4][2], B0[2][2], B1[2][2];
    const char* cA = (const char*)g.A + (size_t)cur.pm * tstepA + AKOFF(cur.pn); const char* cB = (const char*)g.Bt + (size_t)cur.pn * tstepB;
    S.a_ready(cur);
    if constexpr (SP2) {
        PG8_STAGE(PG8_SB(0, 0), cB, voffB); PG8_STAGE(PG8_SB(0, 1), cB + hstepB, voffB); PG8_STAGE(PG8_SA(0, 0), cA, voffA); PG8_STAGE(PG8_SA(0, 1), cA + hstepA, voffA);
        if (wr == 1) PG8_BAR;
        PG8_WAIT_V(2); PG8_BAR;
        PG8_STAGE(PG8_SB(1, 0), cB + kstep, voffB); PG8_STAGE(PG8_SA(1, 0), cA + kstep, voffA); PG8_STAGE(PG8_SB(1, 1), cB + hstepB + kstep, voffB);
        PG8_WAIT_V(6); PG8_BAR;
    } else {
        PG8_STAGE(PG8_SB(0, 0), cB, voffB); PG8_STAGE(PG8_SA(0, 0), cA, voffA); PG8_STAGE(PG8_SB(0, 1), cB + hstepB, voffB); PG8_STAGE(PG8_SA(0, 1), cA + hstepA, voffA);
        if (wr == 1) PG8_BAR;
        PG8_WAIT_V(4); PG8_BAR;
        PG8_STAGE(PG8_SB(1, 0), cB + kstep, voffB); PG8_STAGE(PG8_SA(1, 0), cA + kstep, voffA); PG8_STAGE(PG8_SB(1, 1), cB + hstepB + kstep, voffB);
        PG8_WAIT_V(6); PG8_BAR;
    }
    for (;;) {
        const bool has_next = S.next(ui + 1, nxt);
        const char* nA = has_next ? (const char*)g.A + (size_t)nxt.pm * tstepA + AKOFF(nxt.pn) : cA; const char* nB = has_next ? (const char*)g.Bt + (size_t)nxt.pn * tstepB : cB;
        _Pragma("unroll 1") for (int t = 0; t < nt; t += 2) {
            const bool last = (t == nt - 2);
            const char* a1 = cA + (size_t)(t + 1) * kstep;
            const char* a2 = last ? nA : cA + (size_t)(t + 2) * kstep; const char* b2 = last ? nB : cB + (size_t)(t + 2) * kstep;
            const char* a3 = a2 + kstep; const char* b3 = b2 + kstep;
            if (last && has_next) S.a_ready(nxt);
            if constexpr (SP2) {
            PG8_LDB(B0, 0, 0); PG8_LDB(B1, 0, 1); PG8_SCHED; PG8_LDA(At, 0, 0); PG8_STAGE(PG8_SA(1, 1), a1 + hstepA, voffA);
            PG8_WAIT_V(8); PG8_WAIT_L(0); PG8_BAR; PG8_MMA(0, 0, At, B0); PG8_MMA(0, 1, At, B1); PG8_BAR; PG8_SCHED;
            PG8_LDA(At, 0, 1); PG8_STAGE(PG8_SB(0, 0), b2, voffB); PG8_STAGE(PG8_SB(0, 1), b2 + hstepB, voffB); PG8_STAGE(PG8_SA(0, 0), a2, voffA);
            PG8_WAIT_V(8); PG8_WAIT_L(0); PG8_BAR; PG8_MMA(1, 0, At, B0); PG8_MMA(1, 1, At, B1); PG8_BAR; PG8_SCHED;
            PG8_LDB(B0, 1, 0); PG8_LDB(B1, 1, 1); PG8_SCHED; PG8_LDA(At, 1, 0); PG8_STAGE(PG8_SA(0, 1), a2 + hstepA, voffA);
            PG8_WAIT_V(8); PG8_WAIT_L(0); PG8_BAR; PG8_MMA(0, 0, At, B0); PG8_MMA(0, 1, At, B1); PG8_BAR; PG8_SCHED;
            PG8_LDA(At, 1, 1); PG8_STAGE(PG8_SB(1, 0), b3, voffB); PG8_STAGE(PG8_SB(1, 1), b3 + hstepB, voffB); PG8_STAGE(PG8_SA(1, 0), a3, voffA);
            PG8_WAIT_V(8); PG8_WAIT_L(0); PG8_BAR; PG8_MMA(1, 0, At, B0); PG8_MMA(1, 1, At, B1); PG8_BAR; PG8_SCHED;
            } else {
            PG8_LDB(B0, 0, 0); PG8_SCHED; PG8_LDA(At, 0, 0); PG8_STAGE(PG8_SA(1, 1), a1 + hstepA, voffA);
            PG8_WAIT_L(8); PG8_BAR; PG8_WAIT_L(0); PG8_MMA(0, 0, At, B0); PG8_BAR; PG8_SCHED;
            PG8_LDB(B1, 0, 1); PG8_STAGE(PG8_SB(0, 0), b2, voffB);
            PG8_BAR; PG8_WAIT_L(0); PG8_MMA(0, 1, At, B1); PG8_BAR;
            PG8_LDA(At, 0, 1); PG8_STAGE(PG8_SA(0, 0), a2, voffA);
            PG8_BAR; PG8_WAIT_L(0); PG8_MMA(1, 0, At, B0); PG8_BAR; PG8_SCHED;
            PG8_STAGE(PG8_SB(0, 1), b2 + hstepB, voffB);
            PG8_WAIT_V(6); PG8_BAR; PG8_MMA(1, 1, At, B1); PG8_BAR;
            PG8_LDB(B0, 1, 0); PG8_SCHED; PG8_LDA(At, 1, 0); PG8_STAGE(PG8_SA(0, 1), a2 + hstepA, voffA);
            PG8_WAIT_L(8); PG8_BAR; PG8_WAIT_L(0); PG8_MMA(0, 0, At, B0); PG8_BAR; PG8_SCHED;
            PG8_LDB(B1, 1, 1); PG8_STAGE(PG8_SB(1, 0), b3, voffB);
            PG8_BAR; PG8_WAIT_L(0); PG8_MMA(0, 1, At, B1); PG8_BAR;
            PG8_LDA(At, 1, 1); PG8_STAGE(PG8_SA(1, 0), a3, voffA);
            PG8_BAR; PG8_WAIT_L(0); PG8_MMA(1, 0, At, B0); PG8_BAR; PG8_SCHED;
            PG8_STAGE(PG8_SB(1, 1), b3 + hstepB, voffB);
            PG8_WAIT_V(6); PG8_BAR; PG8_MMA(1, 1, At, B1); PG8_BAR;
            }
        }
        if constexpr (ALIGN_EPI) { if (wr == 0) PG8_BAR; }
        if constexpr (!Epi::AFTER_DRAIN) { E(acc, cur, wr, wc, fr, fq); S.done(cur); }
        if (!has_next) break;
#pragma unroll
        for (int a = 0; a < 2; ++a)
#pragma unroll
            for (int b = 0; b < 2; ++b)
#pragma unroll
                for (int m = 0; m < 4; ++m)
#pragma unroll
                    for (int n = 0; n < 2; ++n) acc[a][b][m][n] = (f32x4){0.f, 0.f, 0.f, 0.f};
        cur = nxt; cA = nA; cB = nB; ++ui;
        if constexpr (ALIGN_EPI) { if (wr == 1) PG8_BAR; }
    }
    PG8_WAIT_V(0);
    if constexpr (!ALIGN_EPI) { if (wr == 0) PG8_BAR; }
    PG8_BAR;
    if constexpr (Epi::AFTER_DRAIN) { E.fused(acc, cur, wr, wc, fr, fq, lds, wid, lane); S.done(cur); }
#undef AKOFF
#undef PG8_SA
#undef PG8_SB
#undef PG8_STAGE
#undef PG8_LDA
#undef PG8_LDB
#undef PG8_MMA
#undef PG8_WAIT_V
#undef PG8_WAIT_L
#undef PG8_BAR
#undef PG8_SCHED
}
}

#ifndef PG8_SP2
#define PG8_SP2 true
#endif
#ifndef PG8_ALIGN
#define PG8_ALIGN true
#endif

#include <hip/hip_bf16.h>
#include <cmath>
namespace attn_body {
using bf16=__hip_bfloat16;
using bf16x8=__attribute__((ext_vector_type(8)))short;
using s16x4=__attribute__((ext_vector_type(4)))short;
using f32x16=__attribute__((ext_vector_type(16)))float;
using u32x4=__attribute__((ext_vector_type(4)))unsigned;
constexpr int D=64,QP=1024,KP=256,LSEQ=16384,NREALR=32768;
constexpr int NW=8,QBLK=32,QB=QBLK*NW,KVBLK=64;

__device__ __forceinline__ int crow(int r,int hi){return (r&3)+8*(r>>2)+4*hi;}
#define SBAR() __builtin_amdgcn_sched_barrier(0)
__device__ __forceinline__ void cmask(f32x16&p0,f32x16&p1,int jb,int qrel,int hi){
  const float NEG=-INFINITY; int kb=64*jb+4*hi;
  #pragma unroll
  for(int r=0;r<16;++r){int kv=kb+(r&3)+8*(r>>2); if(kv>qrel)p0[r]=NEG; if(kv+32>qrel)p1[r]=NEG;}
}

constexpr int NSLOT=3, SLOTB=8192;
constexpr int LDS_K=0, LDS_V=NSLOT*SLOTB, LDS_WS=2*NSLOT*SLOTB, LDS_OST=LDS_WS+NW*64*4, LDS_BYTES=LDS_OST+NW*4096;
constexpr float C2=0.125f*1.4426950408889634f;
__device__ __forceinline__ void glds16(const void*gsrc,unsigned lds_dst){unsigned keep;
  asm volatile("s_mov_b32 %0, m0\n\ts_mov_b32 m0, %2\n\ts_nop 0\n\tglobal_load_lds_dwordx4 %1, off\n\ts_mov_b32 m0, %0":"=&s"(keep):"v"(gsrc),"s"(lds_dst):"memory");}
__device__ __forceinline__ float max3f(float a,float b,float c){float r;asm("v_max3_f32 %0, %1, %2, %3":"=v"(r):"v"(a),"v"(b),"v"(c));return r;}
__device__ __forceinline__ float max2f(float a,float b){float r;asm("v_max_f32_e32 %0, %1, %2":"=v"(r):"v"(a),"v"(b));return r;}
__device__ __forceinline__ float fadd_s(float a,float b){float r;asm("v_add_f32_e32 %0, %1, %2":"=v"(r):"v"(a),"v"(b));return r;}
__device__ __forceinline__ float fsub_s(float a,float b){float r;asm("v_sub_f32_e32 %0, %1, %2":"=v"(r):"v"(a),"v"(b));return r;}
typedef float f32x2_t __attribute__((ext_vector_type(2))); typedef __bf16 bf16x2_t __attribute__((ext_vector_type(2)));
__device__ __forceinline__ unsigned cvtpk_s(float lo,float hi){f32x2_t v={lo,hi};bf16x2_t b=__builtin_convertvector(v,bf16x2_t);return __builtin_bit_cast(unsigned,b);}
#define WAIT_BAR(N) asm volatile("s_waitcnt vmcnt(" #N ") lgkmcnt(0)\n\ts_barrier":::"memory")

__device__ __forceinline__ void qkt(f32x16&p0,f32x16&p1,const char*Kslot,const bf16x8*qr,const f32x16&negm,int r32,int hi){
  const char*kb=Kslot+hi*1024+r32*16;
  #pragma unroll
  for(int d0=0;d0<4;++d0){
    const bf16x8 b0=*reinterpret_cast<const bf16x8*>(kb+d0*2048);
    const bf16x8 b1=*reinterpret_cast<const bf16x8*>(kb+d0*2048+512);
    if(d0==0){p0=__builtin_amdgcn_mfma_f32_32x32x16_bf16(b0,qr[0],negm,0,0,0);p1=__builtin_amdgcn_mfma_f32_32x32x16_bf16(b1,qr[0],negm,0,0,0);}
    else{p0=__builtin_amdgcn_mfma_f32_32x32x16_bf16(b0,qr[d0],p0,0,0,0);p1=__builtin_amdgcn_mfma_f32_32x32x16_bf16(b1,qr[d0],p1,0,0,0);}}
}
typedef __attribute__((address_space(3))) const char* lds_cptr;
typedef short v4i16_t __attribute__((ext_vector_type(4)));
__device__ __forceinline__ void kload8(bf16x8*kf,lds_cptr kp){
  kf[0]=*(const __attribute__((address_space(3))) bf16x8*)(kp);      kf[1]=*(const __attribute__((address_space(3))) bf16x8*)(kp+512);
  kf[2]=*(const __attribute__((address_space(3))) bf16x8*)(kp+2048); kf[3]=*(const __attribute__((address_space(3))) bf16x8*)(kp+2560);
  kf[4]=*(const __attribute__((address_space(3))) bf16x8*)(kp+4096); kf[5]=*(const __attribute__((address_space(3))) bf16x8*)(kp+4608);
  kf[6]=*(const __attribute__((address_space(3))) bf16x8*)(kp+6144); kf[7]=*(const __attribute__((address_space(3))) bf16x8*)(kp+6656);
}
__device__ __forceinline__ void kload2(bf16x8*kf,lds_cptr kp,int j){ kf[2*j]=*(const __attribute__((address_space(3))) bf16x8*)(kp+j*2048); kf[2*j+1]=*(const __attribute__((address_space(3))) bf16x8*)(kp+j*2048+512); }
__device__ __forceinline__ s16x4 vtr(lds_cptr p){ return __builtin_bit_cast(s16x4,__builtin_amdgcn_ds_read_tr16_b64_v4i16((__attribute__((address_space(3))) v4i16_t*)p)); }
__device__ __forceinline__ float rowmax(const f32x16&p0,const f32x16&p1){
  float a=max3f(p0[0],p0[1],p1[0]),b=max3f(p0[2],p0[3],p1[1]);a=max3f(a,p1[2],p1[3]);
  #pragma unroll
  for(int r=4;r<16;r+=4){a=max3f(a,p0[r],p0[r+1]);b=max3f(b,p0[r+2],p0[r+3]);a=max3f(a,p1[r],p1[r+1]);b=max3f(b,p1[r+2],p1[r+3]);}
  const float m=max2f(a,b);
  auto rr=__builtin_amdgcn_permlane32_swap(__float_as_uint(m),__float_as_uint(m),false,false);
  return max2f(__uint_as_float(rr[0]),__uint_as_float(rr[1]));
}
__device__ __forceinline__ void pv(f32x16*o,int vb,bf16x8 pa0,bf16x8 pa1,bf16x8 pa2,bf16x8 pa3){
  #pragma unroll
  for(int d0=0;d0<2;++d0){s16x4 lo[4],hi[4];
    #pragma unroll
    for(int ks=0;ks<4;++ks){
      asm volatile("ds_read_b64_tr_b16 %0,%1 offset:%c2":"=&v"(lo[ks]):"v"(vb),"i"(d0*4096+ks*1024):"memory");
      asm volatile("ds_read_b64_tr_b16 %0,%1 offset:%c2":"=&v"(hi[ks]):"v"(vb),"i"(d0*4096+ks*1024+512):"memory");}
    asm volatile("s_waitcnt lgkmcnt(0)":::"memory");SBAR();
    #define PK(k) (bf16x8){lo[k][0],lo[k][1],lo[k][2],lo[k][3],hi[k][0],hi[k][1],hi[k][2],hi[k][3]}
    o[d0]=__builtin_amdgcn_mfma_f32_32x32x16_bf16(pa0,PK(0),o[d0],0,0,0);
    o[d0]=__builtin_amdgcn_mfma_f32_32x32x16_bf16(pa1,PK(1),o[d0],0,0,0);
    o[d0]=__builtin_amdgcn_mfma_f32_32x32x16_bf16(pa2,PK(2),o[d0],0,0,0);
    o[d0]=__builtin_amdgcn_mfma_f32_32x32x16_bf16(pa3,PK(3),o[d0],0,0,0);
    #undef PK
  }
}

#ifndef ATTN_STORE16
#define ATTN_STORE16(p,v) (*(u32x4*)(p)=(v))
#endif
template<int THRL> __device__ __forceinline__ void attn_unit(int b,int h,long qrow0,int nvalid,int t_base,int NT,int lastmode,float*part_o,float*part_ml,const bf16*Q,const bf16*__restrict__ K,const bf16*__restrict__ V,bf16*O,char*shm){
  int tid_=threadIdx.x; asm volatile("":"+v"(tid_)); const int tid=tid_,lane=tid&63,r32=lane&31,hi=lane>>5; const int wid=__builtin_amdgcn_readfirstlane(tid>>6);
  const long rowbase=(long)b*LSEQ; const long metaoff=((long)(NREALR+b*16)-rowbase)*KP;
  const bf16*Qw=Q+(qrow0+wid*QBLK)*QP+h*D;
  const bf16*Kh=K+rowbase*KP+(h>>2)*D,*Vh=V+rowbase*KP+(h>>2)*D;
  const unsigned lds0=(unsigned)(uintptr_t)shm;
  float*wsf=(float*)(shm+LDS_WS)+wid*64;
  const bf16*ksrc=Kh+(long)lane*KP+wid*8;
  const bf16*vsrc=Vh+(long)(16*(wid&3)+(lane>>2))*KP+(wid>>2)*32+(lane&3)*8;
  const unsigned kdst=lds0+LDS_K+wid*1024, vdst=lds0+LDS_V+wid*1024;
  #define TOFF(tt) ((((tt)+t_base)<256)?(long)((tt)+t_base)*KVBLK*KP:metaoff)
  #define DMA_K(t,slot) glds16(ksrc+TOFF(t),(unsigned)__builtin_amdgcn_readfirstlane(kdst+(slot)))
  #define DMA_V(t,slot) glds16(vsrc+TOFF(t),(unsigned)__builtin_amdgcn_readfirstlane(vdst+(slot)))
  const int vb0=(int)(lds0+LDS_V)+((lane>>4)&1)*32+(lane&3)*8+(4*hi+((lane&15)>>2))*64;
  const char*Kbase=shm+LDS_K; bf16x8 kf[8];
  const lds_cptr shm3=(lds_cptr)shm; const lds_cptr kp0=shm3+LDS_K+hi*1024+r32*16; const lds_cptr vp0=shm3+LDS_V+((lane>>4)&1)*32+(lane&3)*8+(4*hi+((lane&15)>>2))*64;
  DMA_K(0,0);DMA_V(0,0);DMA_K(1,SLOTB);
  bf16x8 qr[4];
  #pragma unroll
  for(int d0=0;d0<4;++d0)qr[d0]=*reinterpret_cast<const bf16x8*>(&Qw[(long)r32*QP+d0*16+hi*8]);
  float mhat=0.f,l_reg=0.f;f32x16 o[2];o[0]=f32x16{};o[1]=f32x16{};f32x16 negm=f32x16{};asm volatile("":"+v"(negm));
    #define CMASK(P0,P1,t) do{}while(0)
  bool resc=false;
  #define START(P0,P1) do{ const float rm=rowmax(P0,P1); resc=false; \
    { const float dl=rm; mhat=fadd_s(mhat,dl); \
      _Pragma("unroll") for(int r=0;r<16;++r){P0[r]=fsub_s(P0[r],dl);P1[r]=fsub_s(P1[r],dl);} \
      _Pragma("unroll") for(int r=0;r<16;++r)negm[r]=-mhat; asm volatile("":"+v"(negm)); } \
    _Pragma("unroll") for(int r=0;r<16;++r)P0[r]=__builtin_amdgcn_exp2f(P0[r]); }while(0)
  #define RESC() do{ if(resc){ asm volatile("s_waitcnt lgkmcnt(0)":::"memory"); \
      _Pragma("unroll") for(int d_=0;d_<2;++d_) _Pragma("unroll") for(int r=0;r<16;++r)o[d_][r]*=wsf[crow(r,hi)]; } }while(0)
  f32x16 pA0,pA1,pB0,pB1;
  int sl_prev=0,sl_cur=0,sl_next=SLOTB;
  #define ROT() do{sl_prev=sl_cur;sl_cur=sl_next;sl_next=(sl_next==(NSLOT-1)*SLOTB)?0:sl_next+SLOTB;}while(0)
  DMA_K(2,2*SLOTB);
  WAIT_BAR(3);
  qkt(pA0,pA1,Kbase,qr,negm,r32,hi);asm volatile("s_nop 15\n\ts_nop 7":"+v"(pA0),"+v"(pA1));CMASK(pA0,pA1,0);
  START(pA0,pA1);
  _Pragma("unroll") for(int r=0;r<16;++r)pA1[r]=__builtin_amdgcn_exp2f(pA1[r]);
  WAIT_BAR(0);
  DMA_K(3,0);DMA_V(1,SLOTB);
  ROT();
  kload8(kf,kp0+sl_cur);
  WAIT_BAR(2);
  s16x4 vlo[8],vhi[8]; u32x4 pw0,pw1,pw2,pw3;
  #define PKW(P,B) cvtpk_s(P[B],P[B+1])
  #define PAF(k) __builtin_bit_cast(bf16x8,pw##k)
  #define VFR(i) (bf16x8){vlo[i][0],vlo[i][1],vlo[i][2],vlo[i][3],vhi[i][0],vhi[i][1],vhi[i][2],vhi[i][3]}
  #define PIN(x) asm volatile("":"+v"(x))
  #define MX3(a,b,c) __builtin_fmaxf(__builtin_fmaxf((a),(b)),(c))
  #define GAPA(MF,A0,A1,A2,A3,W0,W1,PW) do{ MF; sacc+=A0; sacc+=A1; sacc+=A2; sacc+=A3; PIN(sacc); W0; W1; PIN(PW); SBAR(); }while(0)
  #define EX(v) __builtin_amdgcn_exp2f(v)
  #define GAPB(MF,X,B) do{ MF; X[B]=EX(X[B]); X[B+1]=EX(X[B+1]); X[B+2]=EX(X[B+2]); X[B+3]=EX(X[B+3]); PIN(X); SBAR(); }while(0)
  #define VRD(i) do{ vlo[i]=vtr(vp_+(((i)>>2)*4096+((i)&3)*1024)); vhi[i]=vtr(vp_+(((i)>>2)*4096+((i)&3)*1024+512)); }while(0)
  #define KRD(G,j) do{ if(G){ kload2(kf,kp0+sl_next,j); SBAR(); } }while(0)
  #define STEP(C0,C1,P0,P1,t,GK,GV,GL) do{ SBAR(); \
    const lds_cptr vp_=vp0+sl_prev; \
    VRD(0); SBAR(); float sacc=(P0[0]+P0[1]); \
    GAPA(C0=__builtin_amdgcn_mfma_f32_32x32x16_bf16(kf[0],qr[0],negm,0,0,0), P0[2],P0[3],P0[4],P0[5],     pw0[0]=PKW(P0,0), pw0[1]=PKW(P0,2), pw0); \
    VRD(4); SBAR(); GAPA(C1=__builtin_amdgcn_mfma_f32_32x32x16_bf16(kf[1],qr[0],negm,0,0,0), P0[6],P0[7],P0[8],P0[9],     pw0[2]=PKW(P0,4), pw0[3]=PKW(P0,6), pw0); \
    VRD(1); SBAR(); GAPA(C0=__builtin_amdgcn_mfma_f32_32x32x16_bf16(kf[2],qr[1],C0,0,0,0),   P0[10],P0[11],P0[12],P0[13], pw1[0]=PKW(P0,8), pw1[1]=PKW(P0,10), pw1); \
    VRD(5); SBAR(); GAPA(C1=__builtin_amdgcn_mfma_f32_32x32x16_bf16(kf[3],qr[1],C1,0,0,0),   P0[14],P0[15],P1[0],P1[1],   pw1[2]=PKW(P0,12),pw1[3]=PKW(P0,14), pw1); \
    VRD(2); SBAR(); GAPA(C0=__builtin_amdgcn_mfma_f32_32x32x16_bf16(kf[4],qr[2],C0,0,0,0),   P1[2],P1[3],P1[4],P1[5],     pw2[0]=PKW(P1,0), pw2[1]=PKW(P1,2), pw2); \
    VRD(6); SBAR(); GAPA(C1=__builtin_amdgcn_mfma_f32_32x32x16_bf16(kf[5],qr[2],C1,0,0,0),   P1[6],P1[7],P1[8],P1[9],     pw2[2]=PKW(P1,4), pw2[3]=PKW(P1,6), pw2); \
    VRD(3); SBAR(); GAPA(C0=__builtin_amdgcn_mfma_f32_32x32x16_bf16(kf[6],qr[3],C0,0,0,0),   P1[10],P1[11],P1[12],P1[13], pw3[0]=PKW(P1,8), pw3[1]=PKW(P1,10), pw3); \
    VRD(7); SBAR(); GAPA(C1=__builtin_amdgcn_mfma_f32_32x32x16_bf16(kf[7],qr[3],C1,0,0,0),   P1[14],P1[15],0.f,0.f,       pw3[2]=PKW(P1,12),pw3[3]=PKW(P1,14), pw3); \
    l_reg+=sacc; \
    if(GK){DMA_K((t)+3,sl_cur);} if(GV){DMA_V((t)+1,sl_next);} \
    CMASK(C0,C1,t); \
    { float a=MX3(C0[0],C0[1],C1[0]),b=MX3(C0[2],C0[3],C1[1]); a=MX3(a,C1[2],C1[3]); \
      _Pragma("unroll") for(int r=4;r<16;r+=4){a=MX3(a,C0[r],C0[r+1]);b=MX3(b,C0[r+2],C0[r+3]);a=MX3(a,C1[r],C1[r+1]);b=MX3(b,C1[r+2],C1[r+3]);} \
      float rm=__builtin_fmaxf(a,b); { auto rr=__builtin_amdgcn_permlane32_swap(__float_as_uint(rm),__float_as_uint(rm),false,false); rm=__builtin_fmaxf(__uint_as_float(rr[0]),__uint_as_float(rr[1])); } \
      resc=false; \
      if(__builtin_expect(__any(rm>(float)THRL),0)){ const float dl=__builtin_fmaxf(rm,0.f); mhat+=dl; \
        _Pragma("unroll") for(int r=0;r<16;++r){C0[r]-=dl;C1[r]-=dl;} \
        _Pragma("unroll") for(int r=0;r<16;++r)negm[r]=-mhat; asm volatile("":"+v"(negm)); \
        const float f=__builtin_amdgcn_exp2f(-dl); l_reg*=f; if(hi==0)wsf[r32]=f; resc=true; } } \
    SBAR(); \
    GAPB(o[0]=__builtin_amdgcn_mfma_f32_32x32x16_bf16(PAF(0),VFR(0),o[0],0,0,0), C0,0); \
    GAPB(o[1]=__builtin_amdgcn_mfma_f32_32x32x16_bf16(PAF(0),VFR(4),o[1],0,0,0), C0,4); \
    KRD(GL,0); GAPB(o[0]=__builtin_amdgcn_mfma_f32_32x32x16_bf16(PAF(1),VFR(1),o[0],0,0,0), C0,8); \
    KRD(GL,1); GAPB(o[1]=__builtin_amdgcn_mfma_f32_32x32x16_bf16(PAF(1),VFR(5),o[1],0,0,0), C0,12); \
    KRD(GL,2); GAPB(o[0]=__builtin_amdgcn_mfma_f32_32x32x16_bf16(PAF(2),VFR(2),o[0],0,0,0), C1,0); \
    KRD(GL,3); GAPB(o[1]=__builtin_amdgcn_mfma_f32_32x32x16_bf16(PAF(2),VFR(6),o[1],0,0,0), C1,4); \
    GAPB(o[0]=__builtin_amdgcn_mfma_f32_32x32x16_bf16(PAF(3),VFR(3),o[0],0,0,0), C1,8); \
    GAPB(o[1]=__builtin_amdgcn_mfma_f32_32x32x16_bf16(PAF(3),VFR(7),o[1],0,0,0), C1,12); \
    }while(0)
  int t=1;
  #undef CMASK
  #define CMASK(P0,P1,t) do{}while(0)
  for(;t+5<NT;t+=2){
    STEP(pB0,pB1,pA0,pA1,t,true,true,true);     WAIT_BAR(2); RESC(); ROT();
    STEP(pA0,pA1,pB0,pB1,t+1,true,true,true);   WAIT_BAR(2); RESC(); ROT();
  }
  #undef CMASK
  #define CMASK(P0,P1,t) do{ if((t)==NT-1){ if(lastmode==2){ _Pragma("unroll") for(int r_=0;r_<8;++r_)P0[r_]=-INFINITY; } _Pragma("unroll") for(int r_=8;r_<16;++r_)P0[r_]=-INFINITY; _Pragma("unroll") for(int r_=0;r_<16;++r_)P1[r_]=-INFINITY; } }while(0)
  #define ENDW(tt) do{ if((tt)+3<NT){WAIT_BAR(2);} else if((tt)+2<NT){WAIT_BAR(1);} else {WAIT_BAR(0);} }while(0)
  for(;t+1<NT;t+=2){
    STEP(pB0,pB1,pA0,pA1,t,(t+3<NT),(t+1<NT),(t+1<NT));       ENDW(t);   RESC(); ROT();
    STEP(pA0,pA1,pB0,pB1,t+1,(t+4<NT),(t+2<NT),(t+2<NT));     ENDW(t+1); RESC(); ROT();
  }
  { float sacc=pA0[0]+pA0[1]; _Pragma("unroll") for(int r=2;r<16;++r)sacc+=pA0[r]; _Pragma("unroll") for(int r=0;r<16;++r)sacc+=pA1[r]; l_reg+=sacc;
    pw0=(u32x4){PKW(pA0,0),PKW(pA0,2),PKW(pA0,4),PKW(pA0,6)};pw1=(u32x4){PKW(pA0,8),PKW(pA0,10),PKW(pA0,12),PKW(pA0,14)};pw2=(u32x4){PKW(pA1,0),PKW(pA1,2),PKW(pA1,4),PKW(pA1,6)};pw3=(u32x4){PKW(pA1,8),PKW(pA1,10),PKW(pA1,12),PKW(pA1,14)};
    SBAR(); pv(o,vb0+sl_prev,PAF(0),PAF(1),PAF(2),PAF(3)); }
  #undef PKW
  #undef PAF
  #undef VFR
  #undef PIN
  #undef MX3
  #undef GAPA
  #undef GAPB
  #undef EX
  #undef VRD
  #undef KRD
  #undef STEP
  #undef ENDW
  {auto rr=__builtin_amdgcn_permlane32_swap(__float_as_uint(l_reg),__float_as_uint(l_reg),false,false);l_reg=__uint_as_float(rr[0])+__uint_as_float(rr[1]);}
  if(hi==0)wsf[32+r32]=l_reg;asm volatile("s_waitcnt lgkmcnt(0)":::"memory");
  if(part_o){ if(wid==0){
    _Pragma("unroll") for(int r=0;r<8;++r){ _Pragma("unroll") for(int d0=0;d0<2;++d0)part_o[crow(r,hi)*64+d0*32+r32]=o[d0][r]; }
    if(hi==0&&r32<16){part_ml[2*r32]=mhat;part_ml[2*r32+1]=l_reg;} } } else {
  float rli[16];
  #pragma unroll
  for(int r=0;r<16;++r)rli[r]=__builtin_amdgcn_rcpf(wsf[32+crow(r,hi)]);
  bf16*Ow=O+(qrow0+wid*QBLK)*QP+h*D; const int nv=nvalid-wid*QBLK;
  { bf16*stg=(bf16*)(shm+LDS_OST)+wid*2048;
    #pragma unroll
    for(int r=0;r<16;++r){const int orow=crow(r,hi);
      #pragma unroll
      for(int d0=0;d0<2;++d0)stg[orow*64+d0*32+r32]=__float2bfloat16(o[d0][r]*rli[r]);}
    asm volatile("s_waitcnt lgkmcnt(0)":::"memory");
    #pragma unroll
    for(int i=0;i<4;++i){const int row=i*8+(lane>>3),ch=lane&7; const u32x4 v=*(const u32x4*)(stg+row*64+ch*8); if(row<nv)ATTN_STORE16(Ow+(long)row*QP+ch*8,v);} } }
  asm volatile("s_waitcnt lgkmcnt(0)\n\ts_barrier":::"memory");
  #undef TOFF
  #undef DMA_K
  #undef DMA_V
  #undef CMASK
  #undef START
  #undef RESC
  #undef ROT
}
constexpr int ATTN_LDS_BYTES=LDS_BYTES;
#undef SBAR
#undef WAIT_BAR
}


#ifndef PG8_SP2
#define PG8_SP2 true
#endif
#ifndef PG8_ALIGN
#define PG8_ALIGN true
#endif
#define LAS __attribute__((address_space(3)))
#ifndef PHM
#define PHM 0xffff
#endif
using pg8::bf16_t; using pg8::f32x4; using pg8::u32x4; using pg8::bf16x8;
typedef float f32x16_t __attribute__((ext_vector_type(16)));
typedef float f32x2_tt __attribute__((ext_vector_type(2)));
constexpr size_t MiB = 1u << 20;
constexpr size_t WS_COS = 1 * MiB, WS_SIN = 3 * MiB, WS_W = 5 * MiB, WS_XN = 163 * MiB, WS_Y = 229 * MiB, WS_R3 = 295 * MiB, WS_R1 = 361 * MiB,
                 WS_K = WS_R1 + 66 * MiB, WS_V = WS_R1 + 83 * MiB, WS_AGG = 619 * MiB, WS_CIN = 628 * MiB, WS_XB = 635 * MiB, WS_HB = 637 * MiB, WS_END = 702 * MiB;
constexpr size_t WS_CNT = 65536;
constexpr size_t W_IN = 0, W_OUT = W_IN + (size_t)8 * 5632 * 1024, W_QKV = W_OUT + (size_t)8 * 1024 * 2816, W_O = W_QKV + (size_t)2 * 1536 * 1024,
                 W_RIN = W_O + (size_t)2 * 1024 * 1024, W_RG = W_RIN + (size_t)2 * 2048 * 1024, W_RO = W_RG + (size_t)2 * 4096 * 256, W_END = W_RO + (size_t)2 * 1024 * 1024;
static_assert(W_END * 2 <= 158 * MiB, "weights");
constexpr int LDS_BYTES = 147456;
constexpr float ATT_C2 = 0.125f * 1.4426950408889634f;

__device__ __forceinline__ float wave_sum(float v) {
#pragma unroll
    for (int o = 1; o < 64; o <<= 1) v += __shfl_xor(v, o);
    return v;
}
__device__ __forceinline__ unsigned f2bf(float f) { unsigned u = __builtin_bit_cast(unsigned, f); return (u + 0x7fffu + ((u >> 16) & 1u)) >> 16; }
__device__ __forceinline__ unsigned pk2(float lo, float hi) { return f2bf(lo) | (f2bf(hi) << 16); }
__device__ __forceinline__ float bf2f(unsigned b) { return __uint_as_float(b << 16); }

struct TrD { const float* W; bf16_t* WT; int K, N, k0, n0, dr0; };
__device__ __forceinline__ void tr_load(float (&r)[32], const TrD& d, int lane) {
#pragma unroll
    for (int i = 0; i < 32; ++i) { const int kk = 2 * i + (lane >> 5); r[i] = d.W[(size_t)(d.k0 + kk) * d.N + d.n0 + (lane & 31)]; }
}
__device__ __forceinline__ void tr_finish(const float (&r)[32], const TrD& d, float* scr, int lane) {
#pragma unroll
    for (int i = 0; i < 32; ++i) { const int kk = 2 * i + (lane >> 5); scr[kk * 33 + (lane & 31)] = r[i]; }
    __builtin_amdgcn_s_waitcnt(0); asm volatile("" ::: "memory");
    const int c = lane & 7;
#pragma unroll
    for (int j = 0; j < 4; ++j) { const int n = (lane >> 3) + 8 * j; const float* s = scr + (8 * c) * 33 + n;
        u32x4 o; o.x = pk2(s[0 * 33], s[1 * 33]); o.y = pk2(s[2 * 33], s[3 * 33]); o.z = pk2(s[4 * 33], s[5 * 33]); o.w = pk2(s[6 * 33], s[7 * 33]);
        *(u32x4*)(d.WT + (size_t)(d.dr0 + n) * d.K + d.k0 + 8 * c) = o; }
    asm volatile("s_waitcnt lgkmcnt(0)" ::: "memory");
}

#define XB_TMO      128
#define XB_XCNT(j)  (256  + 64 * (j))
#define XB_XSUB(j)  (1280 + 64 * (j))
#define XB_XGEN(j)  (2304 + 64 * (j))
#define XB_TOP      3328
#define XB_TOPGEN   3392
#define XCD_BAR_WORDS 3456
#define XB_SPIN_CAP (1u << 18)

__device__ __forceinline__ unsigned xb_ld(unsigned* p)              { return __hip_atomic_load(p, __ATOMIC_RELAXED, __HIP_MEMORY_SCOPE_AGENT); }
__device__ __forceinline__ unsigned xb_add(unsigned* p, unsigned v) { return __hip_atomic_fetch_add(p, v, __ATOMIC_RELAXED, __HIP_MEMORY_SCOPE_AGENT); }
__device__ __forceinline__ unsigned xb_xcc_id() { return (unsigned)__builtin_amdgcn_s_getreg((3 << 11) | 20) & 0xFu; }
#define XB_SPIN(cond, bar) do { unsigned _sp = 0; while (cond) { __builtin_amdgcn_s_sleep(1); \
    if ((++_sp & 255u) == 0u) { if (xb_ld(&(bar)[XB_TMO])) break; if (_sp > XB_SPIN_CAP) { atomicAdd(&(bar)[XB_TMO], 1u); break; } } } } while (0)

struct XcdBarrier {
    unsigned* bar; unsigned x;
    volatile LAS unsigned* st;
};

__device__ __forceinline__ XcdBarrier xcd_barrier_post(unsigned* bar, volatile LAS unsigned* st) {
    XcdBarrier b; b.bar = bar; b.x = xb_xcc_id(); b.st = st;
    if (threadIdx.x == 0) (void)xb_add(&bar[XB_XCNT(b.x)], 1u);
    return b;
}
__device__ __forceinline__ void xcd_barrier_complete(unsigned* bar, unsigned x, unsigned& nloc, unsigned& nx) {
    const unsigned G = gridDim.x * gridDim.y * gridDim.z;
    unsigned sum, cnt, mine, sp = 0u;
    for (;;) {
        sum = 0u; cnt = 0u; mine = 0u;
#pragma unroll
        for (unsigned j = 0; j < 16; ++j) { const unsigned c = xb_ld(&bar[XB_XCNT(j)]); sum += c; cnt += (c > 0u) ? 1u : 0u; mine = (j == x) ? c : mine; }
        if (sum == G) break;
        __builtin_amdgcn_s_sleep(1);
        if ((++sp & 255u) == 0u) { if (xb_ld(&bar[XB_TMO])) break; if (sp > XB_SPIN_CAP) { atomicAdd(&bar[XB_TMO], 1u); break; } }
    }
    nloc = mine > 0u ? mine : 1u; nx = cnt > 0u ? cnt : 1u;
}

__device__ __forceinline__ void xcd_barrier(const XcdBarrier& b) {
    asm volatile("s_waitcnt vmcnt(0)" ::: "memory");
    __syncthreads();
    if (threadIdx.x == 0) {
        unsigned* bar = b.bar;
        __builtin_amdgcn_s_waitcnt(0);
        unsigned nloc = b.st[0], nx = b.st[1];
        if (nloc == 0u) { xcd_barrier_complete(bar, b.x, nloc, nx); b.st[0] = nloc; b.st[1] = nx; }
        const unsigned old = xb_add(&bar[XB_XSUB(b.x)], 1u);
        const unsigned gen = old / nloc;
        if (old + 1u == (gen + 1u) * nloc) {
            __builtin_amdgcn_fence(__ATOMIC_RELEASE, "agent");
            asm volatile("s_waitcnt vmcnt(0)" ::: "memory");
            const unsigned og = xb_add(&bar[XB_TOP], 1u);
            const unsigned tg = og / nx;
            if (og + 1u == (tg + 1u) * nx) xb_add(&bar[XB_TOPGEN], 1u);
            else XB_SPIN(xb_ld(&bar[XB_TOPGEN]) == tg, bar);
            __builtin_amdgcn_fence(__ATOMIC_ACQUIRE, "agent");
            xb_add(&bar[XB_XGEN(b.x)], 1u);
            asm volatile("s_waitcnt vmcnt(0)" ::: "memory");
        } else {
            XB_SPIN(xb_ld(&bar[XB_XGEN(b.x)]) == gen, bar);
            __builtin_amdgcn_fence(__ATOMIC_ACQUIRE, "agent");
            asm volatile("s_waitcnt vmcnt(0)" ::: "memory");
        }
    }
    __syncthreads();
}

struct Args { const float* in[16]; float* out; unsigned char* ws; };

__device__ __forceinline__ float* hrow_ptr(float* out, float* hmeta, int row) { return row < NREAL ? out + (size_t)row * 1024 : hmeta + (size_t)(row - NREAL) * 1024; }

__device__ __forceinline__ float norm_row_store(const f32x4 (&v)[4], const float* g, bf16_t* orow, int lane) {
    float s = 0.f;
#pragma unroll
    for (int j = 0; j < 4; ++j) s += (v[j].x * v[j].x + v[j].y * v[j].y) + (v[j].z * v[j].z + v[j].w * v[j].w);
    const float r = __builtin_amdgcn_rsqf(wave_sum(s) * (1.f / 1024.f) + NORM_EPS);
    unsigned long long* o8 = (unsigned long long*)orow + lane;
#pragma unroll
    for (int j = 0; j < 4; ++j) { const f32x4 gg = ((const f32x4*)g)[lane + 64 * j];
        o8[64 * j] = (unsigned long long)pk2(v[j].x * r * gg.x, v[j].y * r * gg.y) | ((unsigned long long)pk2(v[j].z * r * gg.z, v[j].w * r * gg.w) << 32); }
    return r;
}

__device__ __forceinline__ float norm_row_store_g(const f32x4 (&v)[4], const f32x4 (&gg)[4], bf16_t* orow, int lane) {
    float s = 0.f;
#pragma unroll
    for (int j = 0; j < 4; ++j) s += (v[j].x * v[j].x + v[j].y * v[j].y) + (v[j].z * v[j].z + v[j].w * v[j].w);
    const float r = __builtin_amdgcn_rsqf(wave_sum(s) * (1.f / 1024.f) + NORM_EPS);
    unsigned long long* o8 = (unsigned long long*)orow + lane;
#pragma unroll
    for (int j = 0; j < 4; ++j) o8[64 * j] = (unsigned long long)pk2(v[j].x * r * gg[j].x, v[j].y * r * gg[j].y) | ((unsigned long long)pk2(v[j].z * r * gg[j].z, v[j].w * r * gg[j].w) << 32);
    return r;
}

__device__ __forceinline__ int crow_(int r, int hi) { return (r & 3) + 8 * (r >> 2) + 4 * hi; }
__device__ __forceinline__ void thin_tile(float* T, float* part, const bf16_t* A, int lda, const bf16_t* B0, const bf16_t* B1, int ldb, int K, int wave, int lane, int tid) {
    const int r32 = lane & 31, hi = lane >> 5, kc = K >> 3, kbeg = wave * kc;
    const bf16_t* ap = A + (size_t)r32 * lda + kbeg + hi * 8;
    const bf16_t* b0p = B0 + (size_t)r32 * ldb + kbeg + hi * 8;
    const bf16_t* b1p = B1 + (size_t)r32 * ldb + kbeg + hi * 8;
    f32x16_t c0 = {}, c1 = {};
#pragma unroll 1
    for (int k = 0; k < kc; k += 128) {
        bf16x8 a[8], b0[8], b1[8];
#pragma unroll
        for (int i = 0; i < 8; ++i) if (k + 16 * i < kc) { a[i] = *(const bf16x8*)(ap + k + 16 * i); b0[i] = *(const bf16x8*)(b0p + k + 16 * i); b1[i] = *(const bf16x8*)(b1p + k + 16 * i); }
#pragma unroll
        for (int i = 0; i < 8; ++i) if (k + 16 * i < kc) {
            c0 = __builtin_amdgcn_mfma_f32_32x32x16_bf16(a[i], b0[i], c0, 0, 0, 0);
            c1 = __builtin_amdgcn_mfma_f32_32x32x16_bf16(a[i], b1[i], c1, 0, 0, 0); }
    }
#pragma unroll
    for (int r = 0; r < 16; ++r) { const int tok = crow_(r, hi); part[wave * 2048 + tok * 64 + r32] = c0[r]; part[wave * 2048 + tok * 64 + 32 + r32] = c1[r]; }
    __syncthreads();
    for (int i = tid; i < 2048; i += 512) { float s = 0.f;
#pragma unroll
        for (int w = 0; w < 8; ++w) s += part[w * 2048 + i];
        T[i] = s; }
    __syncthreads();
}
enum ThinKind { TK_SWIGLU = 0, TK_PLAIN = 1, TK_RECIN = 2, TK_QKV = 3, TK_GATE = 4 };
struct ThinP { const bf16_t* A; int lda; const bf16_t* Bt; int ldb; int K; int nunits;
               bf16_t* O0; bf16_t* O1; bf16_t* O2; unsigned short* AB; const float* p0; const float* p1; };
template <int KIND> __device__ __forceinline__ void thin_phase(unsigned char* lds, const ThinP& P, int tid, int wave, int lane, int bid, int G) {
    float* part = (float*)lds; float* T = (float*)(lds + 65536);
    for (int u = bid; u < P.nunits; u += G) {
        int r0, r1, ak = 0;
        if (KIND == TK_SWIGLU) { const int c0 = 32 * u; r0 = (c0 >> 7) * 256 + (c0 & 127); r1 = r0 + 128; }
        else if (KIND == TK_PLAIN || KIND == TK_RECIN) { r0 = 64 * u; r1 = r0 + 32; }
        else if (KIND == TK_QKV) { r0 = (u >> 2) * 256 + 32 * (u & 3); r1 = r0 + 128; }
        else { const int d = u >> 5, h = (u >> 3) & 3, g32 = u & 7; r0 = (d * 8 + h * 2 + (g32 >> 2)) * 256 + (g32 & 3) * 32; r1 = r0 + 128; ak = h * (ROWS_ALLOC * 256); }
        thin_tile(T, part, P.A + (size_t)NREAL * P.lda + ak, P.lda, P.Bt + (size_t)r0 * P.ldb, P.Bt + (size_t)r1 * P.ldb, P.ldb, P.K, wave, lane, tid);
        if (KIND == TK_SWIGLU) {
            for (int idx = tid; idx < 1024; idx += 512) { const int r = idx >> 5, c = idx & 31; const float gt = T[r * 64 + c], up = T[r * 64 + 32 + c];
                P.O0[(size_t)(NREAL + r) * 2816 + 32 * u + c] = (bf16_t)f2bf(gt * pg8::sigm(gt) * up); }
        } else if (KIND == TK_PLAIN) {
            for (int idx = tid; idx < 2048; idx += 512) { const int r = idx >> 6, c = idx & 63; P.O0[(size_t)(NREAL + r) * 1024 + 64 * u + c] = (bf16_t)f2bf(T[idx]); }
        } else if (KIND == TK_RECIN) {
            for (int idx = tid; idx < 2048; idx += 512) { const int r = idx >> 6, c = idx & 63; const float v = T[idx];
                if (u < 16) P.O0[(size_t)(NREAL + r) * 1024 + 64 * u + c] = (bf16_t)f2bf(pg8::gelu_tanh(v));
                else P.O1[(size_t)(NREAL + r) * 1024 + 64 * (u - 16) + c] = (bf16_t)f2bf(v); }
        } else if (KIND == TK_QKV) {
            for (int idx = tid; idx < 2048; idx += 512) { const int r = idx >> 6, dd = idx & 63; const float v = T[idx];
                if (u < 20) { const float rms = __builtin_amdgcn_rsqf(wave_sum(v * v) * (1.f / 64.f) + NORM_EPS);
                    if (u < 16) P.O0[(size_t)(NREAL + r) * 1024 + 64 * u + dd] = (bf16_t)f2bf(v * rms * P.p0[dd] * ATT_C2);
                    else P.O1[(size_t)(NREAL + r) * 256 + 64 * (u - 16) + dd] = (bf16_t)f2bf(v * rms * P.p1[dd]); }
                else P.O2[(size_t)(NREAL + r) * 256 + 64 * (u - 20) + dd] = (bf16_t)f2bf(v); }
        } else {
            const int d = u >> 5, h = (u >> 3) & 3, g32 = u & 7, cb = h * 256 + g32 * 32;
            for (int idx = tid; idx < 1024; idx += 512) { const int r = idx >> 5, c = idx & 31, ch = cb + c;
                P.AB[((size_t)d * NROWS + NREAL + r) * 1024 + ch] = (unsigned short)pg8::q8pair(pg8::sigm(T[r * 64 + c] + P.p0[(d * 2 + 0) * 1024 + ch]), pg8::sigm(T[r * 64 + 32 + c] + P.p0[(d * 2 + 1) * 1024 + ch])); }
        }
        __syncthreads();
    }
}

__device__ __forceinline__ int chunk_row0(int b, int j) { return j == 0 ? NREAL + b * 16 : b * 16384 + (j - 1) * 64; }
__device__ __forceinline__ void ab_from(unsigned w, float xc, float sp, float& a, float& b) {
    const float r = (float)(w & 0xffu) * (1.f / 255.f), ig = (float)((w >> 8) & 0xffu) * (1.f / 255.f);
    a = __builtin_amdgcn_exp2f(sp * r); b = __builtin_amdgcn_sqrtf(__builtin_fmaf(-a, a, 1.f)) * (ig * xc);
}
__device__ __forceinline__ float sp_of(float lam) { const float e = __builtin_amdgcn_exp2f(-LOG2E * lam); return -8.f * LOG2E * (0.6931471805599453f * __builtin_amdgcn_logf(1.f + e)); }
template <int LEN> __device__ __forceinline__ void scanA_item(const unsigned short* ab, const bf16_t* xc, int dir, float sp, float rb, float ib, f32x2_tt* outp) {
    constexpr int BT = LEN < 32 ? LEN : 32;
    float h = 0.f, P = 1.f;
#pragma unroll 1
    for (int t0 = 0; t0 < LEN; t0 += BT) {
        unsigned w[BT]; unsigned short x[BT];
#pragma unroll
        for (int t = 0; t < BT; ++t) { const int tt = dir ? LEN - 1 - (t0 + t) : t0 + t; w[t] = ab[(size_t)tt * 1024]; x[t] = xc[(size_t)tt * 256]; }
#pragma unroll
        for (int t = 0; t < BT; ++t) { float a, b; ab_from(w[t], bf2f(x[t]), sp, a, b); h = a * h + b; P *= a; }
    }
    *outp = (f32x2_tt){P, h};
}
template <int LEN> __device__ __forceinline__ void scanC_item(const unsigned short* abf, const unsigned short* abb, const bf16_t* xc, const bf16_t* gate, bf16_t* y, float cf, float cb, float spf, float spb, float rbf, float ibf, float rbb, float ibb) {
    constexpr int BT = LEN < 16 ? LEN : 16;
    float hf[LEN]; float h = cf;
#pragma unroll
    for (int t0 = 0; t0 < LEN; t0 += BT) {
        unsigned w[BT]; unsigned short x[BT];
#pragma unroll
        for (int t = 0; t < BT; ++t) { w[t] = abf[(size_t)(t0 + t) * 1024]; x[t] = xc[(size_t)(t0 + t) * 256]; }
#pragma unroll
        for (int t = 0; t < BT; ++t) { float a, b; ab_from(w[t], bf2f(x[t]), spf, a, b); h = a * h + b; hf[t0 + t] = h; }
        asm volatile("" ::: "memory");
    }
    h = cb;
#pragma unroll
    for (int t0 = LEN - BT; t0 >= 0; t0 -= BT) {
        unsigned w[BT]; unsigned short x[BT], g[BT];
#pragma unroll
        for (int t = 0; t < BT; ++t) { w[t] = abb[(size_t)(t0 + t) * 1024]; x[t] = xc[(size_t)(t0 + t) * 256]; g[t] = gate[(size_t)(t0 + t) * 1024]; }
#pragma unroll
        for (int t = BT - 1; t >= 0; --t) { float a, b; ab_from(w[t], bf2f(x[t]), spb, a, b); h = a * h + b;
            y[(size_t)(t0 + t) * 1024] = (bf16_t)f2bf((hf[t0 + t] + h) * bf2f(g[t])); }
        asm volatile("" ::: "memory");
    }
}


template <int LEN> __device__ __forceinline__ void scanA2_item(const unsigned* ab, const unsigned* xc, int dir, float sp0, float sp1, f32x4* outp) {
    constexpr int BT = LEN < 32 ? LEN : 32;
    float h0 = 0.f, P0 = 1.f, h1 = 0.f, P1 = 1.f;
#pragma unroll 1
    for (int t0 = 0; t0 < LEN; t0 += BT) {
        unsigned w[BT], x[BT];
#pragma unroll
        for (int t = 0; t < BT; ++t) { const int tt = dir ? LEN - 1 - (t0 + t) : t0 + t; w[t] = ab[(size_t)tt * 512]; x[t] = xc[(size_t)tt * 128]; }
#pragma unroll
        for (int t = 0; t < BT; ++t) { float a, b; ab_from(w[t] & 0xffffu, __uint_as_float(x[t] << 16), sp0, a, b); h0 = a * h0 + b; P0 *= a;
                                       ab_from(w[t] >> 16, __uint_as_float(x[t] & 0xffff0000u), sp1, a, b); h1 = a * h1 + b; P1 *= a; }
    }
    *outp = (f32x4){P0, h0, P1, h1};
}
typedef unsigned u32x2_tt __attribute__((ext_vector_type(2)));
template <int LEN> __device__ __forceinline__ void scanA4_item(const u32x2_tt* ab, const u32x2_tt* xc, int dir, f32x4 sp, f32x4* outp) {
    constexpr int BT = LEN < 32 ? LEN : 32;
    f32x4 h = {0.f, 0.f, 0.f, 0.f}, P = {1.f, 1.f, 1.f, 1.f};
#pragma unroll 1
    for (int t0 = 0; t0 < LEN; t0 += BT) {
        u32x2_tt w[BT], x[BT];
#pragma unroll
        for (int t = 0; t < BT; ++t) { const int tt = dir ? LEN - 1 - (t0 + t) : t0 + t; w[t] = ab[(size_t)tt * 256]; x[t] = xc[(size_t)tt * 64]; }
#pragma unroll
        for (int t = 0; t < BT; ++t) { float a, b;
            ab_from(w[t].x & 0xffffu, __uint_as_float(x[t].x << 16), sp[0], a, b); h[0] = a * h[0] + b; P[0] *= a;
            ab_from(w[t].x >> 16, __uint_as_float(x[t].x & 0xffff0000u), sp[1], a, b); h[1] = a * h[1] + b; P[1] *= a;
            ab_from(w[t].y & 0xffffu, __uint_as_float(x[t].y << 16), sp[2], a, b); h[2] = a * h[2] + b; P[2] *= a;
            ab_from(w[t].y >> 16, __uint_as_float(x[t].y & 0xffff0000u), sp[3], a, b); h[3] = a * h[3] + b; P[3] *= a; }
    }
    outp[0] = (f32x4){P[0], h[0], P[1], h[1]}; outp[1] = (f32x4){P[2], h[2], P[3], h[3]};
}
template <int LEN> __device__ __forceinline__ void scanC2_item(const unsigned* abf, const unsigned* abb, const unsigned* xc, const unsigned* gate, unsigned* y, f32x2_tt cf, f32x2_tt cb, f32x2_tt spf, f32x2_tt spb) {
    constexpr int BT = LEN < 16 ? LEN : 16;
    float hf0[LEN], hf1[LEN]; float h0 = cf.x, h1 = cf.y;
#pragma unroll
    for (int t0 = 0; t0 < LEN; t0 += BT) {
        unsigned w[BT], x[BT];
#pragma unroll
        for (int t = 0; t < BT; ++t) { w[t] = abf[(size_t)(t0 + t) * 512]; x[t] = xc[(size_t)(t0 + t) * 128]; }
#pragma unroll
        for (int t = 0; t < BT; ++t) { float a, b; ab_from(w[t] & 0xffffu, __uint_as_float(x[t] << 16), spf.x, a, b); h0 = a * h0 + b; hf0[t0 + t] = h0;
                                       ab_from(w[t] >> 16, __uint_as_float(x[t] & 0xffff0000u), spf.y, a, b); h1 = a * h1 + b; hf1[t0 + t] = h1; }
        asm volatile("" ::: "memory");
    }
    h0 = cb.x; h1 = cb.y;
#pragma unroll
    for (int t0 = LEN - BT; t0 >= 0; t0 -= BT) {
        unsigned w[BT], x[BT], g[BT];
#pragma unroll
        for (int t = 0; t < BT; ++t) { w[t] = abb[(size_t)(t0 + t) * 512]; x[t] = xc[(size_t)(t0 + t) * 128]; g[t] = gate[(size_t)(t0 + t) * 512]; }
#pragma unroll
        for (int t = BT - 1; t >= 0; --t) { float a, b; ab_from(w[t] & 0xffffu, __uint_as_float(x[t] << 16), spb.x, a, b); h0 = a * h0 + b;
            ab_from(w[t] >> 16, __uint_as_float(x[t] & 0xffff0000u), spb.y, a, b); h1 = a * h1 + b;
            y[(size_t)(t0 + t) * 512] = pk2((hf0[t0 + t] + h0) * __uint_as_float(g[t] << 16), (hf1[t0 + t] + h1) * __uint_as_float(g[t] & 0xffff0000u)); }
        asm volatile("" ::: "memory");
    }
}

typedef const __attribute__((address_space(4))) Args* KArgP;
#define KARGS() ({ KArgP p_ = (KArgP)__builtin_amdgcn_kernarg_segment_ptr(); asm volatile("" : "+s"(p_)); p_; })
#define GSYNC() do { KArgP apb_ = KARGS(); XcdBarrier b_; b_.bar = (unsigned*)(apb_->ws + 16384); b_.x = xb_xcc_id(); b_.st = (volatile LAS unsigned*)(ldsl + 131072 + 32); xcd_barrier(b_); } while (0)
#define WSP(T, off) ((T*)(ws + (off)))
#ifndef DEFER_CONV
#define DEFER_CONV 0
#endif
#define IDS() int tid_ = threadIdx.x; asm volatile("" : "+v"(tid_)); const int tid = tid_, lane = tid & 63, wave = __builtin_amdgcn_readfirstlane(tid >> 6); const int G = gridDim.x, bid = blockIdx.x; \
              const int vcu = (G % 8 == 0) ? (bid % 8) * (G / 8) + bid / 8 : bid; const int gw = vcu * 8 + wave, NGW = G * 8; const int gtid = bid * 512 + tid, GT = G * 512; \
              (void)lane; (void)vcu; (void)gw; (void)NGW; (void)gtid; (void)GT;

constexpr int IA = 8 * 2816, IB = 8 * 1408, IC = 2 * 768, ID = 2 * 512, IE = 2 * 1024, IF = 32 * 32, IG = 2 * 512, NIT = IA + IB + IC + ID + IE + IF + IG;
constexpr int N_EARLY = 2 * 2816 + 2 * 1408 + 768 + 512, N_DEFER = NIT - N_EARLY;
__device__ __forceinline__ int tr_early_item(int e) { return e < 5632 ? e : e < 8448 ? IA + (e - 5632) : e < 9216 ? IA + IB + (e - 8448) : IA + IB + IC + (e - 9216); }
__device__ __forceinline__ int tr_defer_item(int d) { return d < 16896 ? 5632 + d : d < 25344 ? IA + 2816 + (d - 16896) : d < 26112 ? IA + IB + 768 + (d - 25344) : d < 26624 ? IA + IB + IC + 512 + (d - 26112) : IA + IB + IC + ID + (d - 26624); }
static_assert(N_EARLY == 9728 && N_DEFER == 30720, "conversion item split");
__device__ __forceinline__ TrD tr_decode(KArgP ap, bf16_t* Wb, int r) {
            if (r < IA) { const int mat = r / 2816, q = r % 2816, kb = q / 176, nb = q % 176, n0 = 32 * nb, bj = n0 / 2816, c = n0 % 2816;
                return TrD{ap->in[3] + (size_t)mat * 1024 * 5632, Wb + W_IN + (size_t)mat * 5632 * 1024, 1024, 5632, 64 * kb, n0, (c >> 7) * 256 + bj * 128 + (c & 127)}; } r -= IA;
            if (r < IB) { const int mat = r / 1408, q = r % 1408, kb = q / 32, nb = q % 32;
                return TrD{ap->in[4] + (size_t)mat * 2816 * 1024, Wb + W_OUT + (size_t)mat * 1024 * 2816, 2816, 1024, 64 * kb, 32 * nb, 32 * nb}; } r -= IB;
            if (r < IC) { const int mat = r / 768, q = r % 768, kb = q / 48, nb = q % 48, n0 = 32 * nb, tile = n0 >> 8, rr = n0 & 255;
                return TrD{ap->in[5] + (size_t)mat * 1024 * 1536, Wb + W_QKV + (size_t)mat * 1536 * 1024, 1024, 1536, 64 * kb, n0, tile * 256 + 128 * ((rr & 63) >> 5) + 32 * (rr >> 6)}; } r -= IC;
            if (r < ID) { const int mat = r / 512, q = r % 512, kb = q / 32, nb = q % 32;
                return TrD{ap->in[8] + (size_t)mat * 1024 * 1024, Wb + W_O + (size_t)mat * 1024 * 1024, 1024, 1024, 64 * kb, 32 * nb, 32 * nb}; } r -= ID;
            if (r < IE) { const int mat = r / 1024, q = r % 1024, kb = q / 64, nb = q % 64;
                return TrD{ap->in[9] + (size_t)mat * 1024 * 2048, Wb + W_RIN + (size_t)mat * 2048 * 1024, 1024, 2048, 64 * kb, 32 * nb, 32 * nb}; } r -= IE;
            if (r < IF) { const int sub = r >> 5, q = r & 31, kb = q >> 3, nb = q & 7, n0 = 32 * nb, jl = sub >> 4, d = (sub >> 3) & 1, g = (sub >> 2) & 1, h = sub & 3;
                return TrD{ap->in[12] + (size_t)sub * 256 * 256, Wb + W_RG + (size_t)jl * 4096 * 256, 256, 256, 64 * kb, n0, (d * 8 + h * 2 + (n0 >> 7)) * 256 + g * 128 + (n0 & 127)}; } r -= IF;
            { const int mat = r / 512, q = r % 512, kb = q / 32, nb = q % 32;
                return TrD{ap->in[15] + (size_t)mat * 1024 * 1024, Wb + W_RO + (size_t)mat * 1024 * 1024, 1024, 1024, 64 * kb, 32 * nb, 32 * nb}; }
        }

__global__ void __launch_bounds__(512, 2) fwd_megakernel(Args args_unused) {
    extern __shared__ __attribute__((aligned(16))) unsigned char lds[];
    cg::grid_group grid = cg::this_grid();
    LAS unsigned char* ldsl = (LAS unsigned char*)lds;
    for (int u = threadIdx.x; u < 64; u += 512) ((LAS unsigned*)(ldsl + 131072))[u] = 0u;
    __syncthreads();
    { KArgP ap0 = KARGS(); (void)xcd_barrier_post((unsigned*)(ap0->ws + 16384), (volatile LAS unsigned*)(ldsl + 131072 + 32)); }
    grid.sync();

#if PHM & 1
    {
        KArgP ap = KARGS(); unsigned char* ws = ap->ws; IDS();
        float* scr = (float*)(lds + wave * 16384); bf16_t* Wb = WSP(bf16_t, WS_W);
#ifdef NANFILL
        {
            u32x4* f0 = (u32x4*)(ws + WS_Y); const size_t n16 = (WS_END - WS_Y) / 16; const u32x4 q = {0xffffffffu, 0xffffffffu, 0xffffffffu, 0xffffffffu};
            for (size_t i = gtid; i < n16; i += GT) f0[i] = q;
        }
#endif
        const bool defer_ = DEFER_CONV && G == 256; const int n_pro = defer_ ? N_EARLY : NIT;
#pragma unroll 1
        for (int it = gw; it < n_pro; it += 2 * NGW) {
            const bool hasb = it + NGW < n_pro; const int ib_ = hasb ? it + NGW : it;
            const TrD da = tr_decode(ap, Wb, defer_ ? tr_early_item(it) : it), db = tr_decode(ap, Wb, defer_ ? tr_early_item(ib_) : ib_);
            float ra[32], rb[32]; tr_load(ra, da, lane); tr_load(rb, db, lane);
            tr_finish(ra, da, scr, lane);
            if (hasb) tr_finish(rb, db, scr, lane);
        }
        __builtin_amdgcn_s_waitcnt(0);
        float* tcos = WSP(float, WS_COS); float* tsin = WSP(float, WS_SIN);
        for (int idx = gtid; idx < 16384 * 32; idx += GT) { const int s = idx >> 5, j = idx & 31, jj = j & 15; const float pos = (float)(j < 16 ? (s >> 6) : (s & 63));
            const float inv = __builtin_amdgcn_exp2f(-(float)jj * (13.287712379549449f / 16.f)); const float th = pos * inv;
            const double turns = (double)th * 0.15915494309189535; const float fr = (float)(turns - __builtin_floor(turns));
            tcos[idx] = __builtin_amdgcn_cosf(fr); tsin[idx] = __builtin_amdgcn_sinf(fr); }
        float* HS = WSP(float, WS_XB + 1 * MiB); bf16_t* XN = WSP(bf16_t, WS_XN); const float* gains = ap->in[2];
        f32x4 g0v[4];
#pragma unroll
        for (int j = 0; j < 4; ++j) g0v[j] = ((const f32x4*)gains)[lane + 64 * j];
#pragma unroll 1
        for (int row = gw; row < NROWS; row += 2 * NGW) {
            f32x4 vv[2][4];
#pragma unroll
            for (int q = 0; q < 2; ++q) { const int rq = (row + q * NGW < NROWS) ? row + q * NGW : row;
                const float* src = rq < NREAL ? ap->in[0] + (size_t)rq * 1024 : ap->in[1] + (size_t)((rq - NREAL) & 15) * 1024;
#pragma unroll
                for (int j = 0; j < 4; ++j) vv[q][j] = ((const f32x4*)src)[lane + 64 * j]; }
#pragma unroll
            for (int q = 0; q < 2; ++q) { const int rr = row + q * NGW; if (rr >= NROWS) break;
                const float rstd = norm_row_store_g(vv[q], g0v, XN + (size_t)rr * 1024, lane); if (lane == 0) HS[rr] = __builtin_amdgcn_rcpf(rstd); }
        }
    }
#endif
    GSYNC();

#pragma unroll 1
    for (int layer = 0; layer < 4; ++layer) {
#pragma unroll 1
        for (int stage = 0; stage < 3; ++stage) {
            const int jl = layer >> 1;
#ifdef TESTSKIP
            if (stage == 1 && ((TESTSKIP >> (layer & 1)) & 1)) continue;
#endif
            int oAsel, oK; size_t oBoff; float coef; int gpost_i, gpre_i;
            if (stage != 1) {
                const int f = stage >> 1;
                {
                    KArgP ap = KARGS(); unsigned char* ws = ap->ws; IDS();
                    const bf16_t* Win = WSP(bf16_t, WS_W) + W_IN + (size_t)(layer * 2 + f) * 5632 * 1024; bf16_t* XN = WSP(bf16_t, WS_XN); bf16_t* ACT = WSP(bf16_t, WS_R1);
#if PHM & 2
                    { pg8::Gemm g{XN, Win, 1024, 1024, 1024, 0}; pg8::StaticOrder S; S.init(NREAL, 5632, G, bid); pg8::EpiSwiGLU E{ACT};
                      pg8::gemm_phase<pg8::EpiSwiGLU, pg8::StaticOrder, PG8_ALIGN, PG8_SP2>(ldsl, g, S, E); }
#endif
#if PHM & 4
                    { ThinP P{XN, 1024, Win, 1024, 1024, 88, ACT, nullptr, nullptr, nullptr, nullptr, nullptr}; thin_phase<TK_SWIGLU>(lds, P, tid, wave, lane, bid, G); }
#endif
                }
                GSYNC();
                oAsel = 0; oK = 2816; oBoff = W_OUT + (size_t)(layer * 2 + f) * 1024 * 2816; coef = 0.5f; gpost_i = layer * 6 + (f ? 5 : 1);
                gpre_i = f ? (layer < 3 ? layer * 6 + 6 : -1) : layer * 6 + 2;
            } else if ((layer & 1) == 0) {
                {
                    KArgP ap = KARGS(); unsigned char* ws = ap->ws; IDS();
                    const bf16_t* Wqkv = WSP(bf16_t, WS_W) + W_QKV + (size_t)jl * 1536 * 1024; const float* qg = ap->in[6] + jl * 64; const float* kg = ap->in[7] + jl * 64;
                    bf16_t* XN = WSP(bf16_t, WS_XN); bf16_t* QO = WSP(bf16_t, WS_R1); bf16_t* KB = WSP(bf16_t, WS_K); bf16_t* VB = WSP(bf16_t, WS_V);
#if PHM & 8
                    { pg8::Gemm g{XN, Wqkv, 1024, 1024, 1024, 0}; pg8::StaticOrder S; S.init(NREAL, 1536, G, bid); pg8::EpiQKV E{QO, KB, VB, qg, kg, WSP(float, WS_COS), WSP(float, WS_SIN), ATT_C2};
                      pg8::gemm_phase<pg8::EpiQKV, pg8::StaticOrder, PG8_ALIGN, PG8_SP2>(ldsl, g, S, E); }
#endif
#if PHM & 4
                    { ThinP P{XN, 1024, Wqkv, 1024, 1024, 24, QO, KB, VB, nullptr, qg, kg}; thin_phase<TK_QKV>(lds, P, tid, wave, lane, bid, G); }
#endif
                }
                GSYNC();
#if PHM & 16
                {
                    KArgP ap = KARGS(); unsigned char* ws = ap->ws; IDS();
                    bf16_t* QO = WSP(bf16_t, WS_R1); bf16_t* KB = WSP(bf16_t, WS_K); bf16_t* VB = WSP(bf16_t, WS_V);
                    float* PART_O = WSP(float, WS_AGG); float* PART_ML = WSP(float, WS_AGG + 2 * MiB);
                    for (int i = 0;; ++i) {
                        int bh, qb = 0, tb = 0, nt = 257, lm = 1; bool meta = false; float* po = nullptr; float* pml = nullptr;
                        if (G == 256) { if (i < 8) { bh = vcu >> 3; qb = (vcu & 7) + 8 * i; }
                                        else if (i == 8) { bh = vcu >> 3; meta = true; const int pc = vcu & 7; tb = 32 * pc; nt = 33; lm = (pc == 7) ? 1 : 2;
                                                           po = PART_O + (size_t)((bh * 8 + pc) * 16) * 64; pml = PART_ML + (size_t)((bh * 8 + pc) * 16) * 2; }
                                        else break; }
                        else { const int uid = i * G + bid; if (uid >= 2080) break; if (uid < 2048) { bh = uid >> 6; qb = uid & 63; } else { bh = uid - 2048; meta = true; } }
                        const int b = bh >> 4, h = bh & 15;
                        const long qrow0 = meta ? (long)(NREAL + b * 16) : (long)b * 16384 + (long)qb * 256;
                        attn_body::attn_unit<8>(b, h, qrow0, meta ? 16 : 256, tb, nt, lm, po, pml, (const attn_body::bf16*)QO, (const attn_body::bf16*)KB, (const attn_body::bf16*)VB, (attn_body::bf16*)QO, (char*)lds);
                        if (DEFER_CONV && layer == 0 && G == 256) {
                            const int d0 = ((i * 256 + bid) * 8 + wave) * 2;
                            if (d0 < N_DEFER) { bf16_t* Wb = WSP(bf16_t, WS_W); float* scr = (float*)(lds + wave * 16384);
                                const bool hasb = d0 + 1 < N_DEFER; const TrD da = tr_decode(ap, Wb, tr_defer_item(d0)), db = tr_decode(ap, Wb, tr_defer_item(hasb ? d0 + 1 : d0));
                                float ra[32], rb[32]; tr_load(ra, da, lane); tr_load(rb, db, lane);
                                tr_finish(ra, da, scr, lane);
                                if (hasb) tr_finish(rb, db, scr, lane); }
                            __syncthreads();
                        }
                    }
                }
#endif
                GSYNC();
                {
                    KArgP ap = KARGS(); unsigned char* ws = ap->ws; IDS();
                    if (G == 256) {
                        const float* PART_O = WSP(float, WS_AGG); const float* PART_ML = WSP(float, WS_AGG + 2 * MiB); bf16_t* QO = WSP(bf16_t, WS_R1);
                        for (int idx = gtid; idx < 32 * 16 * 64; idx += GT) { const int bh = idx >> 10, q = (idx >> 6) & 15, d = idx & 63;
                            float mp[8], M = -INFINITY;
#pragma unroll
                            for (int pc = 0; pc < 8; ++pc) { mp[pc] = PART_ML[(size_t)((bh * 8 + pc) * 16 + q) * 2]; M = fmaxf(M, mp[pc]); }
                            float num = 0.f, den = 0.f;
#pragma unroll
                            for (int pc = 0; pc < 8; ++pc) { const float w = __builtin_amdgcn_exp2f(mp[pc] - M); num += w * PART_O[(size_t)((bh * 8 + pc) * 16 + q) * 64 + d]; den += w * PART_ML[(size_t)((bh * 8 + pc) * 16 + q) * 2 + 1]; }
                            QO[(size_t)(NREAL + (bh >> 4) * 16 + q) * 1024 + (bh & 15) * 64 + d] = (bf16_t)f2bf(num / den); }
                    }
                }
                GSYNC();
                oAsel = 1; oK = 1024; oBoff = W_O + (size_t)jl * 1024 * 1024; coef = 1.f; gpost_i = layer * 6 + 3; gpre_i = layer * 6 + 4;
            } else {
                {
                    KArgP ap = KARGS(); unsigned char* ws = ap->ws; IDS();
                    const bf16_t* Wrin = WSP(bf16_t, WS_W) + W_RIN + (size_t)jl * 2048 * 1024; bf16_t* XN = WSP(bf16_t, WS_XN); bf16_t* GATE = WSP(bf16_t, WS_Y); bf16_t* XR = WSP(bf16_t, WS_R3);
#if PHM & 32
                    { pg8::Gemm g{XN, Wrin, 1024, 1024, 1024, 0}; pg8::StaticOrder S; S.init(NREAL, 2048, G, bid); pg8::EpiRecIn E{GATE, XR};
                      pg8::gemm_phase<pg8::EpiRecIn, pg8::StaticOrder, PG8_ALIGN, PG8_SP2>(ldsl, g, S, E); }
#endif
#if PHM & 4
                    { ThinP P{XN, 1024, Wrin, 1024, 1024, 32, GATE, XR, nullptr, nullptr, nullptr, nullptr}; thin_phase<TK_RECIN>(lds, P, tid, wave, lane, bid, G); }
#endif
                }
                GSYNC();
#if PHM & 64
                {
                    KArgP ap = KARGS(); unsigned char* ws = ap->ws; IDS();
                    const bf16_t* XR = WSP(bf16_t, WS_R3); bf16_t* XC = WSP(bf16_t, WS_HB);
                    const float* cw = ap->in[10] + (size_t)jl * 4 * 1024; const float* cbias = ap->in[11] + (size_t)jl * 1024;
                    const int ckc = (gtid & 127) * 8;
                    const f32x4 cb0 = *(const f32x4*)(cbias + ckc), cb1 = *(const f32x4*)(cbias + ckc + 4); f32x4 cw0[4], cw1[4];
#pragma unroll
                    for (int j = 0; j < 4; ++j) { cw0[j] = *(const f32x4*)(cw + j * 1024 + ckc); cw1[j] = *(const f32x4*)(cw + j * 1024 + ckc + 4); }
#pragma unroll 1
                    for (int it0 = gtid; it0 < NROWS * 128; it0 += 2 * GT) {
                        u32x4 xv[2][4]; float wm[2][4]; int Rq[2], ckq[2];
#pragma unroll
                        for (int q = 0; q < 2; ++q) { const int it = (it0 + q * GT < NROWS * 128) ? it0 + q * GT : it0; const int R = it >> 7, ck = (it & 127) * 8; int b, p;
                            if (R < NREAL) { b = R >> 14; p = 16 + (R & 16383); } else { b = (R - NREAL) >> 4; p = (R - NREAL) & 15; }
                            Rq[q] = R; ckq[q] = ck;
#pragma unroll
                            for (int j = 0; j < 4; ++j) { const int pp = p + j - 2; const bool ok = pp >= 0 && pp < 16400; const int sr = ok ? (pp < 16 ? NREAL + b * 16 + pp : b * 16384 + pp - 16) : R;
                                xv[q][j] = *(const u32x4*)(XR + (size_t)sr * 1024 + ck); wm[q][j] = ok ? 1.f : 0.f; } }
#pragma unroll
                        for (int q = 0; q < 2; ++q) { if (q == 1 && it0 + GT >= NROWS * 128) break; const int R = Rq[q], ck = ckq[q];
                            f32x4 a0 = cb0, a1 = cb1;
#pragma unroll
                            for (int j = 0; j < 4; ++j) { const u32x4 x = xv[q][j]; const f32x4 w0 = cw0[j] * wm[q][j], w1 = cw1[j] * wm[q][j];
                                a0[0] += __uint_as_float(x[0] << 16) * w0[0]; a0[1] += __uint_as_float(x[0] & 0xffff0000u) * w0[1]; a0[2] += __uint_as_float(x[1] << 16) * w0[2]; a0[3] += __uint_as_float(x[1] & 0xffff0000u) * w0[3];
                                a1[0] += __uint_as_float(x[2] << 16) * w1[0]; a1[1] += __uint_as_float(x[2] & 0xffff0000u) * w1[1]; a1[2] += __uint_as_float(x[3] << 16) * w1[2]; a1[3] += __uint_as_float(x[3] & 0xffff0000u) * w1[3]; }
                            u32x4 o; o.x = pk2(a0[0], a0[1]); o.y = pk2(a0[2], a0[3]); o.z = pk2(a1[0], a1[1]); o.w = pk2(a1[2], a1[3]);
                            *(u32x4*)(XC + ((size_t)(ck >> 8) * ROWS_ALLOC + R) * 256 + (ck & 255)) = o; }
                    }
                }
#endif
                GSYNC();
                {
                    KArgP ap = KARGS(); unsigned char* ws = ap->ws; IDS();
                    const bf16_t* Wrg = WSP(bf16_t, WS_W) + W_RG + (size_t)jl * 4096 * 256; bf16_t* XC = WSP(bf16_t, WS_HB); unsigned short* AB = WSP(unsigned short, WS_R1);
                    const float* gbias = ap->in[13] + (size_t)jl * 4 * 1024;
#if (PHM & 128) && (!defined(RECTEST) || RECTEST >= 2)
                    { pg8::Gemm g{XC, Wrg, 256, 256, 256, 1}; pg8::StaticOrder S; S.init(NREAL, 4096, G, bid); pg8::EpiGate E{AB, gbias};
                      pg8::gemm_phase<pg8::EpiGate, pg8::StaticOrder, PG8_ALIGN, PG8_SP2>(ldsl, g, S, E); }
#endif
#if (PHM & 4) && (!defined(RECTEST) || RECTEST >= 2)
                    { ThinP P{XC, 256, Wrg, 256, 256, 64, nullptr, nullptr, nullptr, AB, gbias, nullptr}; thin_phase<TK_GATE>(lds, P, tid, wave, lane, bid, G); }
#endif
                }
                GSYNC();
#if (PHM & 256) && (!defined(RECTEST) || RECTEST >= 2)
                {
                    KArgP ap = KARGS(); unsigned char* ws = ap->ws; IDS();
                    const unsigned short* AB = WSP(unsigned short, WS_R1); const bf16_t* XC = WSP(bf16_t, WS_HB); f32x2_tt* AGG = WSP(f32x2_tt, WS_AGG); const float* lam = ap->in[14] + (size_t)jl * 2 * 1024; const float* gbias = ap->in[13] + (size_t)jl * 4 * 1024;
                    for (int it = gw; it < 2 * 2 * NCHUNK * 4; it += NGW) {
                        const int cgp = it & 3, q = it >> 2; int j, db; if (it < 4096) { db = q >> 8; j = 1 + (q & 255); } else { db = q & 3; j = 0; }
                        const int d = db >> 1, b = db & 1, c = cgp * 256 + 4 * lane;
                        const u32x2_tt* ab = (const u32x2_tt*)(AB + ((size_t)d * NROWS + chunk_row0(b, j)) * 1024 + c); f32x4* op = (f32x4*)(AGG + ((size_t)db * NCHUNK + j) * 1024 + c);
                        const u32x2_tt* xp = (const u32x2_tt*)(XC + ((size_t)(c >> 8) * ROWS_ALLOC + chunk_row0(b, j)) * 256 + (c & 255));
                        const f32x4 l4 = *(const f32x4*)(lam + d * 1024 + c); const f32x4 sp4 = {sp_of(l4[0]), sp_of(l4[1]), sp_of(l4[2]), sp_of(l4[3])};
                        if (j == 0) scanA4_item<16>(ab, xp, d, sp4, op); else scanA4_item<64>(ab, xp, d, sp4, op);
                    }
                }
#endif
                GSYNC();
#if (PHM & 512) && (!defined(RECTEST) || RECTEST >= 2)
                {
                    KArgP ap = KARGS(); unsigned char* ws = ap->ws; IDS();
                    if (wave == 0 && bid < 64) {
                        const int idx = bid * 64 + lane, db = idx >> 10, d = db >> 1, c = idx & 1023;
                        const f32x2_tt* ag = WSP(f32x2_tt, WS_AGG) + (size_t)db * NCHUNK * 1024 + c; float* ci = WSP(float, WS_CIN) + (size_t)db * NCHUNK * 1024 + c; float carry = 0.f;
#pragma unroll 1
                        for (int j0 = 0; j0 < 256; j0 += 32) { f32x2_tt v[32];
#pragma unroll
                            for (int k = 0; k < 32; ++k) { const int js = j0 + k; const int jj = d ? NCHUNK - 1 - js : js; v[k] = ag[(size_t)jj * 1024]; }
#pragma unroll
                            for (int k = 0; k < 32; ++k) { const int js = j0 + k; const int jj = d ? NCHUNK - 1 - js : js; ci[(size_t)jj * 1024] = carry; carry = v[k].x * carry + v[k].y; }
                        }
                        ci[(size_t)(d ? 0 : NCHUNK - 1) * 1024] = carry;
                    }
                }
#endif
                GSYNC();
#if PHM & 1024
                {
                    KArgP ap = KARGS(); unsigned char* ws = ap->ws; IDS();
                    const unsigned short* AB = WSP(unsigned short, WS_R1); const bf16_t* XC = WSP(bf16_t, WS_HB); const float* CIN = WSP(float, WS_CIN); const float* lam = ap->in[14] + (size_t)jl * 2 * 1024; const float* gbias = ap->in[13] + (size_t)jl * 4 * 1024;
                    const bf16_t* GATE = WSP(bf16_t, WS_Y); bf16_t* YS = WSP(bf16_t, WS_R3);
                    for (int it = gw; it < 2 * NCHUNK * 8; it += NGW) {
                        const int ln = (int)__builtin_amdgcn_mbcnt_hi(~0u, __builtin_amdgcn_mbcnt_lo(~0u, 0u));
                        const int cgp = it & 7, q = it >> 3; int j, b; if (it < 4096) { b = q >> 8; j = 1 + (q & 255); } else { b = q & 1; j = 0; }
                        const int c = cgp * 128 + 2 * ln; const int r0 = chunk_row0(b, j);
                        const unsigned* abf = (const unsigned*)(AB + ((size_t)r0) * 1024 + c); const unsigned* abb = (const unsigned*)(AB + ((size_t)NROWS + r0) * 1024 + c);
                        const f32x2_tt cf = *(const f32x2_tt*)(CIN + ((size_t)(0 * 2 + b) * NCHUNK + j) * 1024 + c), cb2 = *(const f32x2_tt*)(CIN + ((size_t)(1 * 2 + b) * NCHUNK + j) * 1024 + c);
                        const f32x2_tt spf = {sp_of(lam[c]), sp_of(lam[c + 1])}, spb = {sp_of(lam[1024 + c]), sp_of(lam[1024 + c + 1])};
                        const unsigned* xp = (const unsigned*)(XC + ((size_t)(c >> 8) * ROWS_ALLOC + r0) * 256 + (c & 255));
                        if (j == 0) scanC2_item<16>(abf, abb, xp, (const unsigned*)(GATE + (size_t)r0 * 1024 + c), (unsigned*)(YS + (size_t)r0 * 1024 + c), cf, cb2, spf, spb);
                        else scanC2_item<64>(abf, abb, xp, (const unsigned*)(GATE + (size_t)r0 * 1024 + c), (unsigned*)(YS + (size_t)r0 * 1024 + c), cf, cb2, spf, spb);
                    }
                }
#endif
                GSYNC();
                oAsel = 2; oK = 1024; oBoff = W_RO + (size_t)jl * 1024 * 1024; coef = 1.f; gpost_i = layer * 6 + 3; gpre_i = layer * 6 + 4;
            }
            {
                KArgP ap = KARGS(); unsigned char* ws = ap->ws; IDS();
                const bf16_t* oA = oAsel == 2 ? WSP(bf16_t, WS_R3) : WSP(bf16_t, WS_R1); const bf16_t* oBt = WSP(bf16_t, WS_W) + oBoff; bf16_t* Yb = WSP(bf16_t, WS_Y);
#if PHM & 2048
#ifdef FUSE_NR
                {
                    const int nri = layer * 3 + stage;
                    pg8::PanelSS st1{WSP(float, WS_XB), (unsigned*)(ws + WS_CNT) + (size_t)(2 * nri) * 128 * 64}, st2{WSP(float, WS_XB + 512 * 1024), (unsigned*)(ws + WS_CNT) + (size_t)(2 * nri + 1) * 128 * 64};
                    pg8::EpiNR E{ap->out, WSP(bf16_t, WS_XN), WSP(float, WS_XB + 1 * MiB), ap->in[2] + (size_t)(layer * 6 + 2 * stage) * 1024, ap->in[2] + (size_t)gpost_i * 1024, gpre_i >= 0 ? ap->in[2] + (size_t)gpre_i * 1024 : nullptr, coef, st1, st2};
                    pg8::Gemm g{oA, oBt, oK, oK, oK, 0};
#pragma unroll 1
                    for (int round = 0; round < 2; ++round) { pg8::RoundOrder S; S.base.init(NREAL, 1024, G, bid); S.round = round;
                        pg8::gemm_phase<pg8::EpiNR, pg8::RoundOrder, false, PG8_SP2>(ldsl, g, S, E); }
                }
#else
                { pg8::Gemm g{oA, oBt, oK, oK, oK, 0}; pg8::StaticOrder S; S.init(NREAL, 1024, G, bid); pg8::EpiPlain E{Yb};
                  pg8::gemm_phase<pg8::EpiPlain, pg8::StaticOrder, PG8_ALIGN, PG8_SP2>(ldsl, g, S, E); }
#endif
#endif
#if PHM & 4
                { ThinP P{oA, oK, oBt, oK, oK, 16, Yb, nullptr, nullptr, nullptr, nullptr, nullptr}; thin_phase<TK_PLAIN>(lds, P, tid, wave, lane, bid, G); }
#endif
            }
            GSYNC();
#if PHM & 4096
            {
                KArgP ap = KARGS(); unsigned char* ws = ap->ws; IDS();
                float* out = ap->out; float* HS = WSP(float, WS_XB + 1 * MiB); const bf16_t* Yb = WSP(bf16_t, WS_Y); bf16_t* XN = WSP(bf16_t, WS_XN);
                const float* gpost = ap->in[2] + (size_t)gpost_i * 1024; const float* gpre = gpre_i >= 0 ? ap->in[2] + (size_t)gpre_i * 1024 : nullptr;
                const float* gprev = ap->in[2] + (size_t)(layer * 6 + 2 * stage) * 1024;
                f32x4 ig[4], gpo[4], gpr[4];
#pragma unroll
                for (int j = 0; j < 4; ++j) { const int gi = 2 * (lane + 64 * (j >> 1)) + (j & 1); const f32x4 gg = ((const f32x4*)gprev)[gi];
                    ig[j] = (f32x4){__builtin_amdgcn_rcpf(gg.x), __builtin_amdgcn_rcpf(gg.y), __builtin_amdgcn_rcpf(gg.z), __builtin_amdgcn_rcpf(gg.w)};
                    gpo[j] = ((const f32x4*)gpost)[gi]; gpr[j] = gpre ? ((const f32x4*)gpre)[gi] : (f32x4){0.f, 0.f, 0.f, 0.f}; }
                constexpr int NRR = 2;
#pragma unroll 1
#ifdef FUSE_NR
                for (int row = NREAL + gw; row < NROWS; row += NRR * NGW) {
#else
                for (int row = gw; row < NROWS; row += NRR * NGW) {
#endif
                    u32x4 yw[NRR][2], hw_[NRR][2]; float hsq[NRR];
#pragma unroll
                    for (int q = 0; q < NRR; ++q) { const int rq = (row + q * NGW < NROWS) ? row + q * NGW : row; hsq[q] = __hip_atomic_load(HS + rq, __ATOMIC_RELAXED, __HIP_MEMORY_SCOPE_AGENT);
#pragma unroll
                        for (int jp = 0; jp < 2; ++jp) { yw[q][jp] = ((const u32x4*)(Yb + (size_t)rq * 1024))[lane + 64 * jp]; hw_[q][jp] = ((const u32x4*)(XN + (size_t)rq * 1024))[lane + 64 * jp]; } }
#pragma unroll
                    for (int q = 0; q < NRR; ++q) {
                        const int rr = row + q * NGW; if (rr >= NROWS) break;
                        f32x4 y[4], v[4]; float s = 0.f; const float hs = hsq[q];
#pragma unroll
                        for (int j = 0; j < 4; ++j) { const unsigned lo = yw[q][j >> 1][2 * (j & 1)], hi = yw[q][j >> 1][2 * (j & 1) + 1], hlo = hw_[q][j >> 1][2 * (j & 1)], hhi = hw_[q][j >> 1][2 * (j & 1) + 1];
                            y[j] = (f32x4){__uint_as_float(lo << 16), __uint_as_float(lo & 0xffff0000u), __uint_as_float(hi << 16), __uint_as_float(hi & 0xffff0000u)};
                            v[j] = (f32x4){__uint_as_float(hlo << 16), __uint_as_float(hlo & 0xffff0000u), __uint_as_float(hhi << 16), __uint_as_float(hhi & 0xffff0000u)} * hs * ig[j];
                            s += (y[j].x * y[j].x + y[j].y * y[j].y) + (y[j].z * y[j].z + y[j].w * y[j].w); }
                        const float r = coef * __builtin_amdgcn_rsqf(wave_sum(s) * (1.f / 1024.f) + NORM_EPS);
                        float s2 = 0.f;
#pragma unroll
                        for (int j = 0; j < 4; ++j) { v[j] = v[j] + y[j] * r * gpo[j]; s2 += (v[j].x * v[j].x + v[j].y * v[j].y) + (v[j].z * v[j].z + v[j].w * v[j].w); }
                        if (gpre) {
                            const float rstd = __builtin_amdgcn_rsqf(wave_sum(s2) * (1.f / 1024.f) + NORM_EPS);
#pragma unroll
                            for (int jp = 0; jp < 2; ++jp) { const f32x4 a0 = v[2 * jp] * rstd * gpr[2 * jp], a1 = v[2 * jp + 1] * rstd * gpr[2 * jp + 1];
                                u32x4 o; o.x = pk2(a0.x, a0.y); o.y = pk2(a0.z, a0.w); o.z = pk2(a1.x, a1.y); o.w = pk2(a1.z, a1.w);
                                ((u32x4*)(XN + (size_t)rr * 1024))[lane + 64 * jp] = o; }
                            if (lane == 0) HS[rr] = __builtin_amdgcn_rcpf(rstd);
                        } else if (rr < NREAL) {
#pragma unroll
                            for (int j = 0; j < 4; ++j) ((f32x4*)(out + (size_t)rr * 1024))[2 * (lane + 64 * (j >> 1)) + (j & 1)] = v[j];
                        }
                    }
                }
            }
#endif
            GSYNC();
        }
    }
}

extern "C" void kernel_launch(void* const* d_in, const int* in_sizes, int n_in, void* d_out, int out_size, void* d_ws, size_t ws_size, hipStream_t stream) {
    static int grid_blocks = 0;
    if (grid_blocks == 0) {
        if (n_in != 16 || ws_size < WS_END) { fprintf(stderr, "kernel_launch: unexpected n_in %d / ws_size %zu\n", n_in, ws_size); grid_blocks = -1; return; }
        int dev = 0, cus = 0, per_cu = 0;
        (void)hipGetDevice(&dev); (void)hipDeviceGetAttribute(&cus, hipDeviceAttributeMultiprocessorCount, dev);
        if (hipFuncSetAttribute((const void*)fwd_megakernel, hipFuncAttributeMaxDynamicSharedMemorySize, LDS_BYTES) != hipSuccess) { fprintf(stderr, "kernel_launch: hipFuncSetAttribute failed\n"); grid_blocks = -1; return; }
        if (hipOccupancyMaxActiveBlocksPerMultiprocessor(&per_cu, (const void*)fwd_megakernel, 512, LDS_BYTES) != hipSuccess || per_cu < 1) { fprintf(stderr, "kernel_launch: occupancy query says %d\n", per_cu); per_cu = 1; }
        (void)hipGetLastError();
        grid_blocks = cus > 0 ? cus : 256;
    }
    if (grid_blocks < 0) return;
    if (hipMemsetAsync(d_ws, 0, 1048576, stream) != hipSuccess) { fprintf(stderr, "kernel_launch: hipMemsetAsync failed\n"); return; }
    Args a{};
    for (int i = 0; i < 16; ++i) a.in[i] = (const float*)d_in[i];
    a.out = (float*)d_out; a.ws = (unsigned char*)d_ws;
    void* kargs[] = {&a};
    hipError_t e = hipLaunchCooperativeKernel((const void*)fwd_megakernel, dim3(grid_blocks), dim3(512), kargs, LDS_BYTES, stream);
    if (e != hipSuccess) fprintf(stderr, "cooperative launch failed: %s (grid %d)\n", hipGetErrorString(e), grid_blocks);
}
```

```cpp
#include <hip/hip_runtime.h>
#include <hip/hip_cooperative_groups.h>
#include <cstdio>
#include <cstdint>
namespace cg = cooperative_groups;

constexpr int NREAL = 32768, NROWS = 32800, ROWS_ALLOC = 33280;
constexpr int DMODEL = 1024, DFF = 2816, LSEQ_ = 16384, NCHUNK = 257;
constexpr float NORM_EPS = 1e-6f;
constexpr float LOG2E = 1.4426950408889634f;

namespace pg8 {

#define PG8_LAS __attribute__((address_space(3)))
typedef unsigned short bf16_t;
typedef short bf16x8 __attribute__((ext_vector_type(8)));
typedef float f32x4 __attribute__((ext_vector_type(4)));
typedef unsigned u32x4 __attribute__((ext_vector_type(4)));
constexpr int BM = 256, BK = 64, HALF = 128, HTB = HALF * BK * 2  , STAGE_BYTES = 8 * HTB, NXCD = 8, WGM = 8;

__host__ __device__ __forceinline__ int lds_byte(int r, int c) { const int st = (r >> 4) * 2 + (c >> 5), rr = r & 15, cc = c & 31, ob = rr * 64 + cc * 2; return st * 1024 + (ob ^ (((ob >> 9) & 1) << 5)); }
__host__ __device__ __forceinline__ void stage_rc(int b, int& R, int& C) { const int st = b / 1024, sb = b % 1024, swz = sb ^ (((sb >> 9) & 1) << 5); R = (st >> 1) * 16 + swz / 64; C = (st & 1) * 32 + (swz % 64) / 2; }
__host__ __device__ __forceinline__ int perm32(int rho) { const int n = rho >> 4, i = rho & 15; return 8 * (i >> 2) + 4 * n + (i & 3); }

struct Unit { int pm, pn; };
struct Gemm { const bf16_t* A; const bf16_t* Bt; int lda, ldb, K, akmode; };

struct StaticOrder {
    int nM, nN, nwg, G, c;
    __host__ __device__ void init(int M, int N, int G_, int c_) { nM = M / BM; nN = N / BM; nwg = nM * nN; G = G_; c = c_; }
    __host__ __device__ bool next(int i, Unit& u) const {
        const long L = (long)i * G + c; if (L >= nwg) return false;
        int wgid = (int)L; { const int q = nwg / NXCD, r = nwg % NXCD, xcd = wgid % NXCD, off = wgid / NXCD; wgid = (xcd < r ? xcd * (q + 1) : r * (q + 1) + (xcd - r) * q) + off; }
        const int nig = WGM * nN, gid = wgid / nig, fm = gid * WGM, gsz = (nM - fm) < WGM ? (nM - fm) : WGM;
        u.pm = fm + ((wgid % nig) % gsz); u.pn = (wgid % nig) / gsz; return true;
    }
    __device__ __forceinline__ void a_ready(const Unit&) const {}
    __device__ __forceinline__ void done(const Unit&) const {}
};


typedef float f32x2_cv __attribute__((ext_vector_type(2))); typedef __bf16 bf16x2_cv __attribute__((ext_vector_type(2)));
__device__ __forceinline__ unsigned cvt_pk_bf16(float lo, float hi) { const f32x2_cv v = {lo, hi}; return __builtin_bit_cast(unsigned, __builtin_convertvector(v, bf16x2_cv)); }
__device__ __forceinline__ float sigm(float x) { return __builtin_amdgcn_rcpf(1.f + __builtin_amdgcn_exp2f(-1.4426950408889634f * x)); }
__device__ __forceinline__ float gelu_tanh(float x) { const float z = 0.7978845608028654f * (x + 0.044715f * x * x * x); return x * sigm(2.f * z); }
__device__ __forceinline__ float bf2f(unsigned short b) { return __uint_as_float((unsigned)b << 16); }
__device__ __forceinline__ u32x4 pack8(const f32x4 a, const f32x4 b) { u32x4 w; w.x = cvt_pk_bf16(a[0], a[1]); w.y = cvt_pk_bf16(a[2], a[3]); w.z = cvt_pk_bf16(b[0], b[1]); w.w = cvt_pk_bf16(b[2], b[3]); return w; }
#ifndef WT_STORES
#define WT_STORES 0
#endif
__device__ __forceinline__ void st16(void* p, const u32x4 v) {
#if WT_STORES
    asm volatile("global_store_dwordx4 %0, %1, off sc1\n\ts_nop 1" :: "v"(p), "v"(v) : "memory");
#else
    *(u32x4*)p = v;
#endif
}

struct EpiSwiGLU {
    static constexpr bool PERM = true, AFTER_DRAIN = false;
    bf16_t* O;
    __device__ __forceinline__ void operator()(const f32x4 (&acc)[2][2][4][2], const Unit& u, int wr, int wc, int fr_in, int fq) const {
        int fr = fr_in; asm volatile("" : "+v"(fr));
        const int row0 = u.pm * BM + wr * 64 + fr, col0 = u.pn * 128 + wc * 32 + 8 * fq;
#pragma unroll
        for (int ai = 0; ai < 2; ++ai)
#pragma unroll
            for (int m = 0; m < 4; ++m) {
                f32x4 v[2];
#pragma unroll
                for (int n = 0; n < 2; ++n)
#pragma unroll
                    for (int j = 0; j < 4; ++j) { const float gt = acc[ai][0][m][n][j]; v[n][j] = gt * sigm(gt) * acc[ai][1][m][n][j]; }
                st16((char*)O + ((unsigned)(row0 + ai * HALF + m * 16) * 2816u + (unsigned)col0) * 2u, pack8(v[0], v[1]));
            }
    }
};
struct EpiPlain {
    static constexpr bool PERM = true, AFTER_DRAIN = false;
    bf16_t* O;
    __device__ __forceinline__ void operator()(const f32x4 (&acc)[2][2][4][2], const Unit& u, int wr, int wc, int fr_in, int fq) const {
        int fr = fr_in; asm volatile("" : "+v"(fr));
        const int row0 = u.pm * BM + wr * 64 + fr, col0 = u.pn * BM + wc * 32 + 8 * fq;
#pragma unroll
        for (int ai = 0; ai < 2; ++ai)
#pragma unroll
            for (int m = 0; m < 4; ++m)
#pragma unroll
                for (int bj = 0; bj < 2; ++bj)
                    st16((char*)O + ((unsigned)(row0 + ai * HALF + m * 16) * 1024u + (unsigned)(col0 + bj * HALF)) * 2u, pack8(acc[ai][bj][m][0], acc[ai][bj][m][1]));
    }
};
struct EpiRecIn {
    static constexpr bool PERM = true, AFTER_DRAIN = false;
    bf16_t* G; bf16_t* X;
    __device__ __forceinline__ void operator()(const f32x4 (&acc)[2][2][4][2], const Unit& u, int wr, int wc, int fr_in, int fq) const {
        int fr = fr_in; asm volatile("" : "+v"(fr));
        const int row0 = u.pm * BM + wr * 64 + fr, col0 = (u.pn & 3) * BM + wc * 32 + 8 * fq; const bool isg = u.pn < 4; bf16_t* O = isg ? G : X;
#pragma unroll
        for (int ai = 0; ai < 2; ++ai)
#pragma unroll
            for (int m = 0; m < 4; ++m)
#pragma unroll
                for (int bj = 0; bj < 2; ++bj) {
                    f32x4 v0 = acc[ai][bj][m][0], v1 = acc[ai][bj][m][1];
                    if (isg) {
#pragma unroll
                        for (int j = 0; j < 4; ++j) { v0[j] = gelu_tanh(v0[j]); v1[j] = gelu_tanh(v1[j]); } }
                    st16((char*)O + ((unsigned)(row0 + ai * HALF + m * 16) * 1024u + (unsigned)(col0 + bj * HALF)) * 2u, pack8(v0, v1));
                }
    }
};
struct EpiQKV {
    static constexpr bool PERM = true, AFTER_DRAIN = false;
    bf16_t *Q, *K, *V; const float *qg, *kg, *cs, *sn; float c2;
    __device__ __forceinline__ void operator()(const f32x4 (&acc)[2][2][4][2], const Unit& u, int wr, int wc, int fr_in, int fq) const {
        int fr = fr_in; asm volatile("" : "+v"(fr));
        const int row0 = u.pm * BM + wr * 64 + fr, pn = u.pn;
        if (pn == 5) {
#pragma unroll
            for (int ai = 0; ai < 2; ++ai)
#pragma unroll
                for (int m = 0; m < 4; ++m)
#pragma unroll
                    for (int bj = 0; bj < 2; ++bj)
                        st16((char*)V + ((unsigned)(row0 + ai * HALF + m * 16) * 256u + (unsigned)(wc * 64 + bj * 32 + 8 * fq)) * 2u, pack8(acc[ai][bj][m][0], acc[ai][bj][m][1]));
            return;
        }
        const bool isq = pn < 4; const float* gp = isq ? qg : kg; const float sc = isq ? c2 : 1.f;
        bf16_t* O = isq ? Q : K; const int pitch = isq ? 1024 : 256; const int hc = (isq ? (4 * pn + wc) : wc) * 64 + 8 * fq;
        f32x4 gq[2][2];
#pragma unroll
        for (int n = 0; n < 2; ++n) { gq[0][n] = *(const f32x4*)(gp + 8 * fq + 4 * n); gq[1][n] = *(const f32x4*)(gp + 32 + 8 * fq + 4 * n); }
#pragma unroll
        for (int ai = 0; ai < 2; ++ai)
#pragma unroll
            for (int m = 0; m < 4; ++m) {
                const int row = row0 + ai * HALF + m * 16;
                float ss = 0.f;
#pragma unroll
                for (int bj = 0; bj < 2; ++bj)
#pragma unroll
                    for (int n = 0; n < 2; ++n) { const f32x4 x = acc[ai][bj][m][n]; ss += (x[0] * x[0] + x[1] * x[1]) + (x[2] * x[2] + x[3] * x[3]); }
                ss += __shfl_xor(ss, 16); ss += __shfl_xor(ss, 32);
                const float rms = __builtin_amdgcn_rsqf(ss * (1.f / 64.f) + 1e-6f);
                const int s = row & 16383;
                f32x4 o1[2], o2[2];
#pragma unroll
                for (int n = 0; n < 2; ++n) {
                    const unsigned to = ((unsigned)s * 32u + (unsigned)(8 * fq + 4 * n)) * 4u; const f32x4 c = *(const f32x4*)((const char*)cs + to), sn4 = *(const f32x4*)((const char*)sn + to);
                    const f32x4 g1 = gq[0][n], g2 = gq[1][n];
                    const f32x4 x1 = acc[ai][0][m][n] * rms * g1, x2 = acc[ai][1][m][n] * rms * g2;
                    o1[n] = (x1 * c - x2 * sn4) * sc; o2[n] = (x1 * sn4 + x2 * c) * sc;
                }
                bf16_t* p = (bf16_t*)((char*)O + ((unsigned)row * (unsigned)pitch + (unsigned)hc) * 2u);
                st16(p, pack8(o1[0], o1[1])); st16(p + 32, pack8(o2[0], o2[1]));                asm volatile("" ::: "memory");
            }
    }
};
__device__ __forceinline__ unsigned q8pair(float r, float ig) {
    const unsigned a = (unsigned)__builtin_rintf(r * 255.f), b = (unsigned)__builtin_rintf(ig * 255.f);
    return a | (b << 8);
}
struct EpiGate {
    static constexpr bool PERM = true, AFTER_DRAIN = false;
    unsigned short* AB; const float* gb;
    __device__ __forceinline__ void operator()(const f32x4 (&acc)[2][2][4][2], const Unit& u, int wr, int wc, int fr_in, int fq) const {
        int fr = fr_in; asm volatile("" : "+v"(fr));
        const int row0 = u.pm * BM + wr * 64 + fr, pn = u.pn, d = pn >> 3, ch0 = ((pn >> 1) & 3) * 256 + (pn & 1) * 128 + wc * 32 + 8 * fq;
        unsigned short* ab = AB + (size_t)d * NROWS * 1024;
        f32x4 rb[2], ib[2];
#pragma unroll
        for (int n = 0; n < 2; ++n) { rb[n] = *(const f32x4*)(gb + (d * 2 + 0) * 1024 + ch0 + 4 * n); ib[n] = *(const f32x4*)(gb + (d * 2 + 1) * 1024 + ch0 + 4 * n); }
#pragma unroll
        for (int ai = 0; ai < 2; ++ai)
#pragma unroll
            for (int m = 0; m < 4; ++m) {
                const int row = row0 + ai * HALF + m * 16;
                u32x4 w;
#pragma unroll
                for (int n = 0; n < 2; ++n)
#pragma unroll
                    for (int jj = 0; jj < 2; ++jj)
                        w[n * 2 + jj] = q8pair(sigm(acc[ai][0][m][n][2 * jj] + rb[n][2 * jj]), sigm(acc[ai][1][m][n][2 * jj] + ib[n][2 * jj]))
                                      | (q8pair(sigm(acc[ai][0][m][n][2 * jj + 1] + rb[n][2 * jj + 1]), sigm(acc[ai][1][m][n][2 * jj + 1] + ib[n][2 * jj + 1])) << 16);
                st16((char*)ab + ((unsigned)row * 1024u + (unsigned)ch0) * 2u, w);
            }
    }
};

struct PanelSS {
    float* xbuf;
    unsigned* cnt;
    __device__ __forceinline__ void run(const f32x4 (&v)[2][2][4][2], const Unit& u, int wr, int wc, int fr, int fq, PG8_LAS unsigned char* lds, int wid, int lane) const {
        PG8_LAS float* P = (PG8_LAS float*)lds;
        PG8_LAS float* S = (PG8_LAS float*)(lds + 8192);
#pragma unroll
        for (int ai = 0; ai < 2; ++ai)
#pragma unroll
            for (int m = 0; m < 4; ++m) {
                float s = 0.f;
#pragma unroll
                for (int bj = 0; bj < 2; ++bj)
#pragma unroll
                    for (int n = 0; n < 2; ++n) { const f32x4 x = v[ai][bj][m][n]; s += (x[0] * x[0] + x[1] * x[1]) + (x[2] * x[2] + x[3] * x[3]); }
                s += __shfl_xor(s, 16); s += __shfl_xor(s, 32);
                if (fq == 0) P[(ai * HALF + wr * 64 + m * 16 + fr) * 4 + wc] = s;
            }
        asm volatile("s_waitcnt lgkmcnt(0)" ::: "memory"); __builtin_amdgcn_s_barrier(); asm volatile("" ::: "memory");
        const int row = wid * 32 + (lane & 31);
        if (lane < 32) {
            const float t = (P[row * 4 + 0] + P[row * 4 + 1]) + (P[row * 4 + 2] + P[row * 4 + 3]);
            __hip_atomic_store(xbuf + ((size_t)(u.pm * BM + row) * 4 + u.pn), t, __ATOMIC_RELAXED, __HIP_MEMORY_SCOPE_AGENT);
        }
        asm volatile("s_waitcnt vmcnt(0)" ::: "memory");
        if (lane == 0) __hip_atomic_fetch_add(cnt + 64 * u.pm, 1u, __ATOMIC_RELAXED, __HIP_MEMORY_SCOPE_AGENT);
        if (wid == 0) {
            const unsigned long long t0 = __builtin_amdgcn_s_memrealtime();
            for (;;) {
                if ((unsigned)__builtin_amdgcn_readfirstlane(__hip_atomic_load(cnt + 64 * u.pm, __ATOMIC_RELAXED, __HIP_MEMORY_SCOPE_AGENT)) >= 32u) break;
                if (__builtin_amdgcn_s_memrealtime() - t0 > 2000000ull) break;
                __builtin_amdgcn_s_sleep(2);
            }
            __builtin_amdgcn_fence(__ATOMIC_ACQUIRE, "agent");
        }
        asm volatile("s_waitcnt vmcnt(0) lgkmcnt(0)" ::: "memory"); __builtin_amdgcn_s_barrier(); asm volatile("" ::: "memory");
        if (lane < 32) {
            const float* slot = xbuf + (size_t)(u.pm * BM + row) * 4; float t = 0.f;
#pragma unroll
            for (int k = 0; k < 4; ++k) t += __hip_atomic_load(slot + k, __ATOMIC_RELAXED, __HIP_MEMORY_SCOPE_AGENT);
            S[row] = __builtin_amdgcn_rsqf(t * (1.f / 1024.f) + 1e-6f);
        }
        asm volatile("s_waitcnt lgkmcnt(0)" ::: "memory"); __builtin_amdgcn_s_barrier(); asm volatile("" ::: "memory");
    }
};
struct EpiNR {
    static constexpr bool PERM = false, AFTER_DRAIN = true;
    float* out; bf16_t* xn; float* hs; const float* gprev; const float* gpost; const float* gpre; float coef; PanelSS st1, st2;
    __device__ __forceinline__ void fused(f32x4 (&acc)[2][2][4][2], const Unit& u, int wr, int wc, int fr_in, int fq, PG8_LAS unsigned char* lds, int wid, int lane) const {
        typedef unsigned u32x2v __attribute__((ext_vector_type(2)));
        int fr = fr_in; asm volatile("" : "+v"(fr));
        const PG8_LAS float* S = (const PG8_LAS float*)(lds + 8192);
        const int col0 = u.pn * BM + wc * 32 + 4 * fq;
        st1.run(acc, u, wr, wc, fr, fq, lds, wid, lane);
#pragma unroll
        for (int ai = 0; ai < 2; ++ai)
#pragma unroll
            for (int m = 0; m < 4; ++m) { const int r = ai * HALF + wr * 64 + m * 16 + fr; const float rs = S[r] * coef; const float hsr = hs[u.pm * BM + r]; const unsigned off = ((unsigned)(u.pm * BM + r) * 1024u + (unsigned)col0);
#pragma unroll
                for (int bj = 0; bj < 2; ++bj)
#pragma unroll
                    for (int n = 0; n < 2; ++n) { const u32x2v xw = *(const u32x2v*)((const char*)xn + (off + bj * HALF + n * 16) * 2u);
                        const f32x4 gp = *(const f32x4*)(gprev + col0 + bj * HALF + n * 16), g = *(const f32x4*)(gpost + col0 + bj * HALF + n * 16);
                        const f32x4 bs = (f32x4){__uint_as_float(xw.x << 16) * __builtin_amdgcn_rcpf(gp[0]), __uint_as_float(xw.x & 0xffff0000u) * __builtin_amdgcn_rcpf(gp[1]), __uint_as_float(xw.y << 16) * __builtin_amdgcn_rcpf(gp[2]), __uint_as_float(xw.y & 0xffff0000u) * __builtin_amdgcn_rcpf(gp[3])} * hsr;
                        acc[ai][bj][m][n] = bs + acc[ai][bj][m][n] * rs * g; }
                asm volatile("" : "+v"(acc[ai][0][m][0]), "+v"(acc[ai][0][m][1]), "+v"(acc[ai][1][m][0]), "+v"(acc[ai][1][m][1]));
                asm volatile("" ::: "memory"); }
        if (gpre) st2.run(acc, u, wr, wc, fr, fq, lds, wid, lane);
#pragma unroll
        for (int ai = 0; ai < 2; ++ai)
#pragma unroll
            for (int m = 0; m < 4; ++m) { const int r = ai * HALF + wr * 64 + m * 16 + fr; const float rs = gpre ? S[r] : 0.f; const unsigned off = ((unsigned)(u.pm * BM + r) * 1024u + (unsigned)col0);
#pragma unroll
                for (int bj = 0; bj < 2; ++bj)
#pragma unroll
                    for (int n = 0; n < 2; ++n) { const f32x4 x1 = acc[ai][bj][m][n];
                        if (gpre) { const f32x4 g = *(const f32x4*)(gpre + col0 + bj * HALF + n * 16); const f32x4 o = x1 * rs * g; u32x2v w; w.x = cvt_pk_bf16(o[0], o[1]); w.y = cvt_pk_bf16(o[2], o[3]);
                            *(u32x2v*)((char*)xn + (off + bj * HALF + n * 16) * 2u) = w; }
                        else *(f32x4*)((char*)out + (off + bj * HALF + n * 16) * 4u) = x1; }
                if (gpre && u.pn == 0 && wc == 0 && fq == 0) hs[u.pm * BM + r] = __builtin_amdgcn_rcpf(rs);
                asm volatile("" ::: "memory"); }
    }
};
struct RoundOrder {
    StaticOrder base; int round;
    __device__ bool next(int i, Unit& u) const { return i == 0 ? base.next(round, u) : false; }
    __device__ __forceinline__ void a_ready(const Unit&) const {}
    __device__ __forceinline__ void done(const Unit&) const {}
};
template <class Epi, class Sched, bool ALIGN_EPI = false, bool SP2 = false>
__device__ __forceinline__ void gemm_phase(PG8_LAS unsigned char* lds, const Gemm g, const Sched& S, const Epi& E) {
    int tid_ = threadIdx.x; asm volatile("" : "+v"(tid_)); const int tid = tid_, wid = __builtin_amdgcn_readfirstlane(tid >> 6), lane = tid & 63, wr = wid >> 2, wc = wid & 3, fr = lane & 15, fq = lane >> 4;
    const int K = g.K, nt = K / BK;
    unsigned voffA[2], voffB[2];
#pragma unroll
    for (int i = 0; i < 2; ++i) { int R, C; stage_rc(tid * 16 + i * 8192, R, C); const int Rb = Epi::PERM ? ((R & ~31) + perm32(R & 31)) : R;
        voffA[i] = (unsigned)(R * g.lda + C) * 2u; voffB[i] = (unsigned)(Rb * g.ldb + C) * 2u; }
    const size_t kstep = (size_t)(BK * 2);
    const size_t hstepA = (size_t)HALF * g.lda * 2, hstepB = (size_t)HALF * g.ldb * 2;
    const size_t tstepA = 2 * hstepA, tstepB = 2 * hstepB;
    const unsigned ldsw = (unsigned)wid * 1024u;
    const int aoff = lds_byte(wr * 64 + fr, fq * 8), boff = lds_byte(wc * 32 + fr, fq * 8);
#define AKOFF(pn) ((size_t)(g.akmode ? ((size_t)(((pn) >> 1) & 3) * ((size_t)33280 * 512)) : 0))
#define PG8_SA(b, h) (((b) * 2 + (h)) * HTB)
#define PG8_SB(b, h) ((4 + (b) * 2 + (h)) * HTB)
#define PG8_STAGE(bufoff, gbase, voff) do { _Pragma("unroll") for (int _i = 0; _i < 2; ++_i) \
        __builtin_amdgcn_global_load_lds((const unsigned*)((const char*)(gbase) + (voff)[_i]), (PG8_LAS unsigned*)(lds + (bufoff) + ldsw + _i * 8192), 16, 0, 0); } while (0)
#define PG8_LDA(dst, b, h) do { _Pragma("unroll") for (int m = 0; m < 4; ++m) _Pragma("unroll") for (int k = 0; k < 2; ++k) dst[m][k] = *(const PG8_LAS bf16x8*)(lds + PG8_SA(b, h) + aoff + m * 2048 + k * 1024); } while (0)
#define PG8_LDB(dst, b, h) do { _Pragma("unroll") for (int n = 0; n < 2; ++n) _Pragma("unroll") for (int k = 0; k < 2; ++k) dst[n][k] = *(const PG8_LAS bf16x8*)(lds + PG8_SB(b, h) + boff + n * 2048 + k * 1024); } while (0)
#define PG8_MMA(ai, bj, At, Bt) do { __builtin_amdgcn_s_setprio(1); _Pragma("unroll") for (int m = 0; m < 4; ++m) _Pragma("unroll") for (int n = 0; n < 2; ++n) _Pragma("unroll") for (int k = 0; k < 2; ++k) \
        acc[ai][bj][m][n] = __builtin_amdgcn_mfma_f32_16x16x32_bf16(Bt[n][k], At[m][k], acc[ai][bj][m][n], 0, 0, 0); __builtin_amdgcn_s_setprio(0); } while (0)
#define PG8_WAIT_V(n) asm volatile("s_waitcnt vmcnt(" #n ")" ::: "memory")
#define PG8_WAIT_L(n) asm volatile("s_waitcnt lgkmcnt(" #n ")" ::: "memory")
#define PG8_BAR __builtin_amdgcn_s_barrier()
#define PG8_SCHED __builtin_amdgcn_sched_barrier(0)
    Unit cur, nxt; int ui = 0;
    if (!S.next(0, cur)) return;
    f32x4 acc[2][2][4][2];
#pragma unroll
    for (int a = 0; a < 2; ++a)
#pragma unroll
        for (int b = 0; b < 2; ++b)
#pragma unroll
            for (int m = 0; m < 4; ++m)
#pragma unroll
                for (int n = 0; n < 2; ++n) acc[a][b][m][n] = (f32x4){0.f, 0.f, 0.f, 0.f};
    bf16x8 At[4][2], B0[2][2], B1[2][2];
    const char* cA = (const char*)g.A + (size_t)cur.pm * tstepA + AKOFF(cur.pn); const char* cB = (const char*)g.Bt + (size_t)cur.pn * tstepB;
    S.a_ready(cur);
    if constexpr (SP2) {
        PG8_STAGE(PG8_SB(0, 0), cB, voffB); PG8_STAGE(PG8_SB(0, 1), cB + hstepB, voffB); PG8_STAGE(PG8_SA(0, 0), cA, voffA); PG8_STAGE(PG8_SA(0, 1), cA + hstepA, voffA);
        if (wr == 1) PG8_BAR;
        PG8_WAIT_V(2); PG8_BAR;
        PG8_STAGE(PG8_SB(1, 0), cB + kstep, voffB); PG8_STAGE(PG8_SA(1, 0), cA + kstep, voffA); PG8_STAGE(PG8_SB(1, 1), cB + hstepB + kstep, voffB);
        PG8_WAIT_V(6); PG8_BAR;
    } else {
        PG8_STAGE(PG8_SB(0, 0), cB, voffB); PG8_STAGE(PG8_SA(0, 0), cA, voffA); PG8_STAGE(PG8_SB(0, 1), cB + hstepB, voffB); PG8_STAGE(PG8_SA(0, 1), cA + hstepA, voffA);
        if (wr == 1) PG8_BAR;
        PG8_WAIT_V(4); PG8_BAR;
        PG8_STAGE(PG8_SB(1, 0), cB + kstep, voffB); PG8_STAGE(PG8_SA(1, 0), cA + kstep, voffA); PG8_STAGE(PG8_SB(1, 1), cB + hstepB + kstep, voffB);
        PG8_WAIT_V(6); PG8_BAR;
    }
    for (;;) {
        const bool has_next = S.next(ui + 1, nxt);
        const char* nA = has_next ? (const char*)g.A + (size_t)nxt.pm * tstepA + AKOFF(nxt.pn) : cA; const char* nB = has_next ? (const char*)g.Bt + (size_t)nxt.pn * tstepB : cB;
        _Pragma("unroll 1") for (int t = 0; t < nt; t += 2) {
            const bool last = (t == nt - 2);
            const char* a1 = cA + (size_t)(t + 1) * kstep;
            const char* a2 = last ? nA : cA + (size_t)(t + 2) * kstep; const char* b2 = last ? nB : cB + (size_t)(t + 2) * kstep;
            const char* a3 = a2 + kstep; const char* b3 = b2 + kstep;
            if (last && has_next) S.a_ready(nxt);
            if constexpr (SP2) {
            PG8_LDB(B0, 0, 0); PG8_LDB(B1, 0, 1); PG8_SCHED; PG8_LDA(At, 0, 0); PG8_STAGE(PG8_SA(1, 1), a1 + hstepA, voffA);
            PG8_WAIT_V(8); PG8_WAIT_L(0); PG8_BAR; PG8_MMA(0, 0, At, B0); PG8_MMA(0, 1, At, B1); PG8_BAR; PG8_SCHED;
            PG8_LDA(At, 0, 1); PG8_STAGE(PG8_SB(0, 0), b2, voffB); PG8_STAGE(PG8_SB(0, 1), b2 + hstepB, voffB); PG8_STAGE(PG8_SA(0, 0), a2, voffA);
            PG8_WAIT_V(8); PG8_WAIT_L(0); PG8_BAR; PG8_MMA(1, 0, At, B0); PG8_MMA(1, 1, At, B1); PG8_BAR; PG8_SCHED;
            PG8_LDB(B0, 1, 0); PG8_LDB(B1, 1, 1); PG8_SCHED; PG8_LDA(At, 1, 0); PG8_STAGE(PG8_SA(0, 1), a2 + hstepA, voffA);
            PG8_WAIT_V(8); PG8_WAIT_L(0); PG8_BAR; PG8_MMA(0, 0, At, B0); PG8_MMA(0, 1, At, B1); PG8_BAR; PG8_SCHED;
            PG8_LDA(At, 1, 1); PG8_STAGE(PG8_SB(1, 0), b3, voffB); PG8_STAGE(PG8_SB(1, 1), b3 + hstepB, voffB); PG8_STAGE(PG8_SA(1, 0), a3, voffA);
            PG8_WAIT_V(8); PG8_WAIT_L(0); PG8_BAR; PG8_MMA(1, 0, At, B0); PG8_MMA(1, 1, At, B1); PG8_BAR; PG8_SCHED;
            } else {
            PG8_LDB(B0, 0, 0); PG8_SCHED; PG8_LDA(At, 0, 0); PG8_STAGE(PG8_SA(1, 1), a1 + hstepA, voffA);
            PG8_WAIT_L(8); PG8_BAR; PG8_WAIT_L(0); PG8_MMA(0, 0, At, B0); PG8_BAR; PG8_SCHED;
            PG8_LDB(B1, 0, 1); PG8_STAGE(PG8_SB(0, 0), b2, voffB);
            PG8_BAR; PG8_WAIT_L(0); PG8_MMA(0, 1, At, B1); PG8_BAR;
            PG8_LDA(At, 0, 1); PG8_STAGE(PG8_SA(0, 0), a2, voffA);
            PG8_BAR; PG8_WAIT_L(0); PG8_MMA(1, 0, At, B0); PG8_BAR; PG8_SCHED;
            PG8_STAGE(PG8_SB(0, 1), b2 + hstepB, voffB);
            PG8_WAIT_V(6); PG8_BAR; PG8_MMA(1, 1, At, B1); PG8_BAR;
            PG8_LDB(B0, 1, 0); PG8_SCHED; PG8_LDA(At, 1, 0); PG8_STAGE(PG8_SA(0, 1), a2 + hstepA, voffA);
            PG8_WAIT_L(8); PG8_BAR; PG8_WAIT_L(0); PG8_MMA(0, 0, At, B0); PG8_BAR; PG8_SCHED;
            PG8_LDB(B1, 1, 1); PG8_STAGE(PG8_SB(1, 0), b3, voffB);
            PG8_BAR; PG8_WAIT_L(0); PG8_MMA(0, 1, At, B1); PG8_BAR;
            PG8_LDA(At, 1, 1); PG8_STAGE(PG8_SA(1, 0), a3, voffA);
            PG8_BAR; PG8_WAIT_L(0); PG8_MMA(1, 0, At, B0); PG8_BAR; PG8_SCHED;
            PG8_STAGE(PG8_SB(1, 1), b3 + hstepB, voffB);
            PG8_WAIT_V(6); PG8_BAR; PG8_MMA(1, 1, At, B1); PG8_BAR;
            }
        }
        if constexpr (ALIGN_EPI) { if (wr == 0) PG8_BAR; }
        if constexpr (!Epi::AFTER_DRAIN) { E(acc, cur, wr, wc, fr, fq); S.done(cur); }
        if (!has_next) break;
#pragma unroll
        for (int a = 0; a < 2; ++a)
#pragma unroll
            for (int b = 0; b < 2; ++b)
#pragma unroll
                for (int m = 0; m < 4; ++m)
#pragma unroll
                    for (int n = 0; n < 2; ++n) acc[a][b][m][n] = (f32x4){0.f, 0.f, 0.f, 0.f};
        cur = nxt; cA = nA; cB = nB; ++ui;
        if constexpr (ALIGN_EPI) { if (wr == 1) PG8_BAR; }
    }
    PG8_WAIT_V(0);
    if constexpr (!ALIGN_EPI) { if (wr == 0) PG8_BAR; }
    PG8_BAR;
    if constexpr (Epi::AFTER_DRAIN) { E.fused(acc, cur, wr, wc, fr, fq, lds, wid, lane); S.done(cur); }
#undef AKOFF
#undef PG8_SA
#undef PG8_SB
#undef PG8_STAGE
#undef PG8_LDA
#undef PG8_LDB
#undef PG8_MMA
#undef PG8_WAIT_V
#undef PG8_WAIT_L
#undef PG8_BAR
#undef PG8_SCHED
}
}

#ifndef PG8_SP2
#define PG8_SP2 true
#endif
#ifndef PG8_ALIGN
#define PG8_ALIGN true
#endif

#include <hip/hip_bf16.h>
#include <cmath>
namespace attn_body {
using bf16=__hip_bfloat16;
using bf16x8=__attribute__((ext_vector_type(8)))short;
using s16x4=__attribute__((ext_vector_type(4)))short;
using f32x16=__attribute__((ext_vector_type(16)))float;
using u32x4=__attribute__((ext_vector_type(4)))unsigned;
constexpr int D=64,QP=1024,KP=256,LSEQ=16384,NREALR=32768;
constexpr int NW=8,QBLK=32,QB=QBLK*NW,KVBLK=64;

__device__ __forceinline__ int crow(int r,int hi){return (r&3)+8*(r>>2)+4*hi;}
#define SBAR() __builtin_amdgcn_sched_barrier(0)
__device__ __forceinline__ void cmask(f32x16&p0,f32x16&p1,int jb,int qrel,int hi){
  const float NEG=-INFINITY; int kb=64*jb+4*hi;
  #pragma unroll
  for(int r=0;r<16;++r){int kv=kb+(r&3)+8*(r>>2); if(kv>qrel)p0[r]=NEG; if(kv+32>qrel)p1[r]=NEG;}
}

constexpr int NSLOT=3, SLOTB=8192;
constexpr int LDS_K=0, LDS_V=NSLOT*SLOTB, LDS_WS=2*NSLOT*SLOTB, LDS_OST=LDS_WS+NW*64*4, LDS_BYTES=LDS_OST+NW*4096;
constexpr float C2=0.125f*1.4426950408889634f;
__device__ __forceinline__ void glds16(const void*gsrc,unsigned lds_dst){unsigned keep;
  asm volatile("s_mov_b32 %0, m0\n\ts_mov_b32 m0, %2\n\ts_nop 0\n\tglobal_load_lds_dwordx4 %1, off\n\ts_mov_b32 m0, %0":"=&s"(keep):"v"(gsrc),"s"(lds_dst):"memory");}
__device__ __forceinline__ float max3f(float a,float b,float c){float r;asm("v_max3_f32 %0, %1, %2, %3":"=v"(r):"v"(a),"v"(b),"v"(c));return r;}
__device__ __forceinline__ float max2f(float a,float b){float r;asm("v_max_f32_e32 %0, %1, %2":"=v"(r):"v"(a),"v"(b));return r;}
__device__ __forceinline__ float fadd_s(float a,float b){float r;asm("v_add_f32_e32 %0, %1, %2":"=v"(r):"v"(a),"v"(b));return r;}
__device__ __forceinline__ float fsub_s(float a,float b){float r;asm("v_sub_f32_e32 %0, %1, %2":"=v"(r):"v"(a),"v"(b));return r;}
typedef float f32x2_t __attribute__((ext_vector_type(2))); typedef __bf16 bf16x2_t __attribute__((ext_vector_type(2)));
__device__ __forceinline__ unsigned cvtpk_s(float lo,float hi){f32x2_t v={lo,hi};bf16x2_t b=__builtin_convertvector(v,bf16x2_t);return __builtin_bit_cast(unsigned,b);}
#define WAIT_BAR(N) asm volatile("s_waitcnt vmcnt(" #N ") lgkmcnt(0)\n\ts_barrier":::"memory")

__device__ __forceinline__ void qkt(f32x16&p0,f32x16&p1,const char*Kslot,const bf16x8*qr,const f32x16&negm,int r32,int hi){
  const char*kb=Kslot+hi*1024+r32*16;
  #pragma unroll
  for(int d0=0;d0<4;++d0){
    const bf16x8 b0=*reinterpret_cast<const bf16x8*>(kb+d0*2048);
    const bf16x8 b1=*reinterpret_cast<const bf16x8*>(kb+d0*2048+512);
    if(d0==0){p0=__builtin_amdgcn_mfma_f32_32x32x16_bf16(b0,qr[0],negm,0,0,0);p1=__builtin_amdgcn_mfma_f32_32x32x16_bf16(b1,qr[0],negm,0,0,0);}
    else{p0=__builtin_amdgcn_mfma_f32_32x32x16_bf16(b0,qr[d0],p0,0,0,0);p1=__builtin_amdgcn_mfma_f32_32x32x16_bf16(b1,qr[d0],p1,0,0,0);}}
}
typedef __attribute__((address_space(3))) const char* lds_cptr;
typedef short v4i16_t __attribute__((ext_vector_type(4)));
__device__ __forceinline__ void kload8(bf16x8*kf,lds_cptr kp){
  kf[0]=*(const __attribute__((address_space(3))) bf16x8*)(kp);      kf[1]=*(const __attribute__((address_space(3))) bf16x8*)(kp+512);
  kf[2]=*(const __attribute__((address_space(3))) bf16x8*)(kp+2048); kf[3]=*(const __attribute__((address_space(3))) bf16x8*)(kp+2560);
  kf[4]=*(const __attribute__((address_space(3))) bf16x8*)(kp+4096); kf[5]=*(const __attribute__((address_space(3))) bf16x8*)(kp+4608);
  kf[6]=*(const __attribute__((address_space(3))) bf16x8*)(kp+6144); kf[7]=*(const __attribute__((address_space(3))) bf16x8*)(kp+6656);
}
__device__ __forceinline__ void kload2(bf16x8*kf,lds_cptr kp,int j){ kf[2*j]=*(const __attribute__((address_space(3))) bf16x8*)(kp+j*2048); kf[2*j+1]=*(const __attribute__((address_space(3))) bf16x8*)(kp+j*2048+512); }
__device__ __forceinline__ s16x4 vtr(lds_cptr p){ return __builtin_bit_cast(s16x4,__builtin_amdgcn_ds_read_tr16_b64_v4i16((__attribute__((address_space(3))) v4i16_t*)p)); }
__device__ __forceinline__ float rowmax(const f32x16&p0,const f32x16&p1){
  float a=max3f(p0[0],p0[1],p1[0]),b=max3f(p0[2],p0[3],p1[1]);a=max3f(a,p1[2],p1[3]);
  #pragma unroll
  for(int r=4;r<16;r+=4){a=max3f(a,p0[r],p0[r+1]);b=max3f(b,p0[r+2],p0[r+3]);a=max3f(a,p1[r],p1[r+1]);b=max3f(b,p1[r+2],p1[r+3]);}
  const float m=max2f(a,b);
  auto rr=__builtin_amdgcn_permlane32_swap(__float_as_uint(m),__float_as_uint(m),false,false);
  return max2f(__uint_as_float(rr[0]),__uint_as_float(rr[1]));
}
__device__ __forceinline__ void pv(f32x16*o,int vb,bf16x8 pa0,bf16x8 pa1,bf16x8 pa2,bf16x8 pa3){
  #pragma unroll
  for(int d0=0;d0<2;++d0){s16x4 lo[4],hi[4];
    #pragma unroll
    for(int ks=0;ks<4;++ks){
      asm volatile("ds_read_b64_tr_b16 %0,%1 offset:%c2":"=&v"(lo[ks]):"v"(vb),"i"(d0*4096+ks*1024):"memory");
      asm volatile("ds_read_b64_tr_b16 %0,%1 offset:%c2":"=&v"(hi[ks]):"v"(vb),"i"(d0*4096+ks*1024+512):"memory");}
    asm volatile("s_waitcnt lgkmcnt(0)":::"memory");SBAR();
    #define PK(k) (bf16x8){lo[k][0],lo[k][1],lo[k][2],lo[k][3],hi[k][0],hi[k][1],hi[k][2],hi[k][3]}
    o[d0]=__builtin_amdgcn_mfma_f32_32x32x16_bf16(pa0,PK(0),o[d0],0,0,0);
    o[d0]=__builtin_amdgcn_mfma_f32_32x32x16_bf16(pa1,PK(1),o[d0],0,0,0);
    o[d0]=__builtin_amdgcn_mfma_f32_32x32x16_bf16(pa2,PK(2),o[d0],0,0,0);
    o[d0]=__builtin_amdgcn_mfma_f32_32x32x16_bf16(pa3,PK(3),o[d0],0,0,0);
    #undef PK
  }
}

#ifndef ATTN_STORE16
#define ATTN_STORE16(p,v) (*(u32x4*)(p)=(v))
#endif
template<int THRL> __device__ __forceinline__ void attn_unit(int b,int h,long qrow0,int nvalid,int t_base,int NT,int lastmode,float*part_o,float*part_ml,const bf16*Q,const bf16*__restrict__ K,const bf16*__restrict__ V,bf16*O,char*shm){
  int tid_=threadIdx.x; asm volatile("":"+v"(tid_)); const int tid=tid_,lane=tid&63,r32=lane&31,hi=lane>>5; const int wid=__builtin_amdgcn_readfirstlane(tid>>6);
  const long rowbase=(long)b*LSEQ; const long metaoff=((long)(NREALR+b*16)-rowbase)*KP;
  const bf16*Qw=Q+(qrow0+wid*QBLK)*QP+h*D;
  const bf16*Kh=K+rowbase*KP+(h>>2)*D,*Vh=V+rowbase*KP+(h>>2)*D;
  const unsigned lds0=(unsigned)(uintptr_t)shm;
  float*wsf=(float*)(shm+LDS_WS)+wid*64;
  const bf16*ksrc=Kh+(long)lane*KP+wid*8;
  const bf16*vsrc=Vh+(long)(16*(wid&3)+(lane>>2))*KP+(wid>>2)*32+(lane&3)*8;
  const unsigned kdst=lds0+LDS_K+wid*1024, vdst=lds0+LDS_V+wid*1024;
  #define TOFF(tt) ((((tt)+t_base)<256)?(long)((tt)+t_base)*KVBLK*KP:metaoff)
  #define DMA_K(t,slot) glds16(ksrc+TOFF(t),(unsigned)__builtin_amdgcn_readfirstlane(kdst+(slot)))
  #define DMA_V(t,slot) glds16(vsrc+TOFF(t),(unsigned)__builtin_amdgcn_readfirstlane(vdst+(slot)))
  const int vb0=(int)(lds0+LDS_V)+((lane>>4)&1)*32+(lane&3)*8+(4*hi+((lane&15)>>2))*64;
  const char*Kbase=shm+LDS_K; bf16x8 kf[8];
  const lds_cptr shm3=(lds_cptr)shm; const lds_cptr kp0=shm3+LDS_K+hi*1024+r32*16; const lds_cptr vp0=shm3+LDS_V+((lane>>4)&1)*32+(lane&3)*8+(4*hi+((lane&15)>>2))*64;
  DMA_K(0,0);DMA_V(0,0);DMA_K(1,SLOTB);
  bf16x8 qr[4];
  #pragma unroll
  for(int d0=0;d0<4;++d0)qr[d0]=*reinterpret_cast<const bf16x8*>(&Qw[(long)r32*QP+d0*16+hi*8]);
  float mhat=0.f,l_reg=0.f;f32x16 o[2];o[0]=f32x16{};o[1]=f32x16{};f32x16 negm=f32x16{};asm volatile("":"+v"(negm));
    #define CMASK(P0,P1,t) do{}while(0)
  bool resc=false;
  #define START(P0,P1) do{ const float rm=rowmax(P0,P1); resc=false; \
    { const float dl=rm; mhat=fadd_s(mhat,dl); \
      _Pragma("unroll") for(int r=0;r<16;++r){P0[r]=fsub_s(P0[r],dl);P1[r]=fsub_s(P1[r],dl);} \
      _Pragma("unroll") for(int r=0;r<16;++r)negm[r]=-mhat; asm volatile("":"+v"(negm)); } \
    _Pragma("unroll") for(int r=0;r<16;++r)P0[r]=__builtin_amdgcn_exp2f(P0[r]); }while(0)
  #define RESC() do{ if(resc){ asm volatile("s_waitcnt lgkmcnt(0)":::"memory"); \
      _Pragma("unroll") for(int d_=0;d_<2;++d_) _Pragma("unroll") for(int r=0;r<16;++r)o[d_][r]*=wsf[crow(r,hi)]; } }while(0)
  f32x16 pA0,pA1,pB0,pB1;
  int sl_prev=0,sl_cur=0,sl_next=SLOTB;
  #define ROT() do{sl_prev=sl_cur;sl_cur=sl_next;sl_next=(sl_next==(NSLOT-1)*SLOTB)?0:sl_next+SLOTB;}while(0)
  DMA_K(2,2*SLOTB);
  WAIT_BAR(3);
  qkt(pA0,pA1,Kbase,qr,negm,r32,hi);asm volatile("s_nop 15\n\ts_nop 7":"+v"(pA0),"+v"(pA1));CMASK(pA0,pA1,0);
  START(pA0,pA1);
  _Pragma("unroll") for(int r=0;r<16;++r)pA1[r]=__builtin_amdgcn_exp2f(pA1[r]);
  WAIT_BAR(0);
  DMA_K(3,0);DMA_V(1,SLOTB);
  ROT();
  kload8(kf,kp0+sl_cur);
  WAIT_BAR(2);
  s16x4 vlo[8],vhi[8]; u32x4 pw0,pw1,pw2,pw3;
  #define PKW(P,B) cvtpk_s(P[B],P[B+1])
  #define PAF(k) __builtin_bit_cast(bf16x8,pw##k)
  #define VFR(i) (bf16x8){vlo[i][0],vlo[i][1],vlo[i][2],vlo[i][3],vhi[i][0],vhi[i][1],vhi[i][2],vhi[i][3]}
  #define PIN(x) asm volatile("":"+v"(x))
  #define MX3(a,b,c) __builtin_fmaxf(__builtin_fmaxf((a),(b)),(c))
  #define GAPA(MF,A0,A1,A2,A3,W0,W1,PW) do{ MF; sacc+=A0; sacc+=A1; sacc+=A2; sacc+=A3; PIN(sacc); W0; W1; PIN(PW); SBAR(); }while(0)
  #define EX(v) __builtin_amdgcn_exp2f(v)
  #define GAPB(MF,X,B) do{ MF; X[B]=EX(X[B]); X[B+1]=EX(X[B+1]); X[B+2]=EX(X[B+2]); X[B+3]=EX(X[B+3]); PIN(X); SBAR(); }while(0)
  #define VRD(i) do{ vlo[i]=vtr(vp_+(((i)>>2)*4096+((i)&3)*1024)); vhi[i]=vtr(vp_+(((i)>>2)*4096+((i)&3)*1024+512)); }while(0)
  #define KRD(G,j) do{ if(G){ kload2(kf,kp0+sl_next,j); SBAR(); } }while(0)
  #define STEP(C0,C1,P0,P1,t,GK,GV,GL) do{ SBAR(); \
    const lds_cptr vp_=vp0+sl_prev; \
    VRD(0); SBAR(); float sacc=(P0[0]+P0[1]); \
    GAPA(C0=__builtin_amdgcn_mfma_f32_32x32x16_bf16(kf[0],qr[0],negm,0,0,0), P0[2],P0[3],P0[4],P0[5],     pw0[0]=PKW(P0,0), pw0[1]=PKW(P0,2), pw0); \
    VRD(4); SBAR(); GAPA(C1=__builtin_amdgcn_mfma_f32_32x32x16_bf16(kf[1],qr[0],negm,0,0,0), P0[6],P0[7],P0[8],P0[9],     pw0[2]=PKW(P0,4), pw0[3]=PKW(P0,6), pw0); \
    VRD(1); SBAR(); GAPA(C0=__builtin_amdgcn_mfma_f32_32x32x16_bf16(kf[2],qr[1],C0,0,0,0),   P0[10],P0[11],P0[12],P0[13], pw1[0]=PKW(P0,8), pw1[1]=PKW(P0,10), pw1); \
    VRD(5); SBAR(); GAPA(C1=__builtin_amdgcn_mfma_f32_32x32x16_bf16(kf[3],qr[1],C1,0,0,0),   P0[14],P0[15],P1[0],P1[1],   pw1[2]=PKW(P0,12),pw1[3]=PKW(P0,14), pw1); \
    VRD(2); SBAR(); GAPA(C0=__builtin_amdgcn_mfma_f32_32x32x16_bf16(kf[4],qr[2],C0,0,0,0),   P1[2],P1[3],P1[4],P1[5],     pw2[0]=PKW(P1,0), pw2[1]=PKW(P1,2), pw2); \
    VRD(6); SBAR(); GAPA(C1=__builtin_amdgcn_mfma_f32_32x32x16_bf16(kf[5],qr[2],C1,0,0,0),   P1[6],P1[7],P1[8],P1[9],     pw2[2]=PKW(P1,4), pw2[3]=PKW(P1,6), pw2); \
    VRD(3); SBAR(); GAPA(C0=__builtin_amdgcn_mfma_f32_32x32x16_bf16(kf[6],qr[3],C0,0,0,0),   P1[10],P1[11],P1[12],P1[13], pw3[0]=PKW(P1,8), pw3[1]=PKW(P1,10), pw3); \
    VRD(7); SBAR(); GAPA(C1=__builtin_amdgcn_mfma_f32_32x32x16_bf16(kf[7],qr[3],C1,0,0,0),   P1[14],P1[15],0.f,0.f,       pw3[2]=PKW(P1,12),pw3[3]=PKW(P1,14), pw3); \
    l_reg+=sacc; \
    if(GK){DMA_K((t)+3,sl_cur);} if(GV){DMA_V((t)+1,sl_next);} \
    CMASK(C0,C1,t); \
    { float a=MX3(C0[0],C0[1],C1[0]),b=MX3(C0[2],C0[3],C1[1]); a=MX3(a,C1[2],C1[3]); \
      _Pragma("unroll") for(int r=4;r<16;r+=4){a=MX3(a,C0[r],C0[r+1]);b=MX3(b,C0[r+2],C0[r+3]);a=MX3(a,C1[r],C1[r+1]);b=MX3(b,C1[r+2],C1[r+3]);} \
      float rm=__builtin_fmaxf(a,b); { auto rr=__builtin_amdgcn_permlane32_swap(__float_as_uint(rm),__float_as_uint(rm),false,false); rm=__builtin_fmaxf(__uint_as_float(rr[0]),__uint_as_float(rr[1])); } \
      resc=false; \
      if(__builtin_expect(__any(rm>(float)THRL),0)){ const float dl=__builtin_fmaxf(rm,0.f); mhat+=dl; \
        _Pragma("unroll") for(int r=0;r<16;++r){C0[r]-=dl;C1[r]-=dl;} \
        _Pragma("unroll") for(int r=0;r<16;++r)negm[r]=-mhat; asm volatile("":"+v"(negm)); \
        const float f=__builtin_amdgcn_exp2f(-dl); l_reg*=f; if(hi==0)wsf[r32]=f; resc=true; } } \
    SBAR(); \
    GAPB(o[0]=__builtin_amdgcn_mfma_f32_32x32x16_bf16(PAF(0),VFR(0),o[0],0,0,0), C0,0); \
    GAPB(o[1]=__builtin_amdgcn_mfma_f32_32x32x16_bf16(PAF(0),VFR(4),o[1],0,0,0), C0,4); \
    KRD(GL,0); GAPB(o[0]=__builtin_amdgcn_mfma_f32_32x32x16_bf16(PAF(1),VFR(1),o[0],0,0,0), C0,8); \
    KRD(GL,1); GAPB(o[1]=__builtin_amdgcn_mfma_f32_32x32x16_bf16(PAF(1),VFR(5),o[1],0,0,0), C0,12); \
    KRD(GL,2); GAPB(o[0]=__builtin_amdgcn_mfma_f32_32x32x16_bf16(PAF(2),VFR(2),o[0],0,0,0), C1,0); \
    KRD(GL,3); GAPB(o[1]=__builtin_amdgcn_mfma_f32_32x32x16_bf16(PAF(2),VFR(6),o[1],0,0,0), C1,4); \
    GAPB(o[0]=__builtin_amdgcn_mfma_f32_32x32x16_bf16(PAF(3),VFR(3),o[0],0,0,0), C1,8); \
    GAPB(o[1]=__builtin_amdgcn_mfma_f32_32x32x16_bf16(PAF(3),VFR(7),o[1],0,0,0), C1,12); \
    }while(0)
  int t=1;
  #undef CMASK
  #define CMASK(P0,P1,t) do{}while(0)
  for(;t+5<NT;t+=2){
    STEP(pB0,pB1,pA0,pA1,t,true,true,true);     WAIT_BAR(2); RESC(); ROT();
    STEP(pA0,pA1,pB0,pB1,t+1,true,true,true);   WAIT_BAR(2); RESC(); ROT();
  }
  #undef CMASK
  #define CMASK(P0,P1,t) do{ if((t)==NT-1){ if(lastmode==2){ _Pragma("unroll") for(int r_=0;r_<8;++r_)P0[r_]=-INFINITY; } _Pragma("unroll") for(int r_=8;r_<16;++r_)P0[r_]=-INFINITY; _Pragma("unroll") for(int r_=0;r_<16;++r_)P1[r_]=-INFINITY; } }while(0)
  #define ENDW(tt) do{ if((tt)+3<NT){WAIT_BAR(2);} else if((tt)+2<NT){WAIT_BAR(1);} else {WAIT_BAR(0);} }while(0)
  for(;t+1<NT;t+=2){
    STEP(pB0,pB1,pA0,pA1,t,(t+3<NT),(t+1<NT),(t+1<NT));       ENDW(t);   RESC(); ROT();
    STEP(pA0,pA1,pB0,pB1,t+1,(t+4<NT),(t+2<NT),(t+2<NT));     ENDW(t+1); RESC(); ROT();
  }
  { float sacc=pA0[0]+pA0[1]; _Pragma("unroll") for(int r=2;r<16;++r)sacc+=pA0[r]; _Pragma("unroll") for(int r=0;r<16;++r)sacc+=pA1[r]; l_reg+=sacc;
    pw0=(u32x4){PKW(pA0,0),PKW(pA0,2),PKW(pA0,4),PKW(pA0,6)};pw1=(u32x4){PKW(pA0,8),PKW(pA0,10),PKW(pA0,12),PKW(pA0,14)};pw2=(u32x4){PKW(pA1,0),PKW(pA1,2),PKW(pA1,4),PKW(pA1,6)};pw3=(u32x4){PKW(pA1,8),PKW(pA1,10),PKW(pA1,12),PKW(pA1,14)};
    SBAR(); pv(o,vb0+sl_prev,PAF(0),PAF(1),PAF(2),PAF(3)); }
  #undef PKW
  #undef PAF
  #undef VFR
  #undef PIN
  #undef MX3
  #undef GAPA
  #undef GAPB
  #undef EX
  #undef VRD
  #undef KRD
  #undef STEP
  #undef ENDW
  {auto rr=__builtin_amdgcn_permlane32_swap(__float_as_uint(l_reg),__float_as_uint(l_reg),false,false);l_reg=__uint_as_float(rr[0])+__uint_as_float(rr[1]);}
  if(hi==0)wsf[32+r32]=l_reg;asm volatile("s_waitcnt lgkmcnt(0)":::"memory");
  if(part_o){ if(wid==0){
    _Pragma("unroll") for(int r=0;r<8;++r){ _Pragma("unroll") for(int d0=0;d0<2;++d0)part_o[crow(r,hi)*64+d0*32+r32]=o[d0][r]; }
    if(hi==0&&r32<16){part_ml[2*r32]=mhat;part_ml[2*r32+1]=l_reg;} } } else {
  float rli[16];
  #pragma unroll
  for(int r=0;r<16;++r)rli[r]=__builtin_amdgcn_rcpf(wsf[32+crow(r,hi)]);
  bf16*Ow=O+(qrow0+wid*QBLK)*QP+h*D; const int nv=nvalid-wid*QBLK;
  { bf16*stg=(bf16*)(shm+LDS_OST)+wid*2048;
    #pragma unroll
    for(int r=0;r<16;++r){const int orow=crow(r,hi);
      #pragma unroll
      for(int d0=0;d0<2;++d0)stg[orow*64+d0*32+r32]=__float2bfloat16(o[d0][r]*rli[r]);}
    asm volatile("s_waitcnt lgkmcnt(0)":::"memory");
    #pragma unroll
    for(int i=0;i<4;++i){const int row=i*8+(lane>>3),ch=lane&7; const u32x4 v=*(const u32x4*)(stg+row*64+ch*8); if(row<nv)ATTN_STORE16(Ow+(long)row*QP+ch*8,v);} } }
  asm volatile("s_waitcnt lgkmcnt(0)\n\ts_barrier":::"memory");
  #undef TOFF
  #undef DMA_K
  #undef DMA_V
  #undef CMASK
  #undef START
  #undef RESC
  #undef ROT
}
constexpr int ATTN_LDS_BYTES=LDS_BYTES;
#undef SBAR
#undef WAIT_BAR
}


#ifndef PG8_SP2
#define PG8_SP2 true
#endif
#ifndef PG8_ALIGN
#define PG8_ALIGN true
#endif
#define LAS __attribute__((address_space(3)))
#ifndef PHM
#define PHM 0xffff
#endif
using pg8::bf16_t; using pg8::f32x4; using pg8::u32x4; using pg8::bf16x8;
typedef float f32x16_t __attribute__((ext_vector_type(16)));
typedef float f32x2_tt __attribute__((ext_vector_type(2)));
constexpr size_t MiB = 1u << 20;
constexpr size_t WS_COS = 1 * MiB, WS_SIN = 3 * MiB, WS_W = 5 * MiB, WS_XN = 163 * MiB, WS_Y = 229 * MiB, WS_R3 = 295 * MiB, WS_R1 = 361 * MiB,
                 WS_K = WS_R1 + 66 * MiB, WS_V = WS_R1 + 83 * MiB, WS_AGG = 619 * MiB, WS_CIN = 628 * MiB, WS_XB = 635 * MiB, WS_HB = 637 * MiB, WS_END = 702 * MiB;
constexpr size_t WS_CNT = 65536;
constexpr size_t W_IN = 0, W_OUT = W_IN + (size_t)8 * 5632 * 1024, W_QKV = W_OUT + (size_t)8 * 1024 * 2816, W_O = W_QKV + (size_t)2 * 1536 * 1024,
                 W_RIN = W_O + (size_t)2 * 1024 * 1024, W_RG = W_RIN + (size_t)2 * 2048 * 1024, W_RO = W_RG + (size_t)2 * 4096 * 256, W_END = W_RO + (size_t)2 * 1024 * 1024;
static_assert(W_END * 2 <= 158 * MiB, "weights");
constexpr int LDS_BYTES = 147456;
constexpr float ATT_C2 = 0.125f * 1.4426950408889634f;

__device__ __forceinline__ float wave_sum(float v) {
#pragma unroll
    for (int o = 1; o < 64; o <<= 1) v += __shfl_xor(v, o);
    return v;
}
__device__ __forceinline__ unsigned f2bf(float f) { unsigned u = __builtin_bit_cast(unsigned, f); return (u + 0x7fffu + ((u >> 16) & 1u)) >> 16; }
__device__ __forceinline__ unsigned pk2(float lo, float hi) { return f2bf(lo) | (f2bf(hi) << 16); }
__device__ __forceinline__ float bf2f(unsigned b) { return __uint_as_float(b << 16); }

struct TrD { const float* W; bf16_t* WT; int K, N, k0, n0, dr0; };
__device__ __forceinline__ void tr_load(float (&r)[32], const TrD& d, int lane) {
#pragma unroll
    for (int i = 0; i < 32; ++i) { const int kk = 2 * i + (lane >> 5); r[i] = d.W[(size_t)(d.k0 + kk) * d.N + d.n0 + (lane & 31)]; }
}
__device__ __forceinline__ void tr_finish(const float (&r)[32], const TrD& d, float* scr, int lane) {
#pragma unroll
    for (int i = 0; i < 32; ++i) { const int kk = 2 * i + (lane >> 5); scr[kk * 33 + (lane & 31)] = r[i]; }
    __builtin_amdgcn_s_waitcnt(0); asm volatile("" ::: "memory");
    const int c = lane & 7;
#pragma unroll
    for (int j = 0; j < 4; ++j) { const int n = (lane >> 3) + 8 * j; const float* s = scr + (8 * c) * 33 + n;
        u32x4 o; o.x = pk2(s[0 * 33], s[1 * 33]); o.y = pk2(s[2 * 33], s[3 * 33]); o.z = pk2(s[4 * 33], s[5 * 33]); o.w = pk2(s[6 * 33], s[7 * 33]);
        *(u32x4*)(d.WT + (size_t)(d.dr0 + n) * d.K + d.k0 + 8 * c) = o; }
    asm volatile("s_waitcnt lgkmcnt(0)" ::: "memory");
}

#define XB_TMO      128
#define XB_XCNT(j)  (256  + 64 * (j))
#define XB_XSUB(j)  (1280 + 64 * (j))
#define XB_XGEN(j)  (2304 + 64 * (j))
#define XB_TOP      3328
#define XB_TOPGEN   3392
#define XCD_BAR_WORDS 3456
#define XB_SPIN_CAP (1u << 18)

__device__ __forceinline__ unsigned xb_ld(unsigned* p)              { return __hip_atomic_load(p, __ATOMIC_RELAXED, __HIP_MEMORY_SCOPE_AGENT); }
__device__ __forceinline__ unsigned xb_add(unsigned* p, unsigned v) { return __hip_atomic_fetch_add(p, v, __ATOMIC_RELAXED, __HIP_MEMORY_SCOPE_AGENT); }
__device__ __forceinline__ unsigned xb_xcc_id() { return (unsigned)__builtin_amdgcn_s_getreg((3 << 11) | 20) & 0xFu; }
#define XB_SPIN(cond, bar) do { unsigned _sp = 0; while (cond) { __builtin_amdgcn_s_sleep(1); \
    if ((++_sp & 255u) == 0u) { if (xb_ld(&(bar)[XB_TMO])) break; if (_sp > XB_SPIN_CAP) { atomicAdd(&(bar)[XB_TMO], 1u); break; } } } } while (0)

struct XcdBarrier {
    unsigned* bar; unsigned x;
    volatile LAS unsigned* st;
};

__device__ __forceinline__ XcdBarrier xcd_barrier_post(unsigned* bar, volatile LAS unsigned* st) {
    XcdBarrier b; b.bar = bar; b.x = xb_xcc_id(); b.st = st;
    if (threadIdx.x == 0) (void)xb_add(&bar[XB_XCNT(b.x)], 1u);
    return b;
}
__device__ __forceinline__ void xcd_barrier_complete(unsigned* bar, unsigned x, unsigned& nloc, unsigned& nx) {
    const unsigned G = gridDim.x * gridDim.y * gridDim.z;
    unsigned sum, cnt, mine, sp = 0u;
    for (;;) {
        sum = 0u; cnt = 0u; mine = 0u;
#pragma unroll
        for (unsigned j = 0; j < 16; ++j) { const unsigned c = xb_ld(&bar[XB_XCNT(j)]); sum += c; cnt += (c > 0u) ? 1u : 0u; mine = (j == x) ? c : mine; }
        if (sum == G) break;
        __builtin_amdgcn_s_sleep(1);
        if ((++sp & 255u) == 0u) { if (xb_ld(&bar[XB_TMO])) break; if (sp > XB_SPIN_CAP) { atomicAdd(&bar[XB_TMO], 1u); break; } }
    }
    nloc = mine > 0u ? mine : 1u; nx = cnt > 0u ? cnt : 1u;
}

__device__ __forceinline__ void xcd_barrier(const XcdBarrier& b) {
    asm volatile("s_waitcnt vmcnt(0)" ::: "memory");
    __syncthreads();
    if (threadIdx.x == 0) {
        unsigned* bar = b.bar;
        __builtin_amdgcn_s_waitcnt(0);
        unsigned nloc = b.st[0], nx = b.st[1];
        if (nloc == 0u) { xcd_barrier_complete(bar, b.x, nloc, nx); b.st[0] = nloc; b.st[1] = nx; }
        const unsigned old = xb_add(&bar[XB_XSUB(b.x)], 1u);
        const unsigned gen = old / nloc;
        if (old + 1u == (gen + 1u) * nloc) {
            __builtin_amdgcn_fence(__ATOMIC_RELEASE, "agent");
            asm volatile("s_waitcnt vmcnt(0)" ::: "memory");
            const unsigned og = xb_add(&bar[XB_TOP], 1u);
            const unsigned tg = og / nx;
            if (og + 1u == (tg + 1u) * nx) xb_add(&bar[XB_TOPGEN], 1u);
            else XB_SPIN(xb_ld(&bar[XB_TOPGEN]) == tg, bar);
            __builtin_amdgcn_fence(__ATOMIC_ACQUIRE, "agent");
            xb_add(&bar[XB_XGEN(b.x)], 1u);
            asm volatile("s_waitcnt vmcnt(0)" ::: "memory");
        } else {
            XB_SPIN(xb_ld(&bar[XB_XGEN(b.x)]) == gen, bar);
            __builtin_amdgcn_fence(__ATOMIC_ACQUIRE, "agent");
            asm volatile("s_waitcnt vmcnt(0)" ::: "memory");
        }
    }
    __syncthreads();
}

struct Args { const float* in[16]; float* out; unsigned char* ws; };

__device__ __forceinline__ float* hrow_ptr(float* out, float* hmeta, int row) { return row < NREAL ? out + (size_t)row * 1024 : hmeta + (size_t)(row - NREAL) * 1024; }

__device__ __forceinline__ float norm_row_store(const f32x4 (&v)[4], const float* g, bf16_t* orow, int lane) {
    float s = 0.f;
#pragma unroll
    for (int j = 0; j < 4; ++j) s += (v[j].x * v[j].x + v[j].y * v[j].y) + (v[j].z * v[j].z + v[j].w * v[j].w);
    const float r = __builtin_amdgcn_rsqf(wave_sum(s) * (1.f / 1024.f) + NORM_EPS);
    unsigned long long* o8 = (unsigned long long*)orow + lane;
#pragma unroll
    for (int j = 0; j < 4; ++j) { const f32x4 gg = ((const f32x4*)g)[lane + 64 * j];
        o8[64 * j] = (unsigned long long)pk2(v[j].x * r * gg.x, v[j].y * r * gg.y) | ((unsigned long long)pk2(v[j].z * r * gg.z, v[j].w * r * gg.w) << 32); }
    return r;
}

__device__ __forceinline__ float norm_row_store_g(const f32x4 (&v)[4], const f32x4 (&gg)[4], bf16_t* orow, int lane) {
    float s = 0.f;
#pragma unroll
    for (int j = 0; j < 4; ++j) s += (v[j].x * v[j].x + v[j].y * v[j].y) + (v[j].z * v[j].z + v[j].w * v[j].w);
    const float r = __builtin_amdgcn_rsqf(wave_sum(s) * (1.f / 1024.f) + NORM_EPS);
    unsigned long long* o8 = (unsigned long long*)orow + lane;
#pragma unroll
    for (int j = 0; j < 4; ++j) o8[64 * j] = (unsigned long long)pk2(v[j].x * r * gg[j].x, v[j].y * r * gg[j].y) | ((unsigned long long)pk2(v[j].z * r * gg[j].z, v[j].w * r * gg[j].w) << 32);
    return r;
}

__device__ __forceinline__ int crow_(int r, int hi) { return (r & 3) + 8 * (r >> 2) + 4 * hi; }
__device__ __forceinline__ void thin_tile(float* T, float* part, const bf16_t* A, int lda, const bf16_t* B0, const bf16_t* B1, int ldb, int K, int wave, int lane, int tid) {
    const int r32 = lane & 31, hi = lane >> 5, kc = K >> 3, kbeg = wave * kc;
    const bf16_t* ap = A + (size_t)r32 * lda + kbeg + hi * 8;
    const bf16_t* b0p = B0 + (size_t)r32 * ldb + kbeg + hi * 8;
    const bf16_t* b1p = B1 + (size_t)r32 * ldb + kbeg + hi * 8;
    f32x16_t c0 = {}, c1 = {};
#pragma unroll 1
    for (int k = 0; k < kc; k += 128) {
        bf16x8 a[8], b0[8], b1[8];
#pragma unroll
        for (int i = 0; i < 8; ++i) if (k + 16 * i < kc) { a[i] = *(const bf16x8*)(ap + k + 16 * i); b0[i] = *(const bf16x8*)(b0p + k + 16 * i); b1[i] = *(const bf16x8*)(b1p + k + 16 * i); }
#pragma unroll
        for (int i = 0; i < 8; ++i) if (k + 16 * i < kc) {
            c0 = __builtin_amdgcn_mfma_f32_32x32x16_bf16(a[i], b0[i], c0, 0, 0, 0);
            c1 = __builtin_amdgcn_mfma_f32_32x32x16_bf16(a[i], b1[i], c1, 0, 0, 0); }
    }
#pragma unroll
    for (int r = 0; r < 16; ++r) { const int tok = crow_(r, hi); part[wave * 2048 + tok * 64 + r32] = c0[r]; part[wave * 2048 + tok * 64 + 32 + r32] = c1[r]; }
    __syncthreads();
    for (int i = tid; i < 2048; i += 512) { float s = 0.f;
#pragma unroll
        for (int w = 0; w < 8; ++w) s += part[w * 2048 + i];
        T[i] = s; }
    __syncthreads();
}
__device__ __forceinline__ void thin_tile_h(float* T, float* part, const bf16_t* A, int lda, const bf16_t* Bt, int brow, int ldb, int K, int wave, int lane, int tid) {
    const int r32 = lane & 31, hi = lane >> 5, kc = K >> 3, kbeg = wave * kc;
    const bf16_t* ap = A + (size_t)r32 * lda + kbeg + hi * 8;
    const bf16_t* b0p = Bt + (size_t)brow * ldb + kbeg + hi * 8;
    f32x16_t c0 = {};
#pragma unroll 1
    for (int k = 0; k < kc; k += 128) {
        bf16x8 a[8], b0[8];
#pragma unroll
        for (int i = 0; i < 8; ++i) if (k + 16 * i < kc) { a[i] = *(const bf16x8*)(ap + k + 16 * i); b0[i] = *(const bf16x8*)(b0p + k + 16 * i); }
#pragma unroll
        for (int i = 0; i < 8; ++i) if (k + 16 * i < kc) c0 = __builtin_amdgcn_mfma_f32_32x32x16_bf16(a[i], b0[i], c0, 0, 0, 0);
    }
#pragma unroll
    for (int r = 0; r < 16; ++r) part[wave * 1024 + crow_(r, hi) * 32 + r32] = c0[r];
    __syncthreads();
    for (int i = tid; i < 1024; i += 512) { float s = 0.f;
#pragma unroll
        for (int w = 0; w < 8; ++w) s += part[w * 1024 + i];
        T[(i >> 5) * 64 + (i & 31)] = s; }
    __syncthreads();
}
enum ThinKind { TK_SWIGLU = 0, TK_PLAIN = 1, TK_RECIN = 2, TK_QKV = 3, TK_GATE = 4 };
struct ThinP { const bf16_t* A; int lda; const bf16_t* Bt; int ldb; int K; int nunits;
               bf16_t* O0; bf16_t* O1; bf16_t* O2; unsigned short* AB; const float* p0; const float* p1; };
template <int KIND> __device__ __forceinline__ void thin_phase(unsigned char* lds, const ThinP& P, int tid, int wave, int lane, int bid, int G) {
    float* part = (float*)lds; float* T = (float*)(lds + 65536);
    for (int u = bid; u < P.nunits; u += G) {
        int r0, r1, ak = 0;
        if (KIND == TK_SWIGLU) {
            const int c0 = 16 * u, rg = (c0 >> 7) * 256 + (c0 & 127), r32 = lane & 31;
            thin_tile_h(T, part, P.A + (size_t)NREAL * P.lda, P.lda, P.Bt, rg + (r32 & 15) + (r32 >> 4) * 128, P.ldb, P.K, wave, lane, tid);
            { const int idx = tid; const int r = idx >> 4, c = idx & 15; const float gt = T[r * 64 + c], up = T[r * 64 + 16 + c];
              P.O0[(size_t)(NREAL + r) * 2816 + c0 + c] = (bf16_t)f2bf(gt * pg8::sigm(gt) * up); }
            __syncthreads(); continue;
        } else if (KIND == TK_PLAIN) {
            thin_tile_h(T, part, P.A + (size_t)NREAL * P.lda, P.lda, P.Bt, 32 * u + (lane & 31), P.ldb, P.K, wave, lane, tid);
            for (int idx = tid; idx < 1024; idx += 512) { const int r = idx >> 5, c = idx & 31; P.O0[(size_t)(NREAL + r) * 1024 + 32 * u + c] = (bf16_t)f2bf(T[r * 64 + c]); }
            __syncthreads(); continue;
        }
        else if (KIND == TK_RECIN) { r0 = 64 * u; r1 = r0 + 32; }
        else if (KIND == TK_QKV) { r0 = (u >> 2) * 256 + 32 * (u & 3); r1 = r0 + 128; }
        else { const int d = u >> 5, h = (u >> 3) & 3, g32 = u & 7; r0 = (d * 8 + h * 2 + (g32 >> 2)) * 256 + (g32 & 3) * 32; r1 = r0 + 128; ak = h * (ROWS_ALLOC * 256); }
        thin_tile(T, part, P.A + (size_t)NREAL * P.lda + ak, P.lda, P.Bt + (size_t)r0 * P.ldb, P.Bt + (size_t)r1 * P.ldb, P.ldb, P.K, wave, lane, tid);
        if (KIND == TK_SWIGLU) {
        } else if (KIND == TK_PLAIN) {
        } else if (KIND == TK_RECIN) {
            for (int idx = tid; idx < 2048; idx += 512) { const int r = idx >> 6, c = idx & 63; const float v = T[idx];
                if (u < 16) P.O0[(size_t)(NREAL + r) * 1024 + 64 * u + c] = (bf16_t)f2bf(pg8::gelu_tanh(v));
                else P.O1[(size_t)(NREAL + r) * 1024 + 64 * (u - 16) + c] = (bf16_t)f2bf(v); }
        } else if (KIND == TK_QKV) {
            for (int idx = tid; idx < 2048; idx += 512) { const int r = idx >> 6, dd = idx & 63; const float v = T[idx];
                if (u < 20) { const float rms = __builtin_amdgcn_rsqf(wave_sum(v * v) * (1.f / 64.f) + NORM_EPS);
                    if (u < 16) P.O0[(size_t)(NREAL + r) * 1024 + 64 * u + dd] = (bf16_t)f2bf(v * rms * P.p0[dd] * ATT_C2);
                    else P.O1[(size_t)(NREAL + r) * 256 + 64 * (u - 16) + dd] = (bf16_t)f2bf(v * rms * P.p1[dd]); }
                else P.O2[(size_t)(NREAL + r) * 256 + 64 * (u - 20) + dd] = (bf16_t)f2bf(v); }
        } else {
            const int d = u >> 5, h = (u >> 3) & 3, g32 = u & 7, cb = h * 256 + g32 * 32;
            for (int idx = tid; idx < 1024; idx += 512) { const int r = idx >> 5, c = idx & 31, ch = cb + c;
                P.AB[((size_t)d * NROWS + NREAL + r) * 1024 + ch] = (unsigned short)pg8::q8pair(pg8::sigm(T[r * 64 + c] + P.p0[(d * 2 + 0) * 1024 + ch]), pg8::sigm(T[r * 64 + 32 + c] + P.p0[(d * 2 + 1) * 1024 + ch])); }
        }
        __syncthreads();
    }
}

__device__ __forceinline__ int chunk_row0(int b, int j) { return j == 0 ? NREAL + b * 16 : b * 16384 + (j - 1) * 64; }
__device__ __forceinline__ void ab_from(unsigned w, float xc, float sp, float& a, float& b) {
    const float r = (float)(w & 0xffu) * (1.f / 255.f), ig = (float)((w >> 8) & 0xffu) * (1.f / 255.f);
    a = __builtin_amdgcn_exp2f(sp * r); b = __builtin_amdgcn_sqrtf(__builtin_fmaf(-a, a, 1.f)) * (ig * xc);
}
__device__ __forceinline__ float sp_of(float lam) { const float e = __builtin_amdgcn_exp2f(-LOG2E * lam); return -8.f * LOG2E * (0.6931471805599453f * __builtin_amdgcn_logf(1.f + e)); }
template <int LEN> __device__ __forceinline__ void scanA_item(const unsigned short* ab, const bf16_t* xc, int dir, float sp, float rb, float ib, f32x2_tt* outp) {
    constexpr int BT = LEN < 32 ? LEN : 32;
    float h = 0.f, P = 1.f;
#pragma unroll 1
    for (int t0 = 0; t0 < LEN; t0 += BT) {
        unsigned w[BT]; unsigned short x[BT];
#pragma unroll
        for (int t = 0; t < BT; ++t) { const int tt = dir ? LEN - 1 - (t0 + t) : t0 + t; w[t] = ab[(size_t)tt * 1024]; x[t] = xc[(size_t)tt * 256]; }
#pragma unroll
        for (int t = 0; t < BT; ++t) { float a, b; ab_from(w[t], bf2f(x[t]), sp, a, b); h = a * h + b; P *= a; }
    }
    *outp = (f32x2_tt){P, h};
}
template <int LEN> __device__ __forceinline__ void scanC_item(const unsigned short* abf, const unsigned short* abb, const bf16_t* xc, const bf16_t* gate, bf16_t* y, float cf, float cb, float spf, float spb, float rbf, float ibf, float rbb, float ibb) {
    constexpr int BT = LEN < 16 ? LEN : 16;
    float hf[LEN]; float h = cf;
#pragma unroll
    for (int t0 = 0; t0 < LEN; t0 += BT) {
        unsigned w[BT]; unsigned short x[BT];
#pragma unroll
        for (int t = 0; t < BT; ++t) { w[t] = abf[(size_t)(t0 + t) * 1024]; x[t] = xc[(size_t)(t0 + t) * 256]; }
#pragma unroll
        for (int t = 0; t < BT; ++t) { float a, b; ab_from(w[t], bf2f(x[t]), spf, a, b); h = a * h + b; hf[t0 + t] = h; }
        asm volatile("" ::: "memory");
    }
    h = cb;
#pragma unroll
    for (int t0 = LEN - BT; t0 >= 0; t0 -= BT) {
        unsigned w[BT]; unsigned short x[BT], g[BT];
#pragma unroll
        for (int t = 0; t < BT; ++t) { w[t] = abb[(size_t)(t0 + t) * 1024]; x[t] = xc[(size_t)(t0 + t) * 256]; g[t] = gate[(size_t)(t0 + t) * 1024]; }
#pragma unroll
        for (int t = BT - 1; t >= 0; --t) { float a, b; ab_from(w[t], bf2f(x[t]), spb, a, b); h = a * h + b;
            y[(size_t)(t0 + t) * 1024] = (bf16_t)f2bf((hf[t0 + t] + h) * bf2f(g[t])); }
        asm volatile("" ::: "memory");
    }
}


template <int LEN> __device__ __forceinline__ void scanA2_item(const unsigned* ab, const unsigned* xc, int dir, float sp0, float sp1, f32x4* outp) {
    constexpr int BT = LEN < 32 ? LEN : 32;
    float h0 = 0.f, P0 = 1.f, h1 = 0.f, P1 = 1.f;
#pragma unroll 1
    for (int t0 = 0; t0 < LEN; t0 += BT) {
        unsigned w[BT], x[BT];
#pragma unroll
        for (int t = 0; t < BT; ++t) { const int tt = dir ? LEN - 1 - (t0 + t) : t0 + t; w[t] = ab[(size_t)tt * 512]; x[t] = xc[(size_t)tt * 128]; }
#pragma unroll
        for (int t = 0; t < BT; ++t) { float a, b; ab_from(w[t] & 0xffffu, __uint_as_float(x[t] << 16), sp0, a, b); h0 = a * h0 + b; P0 *= a;
                                       ab_from(w[t] >> 16, __uint_as_float(x[t] & 0xffff0000u), sp1, a, b); h1 = a * h1 + b; P1 *= a; }
    }
    *outp = (f32x4){P0, h0, P1, h1};
}
typedef unsigned u32x2_tt __attribute__((ext_vector_type(2)));
template <int LEN> __device__ __forceinline__ void scanA4_item(const u32x2_tt* ab, const u32x2_tt* xc, int dir, f32x4 sp, f32x4* outp) {
    constexpr int BT = LEN < 32 ? LEN : 32;
    f32x4 h = {0.f, 0.f, 0.f, 0.f}, P = {1.f, 1.f, 1.f, 1.f};
#pragma unroll 1
    for (int t0 = 0; t0 < LEN; t0 += BT) {
        u32x2_tt w[BT], x[BT];
#pragma unroll
        for (int t = 0; t < BT; ++t) { const int tt = dir ? LEN - 1 - (t0 + t) : t0 + t; w[t] = ab[(size_t)tt * 256]; x[t] = xc[(size_t)tt * 64]; }
#pragma unroll
        for (int t = 0; t < BT; ++t) { float a, b;
            ab_from(w[t].x & 0xffffu, __uint_as_float(x[t].x << 16), sp[0], a, b); h[0] = a * h[0] + b; P[0] *= a;
            ab_from(w[t].x >> 16, __uint_as_float(x[t].x & 0xffff0000u), sp[1], a, b); h[1] = a * h[1] + b; P[1] *= a;
            ab_from(w[t].y & 0xffffu, __uint_as_float(x[t].y << 16), sp[2], a, b); h[2] = a * h[2] + b; P[2] *= a;
            ab_from(w[t].y >> 16, __uint_as_float(x[t].y & 0xffff0000u), sp[3], a, b); h[3] = a * h[3] + b; P[3] *= a; }
    }
    outp[0] = (f32x4){P[0], h[0], P[1], h[1]}; outp[1] = (f32x4){P[2], h[2], P[3], h[3]};
}
template <int LEN> __device__ __forceinline__ void scanC2_item(const unsigned* abf, const unsigned* abb, const unsigned* xc, const unsigned* gate, unsigned* y, f32x2_tt cf, f32x2_tt cb, f32x2_tt spf, f32x2_tt spb) {
    constexpr int BT = LEN < 16 ? LEN : 16;
    float hf0[LEN], hf1[LEN]; float h0 = cf.x, h1 = cf.y;
#pragma unroll
    for (int t0 = 0; t0 < LEN; t0 += BT) {
        unsigned w[BT], x[BT];
#pragma unroll
        for (int t = 0; t < BT; ++t) { w[t] = abf[(size_t)(t0 + t) * 512]; x[t] = xc[(size_t)(t0 + t) * 128]; }
#pragma unroll
        for (int t = 0; t < BT; ++t) { float a, b; ab_from(w[t] & 0xffffu, __uint_as_float(x[t] << 16), spf.x, a, b); h0 = a * h0 + b; hf0[t0 + t] = h0;
                                       ab_from(w[t] >> 16, __uint_as_float(x[t] & 0xffff0000u), spf.y, a, b); h1 = a * h1 + b; hf1[t0 + t] = h1; }
        asm volatile("" ::: "memory");
    }
    h0 = cb.x; h1 = cb.y;
#pragma unroll
    for (int t0 = LEN - BT; t0 >= 0; t0 -= BT) {
        unsigned w[BT], x[BT], g[BT];
#pragma unroll
        for (int t = 0; t < BT; ++t) { w[t] = abb[(size_t)(t0 + t) * 512]; x[t] = xc[(size_t)(t0 + t) * 128]; g[t] = gate[(size_t)(t0 + t) * 512]; }
#pragma unroll
        for (int t = BT - 1; t >= 0; --t) { float a, b; ab_from(w[t] & 0xffffu, __uint_as_float(x[t] << 16), spb.x, a, b); h0 = a * h0 + b;
            ab_from(w[t] >> 16, __uint_as_float(x[t] & 0xffff0000u), spb.y, a, b); h1 = a * h1 + b;
            y[(size_t)(t0 + t) * 512] = pk2((hf0[t0 + t] + h0) * __uint_as_float(g[t] << 16), (hf1[t0 + t] + h1) * __uint_as_float(g[t] & 0xffff0000u)); }
        asm volatile("" ::: "memory");
    }
}

typedef const __attribute__((address_space(4))) Args* KArgP;
#define KARGS() ({ KArgP p_ = (KArgP)__builtin_amdgcn_kernarg_segment_ptr(); asm volatile("" : "+s"(p_)); p_; })
#define GSYNC() do { KArgP apb_ = KARGS(); XcdBarrier b_; b_.bar = (unsigned*)(apb_->ws + 16384); b_.x = xb_xcc_id(); b_.st = (volatile LAS unsigned*)(ldsl + 131072 + 32); xcd_barrier(b_); } while (0)
#define WSP(T, off) ((T*)(ws + (off)))
#ifndef DEFER_CONV
#define DEFER_CONV 0
#endif
#define IDS() int tid_ = threadIdx.x; asm volatile("" : "+v"(tid_)); const int tid = tid_, lane = tid & 63, wave = __builtin_amdgcn_readfirstlane(tid >> 6); const int G = gridDim.x, bid = blockIdx.x; \
              const int vcu = (G % 8 == 0) ? (bid % 8) * (G / 8) + bid / 8 : bid; const int gw = vcu * 8 + wave, NGW = G * 8; const int gtid = bid * 512 + tid, GT = G * 512; \
              (void)lane; (void)vcu; (void)gw; (void)NGW; (void)gtid; (void)GT;

constexpr int IA = 8 * 2816, IB = 8 * 1408, IC = 2 * 768, ID = 2 * 512, IE = 2 * 1024, IF = 32 * 32, IG = 2 * 512, NIT = IA + IB + IC + ID + IE + IF + IG;
constexpr int N_EARLY = 2 * 2816 + 2 * 1408 + 768 + 512, N_DEFER = NIT - N_EARLY;
__device__ __forceinline__ int tr_early_item(int e) { return e < 5632 ? e : e < 8448 ? IA + (e - 5632) : e < 9216 ? IA + IB + (e - 8448) : IA + IB + IC + (e - 9216); }
__device__ __forceinline__ int tr_defer_item(int d) { return d < 16896 ? 5632 + d : d < 25344 ? IA + 2816 + (d - 16896) : d < 26112 ? IA + IB + 768 + (d - 25344) : d < 26624 ? IA + IB + IC + 512 + (d - 26112) : IA + IB + IC + ID + (d - 26624); }
static_assert(N_EARLY == 9728 && N_DEFER == 30720, "conversion item split");
__device__ __forceinline__ TrD tr_decode(KArgP ap, bf16_t* Wb, int r) {
            if (r < IA) { const int mat = r / 2816, q = r % 2816, kb = q / 176, nb = q % 176, n0 = 32 * nb, bj = n0 / 2816, c = n0 % 2816;
                return TrD{ap->in[3] + (size_t)mat * 1024 * 5632, Wb + W_IN + (size_t)mat * 5632 * 1024, 1024, 5632, 64 * kb, n0, (c >> 7) * 256 + bj * 128 + (c & 127)}; } r -= IA;
            if (r < IB) { const int mat = r / 1408, q = r % 1408, kb = q / 32, nb = q % 32;
                return TrD{ap->in[4] + (size_t)mat * 2816 * 1024, Wb + W_OUT + (size_t)mat * 1024 * 2816, 2816, 1024, 64 * kb, 32 * nb, 32 * nb}; } r -= IB;
            if (r < IC) { const int mat = r / 768, q = r % 768, kb = q / 48, nb = q % 48, n0 = 32 * nb, tile = n0 >> 8, rr = n0 & 255;
                return TrD{ap->in[5] + (size_t)mat * 1024 * 1536, Wb + W_QKV + (size_t)mat * 1536 * 1024, 1024, 1536, 64 * kb, n0, tile * 256 + 128 * ((rr & 63) >> 5) + 32 * (rr >> 6)}; } r -= IC;
            if (r < ID) { const int mat = r / 512, q = r % 512, kb = q / 32, nb = q % 32;
                return TrD{ap->in[8] + (size_t)mat * 1024 * 1024, Wb + W_O + (size_t)mat * 1024 * 1024, 1024, 1024, 64 * kb, 32 * nb, 32 * nb}; } r -= ID;
            if (r < IE) { const int mat = r / 1024, q = r % 1024, kb = q / 64, nb = q % 64;
                return TrD{ap->in[9] + (size_t)mat * 1024 * 2048, Wb + W_RIN + (size_t)mat * 2048 * 1024, 1024, 2048, 64 * kb, 32 * nb, 32 * nb}; } r -= IE;
            if (r < IF) { const int sub = r >> 5, q = r & 31, kb = q >> 3, nb = q & 7, n0 = 32 * nb, jl = sub >> 4, d = (sub >> 3) & 1, g = (sub >> 2) & 1, h = sub & 3;
                return TrD{ap->in[12] + (size_t)sub * 256 * 256, Wb + W_RG + (size_t)jl * 4096 * 256, 256, 256, 64 * kb, n0, (d * 8 + h * 2 + (n0 >> 7)) * 256 + g * 128 + (n0 & 127)}; } r -= IF;
            { const int mat = r / 512, q = r % 512, kb = q / 32, nb = q % 32;
                return TrD{ap->in[15] + (size_t)mat * 1024 * 1024, Wb + W_RO + (size_t)mat * 1024 * 1024, 1024, 1024, 64 * kb, 32 * nb, 32 * nb}; }
        }

__global__ void __launch_bounds__(512, 2) fwd_megakernel(Args args_unused) {
    extern __shared__ __attribute__((aligned(16))) unsigned char lds[];
    cg::grid_group grid = cg::this_grid();
    LAS unsigned char* ldsl = (LAS unsigned char*)lds;
    for (int u = threadIdx.x; u < 64; u += 512) ((LAS unsigned*)(ldsl + 131072))[u] = 0u;
    __syncthreads();
    { KArgP ap0 = KARGS(); (void)xcd_barrier_post((unsigned*)(ap0->ws + 16384), (volatile LAS unsigned*)(ldsl + 131072 + 32)); }
    grid.sync();

#if PHM & 1
    {
        KArgP ap = KARGS(); unsigned char* ws = ap->ws; IDS();
        float* scr = (float*)(lds + wave * 16384); bf16_t* Wb = WSP(bf16_t, WS_W);
#ifdef NANFILL
        {
            u32x4* f0 = (u32x4*)(ws + WS_Y); const size_t n16 = (WS_END - WS_Y) / 16; const u32x4 q = {0xffffffffu, 0xffffffffu, 0xffffffffu, 0xffffffffu};
            for (size_t i = gtid; i < n16; i += GT) f0[i] = q;
        }
#endif
        const bool defer_ = DEFER_CONV && G == 256; const int n_pro = defer_ ? N_EARLY : NIT;
#pragma unroll 1
        for (int it = gw; it < n_pro; it += 2 * NGW) {
            const bool hasb = it + NGW < n_pro; const int ib_ = hasb ? it + NGW : it;
            const TrD da = tr_decode(ap, Wb, defer_ ? tr_early_item(it) : it), db = tr_decode(ap, Wb, defer_ ? tr_early_item(ib_) : ib_);
            float ra[32], rb[32]; tr_load(ra, da, lane); tr_load(rb, db, lane);
            tr_finish(ra, da, scr, lane);
            if (hasb) tr_finish(rb, db, scr, lane);
        }
        __builtin_amdgcn_s_waitcnt(0);
        float* tcos = WSP(float, WS_COS); float* tsin = WSP(float, WS_SIN);
        for (int idx = gtid; idx < 16384 * 32; idx += GT) { const int s = idx >> 5, j = idx & 31, jj = j & 15; const float pos = (float)(j < 16 ? (s >> 6) : (s & 63));
            const float inv = __builtin_amdgcn_exp2f(-(float)jj * (13.287712379549449f / 16.f)); const float th = pos * inv;
            const double turns = (double)th * 0.15915494309189535; const float fr = (float)(turns - __builtin_floor(turns));
            tcos[idx] = __builtin_amdgcn_cosf(fr); tsin[idx] = __builtin_amdgcn_sinf(fr); }
        float* HS = WSP(float, WS_XB + 1 * MiB); bf16_t* XN = WSP(bf16_t, WS_XN); const float* gains = ap->in[2];
        f32x4 g0v[4];
#pragma unroll
        for (int j = 0; j < 4; ++j) g0v[j] = ((const f32x4*)gains)[lane + 64 * j];
#pragma unroll 1
        for (int row = gw; row < NROWS; row += 2 * NGW) {
            f32x4 vv[2][4];
#pragma unroll
            for (int q = 0; q < 2; ++q) { const int rq = (row + q * NGW < NROWS) ? row + q * NGW : row;
                const float* src = rq < NREAL ? ap->in[0] + (size_t)rq * 1024 : ap->in[1] + (size_t)((rq - NREAL) & 15) * 1024;
#pragma unroll
                for (int j = 0; j < 4; ++j) vv[q][j] = ((const f32x4*)src)[lane + 64 * j]; }
#pragma unroll
            for (int q = 0; q < 2; ++q) { const int rr = row + q * NGW; if (rr >= NROWS) break;
                const float rstd = norm_row_store_g(vv[q], g0v, XN + (size_t)rr * 1024, lane); if (lane == 0) HS[rr] = __builtin_amdgcn_rcpf(rstd); }
        }
    }
#endif
    GSYNC();

#pragma unroll 1
    for (int layer = 0; layer < 4; ++layer) {
#pragma unroll 1
        for (int stage = 0; stage < 3; ++stage) {
            const int jl = layer >> 1;
#ifdef TESTSKIP
            if (stage == 1 && ((TESTSKIP >> (layer & 1)) & 1)) continue;
#endif
            int oAsel, oK; size_t oBoff; float coef; int gpost_i, gpre_i;
            if (stage != 1) {
                const int f = stage >> 1;
                {
                    KArgP ap = KARGS(); unsigned char* ws = ap->ws; IDS();
                    const bf16_t* Win = WSP(bf16_t, WS_W) + W_IN + (size_t)(layer * 2 + f) * 5632 * 1024; bf16_t* XN = WSP(bf16_t, WS_XN); bf16_t* ACT = WSP(bf16_t, WS_R1);
#if PHM & 2
                    { pg8::Gemm g{XN, Win, 1024, 1024, 1024, 0}; pg8::StaticOrder S; S.init(NREAL, 5632, G, bid); pg8::EpiSwiGLU E{ACT};
                      pg8::gemm_phase<pg8::EpiSwiGLU, pg8::StaticOrder, PG8_ALIGN, PG8_SP2>(ldsl, g, S, E); }
#endif
#if PHM & 4
                    { ThinP P{XN, 1024, Win, 1024, 1024, 176, ACT, nullptr, nullptr, nullptr, nullptr, nullptr}; thin_phase<TK_SWIGLU>(lds, P, tid, wave, lane, bid, G); }
#endif
                }
                GSYNC();
                oAsel = 0; oK = 2816; oBoff = W_OUT + (size_t)(layer * 2 + f) * 1024 * 2816; coef = 0.5f; gpost_i = layer * 6 + (f ? 5 : 1);
                gpre_i = f ? (layer < 3 ? layer * 6 + 6 : -1) : layer * 6 + 2;
            } else if ((layer & 1) == 0) {
                {
                    KArgP ap = KARGS(); unsigned char* ws = ap->ws; IDS();
                    const bf16_t* Wqkv = WSP(bf16_t, WS_W) + W_QKV + (size_t)jl * 1536 * 1024; const float* qg = ap->in[6] + jl * 64; const float* kg = ap->in[7] + jl * 64;
                    bf16_t* XN = WSP(bf16_t, WS_XN); bf16_t* QO = WSP(bf16_t, WS_R1); bf16_t* KB = WSP(bf16_t, WS_K); bf16_t* VB = WSP(bf16_t, WS_V);
#if PHM & 8
                    { pg8::Gemm g{XN, Wqkv, 1024, 1024, 1024, 0}; pg8::StaticOrder S; S.init(NREAL, 1536, G, bid); pg8::EpiQKV E{QO, KB, VB, qg, kg, WSP(float, WS_COS), WSP(float, WS_SIN), ATT_C2};
                      pg8::gemm_phase<pg8::EpiQKV, pg8::StaticOrder, PG8_ALIGN, PG8_SP2>(ldsl, g, S, E); }
#endif
#if PHM & 4
                    { ThinP P{XN, 1024, Wqkv, 1024, 1024, 24, QO, KB, VB, nullptr, qg, kg}; thin_phase<TK_QKV>(lds, P, tid, wave, lane, bid, G); }
#endif
                }
                GSYNC();
#if PHM & 16
                {
                    KArgP ap = KARGS(); unsigned char* ws = ap->ws; IDS();
                    bf16_t* QO = WSP(bf16_t, WS_R1); bf16_t* KB = WSP(bf16_t, WS_K); bf16_t* VB = WSP(bf16_t, WS_V);
                    float* PART_O = WSP(float, WS_AGG); float* PART_ML = WSP(float, WS_AGG + 2 * MiB);
                    for (int i = 0;; ++i) {
                        int bh, qb = 0, tb = 0, nt = 257, lm = 1; bool meta = false; float* po = nullptr; float* pml = nullptr;
                        if (G == 256) { if (i < 8) { bh = vcu >> 3; qb = (vcu & 7) + 8 * i; }
                                        else if (i == 8) { bh = vcu >> 3; meta = true; const int pc = vcu & 7; tb = 32 * pc; nt = 33; lm = (pc == 7) ? 1 : 2;
                                                           po = PART_O + (size_t)((bh * 8 + pc) * 16) * 64; pml = PART_ML + (size_t)((bh * 8 + pc) * 16) * 2; }
                                        else break; }
                        else { const int uid = i * G + bid; if (uid >= 2080) break; if (uid < 2048) { bh = uid >> 6; qb = uid & 63; } else { bh = uid - 2048; meta = true; } }
                        const int b = bh >> 4, h = bh & 15;
                        const long qrow0 = meta ? (long)(NREAL + b * 16) : (long)b * 16384 + (long)qb * 256;
                        attn_body::attn_unit<8>(b, h, qrow0, meta ? 16 : 256, tb, nt, lm, po, pml, (const attn_body::bf16*)QO, (const attn_body::bf16*)KB, (const attn_body::bf16*)VB, (attn_body::bf16*)QO, (char*)lds);
                        if (DEFER_CONV && layer == 0 && G == 256) {
                            const int d0 = ((i * 256 + bid) * 8 + wave) * 2;
                            if (d0 < N_DEFER) { bf16_t* Wb = WSP(bf16_t, WS_W); float* scr = (float*)(lds + wave * 16384);
                                const bool hasb = d0 + 1 < N_DEFER; const TrD da = tr_decode(ap, Wb, tr_defer_item(d0)), db = tr_decode(ap, Wb, tr_defer_item(hasb ? d0 + 1 : d0));
                                float ra[32], rb[32]; tr_load(ra, da, lane); tr_load(rb, db, lane);
                                tr_finish(ra, da, scr, lane);
                                if (hasb) tr_finish(rb, db, scr, lane); }
                            __syncthreads();
                        }
                    }
                }
#endif
                GSYNC();
                {
                    KArgP ap = KARGS(); unsigned char* ws = ap->ws; IDS();
                    if (G == 256) {
                        const float* PART_O = WSP(float, WS_AGG); const float* PART_ML = WSP(float, WS_AGG + 2 * MiB); bf16_t* QO = WSP(bf16_t, WS_R1);
                        for (int idx = gtid; idx < 32 * 16 * 64; idx += GT) { const int bh = idx >> 10, q = (idx >> 6) & 15, d = idx & 63;
                            float mp[8], M = -INFINITY;
#pragma unroll
                            for (int pc = 0; pc < 8; ++pc) { mp[pc] = PART_ML[(size_t)((bh * 8 + pc) * 16 + q) * 2]; M = fmaxf(M, mp[pc]); }
                            float num = 0.f, den = 0.f;
#pragma unroll
                            for (int pc = 0; pc < 8; ++pc) { const float w = __builtin_amdgcn_exp2f(mp[pc] - M); num += w * PART_O[(size_t)((bh * 8 + pc) * 16 + q) * 64 + d]; den += w * PART_ML[(size_t)((bh * 8 + pc) * 16 + q) * 2 + 1]; }
                            QO[(size_t)(NREAL + (bh >> 4) * 16 + q) * 1024 + (bh & 15) * 64 + d] = (bf16_t)f2bf(num / den); }
                    }
                }
                GSYNC();
                oAsel = 1; oK = 1024; oBoff = W_O + (size_t)jl * 1024 * 1024; coef = 1.f; gpost_i = layer * 6 + 3; gpre_i = layer * 6 + 4;
            } else {
                {
                    KArgP ap = KARGS(); unsigned char* ws = ap->ws; IDS();
                    const bf16_t* Wrin = WSP(bf16_t, WS_W) + W_RIN + (size_t)jl * 2048 * 1024; bf16_t* XN = WSP(bf16_t, WS_XN); bf16_t* GATE = WSP(bf16_t, WS_Y); bf16_t* XR = WSP(bf16_t, WS_R3);
#if PHM & 32
                    { pg8::Gemm g{XN, Wrin, 1024, 1024, 1024, 0}; pg8::StaticOrder S; S.init(NREAL, 2048, G, bid); pg8::EpiRecIn E{GATE, XR};
                      pg8::gemm_phase<pg8::EpiRecIn, pg8::StaticOrder, PG8_ALIGN, PG8_SP2>(ldsl, g, S, E); }
#endif
#if PHM & 4
                    { ThinP P{XN, 1024, Wrin, 1024, 1024, 32, GATE, XR, nullptr, nullptr, nullptr, nullptr}; thin_phase<TK_RECIN>(lds, P, tid, wave, lane, bid, G); }
#endif
                }
                GSYNC();
#if PHM & 64
                {
                    KArgP ap = KARGS(); unsigned char* ws = ap->ws; IDS();
                    const bf16_t* XR = WSP(bf16_t, WS_R3); bf16_t* XC = WSP(bf16_t, WS_HB);
                    const float* cw = ap->in[10] + (size_t)jl * 4 * 1024; const float* cbias = ap->in[11] + (size_t)jl * 1024;
                    const int ckc = (gtid & 127) * 8;
                    const f32x4 cb0 = *(const f32x4*)(cbias + ckc), cb1 = *(const f32x4*)(cbias + ckc + 4); f32x4 cw0[4], cw1[4];
#pragma unroll
                    for (int j = 0; j < 4; ++j) { cw0[j] = *(const f32x4*)(cw + j * 1024 + ckc); cw1[j] = *(const f32x4*)(cw + j * 1024 + ckc + 4); }
#pragma unroll 1
                    for (int it0 = gtid; it0 < NROWS * 128; it0 += 2 * GT) {
                        u32x4 xv[2][4]; float wm[2][4]; int Rq[2], ckq[2];
#pragma unroll
                        for (int q = 0; q < 2; ++q) { const int it = (it0 + q * GT < NROWS * 128) ? it0 + q * GT : it0; const int R = it >> 7, ck = (it & 127) * 8; int b, p;
                            if (R < NREAL) { b = R >> 14; p = 16 + (R & 16383); } else { b = (R - NREAL) >> 4; p = (R - NREAL) & 15; }
                            Rq[q] = R; ckq[q] = ck;
#pragma unroll
                            for (int j = 0; j < 4; ++j) { const int pp = p + j - 2; const bool ok = pp >= 0 && pp < 16400; const int sr = ok ? (pp < 16 ? NREAL + b * 16 + pp : b * 16384 + pp - 16) : R;
                                xv[q][j] = *(const u32x4*)(XR + (size_t)sr * 1024 + ck); wm[q][j] = ok ? 1.f : 0.f; } }
#pragma unroll
                        for (int q = 0; q < 2; ++q) { if (q == 1 && it0 + GT >= NROWS * 128) break; const int R = Rq[q], ck = ckq[q];
                            f32x4 a0 = cb0, a1 = cb1;
#pragma unroll
                            for (int j = 0; j < 4; ++j) { const u32x4 x = xv[q][j]; const f32x4 w0 = cw0[j] * wm[q][j], w1 = cw1[j] * wm[q][j];
                                a0[0] += __uint_as_float(x[0] << 16) * w0[0]; a0[1] += __uint_as_float(x[0] & 0xffff0000u) * w0[1]; a0[2] += __uint_as_float(x[1] << 16) * w0[2]; a0[3] += __uint_as_float(x[1] & 0xffff0000u) * w0[3];
                                a1[0] += __uint_as_float(x[2] << 16) * w1[0]; a1[1] += __uint_as_float(x[2] & 0xffff0000u) * w1[1]; a1[2] += __uint_as_float(x[3] << 16) * w1[2]; a1[3] += __uint_as_float(x[3] & 0xffff0000u) * w1[3]; }
                            u32x4 o; o.x = pk2(a0[0], a0[1]); o.y = pk2(a0[2], a0[3]); o.z = pk2(a1[0], a1[1]); o.w = pk2(a1[2], a1[3]);
                            *(u32x4*)(XC + ((size_t)(ck >> 8) * ROWS_ALLOC + R) * 256 + (ck & 255)) = o; }
                    }
                }
#endif
                GSYNC();
                {
                    KArgP ap = KARGS(); unsigned char* ws = ap->ws; IDS();
                    const bf16_t* Wrg = WSP(bf16_t, WS_W) + W_RG + (size_t)jl * 4096 * 256; bf16_t* XC = WSP(bf16_t, WS_HB); unsigned short* AB = WSP(unsigned short, WS_R1);
                    const float* gbias = ap->in[13] + (size_t)jl * 4 * 1024;
#if (PHM & 128) && (!defined(RECTEST) || RECTEST >= 2)
                    { pg8::Gemm g{XC, Wrg, 256, 256, 256, 1}; pg8::StaticOrder S; S.init(NREAL, 4096, G, bid); pg8::EpiGate E{AB, gbias};
                      pg8::gemm_phase<pg8::EpiGate, pg8::StaticOrder, PG8_ALIGN, PG8_SP2>(ldsl, g, S, E); }
#endif
#if (PHM & 4) && (!defined(RECTEST) || RECTEST >= 2)
                    { ThinP P{XC, 256, Wrg, 256, 256, 64, nullptr, nullptr, nullptr, AB, gbias, nullptr}; thin_phase<TK_GATE>(lds, P, tid, wave, lane, bid, G); }
#endif
                }
                GSYNC();
#if (PHM & 256) && (!defined(RECTEST) || RECTEST >= 2)
                {
                    KArgP ap = KARGS(); unsigned char* ws = ap->ws; IDS();
                    const unsigned short* AB = WSP(unsigned short, WS_R1); const bf16_t* XC = WSP(bf16_t, WS_HB); f32x2_tt* AGG = WSP(f32x2_tt, WS_AGG); const float* lam = ap->in[14] + (size_t)jl * 2 * 1024; const float* gbias = ap->in[13] + (size_t)jl * 4 * 1024;
                    for (int it = gw; it < 2 * 2 * NCHUNK * 4; it += NGW) {
                        const int cgp = it & 3, q = it >> 2; int j, db; if (it < 4096) { db = q >> 8; j = 1 + (q & 255); } else { db = q & 3; j = 0; }
                        const int d = db >> 1, b = db & 1, c = cgp * 256 + 4 * lane;
                        const u32x2_tt* ab = (const u32x2_tt*)(AB + ((size_t)d * NROWS + chunk_row0(b, j)) * 1024 + c); f32x4* op = (f32x4*)(AGG + ((size_t)db * NCHUNK + j) * 1024 + c);
                        const u32x2_tt* xp = (const u32x2_tt*)(XC + ((size_t)(c >> 8) * ROWS_ALLOC + chunk_row0(b, j)) * 256 + (c & 255));
                        const f32x4 l4 = *(const f32x4*)(lam + d * 1024 + c); const f32x4 sp4 = {sp_of(l4[0]), sp_of(l4[1]), sp_of(l4[2]), sp_of(l4[3])};
                        if (j == 0) scanA4_item<16>(ab, xp, d, sp4, op); else scanA4_item<64>(ab, xp, d, sp4, op);
                    }
                }
#endif
                GSYNC();
#if (PHM & 512) && (!defined(RECTEST) || RECTEST >= 2)
                {
                    KArgP ap = KARGS(); unsigned char* ws = ap->ws; IDS();
                    if (wave == 0 && bid < 64) {
                        const int idx = bid * 64 + lane, db = idx >> 10, d = db >> 1, c = idx & 1023;
                        const f32x2_tt* ag = WSP(f32x2_tt, WS_AGG) + (size_t)db * NCHUNK * 1024 + c; float* ci = WSP(float, WS_CIN) + (size_t)db * NCHUNK * 1024 + c; float carry = 0.f;
#pragma unroll 1
                        for (int j0 = 0; j0 < 256; j0 += 32) { f32x2_tt v[32];
#pragma unroll
                            for (int k = 0; k < 32; ++k) { const int js = j0 + k; const int jj = d ? NCHUNK - 1 - js : js; v[k] = ag[(size_t)jj * 1024]; }
#pragma unroll
                            for (int k = 0; k < 32; ++k) { const int js = j0 + k; const int jj = d ? NCHUNK - 1 - js : js; ci[(size_t)jj * 1024] = carry; carry = v[k].x * carry + v[k].y; }
                        }
                        ci[(size_t)(d ? 0 : NCHUNK - 1) * 1024] = carry;
                    }
                }
#endif
                GSYNC();
#if PHM & 1024
                {
                    KArgP ap = KARGS(); unsigned char* ws = ap->ws; IDS();
                    const unsigned short* AB = WSP(unsigned short, WS_R1); const bf16_t* XC = WSP(bf16_t, WS_HB); const float* CIN = WSP(float, WS_CIN); const float* lam = ap->in[14] + (size_t)jl * 2 * 1024; const float* gbias = ap->in[13] + (size_t)jl * 4 * 1024;
                    const bf16_t* GATE = WSP(bf16_t, WS_Y); bf16_t* YS = WSP(bf16_t, WS_R3);
                    for (int it = gw; it < 2 * NCHUNK * 8; it += NGW) {
                        const int ln = (int)__builtin_amdgcn_mbcnt_hi(~0u, __builtin_amdgcn_mbcnt_lo(~0u, 0u));
                        const int cgp = it & 7, q = it >> 3; int j, b; if (it < 4096) { b = q >> 8; j = 1 + (q & 255); } else { b = q & 1; j = 0; }
                        const int c = cgp * 128 + 2 * ln; const int r0 = chunk_row0(b, j);
                        const unsigned* abf = (const unsigned*)(AB + ((size_t)r0) * 1024 + c); const unsigned* abb = (const unsigned*)(AB + ((size_t)NROWS + r0) * 1024 + c);
                        const f32x2_tt cf = *(const f32x2_tt*)(CIN + ((size_t)(0 * 2 + b) * NCHUNK + j) * 1024 + c), cb2 = *(const f32x2_tt*)(CIN + ((size_t)(1 * 2 + b) * NCHUNK + j) * 1024 + c);
                        const f32x2_tt spf = {sp_of(lam[c]), sp_of(lam[c + 1])}, spb = {sp_of(lam[1024 + c]), sp_of(lam[1024 + c + 1])};
                        const unsigned* xp = (const unsigned*)(XC + ((size_t)(c >> 8) * ROWS_ALLOC + r0) * 256 + (c & 255));
                        if (j == 0) scanC2_item<16>(abf, abb, xp, (const unsigned*)(GATE + (size_t)r0 * 1024 + c), (unsigned*)(YS + (size_t)r0 * 1024 + c), cf, cb2, spf, spb);
                        else scanC2_item<64>(abf, abb, xp, (const unsigned*)(GATE + (size_t)r0 * 1024 + c), (unsigned*)(YS + (size_t)r0 * 1024 + c), cf, cb2, spf, spb);
                    }
                }
#endif
                GSYNC();
                oAsel = 2; oK = 1024; oBoff = W_RO + (size_t)jl * 1024 * 1024; coef = 1.f; gpost_i = layer * 6 + 3; gpre_i = layer * 6 + 4;
            }
            {
                KArgP ap = KARGS(); unsigned char* ws = ap->ws; IDS();
                const bf16_t* oA = oAsel == 2 ? WSP(bf16_t, WS_R3) : WSP(bf16_t, WS_R1); const bf16_t* oBt = WSP(bf16_t, WS_W) + oBoff; bf16_t* Yb = WSP(bf16_t, WS_Y);
#if PHM & 2048
#ifdef FUSE_NR
                {
                    const int nri = layer * 3 + stage;
                    pg8::PanelSS st1{WSP(float, WS_XB), (unsigned*)(ws + WS_CNT) + (size_t)(2 * nri) * 128 * 64}, st2{WSP(float, WS_XB + 512 * 1024), (unsigned*)(ws + WS_CNT) + (size_t)(2 * nri + 1) * 128 * 64};
                    pg8::EpiNR E{ap->out, WSP(bf16_t, WS_XN), WSP(float, WS_XB + 1 * MiB), ap->in[2] + (size_t)(layer * 6 + 2 * stage) * 1024, ap->in[2] + (size_t)gpost_i * 1024, gpre_i >= 0 ? ap->in[2] + (size_t)gpre_i * 1024 : nullptr, coef, st1, st2};
                    pg8::Gemm g{oA, oBt, oK, oK, oK, 0};
#pragma unroll 1
                    for (int round = 0; round < 2; ++round) { pg8::RoundOrder S; S.base.init(NREAL, 1024, G, bid); S.round = round;
                        pg8::gemm_phase<pg8::EpiNR, pg8::RoundOrder, false, PG8_SP2>(ldsl, g, S, E); }
                }
#else
                { pg8::Gemm g{oA, oBt, oK, oK, oK, 0}; pg8::StaticOrder S; S.init(NREAL, 1024, G, bid); pg8::EpiPlain E{Yb};
                  pg8::gemm_phase<pg8::EpiPlain, pg8::StaticOrder, PG8_ALIGN, PG8_SP2>(ldsl, g, S, E); }
#endif
#endif
#if PHM & 4
                { ThinP P{oA, oK, oBt, oK, oK, 32, Yb, nullptr, nullptr, nullptr, nullptr, nullptr}; thin_phase<TK_PLAIN>(lds, P, tid, wave, lane, bid, G); }
#endif
            }
            GSYNC();
#if PHM & 4096
            {
                KArgP ap = KARGS(); unsigned char* ws = ap->ws; IDS();
                float* out = ap->out; float* HS = WSP(float, WS_XB + 1 * MiB); const bf16_t* Yb = WSP(bf16_t, WS_Y); bf16_t* XN = WSP(bf16_t, WS_XN);
                const float* gpost = ap->in[2] + (size_t)gpost_i * 1024; const float* gpre = gpre_i >= 0 ? ap->in[2] + (size_t)gpre_i * 1024 : nullptr;
                const float* gprev = ap->in[2] + (size_t)(layer * 6 + 2 * stage) * 1024;
                f32x4 ig[4], gpo[4], gpr[4];
#pragma unroll
                for (int j = 0; j < 4; ++j) { const int gi = 2 * (lane + 64 * (j >> 1)) + (j & 1); const f32x4 gg = ((const f32x4*)gprev)[gi];
                    ig[j] = (f32x4){__builtin_amdgcn_rcpf(gg.x), __builtin_amdgcn_rcpf(gg.y), __builtin_amdgcn_rcpf(gg.z), __builtin_amdgcn_rcpf(gg.w)};
                    gpo[j] = ((const f32x4*)gpost)[gi]; gpr[j] = gpre ? ((const f32x4*)gpre)[gi] : (f32x4){0.f, 0.f, 0.f, 0.f}; }
                constexpr int NRR = 2;
#pragma unroll 1
#ifdef FUSE_NR
                for (int row = NREAL + gw; row < NROWS; row += NRR * NGW) {
#else
                for (int row = gw; row < NROWS; row += NRR * NGW) {
#endif
#define NRMAP(li) (li)
                    u32x4 yw[NRR][2], hw_[NRR][2]; float hsq[NRR];
#pragma unroll
                    for (int q = 0; q < NRR; ++q) { const int lq = (row + q * NGW < NROWS) ? row + q * NGW : row; const int rq = NRMAP(lq); hsq[q] = __hip_atomic_load(HS + rq, __ATOMIC_RELAXED, __HIP_MEMORY_SCOPE_AGENT);
#pragma unroll
                        for (int jp = 0; jp < 2; ++jp) { yw[q][jp] = ((const u32x4*)(Yb + (size_t)rq * 1024))[lane + 64 * jp]; hw_[q][jp] = ((const u32x4*)(XN + (size_t)rq * 1024))[lane + 64 * jp]; } }
#pragma unroll
                    for (int q = 0; q < NRR; ++q) {
                        const int lr = row + q * NGW; if (lr >= NROWS) break; const int rr = NRMAP(lr);
                        f32x4 y[4], v[4]; float s = 0.f; const float hs = hsq[q];
#pragma unroll
                        for (int j = 0; j < 4; ++j) { const unsigned lo = yw[q][j >> 1][2 * (j & 1)], hi = yw[q][j >> 1][2 * (j & 1) + 1], hlo = hw_[q][j >> 1][2 * (j & 1)], hhi = hw_[q][j >> 1][2 * (j & 1) + 1];
                            y[j] = (f32x4){__uint_as_float(lo << 16), __uint_as_float(lo & 0xffff0000u), __uint_as_float(hi << 16), __uint_as_float(hi & 0xffff0000u)};
                            v[j] = (f32x4){__uint_as_float(hlo << 16), __uint_as_float(hlo & 0xffff0000u), __uint_as_float(hhi << 16), __uint_as_float(hhi & 0xffff0000u)} * hs * ig[j];
                            s += (y[j].x * y[j].x + y[j].y * y[j].y) + (y[j].z * y[j].z + y[j].w * y[j].w); }
                        const float r = coef * __builtin_amdgcn_rsqf(wave_sum(s) * (1.f / 1024.f) + NORM_EPS);
                        float s2 = 0.f;
#pragma unroll
                        for (int j = 0; j < 4; ++j) { v[j] = v[j] + y[j] * r * gpo[j]; s2 += (v[j].x * v[j].x + v[j].y * v[j].y) + (v[j].z * v[j].z + v[j].w * v[j].w); }
                        if (gpre) {
                            const float rstd = __builtin_amdgcn_rsqf(wave_sum(s2) * (1.f / 1024.f) + NORM_EPS);
#pragma unroll
                            for (int jp = 0; jp < 2; ++jp) { const f32x4 a0 = v[2 * jp] * rstd * gpr[2 * jp], a1 = v[2 * jp + 1] * rstd * gpr[2 * jp + 1];
                                u32x4 o; o.x = pk2(a0.x, a0.y); o.y = pk2(a0.z, a0.w); o.z = pk2(a1.x, a1.y); o.w = pk2(a1.z, a1.w);
                                ((u32x4*)(XN + (size_t)rr * 1024))[lane + 64 * jp] = o; }
                            if (lane == 0) HS[rr] = __builtin_amdgcn_rcpf(rstd);
                        } else if (rr < NREAL) {
#pragma unroll
                            for (int j = 0; j < 4; ++j) ((f32x4*)(out + (size_t)rr * 1024))[2 * (lane + 64 * (j >> 1)) + (j & 1)] = v[j];
                        }
                    }
                }
            }
#endif
            GSYNC();
        }
    }
}

extern "C" void kernel_launch(void* const* d_in, const int* in_sizes, int n_in, void* d_out, int out_size, void* d_ws, size_t ws_size, hipStream_t stream) {
    static int grid_blocks = 0;
    if (grid_blocks == 0) {
        if (n_in != 16 || ws_size < WS_END) { fprintf(stderr, "kernel_launch: unexpected n_in %d / ws_size %zu\n", n_in, ws_size); grid_blocks = -1; return; }
        int dev = 0, cus = 0, per_cu = 0;
        (void)hipGetDevice(&dev); (void)hipDeviceGetAttribute(&cus, hipDeviceAttributeMultiprocessorCount, dev);
        if (hipFuncSetAttribute((const void*)fwd_megakernel, hipFuncAttributeMaxDynamicSharedMemorySize, LDS_BYTES) != hipSuccess) { fprintf(stderr, "kernel_launch: hipFuncSetAttribute failed\n"); grid_blocks = -1; return; }
        if (hipOccupancyMaxActiveBlocksPerMultiprocessor(&per_cu, (const void*)fwd_megakernel, 512, LDS_BYTES) != hipSuccess || per_cu < 1) { fprintf(stderr, "kernel_launch: occupancy query says %d\n", per_cu); per_cu = 1; }
        (void)hipGetLastError();
        grid_blocks = cus > 0 ? cus : 256;
    }
    if (grid_blocks < 0) return;
    if (hipMemsetAsync(d_ws, 0, 1048576, stream) != hipSuccess) { fprintf(stderr, "kernel_launch: hipMemsetAsync failed\n"); return; }
    Args a{};
    for (int i = 0; i < 16; ++i) a.in[i] = (const float*)d_in[i];
    a.out = (float*)d_out; a.ws = (unsigned char*)d_ws;
    void* kargs[] = {&a};
    hipError_t e = hipLaunchCooperativeKernel((const void*)fwd_megakernel, dim3(grid_blocks), dim3(512), kargs, LDS_BYTES, stream);
    if (e != hipSuccess) fprintf(stderr, "cooperative launch failed: %s (grid %d)\n", hipGetErrorString(e), grid_blocks);
}
```

```cpp
#include <hip/hip_runtime.h>
#include <hip/hip_cooperative_groups.h>
#include <cstdio>
#include <cstdint>
namespace cg = cooperative_groups;

constexpr int NREAL = 32768, NROWS = 32800, ROWS_ALLOC = 33280;
constexpr int DMODEL = 1024, DFF = 2816, LSEQ_ = 16384, NCHUNK = 257;
constexpr float NORM_EPS = 1e-6f;
constexpr float LOG2E = 1.4426950408889634f;

namespace pg8 {

#define PG8_LAS __attribute__((address_space(3)))
typedef unsigned short bf16_t;
typedef short bf16x8 __attribute__((ext_vector_type(8)));
typedef float f32x4 __attribute__((ext_vector_type(4)));
typedef unsigned u32x4 __attribute__((ext_vector_type(4)));
constexpr int BM = 256, BK = 64, HALF = 128, HTB = HALF * BK * 2  , STAGE_BYTES = 8 * HTB, NXCD = 8, WGM = 8;

__host__ __device__ __forceinline__ int lds_byte(int r, int c) { const int st = (r >> 4) * 2 + (c >> 5), rr = r & 15, cc = c & 31, ob = rr * 64 + cc * 2; return st * 1024 + (ob ^ (((ob >> 9) & 1) << 5)); }
__host__ __device__ __forceinline__ void stage_rc(int b, int& R, int& C) { const int st = b / 1024, sb = b % 1024, swz = sb ^ (((sb >> 9) & 1) << 5); R = (st >> 1) * 16 + swz / 64; C = (st & 1) * 32 + (swz % 64) / 2; }
__host__ __device__ __forceinline__ int perm32(int rho) { const int n = rho >> 4, i = rho & 15; return 8 * (i >> 2) + 4 * n + (i & 3); }

struct Unit { int pm, pn; };
struct Gemm { const bf16_t* A; const bf16_t* Bt; int lda, ldb, K, akmode; };

struct StaticOrder {
    int nM, nN, nwg, G, c;
    __host__ __device__ void init(int M, int N, int G_, int c_) { nM = M / BM; nN = N / BM; nwg = nM * nN; G = G_; c = c_; }
    __host__ __device__ bool next(int i, Unit& u) const {
        const long L = (long)i * G + c; if (L >= nwg) return false;
        int wgid = (int)L; { const int q = nwg / NXCD, r = nwg % NXCD, xcd = wgid % NXCD, off = wgid / NXCD; wgid = (xcd < r ? xcd * (q + 1) : r * (q + 1) + (xcd - r) * q) + off; }
        const int nig = WGM * nN, gid = wgid / nig, fm = gid * WGM, gsz = (nM - fm) < WGM ? (nM - fm) : WGM;
        u.pm = fm + ((wgid % nig) % gsz); u.pn = (wgid % nig) / gsz; return true;
    }
    __device__ __forceinline__ void a_ready(const Unit&) const {}
    __device__ __forceinline__ void done(const Unit&) const {}
};


typedef float f32x2_cv __attribute__((ext_vector_type(2))); typedef __bf16 bf16x2_cv __attribute__((ext_vector_type(2)));
__device__ __forceinline__ unsigned cvt_pk_bf16(float lo, float hi) { const f32x2_cv v = {lo, hi}; return __builtin_bit_cast(unsigned, __builtin_convertvector(v, bf16x2_cv)); }
__device__ __forceinline__ float sigm(float x) { return __builtin_amdgcn_rcpf(1.f + __builtin_amdgcn_exp2f(-1.4426950408889634f * x)); }
__device__ __forceinline__ float gelu_tanh(float x) { const float z = 0.7978845608028654f * (x + 0.044715f * x * x * x); return x * sigm(2.f * z); }
__device__ __forceinline__ float bf2f(unsigned short b) { return __uint_as_float((unsigned)b << 16); }
__device__ __forceinline__ u32x4 pack8(const f32x4 a, const f32x4 b) { u32x4 w; w.x = cvt_pk_bf16(a[0], a[1]); w.y = cvt_pk_bf16(a[2], a[3]); w.z = cvt_pk_bf16(b[0], b[1]); w.w = cvt_pk_bf16(b[2], b[3]); return w; }
#ifndef WT_STORES
#define WT_STORES 0
#endif
__device__ __forceinline__ void st16(void* p, const u32x4 v) {
#if WT_STORES
    asm volatile("global_store_dwordx4 %0, %1, off sc1\n\ts_nop 1" :: "v"(p), "v"(v) : "memory");
#else
    *(u32x4*)p = v;
#endif
}

struct EpiSwiGLU {
    static constexpr bool PERM = true, AFTER_DRAIN = false;
    bf16_t* O;
    __device__ __forceinline__ void operator()(const f32x4 (&acc)[2][2][4][2], const Unit& u, int wr, int wc, int fr_in, int fq) const {
        int fr = fr_in; asm volatile("" : "+v"(fr));
        const int row0 = u.pm * BM + wr * 64 + fr, col0 = u.pn * 128 + wc * 32 + 8 * fq;
#pragma unroll
        for (int ai = 0; ai < 2; ++ai)
#pragma unroll
            for (int m = 0; m < 4; ++m) {
                f32x4 v[2];
#pragma unroll
                for (int n = 0; n < 2; ++n)
#pragma unroll
                    for (int j = 0; j < 4; ++j) { const float gt = acc[ai][0][m][n][j]; v[n][j] = gt * sigm(gt) * acc[ai][1][m][n][j]; }
                st16((char*)O + ((unsigned)(row0 + ai * HALF + m * 16) * 2816u + (unsigned)col0) * 2u, pack8(v[0], v[1]));
            }
    }
};
struct EpiPlain {
    static constexpr bool PERM = true, AFTER_DRAIN = false;
    bf16_t* O;
    __device__ __forceinline__ void operator()(const f32x4 (&acc)[2][2][4][2], const Unit& u, int wr, int wc, int fr_in, int fq) const {
        int fr = fr_in; asm volatile("" : "+v"(fr));
        const int row0 = u.pm * BM + wr * 64 + fr, col0 = u.pn * BM + wc * 32 + 8 * fq;
#pragma unroll
        for (int ai = 0; ai < 2; ++ai)
#pragma unroll
            for (int m = 0; m < 4; ++m)
#pragma unroll
                for (int bj = 0; bj < 2; ++bj)
                    st16((char*)O + ((unsigned)(row0 + ai * HALF + m * 16) * 1024u + (unsigned)(col0 + bj * HALF)) * 2u, pack8(acc[ai][bj][m][0], acc[ai][bj][m][1]));
    }
};
struct EpiRecIn {
    static constexpr bool PERM = true, AFTER_DRAIN = false;
    bf16_t* G; bf16_t* X;
    __device__ __forceinline__ void operator()(const f32x4 (&acc)[2][2][4][2], const Unit& u, int wr, int wc, int fr_in, int fq) const {
        int fr = fr_in; asm volatile("" : "+v"(fr));
        const int row0 = u.pm * BM + wr * 64 + fr, col0 = (u.pn & 3) * BM + wc * 32 + 8 * fq; const bool isg = u.pn < 4; bf16_t* O = isg ? G : X;
#pragma unroll
        for (int ai = 0; ai < 2; ++ai)
#pragma unroll
            for (int m = 0; m < 4; ++m)
#pragma unroll
                for (int bj = 0; bj < 2; ++bj) {
                    f32x4 v0 = acc[ai][bj][m][0], v1 = acc[ai][bj][m][1];
                    if (isg) {
#pragma unroll
                        for (int j = 0; j < 4; ++j) { v0[j] = gelu_tanh(v0[j]); v1[j] = gelu_tanh(v1[j]); } }
                    st16((char*)O + ((unsigned)(row0 + ai * HALF + m * 16) * 1024u + (unsigned)(col0 + bj * HALF)) * 2u, pack8(v0, v1));
                }
    }
};
struct EpiQKV {
    static constexpr bool PERM = true, AFTER_DRAIN = false;
    bf16_t *Q, *K, *V; const float *qg, *kg, *cs, *sn; float c2;
    __device__ __forceinline__ void operator()(const f32x4 (&acc)[2][2][4][2], const Unit& u, int wr, int wc, int fr_in, int fq) const {
        int fr = fr_in; asm volatile("" : "+v"(fr));
        const int row0 = u.pm * BM + wr * 64 + fr, pn = u.pn;
        if (pn == 5) {
#pragma unroll
            for (int ai = 0; ai < 2; ++ai)
#pragma unroll
                for (int m = 0; m < 4; ++m)
#pragma unroll
                    for (int bj = 0; bj < 2; ++bj)
                        st16((char*)V + ((unsigned)(row0 + ai * HALF + m * 16) * 256u + (unsigned)(wc * 64 + bj * 32 + 8 * fq)) * 2u, pack8(acc[ai][bj][m][0], acc[ai][bj][m][1]));
            return;
        }
        const bool isq = pn < 4; const float* gp = isq ? qg : kg; const float sc = isq ? c2 : 1.f;
        bf16_t* O = isq ? Q : K; const int pitch = isq ? 1024 : 256; const int hc = (isq ? (4 * pn + wc) : wc) * 64 + 8 * fq;
        f32x4 gq[2][2];
#pragma unroll
        for (int n = 0; n < 2; ++n) { gq[0][n] = *(const f32x4*)(gp + 8 * fq + 4 * n); gq[1][n] = *(const f32x4*)(gp + 32 + 8 * fq + 4 * n); }
#pragma unroll
        for (int ai = 0; ai < 2; ++ai)
#pragma unroll
            for (int m = 0; m < 4; ++m) {
                const int row = row0 + ai * HALF + m * 16;
                float ss = 0.f;
#pragma unroll
                for (int bj = 0; bj < 2; ++bj)
#pragma unroll
                    for (int n = 0; n < 2; ++n) { const f32x4 x = acc[ai][bj][m][n]; ss += (x[0] * x[0] + x[1] * x[1]) + (x[2] * x[2] + x[3] * x[3]); }
                ss += __shfl_xor(ss, 16); ss += __shfl_xor(ss, 32);
                const float rms = __builtin_amdgcn_rsqf(ss * (1.f / 64.f) + 1e-6f);
                const int s = row & 16383;
                f32x4 o1[2], o2[2];
#pragma unroll
                for (int n = 0; n < 2; ++n) {
                    const unsigned to = ((unsigned)s * 32u + (unsigned)(8 * fq + 4 * n)) * 4u; const f32x4 c = *(const f32x4*)((const char*)cs + to), sn4 = *(const f32x4*)((const char*)sn + to);
                    const f32x4 g1 = gq[0][n], g2 = gq[1][n];
                    const f32x4 x1 = acc[ai][0][m][n] * rms * g1, x2 = acc[ai][1][m][n] * rms * g2;
                    o1[n] = (x1 * c - x2 * sn4) * sc; o2[n] = (x1 * sn4 + x2 * c) * sc;
                }
                bf16_t* p = (bf16_t*)((char*)O + ((unsigned)row * (unsigned)pitch + (unsigned)hc) * 2u);
                st16(p, pack8(o1[0], o1[1])); st16(p + 32, pack8(o2[0], o2[1]));                asm volatile("" ::: "memory");
            }
    }
};
__device__ __forceinline__ unsigned q8pair(float r, float ig) {
    const unsigned a = (unsigned)__builtin_rintf(r * 255.f), b = (unsigned)__builtin_rintf(ig * 255.f);
    return a | (b << 8);
}
struct EpiGate {
    static constexpr bool PERM = true, AFTER_DRAIN = false;
    unsigned short* AB; const float* gb;
    __device__ __forceinline__ void operator()(const f32x4 (&acc)[2][2][4][2], const Unit& u, int wr, int wc, int fr_in, int fq) const {
        int fr = fr_in; asm volatile("" : "+v"(fr));
        const int row0 = u.pm * BM + wr * 64 + fr, pn = u.pn, d = pn >> 3, ch0 = ((pn >> 1) & 3) * 256 + (pn & 1) * 128 + wc * 32 + 8 * fq;
        unsigned short* ab = AB + (size_t)d * NROWS * 1024;
        f32x4 rb[2], ib[2];
#pragma unroll
        for (int n = 0; n < 2; ++n) { rb[n] = *(const f32x4*)(gb + (d * 2 + 0) * 1024 + ch0 + 4 * n); ib[n] = *(const f32x4*)(gb + (d * 2 + 1) * 1024 + ch0 + 4 * n); }
#pragma unroll
        for (int ai = 0; ai < 2; ++ai)
#pragma unroll
            for (int m = 0; m < 4; ++m) {
                const int row = row0 + ai * HALF + m * 16;
                u32x4 w;
#pragma unroll
                for (int n = 0; n < 2; ++n)
#pragma unroll
                    for (int jj = 0; jj < 2; ++jj)
                        w[n * 2 + jj] = q8pair(sigm(acc[ai][0][m][n][2 * jj] + rb[n][2 * jj]), sigm(acc[ai][1][m][n][2 * jj] + ib[n][2 * jj]))
                                      | (q8pair(sigm(acc[ai][0][m][n][2 * jj + 1] + rb[n][2 * jj + 1]), sigm(acc[ai][1][m][n][2 * jj + 1] + ib[n][2 * jj + 1])) << 16);
                st16((char*)ab + ((unsigned)row * 1024u + (unsigned)ch0) * 2u, w);
            }
    }
};

struct PanelSS {
    float* xbuf;
    unsigned* cnt;
    __device__ __forceinline__ void run(const f32x4 (&v)[2][2][4][2], const Unit& u, int wr, int wc, int fr, int fq, PG8_LAS unsigned char* lds, int wid, int lane) const {
        PG8_LAS float* P = (PG8_LAS float*)lds;
        PG8_LAS float* S = (PG8_LAS float*)(lds + 8192);
#pragma unroll
        for (int ai = 0; ai < 2; ++ai)
#pragma unroll
            for (int m = 0; m < 4; ++m) {
                float s = 0.f;
#pragma unroll
                for (int bj = 0; bj < 2; ++bj)
#pragma unroll
                    for (int n = 0; n < 2; ++n) { const f32x4 x = v[ai][bj][m][n]; s += (x[0] * x[0] + x[1] * x[1]) + (x[2] * x[2] + x[3] * x[3]); }
                s += __shfl_xor(s, 16); s += __shfl_xor(s, 32);
                if (fq == 0) P[(ai * HALF + wr * 64 + m * 16 + fr) * 4 + wc] = s;
            }
        asm volatile("s_waitcnt lgkmcnt(0)" ::: "memory"); __builtin_amdgcn_s_barrier(); asm volatile("" ::: "memory");
        const int row = wid * 32 + (lane & 31);
        if (lane < 32) {
            const float t = (P[row * 4 + 0] + P[row * 4 + 1]) + (P[row * 4 + 2] + P[row * 4 + 3]);
            __hip_atomic_store(xbuf + ((size_t)(u.pm * BM + row) * 4 + u.pn), t, __ATOMIC_RELAXED, __HIP_MEMORY_SCOPE_AGENT);
        }
        asm volatile("s_waitcnt vmcnt(0)" ::: "memory");
        if (lane == 0) __hip_atomic_fetch_add(cnt + 64 * u.pm, 1u, __ATOMIC_RELAXED, __HIP_MEMORY_SCOPE_AGENT);
        if (wid == 0) {
            const unsigned long long t0 = __builtin_amdgcn_s_memrealtime();
            for (;;) {
                if ((unsigned)__builtin_amdgcn_readfirstlane(__hip_atomic_load(cnt + 64 * u.pm, __ATOMIC_RELAXED, __HIP_MEMORY_SCOPE_AGENT)) >= 32u) break;
                if (__builtin_amdgcn_s_memrealtime() - t0 > 2000000ull) break;
                __builtin_amdgcn_s_sleep(2);
            }
            __builtin_amdgcn_fence(__ATOMIC_ACQUIRE, "agent");
        }
        asm volatile("s_waitcnt vmcnt(0) lgkmcnt(0)" ::: "memory"); __builtin_amdgcn_s_barrier(); asm volatile("" ::: "memory");
        if (lane < 32) {
            const float* slot = xbuf + (size_t)(u.pm * BM + row) * 4; float t = 0.f;
#pragma unroll
            for (int k = 0; k < 4; ++k) t += __hip_atomic_load(slot + k, __ATOMIC_RELAXED, __HIP_MEMORY_SCOPE_AGENT);
            S[row] = __builtin_amdgcn_rsqf(t * (1.f / 1024.f) + 1e-6f);
        }
        asm volatile("s_waitcnt lgkmcnt(0)" ::: "memory"); __builtin_amdgcn_s_barrier(); asm volatile("" ::: "memory");
    }
};
struct EpiNR {
    static constexpr bool PERM = false, AFTER_DRAIN = true;
    float* out; bf16_t* xn; float* hs; const float* gprev; const float* gpost; const float* gpre; float coef; PanelSS st1, st2;
    __device__ __forceinline__ void fused(f32x4 (&acc)[2][2][4][2], const Unit& u, int wr, int wc, int fr_in, int fq, PG8_LAS unsigned char* lds, int wid, int lane) const {
        typedef unsigned u32x2v __attribute__((ext_vector_type(2)));
        int fr = fr_in; asm volatile("" : "+v"(fr));
        const PG8_LAS float* S = (const PG8_LAS float*)(lds + 8192);
        const int col0 = u.pn * BM + wc * 32 + 4 * fq;
        st1.run(acc, u, wr, wc, fr, fq, lds, wid, lane);
#pragma unroll
        for (int ai = 0; ai < 2; ++ai)
#pragma unroll
            for (int m = 0; m < 4; ++m) { const int r = ai * HALF + wr * 64 + m * 16 + fr; const float rs = S[r] * coef; const float hsr = hs[u.pm * BM + r]; const unsigned off = ((unsigned)(u.pm * BM + r) * 1024u + (unsigned)col0);
#pragma unroll
                for (int bj = 0; bj < 2; ++bj)
#pragma unroll
                    for (int n = 0; n < 2; ++n) { const u32x2v xw = *(const u32x2v*)((const char*)xn + (off + bj * HALF + n * 16) * 2u);
                        const f32x4 gp = *(const f32x4*)(gprev + col0 + bj * HALF + n * 16), g = *(const f32x4*)(gpost + col0 + bj * HALF + n * 16);
                        const f32x4 bs = (f32x4){__uint_as_float(xw.x << 16) * __builtin_amdgcn_rcpf(gp[0]), __uint_as_float(xw.x & 0xffff0000u) * __builtin_amdgcn_rcpf(gp[1]), __uint_as_float(xw.y << 16) * __builtin_amdgcn_rcpf(gp[2]), __uint_as_float(xw.y & 0xffff0000u) * __builtin_amdgcn_rcpf(gp[3])} * hsr;
                        acc[ai][bj][m][n] = bs + acc[ai][bj][m][n] * rs * g; }
                asm volatile("" : "+v"(acc[ai][0][m][0]), "+v"(acc[ai][0][m][1]), "+v"(acc[ai][1][m][0]), "+v"(acc[ai][1][m][1]));
                asm volatile("" ::: "memory"); }
        if (gpre) st2.run(acc, u, wr, wc, fr, fq, lds, wid, lane);
#pragma unroll
        for (int ai = 0; ai < 2; ++ai)
#pragma unroll
            for (int m = 0; m < 4; ++m) { const int r = ai * HALF + wr * 64 + m * 16 + fr; const float rs = gpre ? S[r] : 0.f; const unsigned off = ((unsigned)(u.pm * BM + r) * 1024u + (unsigned)col0);
#pragma unroll
                for (int bj = 0; bj < 2; ++bj)
#pragma unroll
                    for (int n = 0; n < 2; ++n) { const f32x4 x1 = acc[ai][bj][m][n];
                        if (gpre) { const f32x4 g = *(const f32x4*)(gpre + col0 + bj * HALF + n * 16); const f32x4 o = x1 * rs * g; u32x2v w; w.x = cvt_pk_bf16(o[0], o[1]); w.y = cvt_pk_bf16(o[2], o[3]);
                            *(u32x2v*)((char*)xn + (off + bj * HALF + n * 16) * 2u) = w; }
                        else *(f32x4*)((char*)out + (off + bj * HALF + n * 16) * 4u) = x1; }
                if (gpre && u.pn == 0 && wc == 0 && fq == 0) hs[u.pm * BM + r] = __builtin_amdgcn_rcpf(rs);
                asm volatile("" ::: "memory"); }
    }
};
struct RoundOrder {
    StaticOrder base; int round;
    __device__ bool next(int i, Unit& u) const { return i == 0 ? base.next(round, u) : false; }
    __device__ __forceinline__ void a_ready(const Unit&) const {}
    __device__ __forceinline__ void done(const Unit&) const {}
};
template <class Epi, class Sched, bool ALIGN_EPI = false, bool SP2 = false>
__device__ __forceinline__ void gemm_phase(PG8_LAS unsigned char* lds, const Gemm g, const Sched& S, const Epi& E) {
    int tid_ = threadIdx.x; asm volatile("" : "+v"(tid_)); const int tid = tid_, wid = __builtin_amdgcn_readfirstlane(tid >> 6), lane = tid & 63, wr = wid >> 2, wc = wid & 3, fr = lane & 15, fq = lane >> 4;
    const int K = g.K, nt = K / BK;
    unsigned voffA[2], voffB[2];
#pragma unroll
    for (int i = 0; i < 2; ++i) { int R, C; stage_rc(tid * 16 + i * 8192, R, C); const int Rb = Epi::PERM ? ((R & ~31) + perm32(R & 31)) : R;
        voffA[i] = (unsigned)(R * g.lda + C) * 2u; voffB[i] = (unsigned)(Rb * g.ldb + C) * 2u; }
    const size_t kstep = (size_t)(BK * 2);
    const size_t hstepA = (size_t)HALF * g.lda * 2, hstepB = (size_t)HALF * g.ldb * 2;
    const size_t tstepA = 2 * hstepA, tstepB = 2 * hstepB;
    const unsigned ldsw = (unsigned)wid * 1024u;
    const int aoff = lds_byte(wr * 64 + fr, fq * 8), boff = lds_byte(wc * 32 + fr, fq * 8);
#define AKOFF(pn) ((size_t)(g.akmode ? ((size_t)(((pn) >> 1) & 3) * ((size_t)33280 * 512)) : 0))
#define PG8_SA(b, h) (((b) * 2 + (h)) * HTB)
#define PG8_SB(b, h) ((4 + (b) * 2 + (h)) * HTB)
#define PG8_STAGE(bufoff, gbase, voff) do { _Pragma("unroll") for (int _i = 0; _i < 2; ++_i) \
        __builtin_amdgcn_global_load_lds((const unsigned*)((const char*)(gbase) + (voff)[_i]), (PG8_LAS unsigned*)(lds + (bufoff) + ldsw + _i * 8192), 16, 0, 0); } while (0)
#define PG8_LDA(dst, b, h) do { _Pragma("unroll") for (int m = 0; m < 4; ++m) _Pragma("unroll") for (int k = 0; k < 2; ++k) dst[m][k] = *(const PG8_LAS bf16x8*)(lds + PG8_SA(b, h) + aoff + m * 2048 + k * 1024); } while (0)
#define PG8_LDB(dst, b, h) do { _Pragma("unroll") for (int n = 0; n < 2; ++n) _Pragma("unroll") for (int k = 0; k < 2; ++k) dst[n][k] = *(const PG8_LAS bf16x8*)(lds + PG8_SB(b, h) + boff + n * 2048 + k * 1024); } while (0)
#define PG8_MMA(ai, bj, At, Bt) do { __builtin_amdgcn_s_setprio(1); _Pragma("unroll") for (int m = 0; m < 4; ++m) _Pragma("unroll") for (int n = 0; n < 2; ++n) _Pragma("unroll") for (int k = 0; k < 2; ++k) \
        acc[ai][bj][m][n] = __builtin_amdgcn_mfma_f32_16x16x32_bf16(Bt[n][k], At[m][k], acc[ai][bj][m][n], 0, 0, 0); __builtin_amdgcn_s_setprio(0); } while (0)
#define PG8_WAIT_V(n) asm volatile("s_waitcnt vmcnt(" #n ")" ::: "memory")
#define PG8_WAIT_L(n) asm volatile("s_waitcnt lgkmcnt(" #n ")" ::: "memory")
#define PG8_BAR __builtin_amdgcn_s_barrier()
#define PG8_SCHED __builtin_amdgcn_sched_barrier(0)
    Unit cur, nxt; int ui = 0;
    if (!S.next(0, cur)) return;
    f32x4 acc[2][2][4][2];
#pragma unroll
    for (int a = 0; a < 2; ++a)
#pragma unroll
        for (int b = 0; b < 2; ++b)
#pragma unroll
            for (int m = 0; m < 4; ++m)
#pragma unroll
                for (int n = 0; n < 2; ++n) acc[a][b][m][n] = (f32x4){0.f, 0.f, 0.f, 0.f};
    bf16x8 At[4][2], B0[2][2], B1[2][2];
    const char* cA = (const char*)g.A + (size_t)cur.pm * tstepA + AKOFF(cur.pn); const char* cB = (const char*)g.Bt + (size_t)cur.pn * tstepB;
    S.a_ready(cur);
    if constexpr (SP2) {
        PG8_STAGE(PG8_SB(0, 0), cB, voffB); PG8_STAGE(PG8_SB(0, 1), cB + hstepB, voffB); PG8_STAGE(PG8_SA(0, 0), cA, voffA); PG8_STAGE(PG8_SA(0, 1), cA + hstepA, voffA);
        if (wr == 1) PG8_BAR;
        PG8_WAIT_V(2); PG8_BAR;
        PG8_STAGE(PG8_SB(1, 0), cB + kstep, voffB); PG8_STAGE(PG8_SA(1, 0), cA + kstep, voffA); PG8_STAGE(PG8_SB(1, 1), cB + hstepB + kstep, voffB);
        PG8_WAIT_V(6); PG8_BAR;
    } else {
        PG8_STAGE(PG8_SB(0, 0), cB, voffB); PG8_STAGE(PG8_SA(0, 0), cA, voffA); PG8_STAGE(PG8_SB(0, 1), cB + hstepB, voffB); PG8_STAGE(PG8_SA(0, 1), cA + hstepA, voffA);
        if (wr == 1) PG8_BAR;
        PG8_WAIT_V(4); PG8_BAR;
        PG8_STAGE(PG8_SB(1, 0), cB + kstep, voffB); PG8_STAGE(PG8_SA(1, 0), cA + kstep, voffA); PG8_STAGE(PG8_SB(1, 1), cB + hstepB + kstep, voffB);
        PG8_WAIT_V(6); PG8_BAR;
    }
    for (;;) {
        const bool has_next = S.next(ui + 1, nxt);
        const char* nA = has_next ? (const char*)g.A + (size_t)nxt.pm * tstepA + AKOFF(nxt.pn) : cA; const char* nB = has_next ? (const char*)g.Bt + (size_t)nxt.pn * tstepB : cB;
        _Pragma("unroll 1") for (int t = 0; t < nt; t += 2) {
            const bool last = (t == nt - 2);
            const char* a1 = cA + (size_t)(t + 1) * kstep;
            const char* a2 = last ? nA : cA + (size_t)(t + 2) * kstep; const char* b2 = last ? nB : cB + (size_t)(t + 2) * kstep;
            const char* a3 = a2 + kstep; const char* b3 = b2 + kstep;
            if (last && has_next) S.a_ready(nxt);
            if constexpr (SP2) {
            PG8_LDB(B0, 0, 0); PG8_LDB(B1, 0, 1); PG8_SCHED; PG8_LDA(At, 0, 0); PG8_STAGE(PG8_SA(1, 1), a1 + hstepA, voffA);
            PG8_WAIT_V(8); PG8_WAIT_L(0); PG8_BAR; PG8_MMA(0, 0, At, B0); PG8_MMA(0, 1, At, B1); PG8_BAR; PG8_SCHED;
            PG8_LDA(At, 0, 1); PG8_STAGE(PG8_SB(0, 0), b2, voffB); PG8_STAGE(PG8_SB(0, 1), b2 + hstepB, voffB); PG8_STAGE(PG8_SA(0, 0), a2, voffA);
            PG8_WAIT_V(8); PG8_WAIT_L(0); PG8_BAR; PG8_MMA(1, 0, At, B0); PG8_MMA(1, 1, At, B1); PG8_BAR; PG8_SCHED;
            PG8_LDB(B0, 1, 0); PG8_LDB(B1, 1, 1); PG8_SCHED; PG8_LDA(At, 1, 0); PG8_STAGE(PG8_SA(0, 1), a2 + hstepA, voffA);
            PG8_WAIT_V(8); PG8_WAIT_L(0); PG8_BAR; PG8_MMA(0, 0, At, B0); PG8_MMA(0, 1, At, B1); PG8_BAR; PG8_SCHED;
            PG8_LDA(At, 1, 1); PG8_STAGE(PG8_SB(1, 0), b3, voffB); PG8_STAGE(PG8_SB(1, 1), b3 + hstepB, voffB); PG8_STAGE(PG8_SA(1, 0), a3, voffA);
            PG8_WAIT_V(8); PG8_WAIT_L(0); PG8_BAR; PG8_MMA(1, 0, At, B0); PG8_MMA(1, 1, At, B1); PG8_BAR; PG8_SCHED;
            } else {
            PG8_LDB(B0, 0, 0); PG8_SCHED; PG8_LDA(At, 0, 0); PG8_STAGE(PG8_SA(1, 1), a1 + hstepA, voffA);
            PG8_WAIT_L(8); PG8_BAR; PG8_WAIT_L(0); PG8_MMA(0, 0, At, B0); PG8_BAR; PG8_SCHED;
            PG8_LDB(B1, 0, 1); PG8_STAGE(PG8_SB(0, 0), b2, voffB);
            PG8_BAR; PG8_WAIT_L(0); PG8_MMA(0, 1, At, B1); PG8_BAR;
            PG8_LDA(At, 0, 1); PG8_STAGE(PG8_SA(0, 0), a2, voffA);
            PG8_BAR; PG8_WAIT_L(0); PG8_MMA(1, 0, At, B0); PG8_BAR; PG8_SCHED;
            PG8_STAGE(PG8_SB(0, 1), b2 + hstepB, voffB);
            PG8_WAIT_V(6); PG8_BAR; PG8_MMA(1, 1, At, B1); PG8_BAR;
            PG8_LDB(B0, 1, 0); PG8_SCHED; PG8_LDA(At, 1, 0); PG8_STAGE(PG8_SA(0, 1), a2 + hstepA, voffA);
            PG8_WAIT_L(8); PG8_BAR; PG8_WAIT_L(0); PG8_MMA(0, 0, At, B0); PG8_BAR; PG8_SCHED;
            PG8_LDB(B1, 1, 1); PG8_STAGE(PG8_SB(1, 0), b3, voffB);
            PG8_BAR; PG8_WAIT_L(0); PG8_MMA(0, 1, At, B1); PG8_BAR;
            PG8_LDA(At, 1, 1); PG8_STAGE(PG8_SA(1, 0), a3, voffA);
            PG8_BAR; PG8_WAIT_L(0); PG8_MMA(1, 0, At, B0); PG8_BAR; PG8_SCHED;
            PG8_STAGE(PG8_SB(1, 1), b3 + hstepB, voffB);
            PG8_WAIT_V(6); PG8_BAR; PG8_MMA(1, 1, At, B1); PG8_BAR;
            }
        }
        if constexpr (ALIGN_EPI) { if (wr == 0) PG8_BAR; }
        if constexpr (!Epi::AFTER_DRAIN) { E(acc, cur, wr, wc, fr, fq); S.done(cur); }
        if (!has_next) break;
#pragma unroll
        for (int a = 0; a < 2; ++a)
#pragma unroll
            for (int b = 0; b < 2; ++b)
#pragma unroll
                for (int m = 0; m < 4; ++m)
#pragma unroll
                    for (int n = 0; n < 2; ++n) acc[a][b][m][n] = (f32x4){0.f, 0.f, 0.f, 0.f};
        cur = nxt; cA = nA; cB = nB; ++ui;
        if constexpr (ALIGN_EPI) { if (wr == 1) PG8_BAR; }
    }
    PG8_WAIT_V(0);
    if constexpr (!ALIGN_EPI) { if (wr == 0) PG8_BAR; }
    PG8_BAR;
    if constexpr (Epi::AFTER_DRAIN) { E.fused(acc, cur, wr, wc, fr, fq, lds, wid, lane); S.done(cur); }
#undef AKOFF
#undef PG8_SA
#undef PG8_SB
#undef PG8_STAGE
#undef PG8_LDA
#undef PG8_LDB
#undef PG8_MMA
#undef PG8_WAIT_V
#undef PG8_WAIT_L
#undef PG8_BAR
#undef PG8_SCHED
}
}

#ifndef PG8_SP2
#define PG8_SP2 true
#endif
#ifndef PG8_ALIGN
#define PG8_ALIGN true
#endif

#include <hip/hip_bf16.h>
#include <cmath>
namespace attn_body {
using bf16=__hip_bfloat16;
using bf16x8=__attribute__((ext_vector_type(8)))short;
using s16x4=__attribute__((ext_vector_type(4)))short;
using f32x16=__attribute__((ext_vector_type(16)))float;
using u32x4=__attribute__((ext_vector_type(4)))unsigned;
constexpr int D=64,QP=1024,KP=256,LSEQ=16384,NREALR=32768;
constexpr int NW=8,QBLK=32,QB=QBLK*NW,KVBLK=64;

__device__ __forceinline__ int crow(int r,int hi){return (r&3)+8*(r>>2)+4*hi;}
#define SBAR() __builtin_amdgcn_sched_barrier(0)
__device__ __forceinline__ void cmask(f32x16&p0,f32x16&p1,int jb,int qrel,int hi){
  const float NEG=-INFINITY; int kb=64*jb+4*hi;
  #pragma unroll
  for(int r=0;r<16;++r){int kv=kb+(r&3)+8*(r>>2); if(kv>qrel)p0[r]=NEG; if(kv+32>qrel)p1[r]=NEG;}
}

constexpr int NSLOT=3, SLOTB=8192;
constexpr int LDS_K=0, LDS_V=NSLOT*SLOTB, LDS_WS=2*NSLOT*SLOTB, LDS_OST=LDS_WS+NW*64*4, LDS_BYTES=LDS_OST+NW*4096;
constexpr float C2=0.125f*1.4426950408889634f;
__device__ __forceinline__ void glds16(const void*gsrc,unsigned lds_dst){unsigned keep;
  asm volatile("s_mov_b32 %0, m0\n\ts_mov_b32 m0, %2\n\ts_nop 0\n\tglobal_load_lds_dwordx4 %1, off\n\ts_mov_b32 m0, %0":"=&s"(keep):"v"(gsrc),"s"(lds_dst):"memory");}
__device__ __forceinline__ float max3f(float a,float b,float c){float r;asm("v_max3_f32 %0, %1, %2, %3":"=v"(r):"v"(a),"v"(b),"v"(c));return r;}
__device__ __forceinline__ float max2f(float a,float b){float r;asm("v_max_f32_e32 %0, %1, %2":"=v"(r):"v"(a),"v"(b));return r;}
__device__ __forceinline__ float fadd_s(float a,float b){float r;asm("v_add_f32_e32 %0, %1, %2":"=v"(r):"v"(a),"v"(b));return r;}
__device__ __forceinline__ float fsub_s(float a,float b){float r;asm("v_sub_f32_e32 %0, %1, %2":"=v"(r):"v"(a),"v"(b));return r;}
typedef float f32x2_t __attribute__((ext_vector_type(2))); typedef __bf16 bf16x2_t __attribute__((ext_vector_type(2)));
__device__ __forceinline__ unsigned cvtpk_s(float lo,float hi){f32x2_t v={lo,hi};bf16x2_t b=__builtin_convertvector(v,bf16x2_t);return __builtin_bit_cast(unsigned,b);}
#define WAIT_BAR(N) asm volatile("s_waitcnt vmcnt(" #N ") lgkmcnt(0)\n\ts_barrier":::"memory")

__device__ __forceinline__ void qkt(f32x16&p0,f32x16&p1,const char*Kslot,const bf16x8*qr,const f32x16&negm,int r32,int hi){
  const char*kb=Kslot+hi*1024+r32*16;
  #pragma unroll
  for(int d0=0;d0<4;++d0){
    const bf16x8 b0=*reinterpret_cast<const bf16x8*>(kb+d0*2048);
    const bf16x8 b1=*reinterpret_cast<const bf16x8*>(kb+d0*2048+512);
    if(d0==0){p0=__builtin_amdgcn_mfma_f32_32x32x16_bf16(b0,qr[0],negm,0,0,0);p1=__builtin_amdgcn_mfma_f32_32x32x16_bf16(b1,qr[0],negm,0,0,0);}
    else{p0=__builtin_amdgcn_mfma_f32_32x32x16_bf16(b0,qr[d0],p0,0,0,0);p1=__builtin_amdgcn_mfma_f32_32x32x16_bf16(b1,qr[d0],p1,0,0,0);}}
}
typedef __attribute__((address_space(3))) const char* lds_cptr;
typedef short v4i16_t __attribute__((ext_vector_type(4)));
__device__ __forceinline__ void kload8(bf16x8*kf,lds_cptr kp){
  kf[0]=*(const __attribute__((address_space(3))) bf16x8*)(kp);      kf[1]=*(const __attribute__((address_space(3))) bf16x8*)(kp+512);
  kf[2]=*(const __attribute__((address_space(3))) bf16x8*)(kp+2048); kf[3]=*(const __attribute__((address_space(3))) bf16x8*)(kp+2560);
  kf[4]=*(const __attribute__((address_space(3))) bf16x8*)(kp+4096); kf[5]=*(const __attribute__((address_space(3))) bf16x8*)(kp+4608);
  kf[6]=*(const __attribute__((address_space(3))) bf16x8*)(kp+6144); kf[7]=*(const __attribute__((address_space(3))) bf16x8*)(kp+6656);
}
__device__ __forceinline__ void kload2(bf16x8*kf,lds_cptr kp,int j){ kf[2*j]=*(const __attribute__((address_space(3))) bf16x8*)(kp+j*2048); kf[2*j+1]=*(const __attribute__((address_space(3))) bf16x8*)(kp+j*2048+512); }
__device__ __forceinline__ s16x4 vtr(lds_cptr p){ return __builtin_bit_cast(s16x4,__builtin_amdgcn_ds_read_tr16_b64_v4i16((__attribute__((address_space(3))) v4i16_t*)p)); }
__device__ __forceinline__ float rowmax(const f32x16&p0,const f32x16&p1){
  float a=max3f(p0[0],p0[1],p1[0]),b=max3f(p0[2],p0[3],p1[1]);a=max3f(a,p1[2],p1[3]);
  #pragma unroll
  for(int r=4;r<16;r+=4){a=max3f(a,p0[r],p0[r+1]);b=max3f(b,p0[r+2],p0[r+3]);a=max3f(a,p1[r],p1[r+1]);b=max3f(b,p1[r+2],p1[r+3]);}
  const float m=max2f(a,b);
  auto rr=__builtin_amdgcn_permlane32_swap(__float_as_uint(m),__float_as_uint(m),false,false);
  return max2f(__uint_as_float(rr[0]),__uint_as_float(rr[1]));
}
__device__ __forceinline__ void pv(f32x16*o,int vb,bf16x8 pa0,bf16x8 pa1,bf16x8 pa2,bf16x8 pa3){
  #pragma unroll
  for(int d0=0;d0<2;++d0){s16x4 lo[4],hi[4];
    #pragma unroll
    for(int ks=0;ks<4;++ks){
      asm volatile("ds_read_b64_tr_b16 %0,%1 offset:%c2":"=&v"(lo[ks]):"v"(vb),"i"(d0*4096+ks*1024):"memory");
      asm volatile("ds_read_b64_tr_b16 %0,%1 offset:%c2":"=&v"(hi[ks]):"v"(vb),"i"(d0*4096+ks*1024+512):"memory");}
    asm volatile("s_waitcnt lgkmcnt(0)":::"memory");SBAR();
    #define PK(k) (bf16x8){lo[k][0],lo[k][1],lo[k][2],lo[k][3],hi[k][0],hi[k][1],hi[k][2],hi[k][3]}
    o[d0]=__builtin_amdgcn_mfma_f32_32x32x16_bf16(pa0,PK(0),o[d0],0,0,0);
    o[d0]=__builtin_amdgcn_mfma_f32_32x32x16_bf16(pa1,PK(1),o[d0],0,0,0);
    o[d0]=__builtin_amdgcn_mfma_f32_32x32x16_bf16(pa2,PK(2),o[d0],0,0,0);
    o[d0]=__builtin_amdgcn_mfma_f32_32x32x16_bf16(pa3,PK(3),o[d0],0,0,0);
    #undef PK
  }
}

#ifndef ATTN_STORE16
#define ATTN_STORE16(p,v) (*(u32x4*)(p)=(v))
#endif
template<int THRL> __device__ __forceinline__ void attn_unit(int b,int h,long qrow0,int nvalid,int t_base,int NT,int lastmode,float*part_o,float*part_ml,const bf16*Q,const bf16*__restrict__ K,const bf16*__restrict__ V,bf16*O,char*shm){
  int tid_=threadIdx.x; asm volatile("":"+v"(tid_)); const int tid=tid_,lane=tid&63,r32=lane&31,hi=lane>>5; const int wid=__builtin_amdgcn_readfirstlane(tid>>6);
  const long rowbase=(long)b*LSEQ; const long metaoff=((long)(NREALR+b*16)-rowbase)*KP;
  const bf16*Qw=Q+(qrow0+wid*QBLK)*QP+h*D;
  const bf16*Kh=K+rowbase*KP+(h>>2)*D,*Vh=V+rowbase*KP+(h>>2)*D;
  const unsigned lds0=(unsigned)(uintptr_t)shm;
  float*wsf=(float*)(shm+LDS_WS)+wid*64;
  const bf16*ksrc=Kh+(long)lane*KP+wid*8;
  const bf16*vsrc=Vh+(long)(16*(wid&3)+(lane>>2))*KP+(wid>>2)*32+(lane&3)*8;
  const unsigned kdst=lds0+LDS_K+wid*1024, vdst=lds0+LDS_V+wid*1024;
  #define TOFF(tt) ((((tt)+t_base)<256)?(long)((tt)+t_base)*KVBLK*KP:metaoff)
  #define DMA_K(t,slot) glds16(ksrc+TOFF(t),(unsigned)__builtin_amdgcn_readfirstlane(kdst+(slot)))
  #define DMA_V(t,slot) glds16(vsrc+TOFF(t),(unsigned)__builtin_amdgcn_readfirstlane(vdst+(slot)))
  const int vb0=(int)(lds0+LDS_V)+((lane>>4)&1)*32+(lane&3)*8+(4*hi+((lane&15)>>2))*64;
  const char*Kbase=shm+LDS_K; bf16x8 kf[8];
  const lds_cptr shm3=(lds_cptr)shm; const lds_cptr kp0=shm3+LDS_K+hi*1024+r32*16; const lds_cptr vp0=shm3+LDS_V+((lane>>4)&1)*32+(lane&3)*8+(4*hi+((lane&15)>>2))*64;
  DMA_K(0,0);DMA_V(0,0);DMA_K(1,SLOTB);
  bf16x8 qr[4];
  #pragma unroll
  for(int d0=0;d0<4;++d0)qr[d0]=*reinterpret_cast<const bf16x8*>(&Qw[(long)r32*QP+d0*16+hi*8]);
  float mhat=0.f,l_reg=0.f;f32x16 o[2];o[0]=f32x16{};o[1]=f32x16{};f32x16 negm=f32x16{};asm volatile("":"+v"(negm));
    #define CMASK(P0,P1,t) do{}while(0)
  bool resc=false;
  #define START(P0,P1) do{ const float rm=rowmax(P0,P1); resc=false; \
    { const float dl=rm; mhat=fadd_s(mhat,dl); \
      _Pragma("unroll") for(int r=0;r<16;++r){P0[r]=fsub_s(P0[r],dl);P1[r]=fsub_s(P1[r],dl);} \
      _Pragma("unroll") for(int r=0;r<16;++r)negm[r]=-mhat; asm volatile("":"+v"(negm)); } \
    _Pragma("unroll") for(int r=0;r<16;++r)P0[r]=__builtin_amdgcn_exp2f(P0[r]); }while(0)
  #define RESC() do{ if(resc){ asm volatile("s_waitcnt lgkmcnt(0)":::"memory"); \
      _Pragma("unroll") for(int d_=0;d_<2;++d_) _Pragma("unroll") for(int r=0;r<16;++r)o[d_][r]*=wsf[crow(r,hi)]; } }while(0)
  f32x16 pA0,pA1,pB0,pB1;
  int sl_prev=0,sl_cur=0,sl_next=SLOTB;
  #define ROT() do{sl_prev=sl_cur;sl_cur=sl_next;sl_next=(sl_next==(NSLOT-1)*SLOTB)?0:sl_next+SLOTB;}while(0)
  DMA_K(2,2*SLOTB);
  WAIT_BAR(3);
  qkt(pA0,pA1,Kbase,qr,negm,r32,hi);asm volatile("s_nop 15\n\ts_nop 7":"+v"(pA0),"+v"(pA1));CMASK(pA0,pA1,0);
  START(pA0,pA1);
  _Pragma("unroll") for(int r=0;r<16;++r)pA1[r]=__builtin_amdgcn_exp2f(pA1[r]);
  WAIT_BAR(0);
  DMA_K(3,0);DMA_V(1,SLOTB);
  ROT();
  kload8(kf,kp0+sl_cur);
  WAIT_BAR(2);
  s16x4 vlo[8],vhi[8]; u32x4 pw0,pw1,pw2,pw3;
  #define PKW(P,B) cvtpk_s(P[B],P[B+1])
  #define PAF(k) __builtin_bit_cast(bf16x8,pw##k)
  #define VFR(i) (bf16x8){vlo[i][0],vlo[i][1],vlo[i][2],vlo[i][3],vhi[i][0],vhi[i][1],vhi[i][2],vhi[i][3]}
  #define PIN(x) asm volatile("":"+v"(x))
  #define MX3(a,b,c) __builtin_fmaxf(__builtin_fmaxf((a),(b)),(c))
  #define GAPA(MF,A0,A1,A2,A3,W0,W1,PW) do{ MF; sacc+=A0; sacc+=A1; sacc+=A2; sacc+=A3; PIN(sacc); W0; W1; PIN(PW); SBAR(); }while(0)
  #define EX(v) __builtin_amdgcn_exp2f(v)
  #define GAPB(MF,X,B) do{ MF; X[B]=EX(X[B]); X[B+1]=EX(X[B+1]); X[B+2]=EX(X[B+2]); X[B+3]=EX(X[B+3]); PIN(X); SBAR(); }while(0)
  #define VRD(i) do{ vlo[i]=vtr(vp_+(((i)>>2)*4096+((i)&3)*1024)); vhi[i]=vtr(vp_+(((i)>>2)*4096+((i)&3)*1024+512)); }while(0)
  #define KRD(G,j) do{ if(G){ kload2(kf,kp0+sl_next,j); SBAR(); } }while(0)
  #define STEP(C0,C1,P0,P1,t,GK,GV,GL) do{ SBAR(); \
    const lds_cptr vp_=vp0+sl_prev; \
    VRD(0); SBAR(); float sacc=(P0[0]+P0[1]); \
    GAPA(C0=__builtin_amdgcn_mfma_f32_32x32x16_bf16(kf[0],qr[0],negm,0,0,0), P0[2],P0[3],P0[4],P0[5],     pw0[0]=PKW(P0,0), pw0[1]=PKW(P0,2), pw0); \
    VRD(4); SBAR(); GAPA(C1=__builtin_amdgcn_mfma_f32_32x32x16_bf16(kf[1],qr[0],negm,0,0,0), P0[6],P0[7],P0[8],P0[9],     pw0[2]=PKW(P0,4), pw0[3]=PKW(P0,6), pw0); \
    VRD(1); SBAR(); GAPA(C0=__builtin_amdgcn_mfma_f32_32x32x16_bf16(kf[2],qr[1],C0,0,0,0),   P0[10],P0[11],P0[12],P0[13], pw1[0]=PKW(P0,8), pw1[1]=PKW(P0,10), pw1); \
    VRD(5); SBAR(); GAPA(C1=__builtin_amdgcn_mfma_f32_32x32x16_bf16(kf[3],qr[1],C1,0,0,0),   P0[14],P0[15],P1[0],P1[1],   pw1[2]=PKW(P0,12),pw1[3]=PKW(P0,14), pw1); \
    VRD(2); SBAR(); GAPA(C0=__builtin_amdgcn_mfma_f32_32x32x16_bf16(kf[4],qr[2],C0,0,0,0),   P1[2],P1[3],P1[4],P1[5],     pw2[0]=PKW(P1,0), pw2[1]=PKW(P1,2), pw2); \
    VRD(6); SBAR(); GAPA(C1=__builtin_amdgcn_mfma_f32_32x32x16_bf16(kf[5],qr[2],C1,0,0,0),   P1[6],P1[7],P1[8],P1[9],     pw2[2]=PKW(P1,4), pw2[3]=PKW(P1,6), pw2); \
    VRD(3); SBAR(); GAPA(C0=__builtin_amdgcn_mfma_f32_32x32x16_bf16(kf[6],qr[3],C0,0,0,0),   P1[10],P1[11],P1[12],P1[13], pw3[0]=PKW(P1,8), pw3[1]=PKW(P1,10), pw3); \
    VRD(7); SBAR(); GAPA(C1=__builtin_amdgcn_mfma_f32_32x32x16_bf16(kf[7],qr[3],C1,0,0,0),   P1[14],P1[15],0.f,0.f,       pw3[2]=PKW(P1,12),pw3[3]=PKW(P1,14), pw3); \
    l_reg+=sacc; \
    if(GK){DMA_K((t)+3,sl_cur);} if(GV){DMA_V((t)+1,sl_next);} \
    CMASK(C0,C1,t); \
    { float a=MX3(C0[0],C0[1],C1[0]),b=MX3(C0[2],C0[3],C1[1]); a=MX3(a,C1[2],C1[3]); \
      _Pragma("unroll") for(int r=4;r<16;r+=4){a=MX3(a,C0[r],C0[r+1]);b=MX3(b,C0[r+2],C0[r+3]);a=MX3(a,C1[r],C1[r+1]);b=MX3(b,C1[r+2],C1[r+3]);} \
      float rm=__builtin_fmaxf(a,b); { auto rr=__builtin_amdgcn_permlane32_swap(__float_as_uint(rm),__float_as_uint(rm),false,false); rm=__builtin_fmaxf(__uint_as_float(rr[0]),__uint_as_float(rr[1])); } \
      resc=false; \
      if(__builtin_expect(__any(rm>(float)THRL),0)){ const float dl=__builtin_fmaxf(rm,0.f); mhat+=dl; \
        _Pragma("unroll") for(int r=0;r<16;++r){C0[r]-=dl;C1[r]-=dl;} \
        _Pragma("unroll") for(int r=0;r<16;++r)negm[r]=-mhat; asm volatile("":"+v"(negm)); \
        const float f=__builtin_amdgcn_exp2f(-dl); l_reg*=f; if(hi==0)wsf[r32]=f; resc=true; } } \
    SBAR(); \
    GAPB(o[0]=__builtin_amdgcn_mfma_f32_32x32x16_bf16(PAF(0),VFR(0),o[0],0,0,0), C0,0); \
    GAPB(o[1]=__builtin_amdgcn_mfma_f32_32x32x16_bf16(PAF(0),VFR(4),o[1],0,0,0), C0,4); \
    KRD(GL,0); GAPB(o[0]=__builtin_amdgcn_mfma_f32_32x32x16_bf16(PAF(1),VFR(1),o[0],0,0,0), C0,8); \
    KRD(GL,1); GAPB(o[1]=__builtin_amdgcn_mfma_f32_32x32x16_bf16(PAF(1),VFR(5),o[1],0,0,0), C0,12); \
    KRD(GL,2); GAPB(o[0]=__builtin_amdgcn_mfma_f32_32x32x16_bf16(PAF(2),VFR(2),o[0],0,0,0), C1,0); \
    KRD(GL,3); GAPB(o[1]=__builtin_amdgcn_mfma_f32_32x32x16_bf16(PAF(2),VFR(6),o[1],0,0,0), C1,4); \
    GAPB(o[0]=__builtin_amdgcn_mfma_f32_32x32x16_bf16(PAF(3),VFR(3),o[0],0,0,0), C1,8); \
    GAPB(o[1]=__builtin_amdgcn_mfma_f32_32x32x16_bf16(PAF(3),VFR(7),o[1],0,0,0), C1,12); \
    }while(0)
  int t=1;
  #undef CMASK
  #define CMASK(P0,P1,t) do{}while(0)
  for(;t+5<NT;t+=2){
    STEP(pB0,pB1,pA0,pA1,t,true,true,true);     WAIT_BAR(2); RESC(); ROT();
    STEP(pA0,pA1,pB0,pB1,t+1,true,true,true);   WAIT_BAR(2); RESC(); ROT();
  }
  #undef CMASK
  #define CMASK(P0,P1,t) do{ if((t)==NT-1){ if(lastmode==2){ _Pragma("unroll") for(int r_=0;r_<8;++r_)P0[r_]=-INFINITY; } _Pragma("unroll") for(int r_=8;r_<16;++r_)P0[r_]=-INFINITY; _Pragma("unroll") for(int r_=0;r_<16;++r_)P1[r_]=-INFINITY; } }while(0)
  #define ENDW(tt) do{ if((tt)+3<NT){WAIT_BAR(2);} else if((tt)+2<NT){WAIT_BAR(1);} else {WAIT_BAR(0);} }while(0)
  for(;t+1<NT;t+=2){
    STEP(pB0,pB1,pA0,pA1,t,(t+3<NT),(t+1<NT),(t+1<NT));       ENDW(t);   RESC(); ROT();
    STEP(pA0,pA1,pB0,pB1,t+1,(t+4<NT),(t+2<NT),(t+2<NT));     ENDW(t+1); RESC(); ROT();
  }
  { float sacc=pA0[0]+pA0[1]; _Pragma("unroll") for(int r=2;r<16;++r)sacc+=pA0[r]; _Pragma("unroll") for(int r=0;r<16;++r)sacc+=pA1[r]; l_reg+=sacc;
    pw0=(u32x4){PKW(pA0,0),PKW(pA0,2),PKW(pA0,4),PKW(pA0,6)};pw1=(u32x4){PKW(pA0,8),PKW(pA0,10),PKW(pA0,12),PKW(pA0,14)};pw2=(u32x4){PKW(pA1,0),PKW(pA1,2),PKW(pA1,4),PKW(pA1,6)};pw3=(u32x4){PKW(pA1,8),PKW(pA1,10),PKW(pA1,12),PKW(pA1,14)};
    SBAR(); pv(o,vb0+sl_prev,PAF(0),PAF(1),PAF(2),PAF(3)); }
  #undef PKW
  #undef PAF
  #undef VFR
  #undef PIN
  #undef MX3
  #undef GAPA
  #undef GAPB
  #undef EX
  #undef VRD
  #undef KRD
  #undef STEP
  #undef ENDW
  {auto rr=__builtin_amdgcn_permlane32_swap(__float_as_uint(l_reg),__float_as_uint(l_reg),false,false);l_reg=__uint_as_float(rr[0])+__uint_as_float(rr[1]);}
  if(hi==0)wsf[32+r32]=l_reg;asm volatile("s_waitcnt lgkmcnt(0)":::"memory");
  if(part_o){ if(wid==0){
    _Pragma("unroll") for(int r=0;r<8;++r){ _Pragma("unroll") for(int d0=0;d0<2;++d0)part_o[crow(r,hi)*64+d0*32+r32]=o[d0][r]; }
    if(hi==0&&r32<16){part_ml[2*r32]=mhat;part_ml[2*r32+1]=l_reg;} } } else {
  float rli[16];
  #pragma unroll
  for(int r=0;r<16;++r)rli[r]=__builtin_amdgcn_rcpf(wsf[32+crow(r,hi)]);
  bf16*Ow=O+(qrow0+wid*QBLK)*QP+h*D; const int nv=nvalid-wid*QBLK;
  { bf16*stg=(bf16*)(shm+LDS_OST)+wid*2048;
    #pragma unroll
    for(int r=0;r<16;++r){const int orow=crow(r,hi);
      #pragma unroll
      for(int d0=0;d0<2;++d0)stg[orow*64+d0*32+r32]=__float2bfloat16(o[d0][r]*rli[r]);}
    asm volatile("s_waitcnt lgkmcnt(0)":::"memory");
    #pragma unroll
    for(int i=0;i<4;++i){const int row=i*8+(lane>>3),ch=lane&7; const u32x4 v=*(const u32x4*)(stg+row*64+ch*8); if(row<nv)ATTN_STORE16(Ow+(long)row*QP+ch*8,v);} } }
  asm volatile("s_waitcnt lgkmcnt(0)\n\ts_barrier":::"memory");
  #undef TOFF
  #undef DMA_K
  #undef DMA_V
  #undef CMASK
  #undef START
  #undef RESC
  #undef ROT
}
constexpr int ATTN_LDS_BYTES=LDS_BYTES;
#undef SBAR
#undef WAIT_BAR
}


#ifndef PG8_SP2
#define PG8_SP2 true
#endif
#ifndef PG8_ALIGN
#define PG8_ALIGN true
#endif
#define LAS __attribute__((address_space(3)))
#ifndef PHM
#define PHM 0xffff
#endif
using pg8::bf16_t; using pg8::f32x4; using pg8::u32x4; using pg8::bf16x8;
typedef float f32x16_t __attribute__((ext_vector_type(16)));
typedef float f32x2_tt __attribute__((ext_vector_type(2)));
constexpr size_t MiB = 1u << 20;
constexpr size_t WS_COS = 1 * MiB, WS_SIN = 3 * MiB, WS_W = 5 * MiB, WS_XN = 163 * MiB, WS_Y = 229 * MiB, WS_R3 = 295 * MiB, WS_R1 = 361 * MiB,
                 WS_K = WS_R1 + 66 * MiB, WS_V = WS_R1 + 83 * MiB, WS_AGG = 619 * MiB, WS_CIN = 628 * MiB, WS_XB = 635 * MiB, WS_HB = 637 * MiB, WS_END = 702 * MiB;
constexpr size_t WS_CNT = 65536;
constexpr size_t W_IN = 0, W_OUT = W_IN + (size_t)8 * 5632 * 1024, W_QKV = W_OUT + (size_t)8 * 1024 * 2816, W_O = W_QKV + (size_t)2 * 1536 * 1024,
                 W_RIN = W_O + (size_t)2 * 1024 * 1024, W_RG = W_RIN + (size_t)2 * 2048 * 1024, W_RO = W_RG + (size_t)2 * 4096 * 256, W_END = W_RO + (size_t)2 * 1024 * 1024;
static_assert(W_END * 2 <= 158 * MiB, "weights");
constexpr int LDS_BYTES = 147456;
constexpr float ATT_C2 = 0.125f * 1.4426950408889634f;

__device__ __forceinline__ float wave_sum(float v) {
#pragma unroll
    for (int o = 1; o < 64; o <<= 1) v += __shfl_xor(v, o);
    return v;
}
__device__ __forceinline__ unsigned f2bf(float f) { unsigned u = __builtin_bit_cast(unsigned, f); return (u + 0x7fffu + ((u >> 16) & 1u)) >> 16; }
__device__ __forceinline__ unsigned pk2(float lo, float hi) { return f2bf(lo) | (f2bf(hi) << 16); }
__device__ __forceinline__ float bf2f(unsigned b) { return __uint_as_float(b << 16); }

struct TrD { const float* W; bf16_t* WT; int K, N, k0, n0, dr0; };
__device__ __forceinline__ void tr_load(float (&r)[32], const TrD& d, int lane) {
#pragma unroll
    for (int i = 0; i < 32; ++i) { const int kk = 2 * i + (lane >> 5); r[i] = d.W[(size_t)(d.k0 + kk) * d.N + d.n0 + (lane & 31)]; }
}
__device__ __forceinline__ void tr_finish(const float (&r)[32], const TrD& d, float* scr, int lane) {
#pragma unroll
    for (int i = 0; i < 32; ++i) { const int kk = 2 * i + (lane >> 5); scr[kk * 33 + (lane & 31)] = r[i]; }
    __builtin_amdgcn_s_waitcnt(0); asm volatile("" ::: "memory");
    const int c = lane & 7;
#pragma unroll
    for (int j = 0; j < 4; ++j) { const int n = (lane >> 3) + 8 * j; const float* s = scr + (8 * c) * 33 + n;
        u32x4 o; o.x = pk2(s[0 * 33], s[1 * 33]); o.y = pk2(s[2 * 33], s[3 * 33]); o.z = pk2(s[4 * 33], s[5 * 33]); o.w = pk2(s[6 * 33], s[7 * 33]);
        *(u32x4*)(d.WT + (size_t)(d.dr0 + n) * d.K + d.k0 + 8 * c) = o; }
    asm volatile("s_waitcnt lgkmcnt(0)" ::: "memory");
}

#define XB_TMO      128
#define XB_XCNT(j)  (256  + 64 * (j))
#define XB_XSUB(j)  (1280 + 64 * (j))
#define XB_XGEN(j)  (2304 + 64 * (j))
#define XB_TOP      3328
#define XB_TOPGEN   3392
#define XCD_BAR_WORDS 3456
#define XB_SPIN_CAP (1u << 18)

__device__ __forceinline__ unsigned xb_ld(unsigned* p)              { return __hip_atomic_load(p, __ATOMIC_RELAXED, __HIP_MEMORY_SCOPE_AGENT); }
__device__ __forceinline__ unsigned xb_add(unsigned* p, unsigned v) { return __hip_atomic_fetch_add(p, v, __ATOMIC_RELAXED, __HIP_MEMORY_SCOPE_AGENT); }
__device__ __forceinline__ unsigned xb_xcc_id() { return (unsigned)__builtin_amdgcn_s_getreg((3 << 11) | 20) & 0xFu; }
#define XB_SPIN(cond, bar) do { unsigned _sp = 0; while (cond) { __builtin_amdgcn_s_sleep(1); \
    if ((++_sp & 255u) == 0u) { if (xb_ld(&(bar)[XB_TMO])) break; if (_sp > XB_SPIN_CAP) { atomicAdd(&(bar)[XB_TMO], 1u); break; } } } } while (0)

struct XcdBarrier {
    unsigned* bar; unsigned x;
    volatile LAS unsigned* st;
};

__device__ __forceinline__ XcdBarrier xcd_barrier_post(unsigned* bar, volatile LAS unsigned* st) {
    XcdBarrier b; b.bar = bar; b.x = xb_xcc_id(); b.st = st;
    if (threadIdx.x == 0) (void)xb_add(&bar[XB_XCNT(b.x)], 1u);
    return b;
}
__device__ __forceinline__ void xcd_barrier_complete(unsigned* bar, unsigned x, unsigned& nloc, unsigned& nx) {
    const unsigned G = gridDim.x * gridDim.y * gridDim.z;
    unsigned sum, cnt, mine, sp = 0u;
    for (;;) {
        sum = 0u; cnt = 0u; mine = 0u;
#pragma unroll
        for (unsigned j = 0; j < 16; ++j) { const unsigned c = xb_ld(&bar[XB_XCNT(j)]); sum += c; cnt += (c > 0u) ? 1u : 0u; mine = (j == x) ? c : mine; }
        if (sum == G) break;
        __builtin_amdgcn_s_sleep(1);
        if ((++sp & 255u) == 0u) { if (xb_ld(&bar[XB_TMO])) break; if (sp > XB_SPIN_CAP) { atomicAdd(&bar[XB_TMO], 1u); break; } }
    }
    nloc = mine > 0u ? mine : 1u; nx = cnt > 0u ? cnt : 1u;
}

__device__ __forceinline__ void xcd_barrier(const XcdBarrier& b) {
    asm volatile("s_waitcnt vmcnt(0)" ::: "memory");
    __syncthreads();
    if (threadIdx.x == 0) {
        unsigned* bar = b.bar;
        __builtin_amdgcn_s_waitcnt(0);
        unsigned nloc = b.st[0], nx = b.st[1];
        if (nloc == 0u) { xcd_barrier_complete(bar, b.x, nloc, nx); b.st[0] = nloc; b.st[1] = nx; }
        const unsigned old = xb_add(&bar[XB_XSUB(b.x)], 1u);
        const unsigned gen = old / nloc;
        if (old + 1u == (gen + 1u) * nloc) {
            __builtin_amdgcn_fence(__ATOMIC_RELEASE, "agent");
            asm volatile("s_waitcnt vmcnt(0)" ::: "memory");
            const unsigned og = xb_add(&bar[XB_TOP], 1u);
            const unsigned tg = og / nx;
            if (og + 1u == (tg + 1u) * nx) xb_add(&bar[XB_TOPGEN], 1u);
            else XB_SPIN(xb_ld(&bar[XB_TOPGEN]) == tg, bar);
            __builtin_amdgcn_fence(__ATOMIC_ACQUIRE, "agent");
            xb_add(&bar[XB_XGEN(b.x)], 1u);
            asm volatile("s_waitcnt vmcnt(0)" ::: "memory");
        } else {
            XB_SPIN(xb_ld(&bar[XB_XGEN(b.x)]) == gen, bar);
            __builtin_amdgcn_fence(__ATOMIC_ACQUIRE, "agent");
            asm volatile("s_waitcnt vmcnt(0)" ::: "memory");
        }
    }
    __syncthreads();
}

struct Args { const float* in[16]; float* out; unsigned char* ws; };

__device__ __forceinline__ float* hrow_ptr(float* out, float* hmeta, int row) { return row < NREAL ? out + (size_t)row * 1024 : hmeta + (size_t)(row - NREAL) * 1024; }

__device__ __forceinline__ float norm_row_store(const f32x4 (&v)[4], const float* g, bf16_t* orow, int lane) {
    float s = 0.f;
#pragma unroll
    for (int j = 0; j < 4; ++j) s += (v[j].x * v[j].x + v[j].y * v[j].y) + (v[j].z * v[j].z + v[j].w * v[j].w);
    const float r = __builtin_amdgcn_rsqf(wave_sum(s) * (1.f / 1024.f) + NORM_EPS);
    unsigned long long* o8 = (unsigned long long*)orow + lane;
#pragma unroll
    for (int j = 0; j < 4; ++j) { const f32x4 gg = ((const f32x4*)g)[lane + 64 * j];
        o8[64 * j] = (unsigned long long)pk2(v[j].x * r * gg.x, v[j].y * r * gg.y) | ((unsigned long long)pk2(v[j].z * r * gg.z, v[j].w * r * gg.w) << 32); }
    return r;
}

__device__ __forceinline__ float norm_row_store_g(const f32x4 (&v)[4], const f32x4 (&gg)[4], bf16_t* orow, int lane) {
    float s = 0.f;
#pragma unroll
    for (int j = 0; j < 4; ++j) s += (v[j].x * v[j].x + v[j].y * v[j].y) + (v[j].z * v[j].z + v[j].w * v[j].w);
    const float r = __builtin_amdgcn_rsqf(wave_sum(s) * (1.f / 1024.f) + NORM_EPS);
    unsigned long long* o8 = (unsigned long long*)orow + lane;
#pragma unroll
    for (int j = 0; j < 4; ++j) o8[64 * j] = (unsigned long long)pk2(v[j].x * r * gg[j].x, v[j].y * r * gg[j].y) | ((unsigned long long)pk2(v[j].z * r * gg[j].z, v[j].w * r * gg[j].w) << 32);
    return r;
}

__device__ __forceinline__ int crow_(int r, int hi) { return (r & 3) + 8 * (r >> 2) + 4 * hi; }
__device__ __forceinline__ void thin_tile(float* T, float* part, const bf16_t* A, int lda, const bf16_t* B0, const bf16_t* B1, int ldb, int K, int wave, int lane, int tid) {
    const int r32 = lane & 31, hi = lane >> 5, kc = K >> 3, kbeg = wave * kc;
    const bf16_t* ap = A + (size_t)r32 * lda + kbeg + hi * 8;
    const bf16_t* b0p = B0 + (size_t)r32 * ldb + kbeg + hi * 8;
    const bf16_t* b1p = B1 + (size_t)r32 * ldb + kbeg + hi * 8;
    f32x16_t c0 = {}, c1 = {};
#pragma unroll 1
    for (int k = 0; k < kc; k += 128) {
        bf16x8 a[8], b0[8], b1[8];
#pragma unroll
        for (int i = 0; i < 8; ++i) if (k + 16 * i < kc) { a[i] = *(const bf16x8*)(ap + k + 16 * i); b0[i] = *(const bf16x8*)(b0p + k + 16 * i); b1[i] = *(const bf16x8*)(b1p + k + 16 * i); }
#pragma unroll
        for (int i = 0; i < 8; ++i) if (k + 16 * i < kc) {
            c0 = __builtin_amdgcn_mfma_f32_32x32x16_bf16(a[i], b0[i], c0, 0, 0, 0);
            c1 = __builtin_amdgcn_mfma_f32_32x32x16_bf16(a[i], b1[i], c1, 0, 0, 0); }
    }
#pragma unroll
    for (int r = 0; r < 16; ++r) { const int tok = crow_(r, hi); part[wave * 2048 + tok * 64 + r32] = c0[r]; part[wave * 2048 + tok * 64 + 32 + r32] = c1[r]; }
    __syncthreads();
    for (int i = tid; i < 2048; i += 512) { float s = 0.f;
#pragma unroll
        for (int w = 0; w < 8; ++w) s += part[w * 2048 + i];
        T[i] = s; }
    __syncthreads();
}
__device__ __forceinline__ void thin_tile_h(float* T, float* part, const bf16_t* A, int lda, const bf16_t* Bt, int brow, int ldb, int K, int wave, int lane, int tid) {
    const int r32 = lane & 31, hi = lane >> 5, kc = K >> 3, kbeg = wave * kc;
    const bf16_t* ap = A + (size_t)r32 * lda + kbeg + hi * 8;
    const bf16_t* b0p = Bt + (size_t)brow * ldb + kbeg + hi * 8;
    f32x16_t c0 = {};
#pragma unroll 1
    for (int k = 0; k < kc; k += 176) {
        bf16x8 a[11], b0[11];
#pragma unroll
        for (int i = 0; i < 11; ++i) if (k + 16 * i < kc) { a[i] = *(const bf16x8*)(ap + k + 16 * i); b0[i] = *(const bf16x8*)(b0p + k + 16 * i); }
#pragma unroll
        for (int i = 0; i < 11; ++i) if (k + 16 * i < kc) c0 = __builtin_amdgcn_mfma_f32_32x32x16_bf16(a[i], b0[i], c0, 0, 0, 0);
    }
#pragma unroll
    for (int r = 0; r < 16; ++r) part[wave * 1024 + crow_(r, hi) * 32 + r32] = c0[r];
    __syncthreads();
    for (int i = tid; i < 1024; i += 512) { float s = 0.f;
#pragma unroll
        for (int w = 0; w < 8; ++w) s += part[w * 1024 + i];
        T[(i >> 5) * 64 + (i & 31)] = s; }
    __syncthreads();
}
enum ThinKind { TK_SWIGLU = 0, TK_PLAIN = 1, TK_RECIN = 2, TK_QKV = 3, TK_GATE = 4 };
struct ThinP { const bf16_t* A; int lda; const bf16_t* Bt; int ldb; int K; int nunits;
               bf16_t* O0; bf16_t* O1; bf16_t* O2; unsigned short* AB; const float* p0; const float* p1; };
template <int KIND> __device__ __forceinline__ void thin_phase(unsigned char* lds, const ThinP& P, int tid, int wave, int lane, int bid, int G) {
    float* part = (float*)lds; float* T = (float*)(lds + 65536);
    for (int u = bid; u < P.nunits; u += G) {
        int r0, r1, ak = 0;
        if (KIND == TK_SWIGLU) {
            const int c0 = 16 * u, rg = (c0 >> 7) * 256 + (c0 & 127), r32 = lane & 31;
            thin_tile_h(T, part, P.A + (size_t)NREAL * P.lda, P.lda, P.Bt, rg + (r32 & 15) + (r32 >> 4) * 128, P.ldb, P.K, wave, lane, tid);
            { const int idx = tid; const int r = idx >> 4, c = idx & 15; const float gt = T[r * 64 + c], up = T[r * 64 + 16 + c];
              P.O0[(size_t)(NREAL + r) * 2816 + c0 + c] = (bf16_t)f2bf(gt * pg8::sigm(gt) * up); }
            __syncthreads(); continue;
        } else if (KIND == TK_PLAIN) {
            thin_tile_h(T, part, P.A + (size_t)NREAL * P.lda, P.lda, P.Bt, 32 * u + (lane & 31), P.ldb, P.K, wave, lane, tid);
            for (int idx = tid; idx < 1024; idx += 512) { const int r = idx >> 5, c = idx & 31; P.O0[(size_t)(NREAL + r) * 1024 + 32 * u + c] = (bf16_t)f2bf(T[r * 64 + c]); }
            __syncthreads(); continue;
        }
        else if (KIND == TK_RECIN) {
            thin_tile_h(T, part, P.A + (size_t)NREAL * P.lda, P.lda, P.Bt, 32 * u + (lane & 31), P.ldb, P.K, wave, lane, tid);
            for (int idx = tid; idx < 1024; idx += 512) { const int r = idx >> 5, c = idx & 31; const float v = T[r * 64 + c];
                if (u < 32) P.O0[(size_t)(NREAL + r) * 1024 + 32 * u + c] = (bf16_t)f2bf(pg8::gelu_tanh(v));
                else P.O1[(size_t)(NREAL + r) * 1024 + 32 * (u - 32) + c] = (bf16_t)f2bf(v); }
            __syncthreads(); continue;
        } else if (KIND == TK_GATE) {
            const int d = u >> 6, h = (u >> 4) & 3, g16 = u & 15, cb = h * 256 + g16 * 16, rg = (d * 8 + h * 2 + (g16 >> 3)) * 256 + (g16 & 7) * 16, r32 = lane & 31;
            thin_tile_h(T, part, P.A + (size_t)NREAL * P.lda + (size_t)h * (ROWS_ALLOC * 256), P.lda, P.Bt, rg + (r32 & 15) + (r32 >> 4) * 128, P.ldb, P.K, wave, lane, tid);
            { const int idx = tid; const int r = idx >> 4, c = idx & 15, ch = cb + c;
              P.AB[((size_t)d * NROWS + NREAL + r) * 1024 + ch] = (unsigned short)pg8::q8pair(pg8::sigm(T[r * 64 + c] + P.p0[(d * 2 + 0) * 1024 + ch]), pg8::sigm(T[r * 64 + 16 + c] + P.p0[(d * 2 + 1) * 1024 + ch])); }
            __syncthreads(); continue;
        }
        else if (KIND == TK_QKV) { r0 = (u >> 2) * 256 + 32 * (u & 3); r1 = r0 + 128; }
        else { const int d = u >> 5, h = (u >> 3) & 3, g32 = u & 7; r0 = (d * 8 + h * 2 + (g32 >> 2)) * 256 + (g32 & 3) * 32; r1 = r0 + 128; ak = h * (ROWS_ALLOC * 256); }
        thin_tile(T, part, P.A + (size_t)NREAL * P.lda + ak, P.lda, P.Bt + (size_t)r0 * P.ldb, P.Bt + (size_t)r1 * P.ldb, P.ldb, P.K, wave, lane, tid);
        if (KIND == TK_SWIGLU) {
        } else if (KIND == TK_PLAIN) {
        } else if (KIND == TK_RECIN) {
            for (int idx = tid; idx < 2048; idx += 512) { const int r = idx >> 6, c = idx & 63; const float v = T[idx];
                if (u < 16) P.O0[(size_t)(NREAL + r) * 1024 + 64 * u + c] = (bf16_t)f2bf(pg8::gelu_tanh(v));
                else P.O1[(size_t)(NREAL + r) * 1024 + 64 * (u - 16) + c] = (bf16_t)f2bf(v); }
        } else if (KIND == TK_QKV) {
            for (int idx = tid; idx < 2048; idx += 512) { const int r = idx >> 6, dd = idx & 63; const float v = T[idx];
                if (u < 20) { const float rms = __builtin_amdgcn_rsqf(wave_sum(v * v) * (1.f / 64.f) + NORM_EPS);
                    if (u < 16) P.O0[(size_t)(NREAL + r) * 1024 + 64 * u + dd] = (bf16_t)f2bf(v * rms * P.p0[dd] * ATT_C2);
                    else P.O1[(size_t)(NREAL + r) * 256 + 64 * (u - 16) + dd] = (bf16_t)f2bf(v * rms * P.p1[dd]); }
                else P.O2[(size_t)(NREAL + r) * 256 + 64 * (u - 20) + dd] = (bf16_t)f2bf(v); }
        } else {
            const int d = u >> 5, h = (u >> 3) & 3, g32 = u & 7, cb = h * 256 + g32 * 32;
            for (int idx = tid; idx < 1024; idx += 512) { const int r = idx >> 5, c = idx & 31, ch = cb + c;
                P.AB[((size_t)d * NROWS + NREAL + r) * 1024 + ch] = (unsigned short)pg8::q8pair(pg8::sigm(T[r * 64 + c] + P.p0[(d * 2 + 0) * 1024 + ch]), pg8::sigm(T[r * 64 + 32 + c] + P.p0[(d * 2 + 1) * 1024 + ch])); }
        }
        __syncthreads();
    }
}

__device__ __forceinline__ int chunk_row0(int b, int j) { return j == 0 ? NREAL + b * 16 : b * 16384 + (j - 1) * 64; }
__device__ __forceinline__ void ab_from(unsigned w, float xc, float sp, float& a, float& b) {
    const float r = (float)(w & 0xffu) * (1.f / 255.f), ig = (float)((w >> 8) & 0xffu) * (1.f / 255.f);
    a = __builtin_amdgcn_exp2f(sp * r); b = __builtin_amdgcn_sqrtf(__builtin_fmaf(-a, a, 1.f)) * (ig * xc);
}
__device__ __forceinline__ float sp_of(float lam) { const float e = __builtin_amdgcn_exp2f(-LOG2E * lam); return -8.f * LOG2E * (0.6931471805599453f * __builtin_amdgcn_logf(1.f + e)); }
template <int LEN> __device__ __forceinline__ void scanA_item(const unsigned short* ab, const bf16_t* xc, int dir, float sp, float rb, float ib, f32x2_tt* outp) {
    constexpr int BT = LEN < 32 ? LEN : 32;
    float h = 0.f, P = 1.f;
#pragma unroll 1
    for (int t0 = 0; t0 < LEN; t0 += BT) {
        unsigned w[BT]; unsigned short x[BT];
#pragma unroll
        for (int t = 0; t < BT; ++t) { const int tt = dir ? LEN - 1 - (t0 + t) : t0 + t; w[t] = ab[(size_t)tt * 1024]; x[t] = xc[(size_t)tt * 256]; }
#pragma unroll
        for (int t = 0; t < BT; ++t) { float a, b; ab_from(w[t], bf2f(x[t]), sp, a, b); h = a * h + b; P *= a; }
    }
    *outp = (f32x2_tt){P, h};
}
template <int LEN> __device__ __forceinline__ void scanC_item(const unsigned short* abf, const unsigned short* abb, const bf16_t* xc, const bf16_t* gate, bf16_t* y, float cf, float cb, float spf, float spb, float rbf, float ibf, float rbb, float ibb) {
    constexpr int BT = LEN < 16 ? LEN : 16;
    float hf[LEN]; float h = cf;
#pragma unroll
    for (int t0 = 0; t0 < LEN; t0 += BT) {
        unsigned w[BT]; unsigned short x[BT];
#pragma unroll
        for (int t = 0; t < BT; ++t) { w[t] = abf[(size_t)(t0 + t) * 1024]; x[t] = xc[(size_t)(t0 + t) * 256]; }
#pragma unroll
        for (int t = 0; t < BT; ++t) { float a, b; ab_from(w[t], bf2f(x[t]), spf, a, b); h = a * h + b; hf[t0 + t] = h; }
        asm volatile("" ::: "memory");
    }
    h = cb;
#pragma unroll
    for (int t0 = LEN - BT; t0 >= 0; t0 -= BT) {
        unsigned w[BT]; unsigned short x[BT], g[BT];
#pragma unroll
        for (int t = 0; t < BT; ++t) { w[t] = abb[(size_t)(t0 + t) * 1024]; x[t] = xc[(size_t)(t0 + t) * 256]; g[t] = gate[(size_t)(t0 + t) * 1024]; }
#pragma unroll
        for (int t = BT - 1; t >= 0; --t) { float a, b; ab_from(w[t], bf2f(x[t]), spb, a, b); h = a * h + b;
            y[(size_t)(t0 + t) * 1024] = (bf16_t)f2bf((hf[t0 + t] + h) * bf2f(g[t])); }
        asm volatile("" ::: "memory");
    }
}


template <int LEN> __device__ __forceinline__ void scanA2_item(const unsigned* ab, const unsigned* xc, int dir, float sp0, float sp1, f32x4* outp) {
    constexpr int BT = LEN < 32 ? LEN : 32;
    float h0 = 0.f, P0 = 1.f, h1 = 0.f, P1 = 1.f;
#pragma unroll 1
    for (int t0 = 0; t0 < LEN; t0 += BT) {
        unsigned w[BT], x[BT];
#pragma unroll
        for (int t = 0; t < BT; ++t) { const int tt = dir ? LEN - 1 - (t0 + t) : t0 + t; w[t] = ab[(size_t)tt * 512]; x[t] = xc[(size_t)tt * 128]; }
#pragma unroll
        for (int t = 0; t < BT; ++t) { float a, b; ab_from(w[t] & 0xffffu, __uint_as_float(x[t] << 16), sp0, a, b); h0 = a * h0 + b; P0 *= a;
                                       ab_from(w[t] >> 16, __uint_as_float(x[t] & 0xffff0000u), sp1, a, b); h1 = a * h1 + b; P1 *= a; }
    }
    *outp = (f32x4){P0, h0, P1, h1};
}
typedef unsigned u32x2_tt __attribute__((ext_vector_type(2)));
template <int LEN> __device__ __forceinline__ void scanA4_item(const u32x2_tt* ab, const u32x2_tt* xc, int dir, f32x4 sp, f32x4* outp) {
    constexpr int BT = LEN < 32 ? LEN : 32;
    f32x4 h = {0.f, 0.f, 0.f, 0.f}, P = {1.f, 1.f, 1.f, 1.f};
#pragma unroll 1
    for (int t0 = 0; t0 < LEN; t0 += BT) {
        u32x2_tt w[BT], x[BT];
#pragma unroll
        for (int t = 0; t < BT; ++t) { const int tt = dir ? LEN - 1 - (t0 + t) : t0 + t; w[t] = ab[(size_t)tt * 256]; x[t] = xc[(size_t)tt * 64]; }
#pragma unroll
        for (int t = 0; t < BT; ++t) { float a, b;
            ab_from(w[t].x & 0xffffu, __uint_as_float(x[t].x << 16), sp[0], a, b); h[0] = a * h[0] + b; P[0] *= a;
            ab_from(w[t].x >> 16, __uint_as_float(x[t].x & 0xffff0000u), sp[1], a, b); h[1] = a * h[1] + b; P[1] *= a;
            ab_from(w[t].y & 0xffffu, __uint_as_float(x[t].y << 16), sp[2], a, b); h[2] = a * h[2] + b; P[2] *= a;
            ab_from(w[t].y >> 16, __uint_as_float(x[t].y & 0xffff0000u), sp[3], a, b); h[3] = a * h[3] + b; P[3] *= a; }
    }
    outp[0] = (f32x4){P[0], h[0], P[1], h[1]}; outp[1] = (f32x4){P[2], h[2], P[3], h[3]};
}
template <int LEN> __device__ __forceinline__ void scanC2_item(const unsigned* abf, const unsigned* abb, const unsigned* xc, const unsigned* gate, unsigned* y, f32x2_tt cf, f32x2_tt cb, f32x2_tt spf, f32x2_tt spb) {
    constexpr int BT = LEN < 16 ? LEN : 16;
    float hf0[LEN], hf1[LEN]; float h0 = cf.x, h1 = cf.y;
#pragma unroll
    for (int t0 = 0; t0 < LEN; t0 += BT) {
        unsigned w[BT], x[BT];
#pragma unroll
        for (int t = 0; t < BT; ++t) { w[t] = abf[(size_t)(t0 + t) * 512]; x[t] = xc[(size_t)(t0 + t) * 128]; }
#pragma unroll
        for (int t = 0; t < BT; ++t) { float a, b; ab_from(w[t] & 0xffffu, __uint_as_float(x[t] << 16), spf.x, a, b); h0 = a * h0 + b; hf0[t0 + t] = h0;
                                       ab_from(w[t] >> 16, __uint_as_float(x[t] & 0xffff0000u), spf.y, a, b); h1 = a * h1 + b; hf1[t0 + t] = h1; }
        asm volatile("" ::: "memory");
    }
    h0 = cb.x; h1 = cb.y;
#pragma unroll
    for (int t0 = LEN - BT; t0 >= 0; t0 -= BT) {
        unsigned w[BT], x[BT], g[BT];
#pragma unroll
        for (int t = 0; t < BT; ++t) { w[t] = abb[(size_t)(t0 + t) * 512]; x[t] = xc[(size_t)(t0 + t) * 128]; g[t] = gate[(size_t)(t0 + t) * 512]; }
#pragma unroll
        for (int t = BT - 1; t >= 0; --t) { float a, b; ab_from(w[t] & 0xffffu, __uint_as_float(x[t] << 16), spb.x, a, b); h0 = a * h0 + b;
            ab_from(w[t] >> 16, __uint_as_float(x[t] & 0xffff0000u), spb.y, a, b); h1 = a * h1 + b;
            y[(size_t)(t0 + t) * 512] = pk2((hf0[t0 + t] + h0) * __uint_as_float(g[t] << 16), (hf1[t0 + t] + h1) * __uint_as_float(g[t] & 0xffff0000u)); }
        asm volatile("" ::: "memory");
    }
}

typedef const __attribute__((address_space(4))) Args* KArgP;
#define KARGS() ({ KArgP p_ = (KArgP)__builtin_amdgcn_kernarg_segment_ptr(); asm volatile("" : "+s"(p_)); p_; })
#define GSYNC() do { KArgP apb_ = KARGS(); XcdBarrier b_; b_.bar = (unsigned*)(apb_->ws + 16384); b_.x = xb_xcc_id(); b_.st = (volatile LAS unsigned*)(ldsl + 131072 + 32); xcd_barrier(b_); } while (0)
#define WSP(T, off) ((T*)(ws + (off)))
#ifndef DEFER_CONV
#define DEFER_CONV 0
#endif
#define IDS() int tid_ = threadIdx.x; asm volatile("" : "+v"(tid_)); const int tid = tid_, lane = tid & 63, wave = __builtin_amdgcn_readfirstlane(tid >> 6); const int G = gridDim.x, bid = blockIdx.x; \
              const int vcu = (G % 8 == 0) ? (bid % 8) * (G / 8) + bid / 8 : bid; const int gw = vcu * 8 + wave, NGW = G * 8; const int gtid = bid * 512 + tid, GT = G * 512; \
              (void)lane; (void)vcu; (void)gw; (void)NGW; (void)gtid; (void)GT;

constexpr int IA = 8 * 2816, IB = 8 * 1408, IC = 2 * 768, ID = 2 * 512, IE = 2 * 1024, IF = 32 * 32, IG = 2 * 512, NIT = IA + IB + IC + ID + IE + IF + IG;
constexpr int N_EARLY = 2 * 2816 + 2 * 1408 + 768 + 512, N_DEFER = NIT - N_EARLY;
__device__ __forceinline__ int tr_early_item(int e) { return e < 5632 ? e : e < 8448 ? IA + (e - 5632) : e < 9216 ? IA + IB + (e - 8448) : IA + IB + IC + (e - 9216); }
__device__ __forceinline__ int tr_defer_item(int d) { return d < 16896 ? 5632 + d : d < 25344 ? IA + 2816 + (d - 16896) : d < 26112 ? IA + IB + 768 + (d - 25344) : d < 26624 ? IA + IB + IC + 512 + (d - 26112) : IA + IB + IC + ID + (d - 26624); }
static_assert(N_EARLY == 9728 && N_DEFER == 30720, "conversion item split");
__device__ __forceinline__ TrD tr_decode(KArgP ap, bf16_t* Wb, int r) {
            if (r < IA) { const int mat = r / 2816, q = r % 2816, kb = q / 176, nb = q % 176, n0 = 32 * nb, bj = n0 / 2816, c = n0 % 2816;
                return TrD{ap->in[3] + (size_t)mat * 1024 * 5632, Wb + W_IN + (size_t)mat * 5632 * 1024, 1024, 5632, 64 * kb, n0, (c >> 7) * 256 + bj * 128 + (c & 127)}; } r -= IA;
            if (r < IB) { const int mat = r / 1408, q = r % 1408, kb = q / 32, nb = q % 32;
                return TrD{ap->in[4] + (size_t)mat * 2816 * 1024, Wb + W_OUT + (size_t)mat * 1024 * 2816, 2816, 1024, 64 * kb, 32 * nb, 32 * nb}; } r -= IB;
            if (r < IC) { const int mat = r / 768, q = r % 768, kb = q / 48, nb = q % 48, n0 = 32 * nb, tile = n0 >> 8, rr = n0 & 255;
                return TrD{ap->in[5] + (size_t)mat * 1024 * 1536, Wb + W_QKV + (size_t)mat * 1536 * 1024, 1024, 1536, 64 * kb, n0, tile * 256 + 128 * ((rr & 63) >> 5) + 32 * (rr >> 6)}; } r -= IC;
            if (r < ID) { const int mat = r / 512, q = r % 512, kb = q / 32, nb = q % 32;
                return TrD{ap->in[8] + (size_t)mat * 1024 * 1024, Wb + W_O + (size_t)mat * 1024 * 1024, 1024, 1024, 64 * kb, 32 * nb, 32 * nb}; } r -= ID;
            if (r < IE) { const int mat = r / 1024, q = r % 1024, kb = q / 64, nb = q % 64;
                return TrD{ap->in[9] + (size_t)mat * 1024 * 2048, Wb + W_RIN + (size_t)mat * 2048 * 1024, 1024, 2048, 64 * kb, 32 * nb, 32 * nb}; } r -= IE;
            if (r < IF) { const int sub = r >> 5, q = r & 31, kb = q >> 3, nb = q & 7, n0 = 32 * nb, jl = sub >> 4, d = (sub >> 3) & 1, g = (sub >> 2) & 1, h = sub & 3;
                return TrD{ap->in[12] + (size_t)sub * 256 * 256, Wb + W_RG + (size_t)jl * 4096 * 256, 256, 256, 64 * kb, n0, (d * 8 + h * 2 + (n0 >> 7)) * 256 + g * 128 + (n0 & 127)}; } r -= IF;
            { const int mat = r / 512, q = r % 512, kb = q / 32, nb = q % 32;
                return TrD{ap->in[15] + (size_t)mat * 1024 * 1024, Wb + W_RO + (size_t)mat * 1024 * 1024, 1024, 1024, 64 * kb, 32 * nb, 32 * nb}; }
        }

__global__ void __launch_bounds__(512, 2) fwd_megakernel(Args args_unused) {
    extern __shared__ __attribute__((aligned(16))) unsigned char lds[];
    cg::grid_group grid = cg::this_grid();
    LAS unsigned char* ldsl = (LAS unsigned char*)lds;
    for (int u = threadIdx.x; u < 64; u += 512) ((LAS unsigned*)(ldsl + 131072))[u] = 0u;
    __syncthreads();
    { KArgP ap0 = KARGS(); (void)xcd_barrier_post((unsigned*)(ap0->ws + 16384), (volatile LAS unsigned*)(ldsl + 131072 + 32)); }
    grid.sync();

#if PHM & 1
    {
        KArgP ap = KARGS(); unsigned char* ws = ap->ws; IDS();
        float* scr = (float*)(lds + wave * 16384); bf16_t* Wb = WSP(bf16_t, WS_W);
#ifdef NANFILL
        {
            u32x4* f0 = (u32x4*)(ws + WS_Y); const size_t n16 = (WS_END - WS_Y) / 16; const u32x4 q = {0xffffffffu, 0xffffffffu, 0xffffffffu, 0xffffffffu};
            for (size_t i = gtid; i < n16; i += GT) f0[i] = q;
        }
#endif
        const bool defer_ = DEFER_CONV && G == 256; const int n_pro = defer_ ? N_EARLY : NIT;
#pragma unroll 1
        for (int it = gw; it < n_pro; it += 2 * NGW) {
            const bool hasb = it + NGW < n_pro; const int ib_ = hasb ? it + NGW : it;
            const TrD da = tr_decode(ap, Wb, defer_ ? tr_early_item(it) : it), db = tr_decode(ap, Wb, defer_ ? tr_early_item(ib_) : ib_);
            float ra[32], rb[32]; tr_load(ra, da, lane); tr_load(rb, db, lane);
            tr_finish(ra, da, scr, lane);
            if (hasb) tr_finish(rb, db, scr, lane);
        }
        __builtin_amdgcn_s_waitcnt(0);
        float* tcos = WSP(float, WS_COS); float* tsin = WSP(float, WS_SIN);
        for (int idx = gtid; idx < 16384 * 32; idx += GT) { const int s = idx >> 5, j = idx & 31, jj = j & 15; const float pos = (float)(j < 16 ? (s >> 6) : (s & 63));
            const float inv = __builtin_amdgcn_exp2f(-(float)jj * (13.287712379549449f / 16.f)); const float th = pos * inv;
            const double turns = (double)th * 0.15915494309189535; const float fr = (float)(turns - __builtin_floor(turns));
            tcos[idx] = __builtin_amdgcn_cosf(fr); tsin[idx] = __builtin_amdgcn_sinf(fr); }
        float* HS = WSP(float, WS_XB + 1 * MiB); bf16_t* XN = WSP(bf16_t, WS_XN); const float* gains = ap->in[2];
        f32x4 g0v[4];
#pragma unroll
        for (int j = 0; j < 4; ++j) g0v[j] = ((const f32x4*)gains)[lane + 64 * j];
#pragma unroll 1
        for (int row = gw; row < NROWS; row += 2 * NGW) {
            f32x4 vv[2][4];
#pragma unroll
            for (int q = 0; q < 2; ++q) { const int rq = (row + q * NGW < NROWS) ? row + q * NGW : row;
                const float* src = rq < NREAL ? ap->in[0] + (size_t)rq * 1024 : ap->in[1] + (size_t)((rq - NREAL) & 15) * 1024;
#pragma unroll
                for (int j = 0; j < 4; ++j) vv[q][j] = ((const f32x4*)src)[lane + 64 * j]; }
#pragma unroll
            for (int q = 0; q < 2; ++q) { const int rr = row + q * NGW; if (rr >= NROWS) break;
                const float rstd = norm_row_store_g(vv[q], g0v, XN + (size_t)rr * 1024, lane); if (lane == 0) HS[rr] = __builtin_amdgcn_rcpf(rstd); }
        }
    }
#endif
    GSYNC();

#pragma unroll 1
    for (int layer = 0; layer < 4; ++layer) {
#pragma unroll 1
        for (int stage = 0; stage < 3; ++stage) {
            const int jl = layer >> 1;
#ifdef TESTSKIP
            if (stage == 1 && ((TESTSKIP >> (layer & 1)) & 1)) continue;
#endif
            int oAsel, oK; size_t oBoff; float coef; int gpost_i, gpre_i;
            if (stage != 1) {
                const int f = stage >> 1;
                {
                    KArgP ap = KARGS(); unsigned char* ws = ap->ws; IDS();
                    const bf16_t* Win = WSP(bf16_t, WS_W) + W_IN + (size_t)(layer * 2 + f) * 5632 * 1024; bf16_t* XN = WSP(bf16_t, WS_XN); bf16_t* ACT = WSP(bf16_t, WS_R1);
#if PHM & 2
                    { pg8::Gemm g{XN, Win, 1024, 1024, 1024, 0}; pg8::StaticOrder S; S.init(NREAL, 5632, G, bid); pg8::EpiSwiGLU E{ACT};
                      pg8::gemm_phase<pg8::EpiSwiGLU, pg8::StaticOrder, PG8_ALIGN, PG8_SP2>(ldsl, g, S, E); }
#endif
#if PHM & 4
                    { ThinP P{XN, 1024, Win, 1024, 1024, 176, ACT, nullptr, nullptr, nullptr, nullptr, nullptr}; thin_phase<TK_SWIGLU>(lds, P, tid, wave, lane, bid, G); }
#endif
                }
                GSYNC();
                oAsel = 0; oK = 2816; oBoff = W_OUT + (size_t)(layer * 2 + f) * 1024 * 2816; coef = 0.5f; gpost_i = layer * 6 + (f ? 5 : 1);
                gpre_i = f ? (layer < 3 ? layer * 6 + 6 : -1) : layer * 6 + 2;
            } else if ((layer & 1) == 0) {
                {
                    KArgP ap = KARGS(); unsigned char* ws = ap->ws; IDS();
                    const bf16_t* Wqkv = WSP(bf16_t, WS_W) + W_QKV + (size_t)jl * 1536 * 1024; const float* qg = ap->in[6] + jl * 64; const float* kg = ap->in[7] + jl * 64;
                    bf16_t* XN = WSP(bf16_t, WS_XN); bf16_t* QO = WSP(bf16_t, WS_R1); bf16_t* KB = WSP(bf16_t, WS_K); bf16_t* VB = WSP(bf16_t, WS_V);
#if PHM & 8
                    { pg8::Gemm g{XN, Wqkv, 1024, 1024, 1024, 0}; pg8::StaticOrder S; S.init(NREAL, 1536, G, bid); pg8::EpiQKV E{QO, KB, VB, qg, kg, WSP(float, WS_COS), WSP(float, WS_SIN), ATT_C2};
                      pg8::gemm_phase<pg8::EpiQKV, pg8::StaticOrder, PG8_ALIGN, PG8_SP2>(ldsl, g, S, E); }
#endif
#if PHM & 4
                    { ThinP P{XN, 1024, Wqkv, 1024, 1024, 24, QO, KB, VB, nullptr, qg, kg}; thin_phase<TK_QKV>(lds, P, tid, wave, lane, bid, G); }
#endif
                }
                GSYNC();
#if PHM & 16
                {
                    KArgP ap = KARGS(); unsigned char* ws = ap->ws; IDS();
                    bf16_t* QO = WSP(bf16_t, WS_R1); bf16_t* KB = WSP(bf16_t, WS_K); bf16_t* VB = WSP(bf16_t, WS_V);
                    float* PART_O = WSP(float, WS_AGG); float* PART_ML = WSP(float, WS_AGG + 2 * MiB);
                    for (int i = 0;; ++i) {
                        int bh, qb = 0, tb = 0, nt = 257, lm = 1; bool meta = false; float* po = nullptr; float* pml = nullptr;
                        if (G == 256) { if (i < 8) { bh = vcu >> 3; qb = (vcu & 7) + 8 * i; }
                                        else if (i == 8) { bh = vcu >> 3; meta = true; const int pc = vcu & 7; tb = 32 * pc; nt = 33; lm = (pc == 7) ? 1 : 2;
                                                           po = PART_O + (size_t)((bh * 8 + pc) * 16) * 64; pml = PART_ML + (size_t)((bh * 8 + pc) * 16) * 2; }
                                        else break; }
                        else { const int uid = i * G + bid; if (uid >= 2080) break; if (uid < 2048) { bh = uid >> 6; qb = uid & 63; } else { bh = uid - 2048; meta = true; } }
                        const int b = bh >> 4, h = bh & 15;
                        const long qrow0 = meta ? (long)(NREAL + b * 16) : (long)b * 16384 + (long)qb * 256;
                        attn_body::attn_unit<8>(b, h, qrow0, meta ? 16 : 256, tb, nt, lm, po, pml, (const attn_body::bf16*)QO, (const attn_body::bf16*)KB, (const attn_body::bf16*)VB, (attn_body::bf16*)QO, (char*)lds);
                        if (DEFER_CONV && layer == 0 && G == 256) {
                            const int d0 = ((i * 256 + bid) * 8 + wave) * 2;
                            if (d0 < N_DEFER) { bf16_t* Wb = WSP(bf16_t, WS_W); float* scr = (float*)(lds + wave * 16384);
                                const bool hasb = d0 + 1 < N_DEFER; const TrD da = tr_decode(ap, Wb, tr_defer_item(d0)), db = tr_decode(ap, Wb, tr_defer_item(hasb ? d0 + 1 : d0));
                                float ra[32], rb[32]; tr_load(ra, da, lane); tr_load(rb, db, lane);
                                tr_finish(ra, da, scr, lane);
                                if (hasb) tr_finish(rb, db, scr, lane); }
                            __syncthreads();
                        }
                    }
                }
#endif
                GSYNC();
                {
                    KArgP ap = KARGS(); unsigned char* ws = ap->ws; IDS();
                    if (G == 256) {
                        const float* PART_O = WSP(float, WS_AGG); const float* PART_ML = WSP(float, WS_AGG + 2 * MiB); bf16_t* QO = WSP(bf16_t, WS_R1);
                        for (int idx = gtid; idx < 32 * 16 * 64; idx += GT) { const int bh = idx >> 10, q = (idx >> 6) & 15, d = idx & 63;
                            float mp[8], M = -INFINITY;
#pragma unroll
                            for (int pc = 0; pc < 8; ++pc) { mp[pc] = PART_ML[(size_t)((bh * 8 + pc) * 16 + q) * 2]; M = fmaxf(M, mp[pc]); }
                            float num = 0.f, den = 0.f;
#pragma unroll
                            for (int pc = 0; pc < 8; ++pc) { const float w = __builtin_amdgcn_exp2f(mp[pc] - M); num += w * PART_O[(size_t)((bh * 8 + pc) * 16 + q) * 64 + d]; den += w * PART_ML[(size_t)((bh * 8 + pc) * 16 + q) * 2 + 1]; }
                            QO[(size_t)(NREAL + (bh >> 4) * 16 + q) * 1024 + (bh & 15) * 64 + d] = (bf16_t)f2bf(num / den); }
                    }
                }
                GSYNC();
                oAsel = 1; oK = 1024; oBoff = W_O + (size_t)jl * 1024 * 1024; coef = 1.f; gpost_i = layer * 6 + 3; gpre_i = layer * 6 + 4;
            } else {
                {
                    KArgP ap = KARGS(); unsigned char* ws = ap->ws; IDS();
                    const bf16_t* Wrin = WSP(bf16_t, WS_W) + W_RIN + (size_t)jl * 2048 * 1024; bf16_t* XN = WSP(bf16_t, WS_XN); bf16_t* GATE = WSP(bf16_t, WS_Y); bf16_t* XR = WSP(bf16_t, WS_R3);
#if PHM & 32
                    { pg8::Gemm g{XN, Wrin, 1024, 1024, 1024, 0}; pg8::StaticOrder S; S.init(NREAL, 2048, G, bid); pg8::EpiRecIn E{GATE, XR};
                      pg8::gemm_phase<pg8::EpiRecIn, pg8::StaticOrder, PG8_ALIGN, PG8_SP2>(ldsl, g, S, E); }
#endif
#if PHM & 4
                    { ThinP P{XN, 1024, Wrin, 1024, 1024, 64, GATE, XR, nullptr, nullptr, nullptr, nullptr}; thin_phase<TK_RECIN>(lds, P, tid, wave, lane, bid, G); }
#endif
                }
                GSYNC();
#if PHM & 64
                {
                    KArgP ap = KARGS(); unsigned char* ws = ap->ws; IDS();
                    const bf16_t* XR = WSP(bf16_t, WS_R3); bf16_t* XC = WSP(bf16_t, WS_HB);
                    const float* cw = ap->in[10] + (size_t)jl * 4 * 1024; const float* cbias = ap->in[11] + (size_t)jl * 1024;
                    const int ckc = (gtid & 127) * 8;
                    const f32x4 cb0 = *(const f32x4*)(cbias + ckc), cb1 = *(const f32x4*)(cbias + ckc + 4); f32x4 cw0[4], cw1[4];
#pragma unroll
                    for (int j = 0; j < 4; ++j) { cw0[j] = *(const f32x4*)(cw + j * 1024 + ckc); cw1[j] = *(const f32x4*)(cw + j * 1024 + ckc + 4); }
#pragma unroll 1
                    for (int it0 = gtid; it0 < NROWS * 128; it0 += 2 * GT) {
                        u32x4 xv[2][4]; float wm[2][4]; int Rq[2], ckq[2];
#pragma unroll
                        for (int q = 0; q < 2; ++q) { const int it = (it0 + q * GT < NROWS * 128) ? it0 + q * GT : it0; const int R = it >> 7, ck = (it & 127) * 8; int b, p;
                            if (R < NREAL) { b = R >> 14; p = 16 + (R & 16383); } else { b = (R - NREAL) >> 4; p = (R - NREAL) & 15; }
                            Rq[q] = R; ckq[q] = ck;
#pragma unroll
                            for (int j = 0; j < 4; ++j) { const int pp = p + j - 2; const bool ok = pp >= 0 && pp < 16400; const int sr = ok ? (pp < 16 ? NREAL + b * 16 + pp : b * 16384 + pp - 16) : R;
                                xv[q][j] = *(const u32x4*)(XR + (size_t)sr * 1024 + ck); wm[q][j] = ok ? 1.f : 0.f; } }
#pragma unroll
                        for (int q = 0; q < 2; ++q) { if (q == 1 && it0 + GT >= NROWS * 128) break; const int R = Rq[q], ck = ckq[q];
                            f32x4 a0 = cb0, a1 = cb1;
#pragma unroll
                            for (int j = 0; j < 4; ++j) { const u32x4 x = xv[q][j]; const f32x4 w0 = cw0[j] * wm[q][j], w1 = cw1[j] * wm[q][j];
                                a0[0] += __uint_as_float(x[0] << 16) * w0[0]; a0[1] += __uint_as_float(x[0] & 0xffff0000u) * w0[1]; a0[2] += __uint_as_float(x[1] << 16) * w0[2]; a0[3] += __uint_as_float(x[1] & 0xffff0000u) * w0[3];
                                a1[0] += __uint_as_float(x[2] << 16) * w1[0]; a1[1] += __uint_as_float(x[2] & 0xffff0000u) * w1[1]; a1[2] += __uint_as_float(x[3] << 16) * w1[2]; a1[3] += __uint_as_float(x[3] & 0xffff0000u) * w1[3]; }
                            u32x4 o; o.x = pk2(a0[0], a0[1]); o.y = pk2(a0[2], a0[3]); o.z = pk2(a1[0], a1[1]); o.w = pk2(a1[2], a1[3]);
                            *(u32x4*)(XC + ((size_t)(ck >> 8) * ROWS_ALLOC + R) * 256 + (ck & 255)) = o; }
                    }
                }
#endif
                GSYNC();
                {
                    KArgP ap = KARGS(); unsigned char* ws = ap->ws; IDS();
                    const bf16_t* Wrg = WSP(bf16_t, WS_W) + W_RG + (size_t)jl * 4096 * 256; bf16_t* XC = WSP(bf16_t, WS_HB); unsigned short* AB = WSP(unsigned short, WS_R1);
                    const float* gbias = ap->in[13] + (size_t)jl * 4 * 1024;
#if (PHM & 128) && (!defined(RECTEST) || RECTEST >= 2)
                    { pg8::Gemm g{XC, Wrg, 256, 256, 256, 1}; pg8::StaticOrder S; S.init(NREAL, 4096, G, bid); pg8::EpiGate E{AB, gbias};
                      pg8::gemm_phase<pg8::EpiGate, pg8::StaticOrder, PG8_ALIGN, PG8_SP2>(ldsl, g, S, E); }
#endif
#if (PHM & 4) && (!defined(RECTEST) || RECTEST >= 2)
                    { ThinP P{XC, 256, Wrg, 256, 256, 128, nullptr, nullptr, nullptr, AB, gbias, nullptr}; thin_phase<TK_GATE>(lds, P, tid, wave, lane, bid, G); }
#endif
                }
                GSYNC();
#if (PHM & 256) && (!defined(RECTEST) || RECTEST >= 2)
                {
                    KArgP ap = KARGS(); unsigned char* ws = ap->ws; IDS();
                    const unsigned short* AB = WSP(unsigned short, WS_R1); const bf16_t* XC = WSP(bf16_t, WS_HB); f32x2_tt* AGG = WSP(f32x2_tt, WS_AGG); const float* lam = ap->in[14] + (size_t)jl * 2 * 1024; const float* gbias = ap->in[13] + (size_t)jl * 4 * 1024;
                    for (int it = gw; it < 2 * 2 * NCHUNK * 4; it += NGW) {
                        const int cgp = it & 3, q = it >> 2; int j, db; if (it < 4096) { db = q >> 8; j = 1 + (q & 255); } else { db = q & 3; j = 0; }
                        const int d = db >> 1, b = db & 1, c = cgp * 256 + 4 * lane;
                        const u32x2_tt* ab = (const u32x2_tt*)(AB + ((size_t)d * NROWS + chunk_row0(b, j)) * 1024 + c); f32x4* op = (f32x4*)(AGG + ((size_t)db * NCHUNK + j) * 1024 + c);
                        const u32x2_tt* xp = (const u32x2_tt*)(XC + ((size_t)(c >> 8) * ROWS_ALLOC + chunk_row0(b, j)) * 256 + (c & 255));
                        const f32x4 l4 = *(const f32x4*)(lam + d * 1024 + c); const f32x4 sp4 = {sp_of(l4[0]), sp_of(l4[1]), sp_of(l4[2]), sp_of(l4[3])};
                        if (j == 0) scanA4_item<16>(ab, xp, d, sp4, op); else scanA4_item<64>(ab, xp, d, sp4, op);
                    }
                }
#endif
                GSYNC();
#if (PHM & 512) && (!defined(RECTEST) || RECTEST >= 2)
                {
                    KArgP ap = KARGS(); unsigned char* ws = ap->ws; IDS();
                    if (wave == 0 && bid < 64) {
                        const int idx = bid * 64 + lane, db = idx >> 10, d = db >> 1, c = idx & 1023;
                        const f32x2_tt* ag = WSP(f32x2_tt, WS_AGG) + (size_t)db * NCHUNK * 1024 + c; float* ci = WSP(float, WS_CIN) + (size_t)db * NCHUNK * 1024 + c; float carry = 0.f;
#pragma unroll 1
                        for (int j0 = 0; j0 < 256; j0 += 32) { f32x2_tt v[32];
#pragma unroll
                            for (int k = 0; k < 32; ++k) { const int js = j0 + k; const int jj = d ? NCHUNK - 1 - js : js; v[k] = ag[(size_t)jj * 1024]; }
#pragma unroll
                            for (int k = 0; k < 32; ++k) { const int js = j0 + k; const int jj = d ? NCHUNK - 1 - js : js; ci[(size_t)jj * 1024] = carry; carry = v[k].x * carry + v[k].y; }
                        }
                        ci[(size_t)(d ? 0 : NCHUNK - 1) * 1024] = carry;
                    }
                }
#endif
                GSYNC();
#if PHM & 1024
                {
                    KArgP ap = KARGS(); unsigned char* ws = ap->ws; IDS();
                    const unsigned short* AB = WSP(unsigned short, WS_R1); const bf16_t* XC = WSP(bf16_t, WS_HB); const float* CIN = WSP(float, WS_CIN); const float* lam = ap->in[14] + (size_t)jl * 2 * 1024; const float* gbias = ap->in[13] + (size_t)jl * 4 * 1024;
                    const bf16_t* GATE = WSP(bf16_t, WS_Y); bf16_t* YS = WSP(bf16_t, WS_R3);
                    for (int it = gw; it < 2 * NCHUNK * 8; it += NGW) {
                        const int ln = (int)__builtin_amdgcn_mbcnt_hi(~0u, __builtin_amdgcn_mbcnt_lo(~0u, 0u));
                        const int cgp = it & 7, q = it >> 3; int j, b; if (it < 4096) { b = q >> 8; j = 1 + (q & 255); } else { b = q & 1; j = 0; }
                        const int c = cgp * 128 + 2 * ln; const int r0 = chunk_row0(b, j);
                        const unsigned* abf = (const unsigned*)(AB + ((size_t)r0) * 1024 + c); const unsigned* abb = (const unsigned*)(AB + ((size_t)NROWS + r0) * 1024 + c);
                        const f32x2_tt cf = *(const f32x2_tt*)(CIN + ((size_t)(0 * 2 + b) * NCHUNK + j) * 1024 + c), cb2 = *(const f32x2_tt*)(CIN + ((size_t)(1 * 2 + b) * NCHUNK + j) * 1024 + c);
                        const f32x2_tt spf = {sp_of(lam[c]), sp_of(lam[c + 1])}, spb = {sp_of(lam[1024 + c]), sp_of(lam[1024 + c + 1])};
                        const unsigned* xp = (const unsigned*)(XC + ((size_t)(c >> 8) * ROWS_ALLOC + r0) * 256 + (c & 255));
                        if (j == 0) scanC2_item<16>(abf, abb, xp, (const unsigned*)(GATE + (size_t)r0 * 1024 + c), (unsigned*)(YS + (size_t)r0 * 1024 + c), cf, cb2, spf, spb);
                        else scanC2_item<64>(abf, abb, xp, (const unsigned*)(GATE + (size_t)r0 * 1024 + c), (unsigned*)(YS + (size_t)r0 * 1024 + c), cf, cb2, spf, spb);
                    }
                }
#endif
                GSYNC();
                oAsel = 2; oK = 1024; oBoff = W_RO + (size_t)jl * 1024 * 1024; coef = 1.f; gpost_i = layer * 6 + 3; gpre_i = layer * 6 + 4;
            }
            {
                KArgP ap = KARGS(); unsigned char* ws = ap->ws; IDS();
                const bf16_t* oA = oAsel == 2 ? WSP(bf16_t, WS_R3) : WSP(bf16_t, WS_R1); const bf16_t* oBt = WSP(bf16_t, WS_W) + oBoff; bf16_t* Yb = WSP(bf16_t, WS_Y);
#if PHM & 2048
#ifdef FUSE_NR
                {
                    const int nri = layer * 3 + stage;
                    pg8::PanelSS st1{WSP(float, WS_XB), (unsigned*)(ws + WS_CNT) + (size_t)(2 * nri) * 128 * 64}, st2{WSP(float, WS_XB + 512 * 1024), (unsigned*)(ws + WS_CNT) + (size_t)(2 * nri + 1) * 128 * 64};
                    pg8::EpiNR E{ap->out, WSP(bf16_t, WS_XN), WSP(float, WS_XB + 1 * MiB), ap->in[2] + (size_t)(layer * 6 + 2 * stage) * 1024, ap->in[2] + (size_t)gpost_i * 1024, gpre_i >= 0 ? ap->in[2] + (size_t)gpre_i * 1024 : nullptr, coef, st1, st2};
                    pg8::Gemm g{oA, oBt, oK, oK, oK, 0};
#pragma unroll 1
                    for (int round = 0; round < 2; ++round) { pg8::RoundOrder S; S.base.init(NREAL, 1024, G, bid); S.round = round;
                        pg8::gemm_phase<pg8::EpiNR, pg8::RoundOrder, false, PG8_SP2>(ldsl, g, S, E); }
                }
#else
                { pg8::Gemm g{oA, oBt, oK, oK, oK, 0}; pg8::StaticOrder S; S.init(NREAL, 1024, G, bid); pg8::EpiPlain E{Yb};
                  pg8::gemm_phase<pg8::EpiPlain, pg8::StaticOrder, PG8_ALIGN, PG8_SP2>(ldsl, g, S, E); }
#endif
#endif
#if PHM & 4
                { ThinP P{oA, oK, oBt, oK, oK, 32, Yb, nullptr, nullptr, nullptr, nullptr, nullptr}; thin_phase<TK_PLAIN>(lds, P, tid, wave, lane, bid, G); }
#endif
            }
            GSYNC();
#if PHM & 4096
            {
                KArgP ap = KARGS(); unsigned char* ws = ap->ws; IDS();
                float* out = ap->out; float* HS = WSP(float, WS_XB + 1 * MiB); const bf16_t* Yb = WSP(bf16_t, WS_Y); bf16_t* XN = WSP(bf16_t, WS_XN);
                const float* gpost = ap->in[2] + (size_t)gpost_i * 1024; const float* gpre = gpre_i >= 0 ? ap->in[2] + (size_t)gpre_i * 1024 : nullptr;
                const float* gprev = ap->in[2] + (size_t)(layer * 6 + 2 * stage) * 1024;
                f32x4 ig[4], gpo[4], gpr[4];
#pragma unroll
                for (int j = 0; j < 4; ++j) { const int gi = 2 * (lane + 64 * (j >> 1)) + (j & 1); const f32x4 gg = ((const f32x4*)gprev)[gi];
                    ig[j] = (f32x4){__builtin_amdgcn_rcpf(gg.x), __builtin_amdgcn_rcpf(gg.y), __builtin_amdgcn_rcpf(gg.z), __builtin_amdgcn_rcpf(gg.w)};
                    gpo[j] = ((const f32x4*)gpost)[gi]; gpr[j] = gpre ? ((const f32x4*)gpre)[gi] : (f32x4){0.f, 0.f, 0.f, 0.f}; }
                constexpr int NRR = 2;
#pragma unroll 1
#ifdef FUSE_NR
                for (int row = NREAL + gw; row < NROWS; row += NRR * NGW) {
#else
                for (int row = gw; row < NROWS; row += NRR * NGW) {
#endif
#define NRMAP(li) (li)
                    u32x4 yw[NRR][2], hw_[NRR][2]; float hsq[NRR];
#pragma unroll
                    for (int q = 0; q < NRR; ++q) { const int lq = (row + q * NGW < NROWS) ? row + q * NGW : row; const int rq = NRMAP(lq); hsq[q] = __hip_atomic_load(HS + rq, __ATOMIC_RELAXED, __HIP_MEMORY_SCOPE_AGENT);
#pragma unroll
                        for (int jp = 0; jp < 2; ++jp) { yw[q][jp] = ((const u32x4*)(Yb + (size_t)rq * 1024))[lane + 64 * jp]; hw_[q][jp] = ((const u32x4*)(XN + (size_t)rq * 1024))[lane + 64 * jp]; } }
#pragma unroll
                    for (int q = 0; q < NRR; ++q) {
                        const int lr = row + q * NGW; if (lr >= NROWS) break; const int rr = NRMAP(lr);
                        f32x4 y[4], v[4]; float s = 0.f; const float hs = hsq[q];
#pragma unroll
                        for (int j = 0; j < 4; ++j) { const unsigned lo = yw[q][j >> 1][2 * (j & 1)], hi = yw[q][j >> 1][2 * (j & 1) + 1], hlo = hw_[q][j >> 1][2 * (j & 1)], hhi = hw_[q][j >> 1][2 * (j & 1) + 1];
                            y[j] = (f32x4){__uint_as_float(lo << 16), __uint_as_float(lo & 0xffff0000u), __uint_as_float(hi << 16), __uint_as_float(hi & 0xffff0000u)};
                            v[j] = (f32x4){__uint_as_float(hlo << 16), __uint_as_float(hlo & 0xffff0000u), __uint_as_float(hhi << 16), __uint_as_float(hhi & 0xffff0000u)} * hs * ig[j];
                            s += (y[j].x * y[j].x + y[j].y * y[j].y) + (y[j].z * y[j].z + y[j].w * y[j].w); }
                        const float r = coef * __builtin_amdgcn_rsqf(wave_sum(s) * (1.f / 1024.f) + NORM_EPS);
                        float s2 = 0.f;
#pragma unroll
                        for (int j = 0; j < 4; ++j) { v[j] = v[j] + y[j] * r * gpo[j]; s2 += (v[j].x * v[j].x + v[j].y * v[j].y) + (v[j].z * v[j].z + v[j].w * v[j].w); }
                        if (gpre) {
                            const float rstd = __builtin_amdgcn_rsqf(wave_sum(s2) * (1.f / 1024.f) + NORM_EPS);
#pragma unroll
                            for (int jp = 0; jp < 2; ++jp) { const f32x4 a0 = v[2 * jp] * rstd * gpr[2 * jp], a1 = v[2 * jp + 1] * rstd * gpr[2 * jp + 1];
                                u32x4 o; o.x = pk2(a0.x, a0.y); o.y = pk2(a0.z, a0.w); o.z = pk2(a1.x, a1.y); o.w = pk2(a1.z, a1.w);
                                ((u32x4*)(XN + (size_t)rr * 1024))[lane + 64 * jp] = o; }
                            if (lane == 0) HS[rr] = __builtin_amdgcn_rcpf(rstd);
                        } else if (rr < NREAL) {
#pragma unroll
                            for (int j = 0; j < 4; ++j) ((f32x4*)(out + (size_t)rr * 1024))[2 * (lane + 64 * (j >> 1)) + (j & 1)] = v[j];
                        }
                    }
                }
            }
#endif
            GSYNC();
        }
    }
}

extern "C" void kernel_launch(void* const* d_in, const int* in_sizes, int n_in, void* d_out, int out_size, void* d_ws, size_t ws_size, hipStream_t stream) {
    static int grid_blocks = 0;
    if (grid_blocks == 0) {
        if (n_in != 16 || ws_size < WS_END) { fprintf(stderr, "kernel_launch: unexpected n_in %d / ws_size %zu\n", n_in, ws_size); grid_blocks = -1; return; }
        int dev = 0, cus = 0, per_cu = 0;
        (void)hipGetDevice(&dev); (void)hipDeviceGetAttribute(&cus, hipDeviceAttributeMultiprocessorCount, dev);
        if (hipFuncSetAttribute((const void*)fwd_megakernel, hipFuncAttributeMaxDynamicSharedMemorySize, LDS_BYTES) != hipSuccess) { fprintf(stderr, "kernel_launch: hipFuncSetAttribute failed\n"); grid_blocks = -1; return; }
        if (hipOccupancyMaxActiveBlocksPerMultiprocessor(&per_cu, (const void*)fwd_megakernel, 512, LDS_BYTES) != hipSuccess || per_cu < 1) { fprintf(stderr, "kernel_launch: occupancy query says %d\n", per_cu); per_cu = 1; }
        (void)hipGetLastError();
        grid_blocks = cus > 0 ? cus : 256;
    }
    if (grid_blocks < 0) return;
    if (hipMemsetAsync(d_ws, 0, 1048576, stream) != hipSuccess) { fprintf(stderr, "kernel_launch: hipMemsetAsync failed\n"); return; }
    Args a{};
    for (int i = 0; i < 16; ++i) a.in[i] = (const float*)d_in[i];
    a.out = (float*)d_out; a.ws = (unsigned char*)d_ws;
    void* kargs[] = {&a};
    hipError_t e = hipLaunchCooperativeKernel((const void*)fwd_megakernel, dim3(grid_blocks), dim3(512), kargs, LDS_BYTES, stream);
    if (e != hipSuccess) fprintf(stderr, "cooperative launch failed: %s (grid %d)\n", hipGetErrorString(e), grid_blocks);
}
```
